# Optimizing an MI355X kernel written in HIP

```python
import math, functools
import jax, jax.numpy as jnp
from jax import lax
import numpy as np

D_MODEL = 1024
BATCH = 8
SEQ = 2048
DEPTH = 1
DEC_BATCH = 32
DEC_SEQ = 8
PAST_LEN = 16384
PAGE_SIZE = 128

N_META = 16
D_RNN = D_MODEL
RG_BLOCKS = 8
RG_BLOCK = D_RNN // RG_BLOCKS
CONV_W = 4
RG_C = 8.0
N_HEADS = 8
QK_NOPE = 128
QK_ROPE = 64
V_HEAD = 128
KV_LORA = 512
Q_LORA = 768
ROPE_THETA = 10000.0
Q_BLOCK = 128
D_FF = 4 * D_MODEL
DN_ALPHA = (2.0 * DEPTH) ** 0.25
DN_BETA = (8.0 * DEPTH) ** -0.25
EPS = 1e-5
SPLITS = [D_RNN, 2 * D_RNN, 2 * D_RNN + Q_LORA, 2 * D_RNN + Q_LORA + KV_LORA,
          2 * D_RNN + Q_LORA + KV_LORA + QK_ROPE]
N_IN = 2 * D_RNN + Q_LORA + KV_LORA + QK_ROPE + 2 * D_MODEL

kernel_name = "hawk_mla_gated_hybrid_step"


def layer_norm(x, g, b):
    xf = x.astype(jnp.float32)
    mu = jnp.mean(xf, -1, keepdims=True)
    var = jnp.mean(jnp.square(xf - mu), -1, keepdims=True)
    return ((xf - mu) * lax.rsqrt(var + EPS) * g.astype(jnp.float32) + b.astype(jnp.float32)).astype(x.dtype)


def rms_norm(x, g):
    xf = x.astype(jnp.float32)
    return (xf * lax.rsqrt(jnp.mean(jnp.square(xf), -1, keepdims=True) + EPS) * g.astype(jnp.float32)).astype(x.dtype)


def rope(x, pos):
    half = QK_ROPE // 2
    inv = 1.0 / (ROPE_THETA ** (jnp.arange(half, dtype=jnp.float32) / half))
    ang = pos.astype(jnp.float32)[:, None] * inv[None, :]
    shape = (1, pos.shape[0]) + (1,) * (x.ndim - 3) + (half,)
    cos = jnp.cos(ang).reshape(shape)
    sin = jnp.sin(ang).reshape(shape)
    xf = x.astype(jnp.float32)
    x1, x2 = xf[..., :half], xf[..., half:]
    return jnp.concatenate([x1 * cos - x2 * sin, x1 * sin + x2 * cos], -1).astype(x.dtype)


def causal_conv(x_ext, w, b):
    t = x_ext.shape[1] - (CONV_W - 1)
    y = b
    for k in range(CONV_W):
        y = y + x_ext[:, k:k + t] * w[k]
    return y


def rg_lru(x, h0, wa, ba, wx, bx, lam):
    bn, t, c = x.shape
    xf = x.astype(jnp.float32)
    xb = xf.reshape(bn, t, RG_BLOCKS, RG_BLOCK)
    r = jax.nn.sigmoid(jnp.einsum('btnc,ncd->btnd', xb, wa.astype(jnp.float32)).reshape(bn, t, c) + ba.astype(jnp.float32))
    i = jax.nn.sigmoid(jnp.einsum('btnc,ncd->btnd', xb, wx.astype(jnp.float32)).reshape(bn, t, c) + bx.astype(jnp.float32))
    log_a = -RG_C * r * jax.nn.softplus(-lam.astype(jnp.float32))
    a = jnp.exp(log_a)
    u = jnp.sqrt(-jnp.expm1(2.0 * log_a)) * (i * xf)

    def combine(lhs, rhs):
        a1, b1 = lhs
        a2, b2 = rhs
        return a1 * a2, a2 * b1 + b2

    a_cum, h_zero = lax.associative_scan(combine, (a, u), axis=1)
    h = a_cum * h0.astype(jnp.float32)[:, None, :] + h_zero
    return h.astype(x.dtype), h[:, -1].astype(x.dtype)


def mla_prompt(q_nope, q_pe, ckv, kpe, w_uk, w_uv):
    bn, t = ckv.shape[:2]
    k_nope = jnp.einsum('btr,rhd->bthd', ckv, w_uk)
    v = jnp.einsum('btr,rhd->bthd', ckv, w_uv)
    nb = -(-t // Q_BLOCK)
    tp = nb * Q_BLOCK
    pad = ((0, 0), (0, tp - t), (0, 0), (0, 0))
    qn = jnp.pad(q_nope, pad).reshape(bn, nb, Q_BLOCK, N_HEADS, QK_NOPE).swapaxes(0, 1)
    qp = jnp.pad(q_pe, pad).reshape(bn, nb, Q_BLOCK, N_HEADS, QK_ROPE).swapaxes(0, 1)
    qpos = jnp.arange(tp).reshape(nb, Q_BLOCK)
    kpos = jnp.arange(t)
    scale = (QK_NOPE + QK_ROPE) ** -0.5
    neg = jnp.finfo(jnp.float32).min

    def block(args):
        qn_b, qp_b, qpos_b = args
        s = jnp.einsum('bqhd,bkhd->bhqk', qn_b, k_nope) + jnp.einsum('bqhp,bkp->bhqk', qp_b, kpe)
        s = jnp.where(kpos[None, :] <= qpos_b[:, None], s.astype(jnp.float32) * scale, neg)
        p = jax.nn.softmax(s, axis=-1).astype(v.dtype)
        return jnp.einsum('bhqk,bkhd->bqhd', p, v)

    o = lax.map(block, (qn, qp, qpos))
    return o.swapaxes(0, 1).reshape(bn, tp, N_HEADS, V_HEAD)[:, :t]


def mla_sample(q_nope, q_pe, ckv_new, kpe_new, w_uk, w_uv, ckv_pool, kpe_pool, page_table):
    bd, tq = q_nope.shape[:2]
    ckv_past = ckv_pool[page_table].reshape(bd, -1, KV_LORA)
    kpe_past = kpe_pool[page_table].reshape(bd, -1, QK_ROPE)
    n_past = ckv_past.shape[1]
    q_lat = jnp.einsum('bqhd,rhd->bqhr', q_nope, w_uk)
    scale = (QK_NOPE + QK_ROPE) ** -0.5
    s_past = jnp.einsum('bqhr,bkr->bhqk', q_lat, ckv_past) + jnp.einsum('bqhp,bkp->bhqk', q_pe, kpe_past)
    s_new = jnp.einsum('bqhr,bkr->bhqk', q_lat, ckv_new) + jnp.einsum('bqhp,bkp->bhqk', q_pe, kpe_new)
    causal = jnp.tril(jnp.ones((tq, tq), dtype=bool))
    s_new = jnp.where(causal, s_new.astype(jnp.float32) * scale, jnp.finfo(jnp.float32).min)
    s = jnp.concatenate([s_past.astype(jnp.float32) * scale, s_new], axis=-1)
    p = jax.nn.softmax(s, axis=-1).astype(ckv_past.dtype)
    o_lat = (jnp.einsum('bhqk,bkr->bqhr', p[..., :n_past], ckv_past)
             + jnp.einsum('bhqk,bkr->bqhr', p[..., n_past:], ckv_new))
    return jnp.einsum('bqhr,rhd->bqhd', o_lat, w_uv)


def trunk_layer(h, pos, conv_prev, h_prev, attend, lw):
    (w_in, b_gate, conv_w, conv_b, rg_wa, rg_ba, rg_wx, rg_bx, rg_lambda, w_br_r,
     q_norm_g, w_uq, kv_norm_g, w_uk, w_uv, w_br_m, w_o, ln1_g, ln1_b,
     w_up, b_up, w_down, b_down, ln2_g, ln2_b) = lw
    bn, t, _ = h.shape
    u = h @ w_in
    rx, rg, cq, ckv_raw, kpe_raw, gates = jnp.split(u, SPLITS + [N_IN - 2 * D_MODEL], axis=-1)[:6] if False else jnp.split(u, SPLITS + [SPLITS[-1] + QK_ROPE * 0 + 0], axis=-1)[:0] or jnp.split(u, SPLITS, axis=-1)[:5] + [u[..., SPLITS[-1] + QK_ROPE:]] if False else _split_cols(u)
    g_r, g_m = jnp.split(jax.nn.sigmoid(gates + b_gate), 2, axis=-1)
    x_ext = jnp.concatenate([conv_prev.astype(rx.dtype), rx], axis=1)
    xc = causal_conv(x_ext, conv_w, conv_b)
    hr, h_last = rg_lru(xc, h_prev, rg_wa, rg_ba, rg_wx, rg_bx, rg_lambda)
    z_r = (hr * jax.nn.gelu(rg)) @ w_br_r
    q = jnp.einsum('btc,chd->bthd', rms_norm(cq, q_norm_g), w_uq)
    q_nope = q[..., :QK_NOPE]
    q_pe = rope(q[..., QK_NOPE:], pos)
    ckv = rms_norm(ckv_raw, kv_norm_g)
    kpe = rope(kpe_raw, pos)
    o = attend(q_nope, q_pe, ckv, kpe, w_uk, w_uv)
    z_m = o.reshape(bn, t, N_HEADS * V_HEAD) @ w_br_m
    mix = (g_r * z_r + g_m * z_m) @ w_o
    x1 = layer_norm(DN_ALPHA * h + mix, ln1_g, ln1_b)
    f = jnp.square(jax.nn.relu(x1 @ w_up + b_up)) @ w_down + b_down
    x2 = layer_norm(DN_ALPHA * x1 + f, ln2_g, ln2_b)
    new_conv = x_ext[:, -(CONV_W - 1):]
    return x2, ckv, kpe, new_conv, h_last


def _split_cols(u):
    rx = u[..., :SPLITS[0]]
    rg = u[..., SPLITS[0]:SPLITS[1]]
    cq = u[..., SPLITS[1]:SPLITS[2]]
    ckv_raw = u[..., SPLITS[2]:SPLITS[3]]
    kpe_raw = u[..., SPLITS[3]:SPLITS[4]]
    gates = u[..., SPLITS[4]:]
    return rx, rg, cq, ckv_raw, kpe_raw, gates


def setup_inputs(seed: int = 0) -> dict:
    key = jax.random.key(seed)
    ks = jax.random.split(key, 40)
    n_pages = PAST_LEN // PAGE_SIZE
    n_used = DEC_BATCH * n_pages
    n_phys = n_used + max(1, n_used // 4)
    f32 = jnp.float32

    def nrm(k, shape, scale):
        return jax.random.normal(k, shape, f32) * scale

    def gain(k, n):
        return 1.0 + 0.02 * jax.random.normal(k, (DEPTH, n), f32)

    a0 = jax.random.uniform(ks[12], (DEPTH, D_RNN), f32, minval=0.9, maxval=0.999)
    return {
        "x_prompt": nrm(ks[0], (BATCH, SEQ, D_MODEL), 1.0),
        "x_sample": nrm(ks[1], (DEC_BATCH, DEC_SEQ, D_MODEL), 1.0),
        "cache_ckv": nrm(ks[2], (DEPTH, n_phys, PAGE_SIZE, KV_LORA), 1.0),
        "cache_kpe": nrm(ks[3], (DEPTH, n_phys, PAGE_SIZE, QK_ROPE), 1.0),
        "page_table": jax.random.permutation(ks[4], n_phys)[:n_used].reshape(DEC_BATCH, n_pages).astype(jnp.int32),
        "state_conv": nrm(ks[5], (DEPTH, DEC_BATCH, CONV_W - 1, D_RNN), 1.0),
        "state_rglru": nrm(ks[6], (DEPTH, DEC_BATCH, D_RNN), 0.5),
        "meta_tokens": nrm(ks[7], (N_META, D_MODEL), 1.0),
        "ln_in_g": 1.0 + 0.02 * jax.random.normal(ks[8], (D_MODEL,), f32),
        "ln_in_b": nrm(ks[9], (D_MODEL,), 0.02),
        "w_in": nrm(ks[10], (DEPTH, D_MODEL, N_IN), D_MODEL ** -0.5),
        "b_gate": nrm(ks[11], (DEPTH, 2 * D_MODEL), 0.02),
        "conv_w": nrm(ks[13], (DEPTH, CONV_W, D_RNN), CONV_W ** -0.5),
        "conv_b": nrm(ks[14], (DEPTH, D_RNN), 0.02),
        "rg_wa": nrm(ks[15], (DEPTH, RG_BLOCKS, RG_BLOCK, RG_BLOCK), RG_BLOCK ** -0.5),
        "rg_ba": nrm(ks[16], (DEPTH, D_RNN), 0.02),
        "rg_wx": nrm(ks[17], (DEPTH, RG_BLOCKS, RG_BLOCK, RG_BLOCK), RG_BLOCK ** -0.5),
        "rg_bx": nrm(ks[18], (DEPTH, D_RNN), 0.02),
        "rg_lambda": jnp.log(a0) - jnp.log1p(-a0),
        "w_br_r": nrm(ks[19], (DEPTH, D_RNN, D_MODEL), D_RNN ** -0.5),
        "q_norm_g": gain(ks[20], Q_LORA),
        "w_uq": nrm(ks[21], (DEPTH, Q_LORA, N_HEADS, QK_NOPE + QK_ROPE), Q_LORA ** -0.5),
        "kv_norm_g": gain(ks[22], KV_LORA),
        "w_uk": nrm(ks[23], (DEPTH, KV_LORA, N_HEADS, QK_NOPE), KV_LORA ** -0.5),
        "w_uv": nrm(ks[24], (DEPTH, KV_LORA, N_HEADS, V_HEAD), KV_LORA ** -0.5),
        "w_br_m": nrm(ks[25], (DEPTH, N_HEADS * V_HEAD, D_MODEL), (N_HEADS * V_HEAD) ** -0.5),
        "w_o": nrm(ks[26], (DEPTH, D_MODEL, D_MODEL), DN_BETA * D_MODEL ** -0.5),
        "ln1_g": gain(ks[27], D_MODEL),
        "ln1_b": nrm(ks[28], (DEPTH, D_MODEL), 0.02),
        "w_up": nrm(ks[29], (DEPTH, D_MODEL, D_FF), D_MODEL ** -0.5),
        "b_up": nrm(ks[30], (DEPTH, D_FF), 0.02),
        "w_down": nrm(ks[31], (DEPTH, D_FF, D_MODEL), DN_BETA * D_FF ** -0.5),
        "b_down": nrm(ks[32], (DEPTH, D_MODEL), 0.02),
        "ln2_g": gain(ks[33], D_MODEL),
        "ln2_b": nrm(ks[34], (DEPTH, D_MODEL), 0.02),
    }


def reference(x_prompt, x_sample, cache_ckv, cache_kpe, page_table, state_conv, state_rglru,
              meta_tokens, ln_in_g, ln_in_b, w_in, b_gate, conv_w, conv_b, rg_wa, rg_ba, rg_wx, rg_bx,
              rg_lambda, w_br_r, q_norm_g, w_uq, kv_norm_g, w_uk, w_uv, w_br_m, w_o, ln1_g, ln1_b,
              w_up, b_up, w_down, b_down, ln2_g, ln2_b):
    bn = x_prompt.shape[0]
    bd, ts = x_sample.shape[:2]
    meta = jnp.broadcast_to(meta_tokens.astype(x_prompt.dtype)[None], (bn, N_META, D_MODEL))
    hp = layer_norm(jnp.concatenate([meta, x_prompt], axis=1), ln_in_g, ln_in_b)
    hs = layer_norm(x_sample, ln_in_g, ln_in_b)
    pos_p = jnp.arange(hp.shape[1])
    pos_s = PAST_LEN + jnp.arange(ts)
    p_ckv, p_kpe, p_conv, p_h, s_ckv, s_kpe, s_conv, s_h = [], [], [], [], [], [], [], []
    for l in range(DEPTH):
        lw = (w_in[l], b_gate[l], conv_w[l], conv_b[l], rg_wa[l], rg_ba[l], rg_wx[l], rg_bx[l],
              rg_lambda[l], w_br_r[l], q_norm_g[l], w_uq[l], kv_norm_g[l], w_uk[l], w_uv[l],
              w_br_m[l], w_o[l], ln1_g[l], ln1_b[l], w_up[l], b_up[l], w_down[l], b_down[l],
              ln2_g[l], ln2_b[l])
        conv0 = jnp.zeros((bn, CONV_W - 1, D_RNN), hp.dtype)
        h0 = jnp.zeros((bn, D_RNN), hp.dtype)
        hp, ck, kp, cv, hl = trunk_layer(hp, pos_p, conv0, h0, mla_prompt, lw)
        p_ckv.append(ck); p_kpe.append(kp); p_conv.append(cv); p_h.append(hl)
        attend_s = functools.partial(mla_sample, ckv_pool=cache_ckv[l], kpe_pool=cache_kpe[l],
                                     page_table=page_table)
        hs, ck, kp, cv, hl = trunk_layer(hs, pos_s, state_conv[l], state_rglru[l], attend_s, lw)
        s_ckv.append(ck); s_kpe.append(kp); s_conv.append(cv); s_h.append(hl)
    y_prompt = hp[:, N_META:]
    y_sample = hs
    prompt_ckv = jnp.stack(p_ckv)
    prompt_kpe = jnp.stack(p_kpe)
    prompt_conv = jnp.stack(p_conv)
    prompt_rglru = jnp.stack(p_h)
    sample_ckv = jnp.stack(s_ckv)
    sample_kpe = jnp.stack(s_kpe)
    sample_conv = jnp.stack(s_conv)
    sample_rglru = jnp.stack(s_h)
    return (y_prompt, y_sample, prompt_ckv, prompt_kpe, prompt_conv, prompt_rglru,
            sample_ckv, sample_kpe, sample_conv, sample_rglru)
```

```cpp
#include <hip/hip_runtime.h>
#include <cstdio>
#include <cstdint>

#ifndef MK_PER_PHASE
#define MK_PER_PHASE 0
#endif

#define GAS __attribute__((address_space(1)))
#define LAS __attribute__((address_space(3)))
typedef unsigned short bf16;
typedef short bf16x8 __attribute__((ext_vector_type(8)));
typedef short s16x4 __attribute__((ext_vector_type(4)));
typedef float f32x2 __attribute__((ext_vector_type(2)));
typedef float f32x4 __attribute__((ext_vector_type(4)));
typedef float f32x16 __attribute__((ext_vector_type(16)));
typedef unsigned u32x2 __attribute__((ext_vector_type(2)));
typedef unsigned u32x4 __attribute__((ext_vector_type(4)));

constexpr int D = 1024, NB = 8, SEQ = 2048, NMETA = 16, TP = SEQ + NMETA;
constexpr int DB = 32, DS = 8, PAST = 16384, PAGE = 128, NPAGES = PAST / PAGE;
constexpr int NH = 8, QKN = 128, QKR = 64, VH = 128, KVL = 512, QL = 768, DFF = 4096;
constexpr int NIN = 5440, NINP = 5632;
constexpr int ROW_S = NB * SEQ;
constexpr int ROW_M = ROW_S + DB * DS;
constexpr int R = 16896;
constexpr float EPS = 1e-5f;
constexpr float DN_ALPHA = 1.189207115002721f;
constexpr float SM_SCALE = 0.07216878364870322f;
constexpr float LOG2E = 1.4426950408889634f;
constexpr int NROPE = TP + DS;
constexpr int NSPLIT = 8;

constexpr size_t O_YP = 0, O_YS = O_YP + (size_t)NB * SEQ * D, O_PCKV = O_YS + (size_t)DB * DS * D, O_PKPE = O_PCKV + (size_t)NB * TP * KVL,
    O_PCONV = O_PKPE + (size_t)NB * TP * QKR, O_PH = O_PCONV + (size_t)NB * 3 * D, O_SCKV = O_PH + (size_t)NB * D, O_SKPE = O_SCKV + (size_t)DB * DS * KVL,
    O_SCONV = O_SKPE + (size_t)DB * DS * QKR, O_SH = O_SCONV + (size_t)DB * 3 * D, O_END = O_SH + (size_t)DB * D;
static_assert(O_END == 26861568, "output size");

constexpr size_t al256(size_t x) { return (x + 255) & ~(size_t)255; }
constexpr size_t WS_CTL = 0, CTL_BYTES = 1u << 20;
constexpr size_t WS_WIN = CTL_BYTES;
constexpr size_t WS_WQ = WS_WIN + al256((size_t)NINP * D * 2);
constexpr size_t WS_WKV = WS_WQ + al256((size_t)1536 * QL * 2);
constexpr size_t WS_WBRR = WS_WKV + al256((size_t)2048 * KVL * 2);
constexpr size_t WS_WBRM = WS_WBRR + al256((size_t)D * D * 2);
constexpr size_t WS_WO = WS_WBRM + al256((size_t)D * D * 2);
constexpr size_t WS_WUP = WS_WO + al256((size_t)D * D * 2);
constexpr size_t WS_WDN = WS_WUP + al256((size_t)DFF * D * 2);
constexpr size_t WS_WAX = WS_WDN + al256((size_t)DFF * D * 2);
constexpr size_t WS_WUKS = WS_WAX + al256((size_t)8 * 256 * 128 * 2);
constexpr size_t WS_ROPEC = WS_WUKS + al256((size_t)8 * 512 * 128 * 2);
constexpr size_t WS_ROPES = WS_ROPEC + al256((size_t)NROPE * 32 * 4);
constexpr size_t WS_SPL = WS_ROPES + al256((size_t)NROPE * 32 * 4);
constexpr size_t WS_H = WS_SPL + al256(4096);
constexpr size_t WS_RX = WS_H + al256((size_t)R * D * 2);
constexpr size_t WS_GRG = WS_RX + al256((size_t)R * D * 2);
constexpr size_t WS_CQ = WS_GRG + al256((size_t)R * D * 2);
constexpr size_t WS_CKVR = WS_CQ + al256((size_t)R * QL * 2);
constexpr size_t WS_G = WS_CKVR + al256((size_t)R * KVL * 2);
constexpr size_t WS_KPE = WS_G + al256((size_t)R * 2048 * 2);
constexpr size_t WS_SSQQ = WS_KPE + al256((size_t)R * 64 * 2);
constexpr size_t WS_SSQKV = WS_SSQQ + al256((size_t)R * 12 * 4);
constexpr size_t WS_QA = WS_SSQKV + al256((size_t)R * 8 * 4);
constexpr size_t WS_KN = WS_QA + al256((size_t)R * 1536 * 2);
constexpr size_t WS_V = WS_KN + al256((size_t)R * D * 2);
constexpr size_t WS_CKVNS = WS_V + al256((size_t)R * D * 2);
constexpr size_t WS_SEG = WS_CKVNS + al256((size_t)256 * KVL * 2);
constexpr size_t WS_HRG = WS_SEG + al256((size_t)8 * 3 * 1024 * 2 * 4);
constexpr size_t WS_O = WS_HRG + al256((size_t)R * D * 2);
constexpr size_t WS_OPART = WS_O + al256((size_t)R * D * 2);
constexpr size_t WS_ML = WS_OPART + al256((size_t)DB * NSPLIT * 64 * 512 * 4);
constexpr size_t WS_MIX = WS_ML + al256((size_t)DB * NSPLIT * 64 * 2 * 4);
constexpr size_t WS_PRE = WS_MIX + al256((size_t)R * D * 2);
constexpr size_t WS_X1 = WS_PRE + al256((size_t)R * D * 4);
constexpr size_t WS_U = WS_X1 + al256((size_t)R * D * 2);
constexpr size_t WS_END = WS_U + al256((size_t)R * DFF * 2);
static_assert(WS_END < (1ull << 32), "32-bit workspace offsets");

constexpr int CW_BAR = 4096;

constexpr int LDS_BYTES = 147456;
constexpr int MISC_OFF = 135168;
constexpr int NWAVES = 8, NTHR = 512;

__device__ __forceinline__ float bf2f(unsigned short b) { return __uint_as_float(((unsigned)b) << 16); }
__device__ __forceinline__ float bflo(unsigned w) { return __uint_as_float(w << 16); }
__device__ __forceinline__ float bfhi(unsigned w) { return __uint_as_float(w & 0xffff0000u); }
typedef __bf16 bf16x2_t __attribute__((ext_vector_type(2)));
__device__ __forceinline__ unsigned cvt_pk_bf16(float lo, float hi) { const f32x2 v = {lo, hi}; return __builtin_bit_cast(unsigned, __builtin_convertvector(v, bf16x2_t)); }
__device__ __forceinline__ float fast_exp2(float x) { return __builtin_amdgcn_exp2f(x); }
__device__ __forceinline__ float fast_rcp(float x) { return __builtin_amdgcn_rcpf(x); }
__device__ __forceinline__ float sigmoidf_(float x) { return fast_rcp(1.0f + fast_exp2(-x * LOG2E)); }
__device__ __forceinline__ float gelu_tanh(float x) { const float y = 0.7978845608028654f * (x + 0.044715f * x * x * x); return x * fast_rcp(1.0f + fast_exp2(-2.0f * LOG2E * y)); }
__device__ __forceinline__ float wave_sum(float v) {
#pragma unroll
    for (int o = 1; o < 64; o <<= 1) v += __shfl_xor(v, o);
    return v;
}
#define LDS_WAIT() asm volatile("s_waitcnt lgkmcnt(0)" ::: "memory")
#define VM_WAIT() asm volatile("s_waitcnt vmcnt(0)" ::: "memory")
namespace pg8 {
#define PG8_LAS __attribute__((address_space(3)))
constexpr int BM = 256, BK = 64, HALF = 128, HTB = HALF * BK * 2  , STAGE_BYTES = 8 * HTB, NXCD = 8, WGM = 8;
__host__ __device__ __forceinline__ int lds_byte(int r, int c) { const int st = (r >> 4) * 2 + (c >> 5), rr = r & 15, cc = c & 31, ob = rr * 64 + cc * 2; return st * 1024 + (ob ^ (((ob >> 9) & 1) << 5)); }
__host__ __device__ __forceinline__ void stage_rc(int b, int& R, int& C) { const int st = b / 1024, sb = b % 1024, swz = sb ^ (((sb >> 9) & 1) << 5); R = (st >> 1) * 16 + swz / 64; C = (st & 1) * 32 + (swz % 64) / 2; }
__host__ __device__ __forceinline__ int perm32(int rho) { const int n = rho >> 4, i = rho & 15; return 8 * (i >> 2) + 4 * n + (i & 3); }

struct Unit { const char* A; const char* B; int pm, pn; };

struct TileSched {
    const char* A; const char* B; size_t aT, bT; int nM, nN, nwg, G, c, rm_from, rm_add;
    __device__ __forceinline__ void init(const void* A_, const void* B_, int K, int nM_, int nN_, int G_, int c_, int rm_from_ = 1 << 30, int rm_add_ = 0) {
        A = (const char*)A_; B = (const char*)B_; aT = (size_t)BM * K * 2; bT = aT; nM = nM_; nN = nN_; nwg = nM * nN; G = G_; c = c_; rm_from = rm_from_; rm_add = rm_add_; }
    __device__ __forceinline__ bool next(int i, Unit& u) const {
        const long L = (long)i * G + c; if (L >= nwg) return false;
        int wgid = (int)L; { const int q = nwg / NXCD, r = nwg % NXCD, xcd = wgid % NXCD, off = wgid / NXCD; wgid = (xcd < r ? xcd * (q + 1) : r * (q + 1) + (xcd - r) * q) + off; }
        const int nig = WGM * nN, gid = wgid / nig, fm = gid * WGM, gsz = (nM - fm) < WGM ? (nM - fm) : WGM;
        int pm = fm + ((wgid % nig) % gsz); const int pn = (wgid % nig) / gsz; if (pm >= rm_from) pm += rm_add;
        u.pm = pm; u.pn = pn; u.A = A + (size_t)pm * aT; u.B = B + (size_t)pn * bT; return true;
    }
    __device__ __forceinline__ void a_ready(const Unit&) const {}
    __device__ __forceinline__ void done(const Unit&) const {}
};
template <class Epi, class Sched, bool ALIGN_EPI = false, bool SP2 = false>
__device__ __forceinline__ void gemm_phase(PG8_LAS unsigned char* lds, const int K, const Sched& S, const Epi& E) {
    const int tid = threadIdx.x, wid = __builtin_amdgcn_readfirstlane(tid >> 6), lane = tid & 63, wr = wid >> 2, wc = wid & 3, fr = lane & 15, fq = lane >> 4;
    const int nt = K / BK;
    unsigned voffA[2], voffB[2];
#pragma unroll
    for (int i = 0; i < 2; ++i) { int R, C; stage_rc(tid * 16 + i * 8192, R, C); const int Rb = Epi::PERM ? ((R & ~31) + perm32(R & 31)) : R;
        voffA[i] = (unsigned)(R * K + C) * 2u; voffB[i] = (unsigned)(Rb * K + C) * 2u; }
    const size_t kstep = (size_t)(BK * 2);
    const size_t hstep = (size_t)HALF * K * 2;
    const unsigned ldsw = (unsigned)wid * 1024u;
    const int aoff = lds_byte(wr * 64 + fr, fq * 8), boff = lds_byte(wc * 32 + fr, fq * 8);
#define PG8_SA(b, h) (((b) * 2 + (h)) * HTB)
#define PG8_SB(b, h) ((4 + (b) * 2 + (h)) * HTB)
#define PG8_STAGE(bufoff, gbase, voff) do { _Pragma("unroll") for (int _i = 0; _i < 2; ++_i) \
        __builtin_amdgcn_global_load_lds((const unsigned*)((const char*)(gbase) + (voff)[_i]), (PG8_LAS unsigned*)(lds + (bufoff) + ldsw + _i * 8192), 16, 0, 0); } while (0)
#define PG8_LDA(dst, b, h) do { _Pragma("unroll") for (int m = 0; m < 4; ++m) _Pragma("unroll") for (int k = 0; k < 2; ++k) dst[m][k] = *(const PG8_LAS bf16x8*)(lds + PG8_SA(b, h) + aoff + m * 2048 + k * 1024); } while (0)
#define PG8_LDB(dst, b, h) do { _Pragma("unroll") for (int n = 0; n < 2; ++n) _Pragma("unroll") for (int k = 0; k < 2; ++k) dst[n][k] = *(const PG8_LAS bf16x8*)(lds + PG8_SB(b, h) + boff + n * 2048 + k * 1024); } while (0)
#define PG8_MMA(ai, bj, At, Bt) do { __builtin_amdgcn_s_setprio(1); _Pragma("unroll") for (int m = 0; m < 4; ++m) _Pragma("unroll") for (int n = 0; n < 2; ++n) _Pragma("unroll") for (int k = 0; k < 2; ++k) \
        acc[ai][bj][m][n] = __builtin_amdgcn_mfma_f32_16x16x32_bf16(Bt[n][k], At[m][k], acc[ai][bj][m][n], 0, 0, 0); __builtin_amdgcn_s_setprio(0); } while (0)
#define PG8_WAIT_V(n) asm volatile("s_waitcnt vmcnt(" #n ")" ::: "memory")
#define PG8_WAIT_L(n) asm volatile("s_waitcnt lgkmcnt(" #n ")" ::: "memory")
#define PG8_BAR __builtin_amdgcn_s_barrier()
#define PG8_SCHED __builtin_amdgcn_sched_barrier(0)
    Unit cur, nxt; int ui = 0;
    if (!S.next(0, cur)) return;
    f32x4 acc[2][2][4][2];
#pragma unroll
    for (int a = 0; a < 2; ++a)
#pragma unroll
        for (int b = 0; b < 2; ++b)
#pragma unroll
            for (int m = 0; m < 4; ++m)
#pragma unroll
                for (int n = 0; n < 2; ++n) acc[a][b][m][n] = (f32x4){0.f, 0.f, 0.f, 0.f};
    bf16x8 At[4][2], B0[2][2], B1[2][2];
    const char* cA = cur.A; const char* cB = cur.B;
    S.a_ready(cur);
    if constexpr (SP2) {
        PG8_STAGE(PG8_SB(0, 0), cB, voffB); PG8_STAGE(PG8_SB(0, 1), cB + hstep, voffB); PG8_STAGE(PG8_SA(0, 0), cA, voffA); PG8_STAGE(PG8_SA(0, 1), cA + hstep, voffA);
        if (wr == 1) PG8_BAR;
        PG8_WAIT_V(2); PG8_BAR;
        PG8_STAGE(PG8_SB(1, 0), cB + kstep, voffB); PG8_STAGE(PG8_SA(1, 0), cA + kstep, voffA); PG8_STAGE(PG8_SB(1, 1), cB + hstep + kstep, voffB);
        PG8_WAIT_V(6); PG8_BAR;
    } else {
        PG8_STAGE(PG8_SB(0, 0), cB, voffB); PG8_STAGE(PG8_SA(0, 0), cA, voffA); PG8_STAGE(PG8_SB(0, 1), cB + hstep, voffB); PG8_STAGE(PG8_SA(0, 1), cA + hstep, voffA);
        if (wr == 1) PG8_BAR;
        PG8_WAIT_V(4); PG8_BAR;
        PG8_STAGE(PG8_SB(1, 0), cB + kstep, voffB); PG8_STAGE(PG8_SA(1, 0), cA + kstep, voffA); PG8_STAGE(PG8_SB(1, 1), cB + hstep + kstep, voffB);
        PG8_WAIT_V(6); PG8_BAR;
    }
    for (;;) {
        const bool has_next = S.next(ui + 1, nxt);
        const char* nA = has_next ? nxt.A : cA; const char* nB = has_next ? nxt.B : cB;
        for (int t = 0; t < nt; t += 2) {
            const bool last = (t == nt - 2);
            const char* a1 = cA + (size_t)(t + 1) * kstep;
            const char* a2 = last ? nA : cA + (size_t)(t + 2) * kstep; const char* b2 = last ? nB : cB + (size_t)(t + 2) * kstep;
            const char* a3 = a2 + kstep; const char* b3 = b2 + kstep;
            if (last && has_next) S.a_ready(nxt);
            if constexpr (SP2) {
            PG8_LDB(B0, 0, 0); PG8_LDB(B1, 0, 1); PG8_SCHED; PG8_LDA(At, 0, 0); PG8_STAGE(PG8_SA(1, 1), a1 + hstep, voffA);
            PG8_WAIT_V(8); PG8_WAIT_L(0); PG8_BAR; PG8_MMA(0, 0, At, B0); PG8_MMA(0, 1, At, B1); PG8_BAR; PG8_SCHED;
            PG8_LDA(At, 0, 1); PG8_STAGE(PG8_SB(0, 0), b2, voffB); PG8_STAGE(PG8_SB(0, 1), b2 + hstep, voffB); PG8_STAGE(PG8_SA(0, 0), a2, voffA);
            PG8_WAIT_V(8); PG8_WAIT_L(0); PG8_BAR; PG8_MMA(1, 0, At, B0); PG8_MMA(1, 1, At, B1); PG8_BAR; PG8_SCHED;
            PG8_LDB(B0, 1, 0); PG8_LDB(B1, 1, 1); PG8_SCHED; PG8_LDA(At, 1, 0); PG8_STAGE(PG8_SA(0, 1), a2 + hstep, voffA);
            PG8_WAIT_V(8); PG8_WAIT_L(0); PG8_BAR; PG8_MMA(0, 0, At, B0); PG8_MMA(0, 1, At, B1); PG8_BAR; PG8_SCHED;
            PG8_LDA(At, 1, 1); PG8_STAGE(PG8_SB(1, 0), b3, voffB); PG8_STAGE(PG8_SB(1, 1), b3 + hstep, voffB); PG8_STAGE(PG8_SA(1, 0), a3, voffA);
            PG8_WAIT_V(8); PG8_WAIT_L(0); PG8_BAR; PG8_MMA(1, 0, At, B0); PG8_MMA(1, 1, At, B1); PG8_BAR; PG8_SCHED;
            } else {
            PG8_LDB(B0, 0, 0); PG8_SCHED; PG8_LDA(At, 0, 0); PG8_STAGE(PG8_SA(1, 1), a1 + hstep, voffA);
            PG8_WAIT_L(8); PG8_BAR; PG8_WAIT_L(0); PG8_MMA(0, 0, At, B0); PG8_BAR; PG8_SCHED;
            PG8_LDB(B1, 0, 1); PG8_STAGE(PG8_SB(0, 0), b2, voffB);
            PG8_BAR; PG8_WAIT_L(0); PG8_MMA(0, 1, At, B1); PG8_BAR;
            PG8_LDA(At, 0, 1); PG8_STAGE(PG8_SA(0, 0), a2, voffA);
            PG8_BAR; PG8_WAIT_L(0); PG8_MMA(1, 0, At, B0); PG8_BAR; PG8_SCHED;
            PG8_STAGE(PG8_SB(0, 1), b2 + hstep, voffB);
            PG8_WAIT_V(6); PG8_BAR; PG8_MMA(1, 1, At, B1); PG8_BAR;
            PG8_LDB(B0, 1, 0); PG8_SCHED; PG8_LDA(At, 1, 0); PG8_STAGE(PG8_SA(0, 1), a2 + hstep, voffA);
            PG8_WAIT_L(8); PG8_BAR; PG8_WAIT_L(0); PG8_MMA(0, 0, At, B0); PG8_BAR; PG8_SCHED;
            PG8_LDB(B1, 1, 1); PG8_STAGE(PG8_SB(1, 0), b3, voffB);
            PG8_BAR; PG8_WAIT_L(0); PG8_MMA(0, 1, At, B1); PG8_BAR;
            PG8_LDA(At, 1, 1); PG8_STAGE(PG8_SA(1, 0), a3, voffA);
            PG8_BAR; PG8_WAIT_L(0); PG8_MMA(1, 0, At, B0); PG8_BAR; PG8_SCHED;
            PG8_STAGE(PG8_SB(1, 1), b3 + hstep, voffB);
            PG8_WAIT_V(6); PG8_BAR; PG8_MMA(1, 1, At, B1); PG8_BAR;
            }
        }
        if constexpr (ALIGN_EPI) { if (wr == 0) PG8_BAR; }
        if constexpr (!Epi::AFTER_DRAIN) { E(acc, cur, wr, wc, fr, fq); S.done(cur); }
        if (!has_next) break;
#pragma unroll
        for (int a = 0; a < 2; ++a)
#pragma unroll
            for (int b = 0; b < 2; ++b)
#pragma unroll
                for (int m = 0; m < 4; ++m)
#pragma unroll
                    for (int n = 0; n < 2; ++n) acc[a][b][m][n] = (f32x4){0.f, 0.f, 0.f, 0.f};
        cur = nxt; cA = nA; cB = nB; ++ui;
        if constexpr (ALIGN_EPI) { if (wr == 1) PG8_BAR; }
    }
    PG8_WAIT_V(0);
    if constexpr (!ALIGN_EPI) { if (wr == 0) PG8_BAR; }
    PG8_BAR;
    if constexpr (Epi::AFTER_DRAIN) { E.fused(acc, cur, wr, wc, fr, fq, lds, wid, lane); S.done(cur); }
#undef PG8_SA
#undef PG8_SB
#undef PG8_STAGE
#undef PG8_LDA
#undef PG8_LDB
#undef PG8_MMA
#undef PG8_WAIT_V
#undef PG8_WAIT_L
#undef PG8_BAR
#undef PG8_SCHED
}
}
#define RLX_AGENT __ATOMIC_RELAXED, __HIP_MEMORY_SCOPE_AGENT
#define XB_TMO      128
#define XB_XCNT(j)  (256  + 64 * (j))
#define XB_XSUB(j)  (1280 + 64 * (j))
#define XB_XGEN(j)  (2304 + 64 * (j))
#define XB_TOP      3328
#define XB_TOPGEN   3392
#define XCD_BAR_WORDS 3456
#define XB_SPIN_CAP (1u << 18)

__device__ __forceinline__ unsigned xb_ld(unsigned* p)              { return __hip_atomic_load(p, __ATOMIC_RELAXED, __HIP_MEMORY_SCOPE_AGENT); }
__device__ __forceinline__ unsigned xb_add(unsigned* p, unsigned v) { return __hip_atomic_fetch_add(p, v, __ATOMIC_RELAXED, __HIP_MEMORY_SCOPE_AGENT); }
__device__ __forceinline__ unsigned xb_xcc_id() { return (unsigned)__builtin_amdgcn_s_getreg((3 << 11) | 20) & 0xFu; }
#define XB_SPIN(cond, bar) do { unsigned _sp = 0; while (cond) { __builtin_amdgcn_s_sleep(1); \
    if ((++_sp & 255u) == 0u) { if (xb_ld(&(bar)[XB_TMO])) break; if (_sp > XB_SPIN_CAP) { atomicAdd(&(bar)[XB_TMO], 1u); break; } } } } while (0)

struct XcdBarrier {
    unsigned* bar; unsigned x;
    volatile LAS unsigned* st;
};

__device__ __forceinline__ XcdBarrier xcd_barrier_post(unsigned* bar, volatile LAS unsigned* st) {
    XcdBarrier b; b.bar = bar; b.x = xb_xcc_id(); b.st = st;
    if (threadIdx.x == 0) (void)xb_add(&bar[XB_XCNT(b.x)], 1u);
    return b;
}
__device__ __forceinline__ void xcd_barrier_complete(unsigned* bar, unsigned x, unsigned& nloc, unsigned& nx) {
    const unsigned G = gridDim.x * gridDim.y * gridDim.z;
    unsigned sum, cnt, mine, sp = 0u;
    for (;;) {
        sum = 0u; cnt = 0u; mine = 0u;
#pragma unroll
        for (unsigned j = 0; j < 16; ++j) { const unsigned c = xb_ld(&bar[XB_XCNT(j)]); sum += c; cnt += (c > 0u) ? 1u : 0u; mine = (j == x) ? c : mine; }
        if (sum == G) break;
        __builtin_amdgcn_s_sleep(1);
        if ((++sp & 255u) == 0u) { if (xb_ld(&bar[XB_TMO])) break; if (sp > XB_SPIN_CAP) { atomicAdd(&bar[XB_TMO], 1u); break; } }
    }
    nloc = mine > 0u ? mine : 1u; nx = cnt > 0u ? cnt : 1u;
}

__device__ __forceinline__ void xcd_barrier(const XcdBarrier& b) {
    asm volatile("s_waitcnt vmcnt(0)" ::: "memory");
    __syncthreads();
    if (threadIdx.x == 0) {
        unsigned* bar = b.bar;
        __builtin_amdgcn_s_waitcnt(0);
        unsigned nloc = b.st[0], nx = b.st[1];
        if (nloc == 0u) { xcd_barrier_complete(bar, b.x, nloc, nx); b.st[0] = nloc; b.st[1] = nx; }
        const unsigned old = xb_add(&bar[XB_XSUB(b.x)], 1u);
        const unsigned gen = old / nloc;
        if (old + 1u == (gen + 1u) * nloc) {
            __builtin_amdgcn_fence(__ATOMIC_RELEASE, "agent");
            asm volatile("s_waitcnt vmcnt(0)" ::: "memory");
            const unsigned og = xb_add(&bar[XB_TOP], 1u);
            const unsigned tg = og / nx;
            if (og + 1u == (tg + 1u) * nx) xb_add(&bar[XB_TOPGEN], 1u);
            else XB_SPIN(xb_ld(&bar[XB_TOPGEN]) == tg, bar);
            __builtin_amdgcn_fence(__ATOMIC_ACQUIRE, "agent");
            xb_add(&bar[XB_XGEN(b.x)], 1u);
            asm volatile("s_waitcnt vmcnt(0)" ::: "memory");
        } else {
            XB_SPIN(xb_ld(&bar[XB_XGEN(b.x)]) == gen, bar);
            __builtin_amdgcn_fence(__ATOMIC_ACQUIRE, "agent");
            asm volatile("s_waitcnt vmcnt(0)" ::: "memory");
        }
    }
    __syncthreads();
}

__device__ __forceinline__ int rope_idx_of_row(int row) {
    if (row < ROW_S) return NMETA + (row & (SEQ - 1));
    if (row < ROW_M) return TP + ((row - ROW_S) & (DS - 1));
    if (row < ROW_M + NMETA) return row - ROW_M;
    return -1;
}
namespace pg8 {
#define EPI_ROWS(ai, m) (row0 + (ai) * HALF + (m) * 16)
__device__ __forceinline__ u32x4 pack8(const f32x4 v0, const f32x4 v1) { u32x4 w; w.x = cvt_pk_bf16(v0[0], v0[1]); w.y = cvt_pk_bf16(v0[2], v0[3]); w.z = cvt_pk_bf16(v1[0], v1[1]); w.w = cvt_pk_bf16(v1[2], v1[3]); return w; }
__device__ __forceinline__ void unpack8(const u32x4 w, f32x4& v0, f32x4& v1) { v0 = (f32x4){bflo(w.x), bfhi(w.x), bflo(w.y), bfhi(w.y)}; v1 = (f32x4){bflo(w.z), bfhi(w.z), bflo(w.w), bfhi(w.w)}; }

struct EpiWin {
    static constexpr bool PERM = true, AFTER_DRAIN = false;
    bf16 *RX, *GRG, *CQ, *CKVR, *G, *KPE; float *SSQQ, *SSQKV; const float* b_gate; const float *ropec, *ropes; float* out;
    __device__ __forceinline__ void operator()(const f32x4 (&acc)[2][2][4][2], const Unit& u, int wr, int wc, int fr, int fq) const {
        const int pn = u.pn, row0 = u.pm * BM + wr * 64 + fr, cw = wc * 32 + 8 * fq;
        if (pn < 4 || (pn >= 8 && pn < 13)) {
            bf16* base; int ld, colt, nslot = 0, slot0 = 0; float* ssq = nullptr;
            if (pn < 4) { base = RX; ld = D; colt = pn * BM; }
            else if (pn < 11) { base = CQ; ld = QL; colt = (pn - 8) * BM; ssq = SSQQ; nslot = 12; slot0 = (pn - 8) * 4 + wc; }
            else { base = CKVR; ld = KVL; colt = (pn - 11) * BM; ssq = SSQKV; nslot = 8; slot0 = (pn - 11) * 4 + wc; }
#pragma unroll
            for (int ai = 0; ai < 2; ++ai)
#pragma unroll
                for (int m = 0; m < 4; ++m) { const int row = EPI_ROWS(ai, m); float s = 0.f;
#pragma unroll
                    for (int bj = 0; bj < 2; ++bj) { const f32x4 v0 = acc[ai][bj][m][0], v1 = acc[ai][bj][m][1];
                        *(u32x4*)(base + (size_t)row * ld + colt + bj * HALF + cw) = pack8(v0, v1);
                        s += (v0[0] * v0[0] + v0[1] * v0[1]) + (v0[2] * v0[2] + v0[3] * v0[3]) + (v1[0] * v1[0] + v1[1] * v1[1]) + (v1[2] * v1[2] + v1[3] * v1[3]); }
                    if (ssq) { s += __shfl_xor(s, 16); s += __shfl_xor(s, 32); if (fq == 0) ssq[(size_t)row * nslot + slot0] = s; } }
        } else if (pn < 8) {
            const int colt = (pn - 4) * BM;
#pragma unroll
            for (int ai = 0; ai < 2; ++ai)
#pragma unroll
                for (int m = 0; m < 4; ++m) { const int row = EPI_ROWS(ai, m);
#pragma unroll
                    for (int bj = 0; bj < 2; ++bj) { f32x4 v0 = acc[ai][bj][m][0], v1 = acc[ai][bj][m][1];
#pragma unroll
                        for (int j = 0; j < 4; ++j) { v0[j] = gelu_tanh(v0[j]); v1[j] = gelu_tanh(v1[j]); }
                        *(u32x4*)(GRG + (size_t)row * D + colt + bj * HALF + cw) = pack8(v0, v1); } }
        } else if (pn < 21) {
            const int colt = (pn - 13) * BM;
            f32x4 bv[2][2];
#pragma unroll
            for (int bj = 0; bj < 2; ++bj)
#pragma unroll
                for (int n = 0; n < 2; ++n) bv[bj][n] = *(const f32x4*)(b_gate + colt + bj * HALF + cw + 4 * n);
#pragma unroll
            for (int ai = 0; ai < 2; ++ai)
#pragma unroll
                for (int m = 0; m < 4; ++m) { const int row = EPI_ROWS(ai, m);
#pragma unroll
                    for (int bj = 0; bj < 2; ++bj) { f32x4 v0 = acc[ai][bj][m][0] + bv[bj][0], v1 = acc[ai][bj][m][1] + bv[bj][1];
#pragma unroll
                        for (int j = 0; j < 4; ++j) { v0[j] = sigmoidf_(v0[j]); v1[j] = sigmoidf_(v1[j]); }
                        *(u32x4*)(G + (size_t)row * 2048 + colt + bj * HALF + cw) = pack8(v0, v1); } }
        } else if (wc == 0) {
#pragma unroll
            for (int ai = 0; ai < 2; ++ai)
#pragma unroll
                for (int m = 0; m < 4; ++m) { const int row = EPI_ROWS(ai, m); const int pi = rope_idx_of_row(row);
                    if (pi >= 0) {
#pragma unroll
                        for (int n = 0; n < 2; ++n) { const int i0 = 8 * fq + 4 * n;
                            const f32x4 cs = *(const f32x4*)(ropec + pi * 32 + i0), sn = *(const f32x4*)(ropes + pi * 32 + i0);
                            const f32x4 x1 = acc[ai][0][m][n], x2 = acc[ai][1][m][n];
                            const f32x4 o1 = x1 * cs - x2 * sn, o2 = x1 * sn + x2 * cs;
                            u32x2 w1, w2; w1.x = cvt_pk_bf16(o1[0], o1[1]); w1.y = cvt_pk_bf16(o1[2], o1[3]); w2.x = cvt_pk_bf16(o2[0], o2[1]); w2.y = cvt_pk_bf16(o2[2], o2[3]);
                            *(u32x2*)(KPE + (size_t)row * 64 + i0) = w1; *(u32x2*)(KPE + (size_t)row * 64 + 32 + i0) = w2;
                            if (row < ROW_S) { float* o = out + O_PKPE + ((size_t)(row >> 11) * TP + pi) * 64 + i0; *(f32x4*)o = o1; *(f32x4*)(o + 32) = o2; }
                            else if (row < ROW_M) { float* o = out + O_SKPE + (size_t)(row - ROW_S) * 64 + i0; *(f32x4*)o = o1; *(f32x4*)(o + 32) = o2; }
                            else {
#pragma unroll
                                for (int b = 0; b < NB; ++b) { float* o = out + O_PKPE + ((size_t)b * TP + pi) * 64 + i0; *(f32x4*)o = o1; *(f32x4*)(o + 32) = o2; } } } } }
        }
    }
};
struct EpiQ {
    static constexpr bool PERM = true, AFTER_DRAIN = false;
    bf16* QA; const float* SSQQ; const float *ropec, *ropes;
    __device__ __forceinline__ void operator()(const f32x4 (&acc)[2][2][4][2], const Unit& u, int wr, int wc, int fr, int fq) const {
        const int pn = u.pn, row0 = u.pm * BM + wr * 64 + fr, cw = wc * 32 + 8 * fq;
#pragma unroll
        for (int ai = 0; ai < 2; ++ai)
#pragma unroll
            for (int m = 0; m < 4; ++m) { const int row = EPI_ROWS(ai, m);
                const f32x4 s0 = *(const f32x4*)(SSQQ + (size_t)row * 12), s1 = *(const f32x4*)(SSQQ + (size_t)row * 12 + 4), s2 = *(const f32x4*)(SSQQ + (size_t)row * 12 + 8);
                const float ss = ((s0[0] + s0[1]) + (s0[2] + s0[3])) + ((s1[0] + s1[1]) + (s1[2] + s1[3])) + ((s2[0] + s2[1]) + (s2[2] + s2[3]));
                const float rstd = 1.0f / sqrtf(ss * (1.0f / QL) + EPS);
                if (pn < 4) {
#pragma unroll
                    for (int bj = 0; bj < 2; ++bj) { const int h = pn * 2 + bj;
                        *(u32x4*)(QA + (size_t)row * 1536 + h * 192 + cw) = pack8(acc[ai][bj][m][0] * rstd, acc[ai][bj][m][1] * rstd); }
                } else {
                    const int h = (pn - 4) * 4 + wc; int pi = rope_idx_of_row(row); if (pi < 0) pi = 0;
#pragma unroll
                    for (int n = 0; n < 2; ++n) { const int i0 = 8 * fq + 4 * n;
                        const f32x4 cs = *(const f32x4*)(ropec + pi * 32 + i0), sn = *(const f32x4*)(ropes + pi * 32 + i0);
                        const f32x4 x1 = acc[ai][0][m][n] * rstd, x2 = acc[ai][1][m][n] * rstd;
                        const f32x4 o1 = x1 * cs - x2 * sn, o2 = x1 * sn + x2 * cs;
                        u32x2 w1, w2; w1.x = cvt_pk_bf16(o1[0], o1[1]); w1.y = cvt_pk_bf16(o1[2], o1[3]); w2.x = cvt_pk_bf16(o2[0], o2[1]); w2.y = cvt_pk_bf16(o2[2], o2[3]);
                        *(u32x2*)(QA + (size_t)row * 1536 + h * 192 + 128 + i0) = w1; *(u32x2*)(QA + (size_t)row * 1536 + h * 192 + 160 + i0) = w2; }
                } }
    }
};
struct EpiKV {
    static constexpr bool PERM = true, AFTER_DRAIN = false;
    bf16 *KN, *V; const float* SSQKV;
    __device__ __forceinline__ void operator()(const f32x4 (&acc)[2][2][4][2], const Unit& u, int wr, int wc, int fr, int fq) const {
        const int pn = u.pn, row0 = u.pm * BM + wr * 64 + fr, cw = wc * 32 + 8 * fq;
        bf16* base = pn < 4 ? KN : V; const int colt = (pn & 3) * BM;
#pragma unroll
        for (int ai = 0; ai < 2; ++ai)
#pragma unroll
            for (int m = 0; m < 4; ++m) { const int row = EPI_ROWS(ai, m);
                const f32x4 s0 = *(const f32x4*)(SSQKV + (size_t)row * 8), s1 = *(const f32x4*)(SSQKV + (size_t)row * 8 + 4);
                const float ss = ((s0[0] + s0[1]) + (s0[2] + s0[3])) + ((s1[0] + s1[1]) + (s1[2] + s1[3]));
                const float rstd = 1.0f / sqrtf(ss * (1.0f / KVL) + EPS);
#pragma unroll
                for (int bj = 0; bj < 2; ++bj) *(u32x4*)(base + (size_t)row * D + colt + bj * HALF + cw) = pack8(acc[ai][bj][m][0] * rstd, acc[ai][bj][m][1] * rstd); }
    }
};
template <int MODE> struct EpiZ {
    static constexpr bool PERM = true, AFTER_DRAIN = false;
    bf16* MIX; const bf16* G;
    __device__ __forceinline__ void operator()(const f32x4 (&acc)[2][2][4][2], const Unit& u, int wr, int wc, int fr, int fq) const {
        const int row0 = u.pm * BM + wr * 64 + fr, col0 = u.pn * BM + wc * 32 + 8 * fq;
#pragma unroll
        for (int ai = 0; ai < 2; ++ai)
#pragma unroll
            for (int m = 0; m < 4; ++m) { const int row = EPI_ROWS(ai, m);
#pragma unroll
                for (int bj = 0; bj < 2; ++bj) { const int col = col0 + bj * HALF;
                    f32x4 g0, g1; unpack8(*(const u32x4*)(G + (size_t)row * 2048 + MODE * D + col), g0, g1);
                    f32x4 v0 = acc[ai][bj][m][0] * g0, v1 = acc[ai][bj][m][1] * g1;
                    if (MODE == 1) { f32x4 t0, t1; unpack8(*(const u32x4*)(MIX + (size_t)row * D + col), t0, t1); v0 += t0; v1 += t1; }
                    *(u32x4*)(MIX + (size_t)row * D + col) = pack8(v0, v1); } }
    }
};
struct EpiRes {
    static constexpr bool PERM = false, AFTER_DRAIN = false;
    float* OUT; const bf16* RES; const float* bias;
    __device__ __forceinline__ void operator()(const f32x4 (&acc)[2][2][4][2], const Unit& u, int wr, int wc, int fr, int fq) const {
        const int row0 = u.pm * BM + wr * 64 + fr, col0 = u.pn * BM + wc * 32 + 4 * fq;
        f32x4 bv[2][2];
#pragma unroll
        for (int bj = 0; bj < 2; ++bj)
#pragma unroll
            for (int n = 0; n < 2; ++n) bv[bj][n] = bias ? *(const f32x4*)(bias + col0 + bj * HALF + n * 16) : (f32x4){0.f, 0.f, 0.f, 0.f};
#pragma unroll
        for (int ai = 0; ai < 2; ++ai)
#pragma unroll
            for (int m = 0; m < 4; ++m) { const size_t ro = (size_t)EPI_ROWS(ai, m) * D + col0;
#pragma unroll
                for (int bj = 0; bj < 2; ++bj)
#pragma unroll
                    for (int n = 0; n < 2; ++n) { const u32x2 w = *(const u32x2*)(RES + ro + bj * HALF + n * 16);
                        const f32x4 r = (f32x4){bflo(w.x), bfhi(w.x), bflo(w.y), bfhi(w.y)};
                        *(f32x4*)(OUT + ro + bj * HALF + n * 16) = r * DN_ALPHA + acc[ai][bj][m][n] + bv[bj][n]; } }
    }
};
struct EpiUp {
    static constexpr bool PERM = true, AFTER_DRAIN = false;
    bf16* U; const float* bias;
    __device__ __forceinline__ void operator()(const f32x4 (&acc)[2][2][4][2], const Unit& u, int wr, int wc, int fr, int fq) const {
        const int row0 = u.pm * BM + wr * 64 + fr, col0 = u.pn * BM + wc * 32 + 8 * fq;
        f32x4 bv[2][2];
#pragma unroll
        for (int bj = 0; bj < 2; ++bj)
#pragma unroll
            for (int n = 0; n < 2; ++n) bv[bj][n] = *(const f32x4*)(bias + col0 + bj * HALF + 4 * n);
#pragma unroll
        for (int ai = 0; ai < 2; ++ai)
#pragma unroll
            for (int m = 0; m < 4; ++m) { const int row = EPI_ROWS(ai, m);
#pragma unroll
                for (int bj = 0; bj < 2; ++bj) { f32x4 v0 = acc[ai][bj][m][0] + bv[bj][0], v1 = acc[ai][bj][m][1] + bv[bj][1];
#pragma unroll
                    for (int j = 0; j < 4; ++j) { const float a = fmaxf(v0[j], 0.f), b = fmaxf(v1[j], 0.f); v0[j] = a * a; v1[j] = b * b; }
                    *(u32x4*)(U + (size_t)row * DFF + col0 + bj * HALF) = pack8(v0, v1); } }
    }
};
#undef EPI_ROWS
}
struct Frame {
    LAS unsigned char* lds;
    volatile LAS unsigned* MISC;
    unsigned* ctl;
    int tid, lane, wave, vcu, G;
    const void* const* in;
    float* out; unsigned char* ws;
};
struct Args { const void* in[35]; float* out; unsigned char* ws; int ph_lo, ph_hi; };
#define IN_F(i) ((const float*)args.in[i])
enum { I_XP = 0, I_XS, I_CCKV, I_CKPE, I_PT, I_SCONV, I_SRG, I_META, I_LNG, I_LNB, I_WIN, I_BGATE, I_CONVW, I_CONVB, I_WA, I_BA, I_WX, I_BX, I_LAM, I_WBRR,
       I_QG, I_WUQ, I_KVG, I_WUK, I_WUV, I_WBRM, I_WO, I_LN1G, I_LN1B, I_WUP, I_BUP, I_WDN, I_BDN, I_LN2G, I_LN2B };

__device__ __forceinline__ void tr_item(const float* src, size_t ldn, int scol0, bf16* dst, int dK, int drow0, int k0, const float* kscale, LAS float* scr, int lane) {
    if (scol0 >= 0) {
#pragma unroll 8
        for (int i = 0; i < 32; ++i) { const int kk = 2 * i + (lane >> 5); scr[kk * 33 + (lane & 31)] = src[(size_t)(k0 + kk) * ldn + scol0 + (lane & 31)]; }
    } else {
#pragma unroll 8
        for (int i = 0; i < 32; ++i) { const int kk = 2 * i + (lane >> 5); scr[kk * 33 + (lane & 31)] = 0.f; }
    }
    LDS_WAIT(); asm volatile("" ::: "memory");
    const int c = lane & 7;
    float ks[8];
#pragma unroll
    for (int e = 0; e < 8; ++e) ks[e] = kscale ? kscale[k0 + 8 * c + e] : 1.0f;
#pragma unroll
    for (int j = 0; j < 4; ++j) { const int n = (lane >> 3) + 8 * j; const LAS float* s = scr + (8 * c) * 33 + n;
        u32x4 o; o.x = cvt_pk_bf16(s[0 * 33] * ks[0], s[1 * 33] * ks[1]); o.y = cvt_pk_bf16(s[2 * 33] * ks[2], s[3 * 33] * ks[3]);
        o.z = cvt_pk_bf16(s[4 * 33] * ks[4], s[5 * 33] * ks[5]); o.w = cvt_pk_bf16(s[6 * 33] * ks[6], s[7 * 33] * ks[7]);
        *(u32x4*)(dst + (size_t)(drow0 + n) * dK + k0 + 8 * c) = o; }
    LDS_WAIT(); asm volatile("" ::: "memory");
}
__device__ __forceinline__ void ln_row(const float* xrow, const float* g, const float* b, bf16* obf, float* of32, int lane) {
    const f32x4* xr = (const f32x4*)xrow + lane;
    f32x4 v[4]; float s = 0.f;
#pragma unroll
    for (int j = 0; j < 4; ++j) { v[j] = xr[64 * j]; s += (v[j].x + v[j].y) + (v[j].z + v[j].w); }
    const float mean = wave_sum(s) * (1.f / D); float s2 = 0.f;
#pragma unroll
    for (int j = 0; j < 4; ++j) { v[j] = v[j] - mean; s2 += (v[j].x * v[j].x + v[j].y * v[j].y) + (v[j].z * v[j].z + v[j].w * v[j].w); }
    const float rstd = 1.f / sqrtf(wave_sum(s2) * (1.f / D) + EPS);
#pragma unroll
    for (int j = 0; j < 4; ++j) { const f32x4 gg = ((const f32x4*)g)[lane + 64 * j], bb = ((const f32x4*)b)[lane + 64 * j]; const f32x4 y = v[j] * rstd * gg + bb;
        if (obf) { u32x2 w; w.x = cvt_pk_bf16(y.x, y.y); w.y = cvt_pk_bf16(y.z, y.w); ((u32x2*)obf)[lane + 64 * j] = w; }
        if (of32) ((f32x4*)of32)[lane + 64 * j] = y; }
}
__device__ __forceinline__ const float* src_row(const float* xp, const float* xs, const float* meta, int row) {
    if (row < ROW_S) return xp + (size_t)row * D;
    if (row < ROW_M) return xs + (size_t)(row - ROW_S) * D;
    if (row < ROW_M + NMETA) return meta + (size_t)(row - ROW_M) * D;
    return nullptr;
}
__device__ __forceinline__ void p0_prologue(const Frame& F, const Args& args) {
    unsigned char* ws = F.ws;
    LAS float* scr = (LAS float*)(F.lds + F.wave * 16384);
    const int gw = F.vcu * NWAVES + F.wave, NGW = F.G * NWAVES, lane = F.lane;
    constexpr int I_1 = 16 * (NINP / 32), I_2 = 12 * 48, I_3 = 8 * 32, I_4 = 8 * 32, I_5 = 16 * 32, I_8 = 16 * 128, I_9 = 64 * 32, I_10 = 8 * 8;
    constexpr int NITEMS = I_1 + I_2 + I_3 + I_4 + 3 * I_5 + I_8 + I_9 + 2 * I_10;
    for (int it = gw; it < NITEMS; it += NGW) {
        int r = it;
        if (r < I_1) { const int nb = r % (NINP / 32), kb = r / (NINP / 32), n0 = 32 * nb; int sc;
            if (n0 < 3328) sc = n0; else if (n0 < 5376) sc = n0 + 64; else { const int w = n0 - 5376; sc = (w == 0) ? 3328 : (w == 128 ? 3360 : -1); }
            tr_item(IN_F(I_WIN), NIN, sc, (bf16*)(ws + WS_WIN), D, n0, 64 * kb, nullptr, scr, lane); continue; } r -= I_1;
        if (r < I_2) { const int nb = r % 48, kb = r / 48, n0 = 32 * nb; int sc;
            if (n0 < 1024) sc = (n0 >> 7) * 192 + (n0 & 127);
            else { const int w = n0 - 1024, tt = w >> 8, wi = w & 255, half = wi >> 7, hh = (wi & 127) >> 5; sc = (4 * tt + hh) * 192 + 128 + 32 * half; }
            tr_item(IN_F(I_WUQ), 1536, sc, (bf16*)(ws + WS_WQ), QL, n0, 64 * kb, IN_F(I_QG), scr, lane); continue; } r -= I_2;
        if (r < I_3) { const int nb = r % 32, kb = r / 32; tr_item(IN_F(I_WUK), 1024, 32 * nb, (bf16*)(ws + WS_WKV), KVL, 32 * nb, 64 * kb, IN_F(I_KVG), scr, lane); continue; } r -= I_3;
        if (r < I_4) { const int nb = r % 32, kb = r / 32; tr_item(IN_F(I_WUV), 1024, 32 * nb, (bf16*)(ws + WS_WKV), KVL, 1024 + 32 * nb, 64 * kb, IN_F(I_KVG), scr, lane); continue; } r -= I_4;
        if (r < I_5) { const int nb = r % 32, kb = r / 32; tr_item(IN_F(I_WBRR), D, 32 * nb, (bf16*)(ws + WS_WBRR), D, 32 * nb, 64 * kb, nullptr, scr, lane); continue; } r -= I_5;
        if (r < I_5) { const int nb = r % 32, kb = r / 32; tr_item(IN_F(I_WBRM), D, 32 * nb, (bf16*)(ws + WS_WBRM), D, 32 * nb, 64 * kb, nullptr, scr, lane); continue; } r -= I_5;
        if (r < I_5) { const int nb = r % 32, kb = r / 32; tr_item(IN_F(I_WO), D, 32 * nb, (bf16*)(ws + WS_WO), D, 32 * nb, 64 * kb, nullptr, scr, lane); continue; } r -= I_5;
        if (r < I_8) { const int nb = r % 128, kb = r / 128; tr_item(IN_F(I_WUP), DFF, 32 * nb, (bf16*)(ws + WS_WUP), D, 32 * nb, 64 * kb, nullptr, scr, lane); continue; } r -= I_8;
        if (r < I_9) { const int nb = r % 32, kb = r / 32; tr_item(IN_F(I_WDN), D, 32 * nb, (bf16*)(ws + WS_WDN), DFF, 32 * nb, 64 * kb, nullptr, scr, lane); continue; } r -= I_9;
        if (r < I_10) { const int blk = r >> 3, nb = r & 3, kb = (r >> 2) & 1; tr_item(IN_F(I_WA) + (size_t)blk * 128 * 128, 128, 32 * nb, (bf16*)(ws + WS_WAX), 128, blk * 256 + 32 * nb, 64 * kb, nullptr, scr, lane); continue; } r -= I_10;
        { const int blk = r >> 3, nb = r & 3, kb = (r >> 2) & 1; tr_item(IN_F(I_WX) + (size_t)blk * 128 * 128, 128, 32 * nb, (bf16*)(ws + WS_WAX), 128, blk * 256 + 128 + 32 * nb, 64 * kb, nullptr, scr, lane); }
    }
    const int gt = F.vcu * NTHR + F.tid, NGT = F.G * NTHR;
    for (int i = gt; i < 8 * 512 * 16; i += NGT) { const int c8 = i & 15, r = (i >> 4) & 511, h = i >> 13;
        const f32x4 a = *(const f32x4*)(IN_F(I_WUK) + (size_t)r * 1024 + h * 128 + c8 * 8), b = *(const f32x4*)(IN_F(I_WUK) + (size_t)r * 1024 + h * 128 + c8 * 8 + 4);
        *(u32x4*)((bf16*)(ws + WS_WUKS) + ((size_t)h * 512 + r) * 128 + c8 * 8) = pg8::pack8(a, b); }
    for (int i = gt; i < NROPE * 32; i += NGT) { const int pi = i >> 5, k = i & 31; const int pos = pi < TP ? pi : PAST + (pi - TP);
        double pw = 1.0; for (int j = 0; j < k; ++j) pw *= 1.3335214321633240;
        const float inv = 1.0f / (float)pw; const float ang = (float)pos * inv; const double a = (double)ang;
        const double n2 = __builtin_rint(a * 0.15915494309189535); const double r = (a - n2 * 6.283185307179586) - n2 * 2.4492935982947064e-16;
        const double q = __builtin_rint(r * 0.6366197723675814); const double t = (r - q * 1.5707963267948966) - q * 6.123233995736766e-17; const int qi = ((int)q) & 3;
        const double t2 = t * t;
        const double st = t * (1.0 + t2 * (-1.0 / 6 + t2 * (1.0 / 120 + t2 * (-1.0 / 5040 + t2 * (1.0 / 362880 + t2 * (-1.0 / 39916800 + t2 * (1.0 / 6227020800.0)))))));
        const double ct = 1.0 + t2 * (-0.5 + t2 * (1.0 / 24 + t2 * (-1.0 / 720 + t2 * (1.0 / 40320 + t2 * (-1.0 / 3628800 + t2 * (1.0 / 479001600.0 + t2 * (-1.0 / 87178291200.0)))))));
        const double cv = qi == 0 ? ct : (qi == 1 ? -st : (qi == 2 ? -ct : st)), sv = qi == 0 ? st : (qi == 1 ? ct : (qi == 2 ? -st : -ct));
        ((float*)(ws + WS_ROPEC))[i] = (float)cv; ((float*)(ws + WS_ROPES))[i] = (float)sv; }
    for (int i = gt; i < D; i += NGT) { const float l = IN_F(I_LAM)[i]; ((float*)(ws + WS_SPL))[i] = (l > 0.f) ? log1pf(expf(-l)) : (-l + log1pf(expf(l))); }
    for (int m = gw; m < R; m += NGW) { const float* s = src_row(IN_F(I_XP), IN_F(I_XS), IN_F(I_META), m); bf16* o = (bf16*)(ws + WS_H) + (size_t)m * D;
        if (s) ln_row(s, IN_F(I_LNG), IN_F(I_LNB), o, nullptr, lane);
        else { for (int j = 0; j < 2; ++j) ((u32x4*)o)[lane + 64 * j] = (u32x4){0u, 0u, 0u, 0u}; } }
}
constexpr int RG_XC = 0;
constexpr int RG_XF = 16384;
constexpr int RG_AB = RG_XF + 64 * 132 * 4;
constexpr int RG_SUM = RG_AB + 64 * 132 * 4;
constexpr int RG_END = RG_SUM + 4 * 128 * 2 * 4;
static_assert(RG_END <= MISC_OFF, "rg lds");
__device__ __forceinline__ unsigned off256(unsigned row, unsigned ch) { return 256u * row + 16u * (ch ^ (((row & 3) << 2) | ((row >> 2) & 3))); }

struct RgParams {
    const bf16 *RX, *GRG, *WAX; bf16* HRG; const float *conv_w, *conv_b, *ba, *bx, *spl, *state_conv, *state_rg; float* SEG; float* out;
};
__device__ __forceinline__ int prompt_row(int b, int p) { return p < NMETA ? ROW_M + p : b * SEQ + (p - NMETA); }

template <int MODE>
__device__ __forceinline__ void rg_unit(const Frame& F, const RgParams& P, const int b  , const int n, const int seg) {
    LAS unsigned char* lds = F.lds;
    int tid = F.tid; asm volatile("" : "+v"(tid));
    const int lane = tid & 63, wave = F.wave;
    const int cb = wave & 3, tb = wave >> 2, hh = lane >> 5, l31 = lane & 31;
    bf16x8 wfa[8], wfx[8];
    { const bf16* wa = P.WAX + ((size_t)n * 256 + 32 * cb + l31) * 128 + 8 * hh; const bf16* wx = wa + 128 * 128;
#pragma unroll
      for (int ks = 0; ks < 8; ++ks) { wfa[ks] = *(const bf16x8*)(wa + 16 * ks); wfx[ks] = *(const bf16x8*)(wx + 16 * ks); } }
    const int cg_e = n * 128 + 32 * cb + l31;
    const float ba_c = P.ba[cg_e], bx_c = P.bx[cg_e], spl8 = -8.0f * P.spl[cg_e] * LOG2E;
    const int sc_c = tid & 127, sc_q = tid >> 7, cg_s = n * 128 + sc_c;
    const int cv_tp = tid >> 4, cv_c8 = tid & 15, cg_v = n * 128 + 8 * cv_c8;
    float cw[4][8], cbias[8];
#pragma unroll
    for (int k = 0; k < 4; ++k) { const f32x4 a = *(const f32x4*)(P.conv_w + k * D + cg_v), c = *(const f32x4*)(P.conv_w + k * D + cg_v + 4);
#pragma unroll
        for (int e = 0; e < 4; ++e) { cw[k][e] = a[e]; cw[k][4 + e] = c[e]; } }
    { const f32x4 a = *(const f32x4*)(P.conv_b + cg_v), c = *(const f32x4*)(P.conv_b + cg_v + 4);
#pragma unroll
      for (int e = 0; e < 4; ++e) { cbias[e] = a[e]; cbias[4 + e] = c[e]; } }
    float hc = 0.f, cA = 1.f;
    if (MODE == 1) { for (int s2 = 0; s2 < seg; ++s2) { const f32x2 sv = *(const f32x2*)(P.SEG + (((size_t)b * 3 + s2) * D + cg_s) * 2); hc = sv.x * hc + sv.y; } }
    const int nchunks = (MODE == 2) ? 1 : (seg == 0 ? 9 : 8);
    for (int ch = 0; ch < nchunks; ++ch) {
        int p0 = 0, nvalid = 64;
        if (MODE != 2) { if (seg == 0) { if (ch == 0) { p0 = 0; nvalid = NMETA; } else p0 = NMETA + 64 * (ch - 1); } else p0 = NMETA + 512 * seg + 64 * ch; }
        {
            float x[5][8];
            if (MODE != 2) {
#pragma unroll
                for (int r = 0; r < 5; ++r) { const int p = p0 + 2 * cv_tp - 3 + r;
                    u32x4 w = (u32x4){0u, 0u, 0u, 0u};
                    if (p >= 0) w = *(const u32x4*)(P.RX + (size_t)prompt_row(b, p < TP ? p : TP - 1) * D + cg_v);
                    x[r][0] = bflo(w.x); x[r][1] = bfhi(w.x); x[r][2] = bflo(w.y); x[r][3] = bfhi(w.y); x[r][4] = bflo(w.z); x[r][5] = bfhi(w.z); x[r][6] = bflo(w.w); x[r][7] = bfhi(w.w); }
            }
            if (MODE == 2) {
#pragma unroll
                for (int t = 0; t < 2; ++t) { const int row = 2 * cv_tp + t, j = row & 7, bb = 8 * b + (row >> 3);
                    float acc[8];
#pragma unroll
                    for (int e = 0; e < 8; ++e) acc[e] = cbias[e];
#pragma unroll
                    for (int k = 0; k < 4; ++k) { const int xi = j + k; float xv[8];
                        if (xi < 3) { const f32x4 a = *(const f32x4*)(P.state_conv + ((size_t)bb * 3 + xi) * D + cg_v), c = *(const f32x4*)(P.state_conv + ((size_t)bb * 3 + xi) * D + cg_v + 4);
#pragma unroll
                            for (int e = 0; e < 4; ++e) { xv[e] = a[e]; xv[4 + e] = c[e]; } }
                        else { const u32x4 w = *(const u32x4*)(P.RX + (size_t)(ROW_S + bb * 8 + xi - 3) * D + cg_v);
#pragma unroll
                            for (int e = 0; e < 4; ++e) { const unsigned ww = e == 0 ? w.x : e == 1 ? w.y : e == 2 ? w.z : w.w; xv[2 * e] = bflo(ww); xv[2 * e + 1] = bfhi(ww); } }
#pragma unroll
                        for (int e = 0; e < 8; ++e) acc[e] += xv[e] * cw[k][e]; }
                    *(LAS f32x4*)(lds + RG_XF + (row * 132 + 8 * cv_c8) * 4) = (f32x4){acc[0], acc[1], acc[2], acc[3]};
                    *(LAS f32x4*)(lds + RG_XF + (row * 132 + 8 * cv_c8 + 4) * 4) = (f32x4){acc[4], acc[5], acc[6], acc[7]};
                    u32x4 o; o.x = cvt_pk_bf16(acc[0], acc[1]); o.y = cvt_pk_bf16(acc[2], acc[3]); o.z = cvt_pk_bf16(acc[4], acc[5]); o.w = cvt_pk_bf16(acc[6], acc[7]);
                    *(LAS u32x4*)(lds + RG_XC + off256(row, cv_c8)) = o; }
            } else {
#pragma unroll
                for (int t = 0; t < 2; ++t) { const int row = 2 * cv_tp + t;
                    float acc[8];
#pragma unroll
                    for (int e = 0; e < 8; ++e) acc[e] = cbias[e] + x[t][e] * cw[0][e] + x[t + 1][e] * cw[1][e] + x[t + 2][e] * cw[2][e] + x[t + 3][e] * cw[3][e];
                    *(LAS f32x4*)(lds + RG_XF + (row * 132 + 8 * cv_c8) * 4) = (f32x4){acc[0], acc[1], acc[2], acc[3]};
                    *(LAS f32x4*)(lds + RG_XF + (row * 132 + 8 * cv_c8 + 4) * 4) = (f32x4){acc[4], acc[5], acc[6], acc[7]};
                    u32x4 o; o.x = cvt_pk_bf16(acc[0], acc[1]); o.y = cvt_pk_bf16(acc[2], acc[3]); o.z = cvt_pk_bf16(acc[4], acc[5]); o.w = cvt_pk_bf16(acc[6], acc[7]);
                    *(LAS u32x4*)(lds + RG_XC + off256(row, cv_c8)) = o; }
            }
        }
        __syncthreads();
        f32x16 ga = {}, gx = {};
#pragma unroll
        for (int ks = 0; ks < 8; ++ks) { const bf16x8 af = *(const LAS bf16x8*)(lds + RG_XC + off256(32 * tb + l31, 2 * ks + hh));
            ga = __builtin_amdgcn_mfma_f32_32x32x16_bf16(af, wfa[ks], ga, 0, 0, 0); gx = __builtin_amdgcn_mfma_f32_32x32x16_bf16(af, wfx[ks], gx, 0, 0, 0); }
#pragma unroll
        for (int r = 0; r < 16; ++r) { const int tok = 32 * tb + (r & 3) + 8 * (r >> 2) + 4 * hh; LAS float* xf = (LAS float*)(lds + RG_XF) + tok * 132 + 32 * cb + l31; LAS float* ab = (LAS float*)(lds + RG_AB) + tok * 132 + 32 * cb + l31;
            const float rr = sigmoidf_(ga[r] + ba_c), ii = sigmoidf_(gx[r] + bx_c);
            float a = fast_exp2(rr * spl8); float u = sqrtf(fmaxf(1.0f - a * a, 0.f)) * ii * (*xf);
            if (tok >= nvalid) { a = 1.f; u = 0.f; }
            *ab = a; *xf = u; }
        __syncthreads();
        if (MODE == 2) {
#pragma unroll
            for (int t2 = 0; t2 < 2; ++t2) { const int bb = 8 * b + 2 * sc_q + t2; float h = P.state_rg[(size_t)bb * D + cg_s];
#pragma unroll
                for (int j = 0; j < 8; ++j) { const int row = 16 * sc_q + 8 * t2 + j; LAS float* ab = (LAS float*)(lds + RG_AB) + row * 132 + sc_c; const float u = ((LAS float*)(lds + RG_XF))[row * 132 + sc_c];
                    h = (*ab) * h + u; *ab = h; }
                P.out[O_SH + (size_t)bb * D + cg_s] = h; }
            __syncthreads();
        } else {
            float A = 1.f, Hh = 0.f;
#pragma unroll
            for (int i = 0; i < 16; ++i) { const int row = 16 * sc_q + i; const float a = ((LAS float*)(lds + RG_AB))[row * 132 + sc_c], u = ((LAS float*)(lds + RG_XF))[row * 132 + sc_c]; Hh = a * Hh + u; A *= a; }
            *(LAS f32x2*)(lds + RG_SUM + (sc_q * 128 + sc_c) * 8) = (f32x2){A, Hh};
            __syncthreads();
            float hin = hc, hend = hc, Aend = 1.f;
#pragma unroll
            for (int q = 0; q < 4; ++q) { const f32x2 sv = *(LAS f32x2*)(lds + RG_SUM + (q * 128 + sc_c) * 8); if (q < sc_q) hin = sv.x * hin + sv.y; hend = sv.x * hend + sv.y; Aend *= sv.x; }
            hc = hend; cA *= Aend;
            if (MODE == 1) {
                float h = hin;
#pragma unroll
                for (int i = 0; i < 16; ++i) { const int row = 16 * sc_q + i; LAS float* ab = (LAS float*)(lds + RG_AB) + row * 132 + sc_c; const float u = ((LAS float*)(lds + RG_XF))[row * 132 + sc_c]; h = (*ab) * h + u; *ab = h; }
                __syncthreads();
            }
        }
        if (MODE != 0) {
#pragma unroll
            for (int t = 0; t < 2; ++t) { const int row = 2 * cv_tp + t; int grow;
                if (MODE == 2) grow = ROW_S + 64 * b + row; else { const int p = p0 + row; grow = prompt_row(b, p < TP ? p : TP - 1); }
                if (MODE == 2 || (row < nvalid && p0 >= NMETA)) {
                    const f32x4 h0 = *(const LAS f32x4*)(lds + RG_AB + (row * 132 + 8 * cv_c8) * 4), h1 = *(const LAS f32x4*)(lds + RG_AB + (row * 132 + 8 * cv_c8 + 4) * 4);
                    f32x4 g0, g1; pg8::unpack8(*(const u32x4*)(P.GRG + (size_t)grow * D + cg_v), g0, g1);
                    *(u32x4*)(P.HRG + (size_t)grow * D + cg_v) = pg8::pack8(h0 * g0, h1 * g1); } }
        }
        if (MODE == 0) __syncthreads();
    }
    if (MODE == 0) { if (sc_q == 0) *(f32x2*)(P.SEG + (((size_t)b * 3 + seg) * D + cg_s) * 2) = (f32x2){cA, hc}; }
    if (MODE == 1 && seg == 3) { if (sc_q == 0) P.out[O_PH + (size_t)b * D + cg_s] = hc; }
    __syncthreads();
}
constexpr int PA_KB = 64 * 384, PA_VB = 64 * 256;
constexpr int PA_K0 = 0, PA_V0 = 2 * PA_KB, PA_END = PA_V0 + 2 * PA_VB;
static_assert(PA_END <= MISC_OFF, "prompt attention lds");
__device__ __forceinline__ unsigned offK384(unsigned row, unsigned ch) { return 384u * row + 16u * (ch ^ ((row >> 1) & 7)); }
struct PAttnParams { const bf16 *QA, *KN, *KPE, *V; bf16* O; };

__device__ __forceinline__ void pattn_unit(const Frame& F, const PAttnParams& P, const int b, const int h, const int x) {
    LAS unsigned char* lds = F.lds;
    int lane = F.lane; asm volatile("" : "+v"(lane));
    const int w = F.wave, hh = lane >> 5, l31 = lane & 31;
#pragma nounroll
    for (int half = 0; half < 2; ++half) {
    const int xb = half ? 7 - x : x;
    const int tq = 256 * xb + 32 * w + l31;
    const size_t qrow = (size_t)b * SEQ + tq;
    bf16x8 qf[12];
#pragma unroll
    for (int s = 0; s < 12; ++s) qf[s] = *(const bf16x8*)(P.QA + qrow * 1536 + h * 192 + 16 * s + 8 * hh);
    f32x16 o[4];
#pragma unroll
    for (int i = 0; i < 4; ++i) o[i] = (f32x16){};
    float m = -1e30f, l = 0.f;
    const int ntiles = 1 + 4 * (xb + 1);
    unsigned ksrc[3], kstep[3], vsrc[2];
    const char* wsb = (const char*)P.KN - WS_KN;
#pragma unroll
    for (int i = 0; i < 3; ++i) { const unsigned pos = 1024u * (w + 8 * i) + 16u * lane, row = pos / 384u, chp = (pos % 384u) >> 4, ch = chp ^ ((row >> 1) & 7u);
        if (ch < 16) { ksrc[i] = (unsigned)WS_KN + (row * D + h * 128 + 8 * ch) * 2u; kstep[i] = D * 2; } else { ksrc[i] = (unsigned)WS_KPE + (row * 64 + 8 * (ch - 16)) * 2u; kstep[i] = 64 * 2; } }
#pragma unroll
    for (int i = 0; i < 2; ++i) { const unsigned pos = 1024u * (w + 8 * i) + 16u * lane, row = pos >> 8, chp = (pos & 255u) >> 4, ch = chp ^ (((row & 3) << 2) | ((row >> 2) & 3));
        vsrc[i] = (unsigned)WS_V + (row * D + h * 128 + 8 * ch) * 2u; }
    auto issue = [&](int it, int buf) {
        const unsigned row0 = it == 0 ? (unsigned)ROW_M : (unsigned)(b * SEQ + 64 * (it - 1));
#pragma unroll
        for (int i = 0; i < 3; ++i) __builtin_amdgcn_global_load_lds((const unsigned*)(wsb + (ksrc[i] + row0 * kstep[i])), (LAS unsigned*)(lds + PA_K0 + buf * PA_KB + 1024 * (w + 8 * i)), 16, 0, 0);
#pragma unroll
        for (int i = 0; i < 2; ++i) __builtin_amdgcn_global_load_lds((const unsigned*)(wsb + (vsrc[i] + row0 * (unsigned)(D * 2))), (LAS unsigned*)(lds + PA_V0 + buf * PA_VB + 1024 * (w + 8 * i)), 16, 0, 0);
    };
    issue(0, 0); VM_WAIT(); __syncthreads();
    constexpr float SC = SM_SCALE * LOG2E;
    const int trq = (lane & 15) >> 2, trp = lane & 3, trblk = (lane >> 4) & 1;
    unsigned kb4[4], vb8[2][4];
    { const unsigned sw = (l31 >> 1) & 7u, a = sw >> 1, c = sw & 1u;
#pragma unroll
      for (int v = 0; v < 4; ++v) kb4[v] = 384u * l31 + 16u * ((unsigned)hh ^ c) + 32u * ((unsigned)v ^ a);
      const unsigned clo = 2u * trblk + (trp >> 1);
#pragma unroll
      for (int t = 0; t < 2; ++t)
#pragma unroll
          for (int db = 0; db < 4; ++db) vb8[t][db] = 256u * (4u * hh + trq) + 8u * (trp & 1) + 16u * (clo ^ ((2u * t + hh) & 3u)) + 64u * ((unsigned)db ^ (unsigned)trq); }
#pragma nounroll
    for (int it = 0; it < ntiles; ++it) {
        const int buf = it & 1;
        if (it + 1 < ntiles) issue(it + 1, buf ^ 1);
        const int qmin = 256 * xb + 32 * w; const bool skip = (it > 0) && (64 * (it - 1) > qmin + 31);
        const int lim0 = (it == 0) ? NMETA : tq - 64 * (it - 1) + 1, lim1 = (it == 0) ? 0 : lim0 - 32;
        if (!skip) {
            f32x16 p0 = (f32x16){}, p1 = (f32x16){};
            const LAS unsigned char* Kb = lds + PA_K0 + buf * PA_KB;
#pragma unroll
            for (int sg = 0; sg < 6; ++sg) {
#pragma unroll
                for (int s = 2 * sg; s < 2 * sg + 2; ++s) { const bf16x8 a0 = *(const LAS bf16x8*)(Kb + kb4[s & 3] + 128 * (s >> 2)), a1 = *(const LAS bf16x8*)(Kb + kb4[s & 3] + 12288 + 128 * (s >> 2));
                    p0 = __builtin_amdgcn_mfma_f32_32x32x16_bf16(a0, qf[s], p0, 0, 0, 0); p1 = __builtin_amdgcn_mfma_f32_32x32x16_bf16(a1, qf[s], p1, 0, 0, 0); }
                __builtin_amdgcn_sched_barrier(0); }
            float pmax = -3e38f;
#pragma unroll
            for (int r = 0; r < 16; ++r) { const int kl = (r & 3) + 8 * (r >> 2) + 4 * hh;
                float x0 = p0[r] * SC, x1 = p1[r] * SC;
                x0 = kl < lim0 ? x0 : -3e38f; x1 = kl < lim1 ? x1 : -3e38f;
                p0[r] = x0; p1[r] = x1; pmax = fmaxf(pmax, fmaxf(x0, x1)); }
            pmax = fmaxf(pmax, __shfl_xor(pmax, 32));
            const float mn = fmaxf(m, pmax), alpha = fast_exp2(m - mn); m = mn;
            float ps = 0.f;
#pragma unroll
            for (int r = 0; r < 16; ++r) { p0[r] = fast_exp2(p0[r] - mn); p1[r] = fast_exp2(p1[r] - mn); ps += p0[r] + p1[r]; }
            l = l * alpha + ps;
#pragma unroll
            for (int i = 0; i < 4; ++i) o[i] = o[i] * alpha;
            const LAS unsigned char* Vb = lds + PA_V0 + buf * PA_VB;
#pragma unroll
            for (int kb = 0; kb < 2; ++kb)
#pragma unroll
                for (int s2 = 0; s2 < 2; ++s2) {
                    bf16x8 pf; { const f32x16& pp = kb ? p1 : p0; u32x4 t; t.x = cvt_pk_bf16(pp[8 * s2 + 0], pp[8 * s2 + 1]); t.y = cvt_pk_bf16(pp[8 * s2 + 2], pp[8 * s2 + 3]); t.z = cvt_pk_bf16(pp[8 * s2 + 4], pp[8 * s2 + 5]); t.w = cvt_pk_bf16(pp[8 * s2 + 6], pp[8 * s2 + 7]); pf = __builtin_bit_cast(bf16x8, t); }
#pragma unroll
                    for (int db = 0; db < 4; ++db) {
                        const s16x4 t0 = __builtin_amdgcn_ds_read_tr16_b64_v4i16((LAS s16x4*)(Vb + vb8[0][db] + 256 * (32 * kb + 16 * s2)));
                        const s16x4 t1 = __builtin_amdgcn_ds_read_tr16_b64_v4i16((LAS s16x4*)(Vb + vb8[1][db] + 256 * (32 * kb + 16 * s2 + 8)));
                        bf16x8 vf; vf[0] = t0[0]; vf[1] = t0[1]; vf[2] = t0[2]; vf[3] = t0[3]; vf[4] = t1[0]; vf[5] = t1[1]; vf[6] = t1[2]; vf[7] = t1[3];
                        o[db] = __builtin_amdgcn_mfma_f32_32x32x16_bf16(vf, pf, o[db], 0, 0, 0); }
                    __builtin_amdgcn_sched_barrier(0); }
        }
        VM_WAIT(); __syncthreads();
    }
    l += __shfl_xor(l, 32);
    const float il = 1.0f / l;
    bf16* orow = P.O + qrow * D + h * 128;
#pragma unroll
    for (int db = 0; db < 4; ++db)
#pragma unroll
        for (int rq = 0; rq < 4; ++rq) { u32x2 wv; wv.x = cvt_pk_bf16(o[db][4 * rq] * il, o[db][4 * rq + 1] * il); wv.y = cvt_pk_bf16(o[db][4 * rq + 2] * il, o[db][4 * rq + 3] * il);
            *(u32x2*)(orow + 32 * db + 8 * rq + 4 * hh) = wv; }
    __syncthreads();
    }
}
constexpr int SA_CKVB = 32 * 1024, SA_KPEB = 32 * 128;
constexpr int SA_CKV0 = 0, SA_KPE0 = 2 * SA_CKVB, SA_SB = SA_KPE0 + 2 * SA_KPEB, SA_PB = SA_SB + 64 * 36 * 4, SA_AL = SA_PB + 64 * 64, SA_END = SA_AL + 256;
constexpr int SA_QL = 0;
static_assert(64 * 576 * 2 <= SA_SB && SA_END <= MISC_OFF, "sample attention lds");
__device__ __forceinline__ unsigned off1024(unsigned row, unsigned ch) { return 1024u * row + 16u * (ch ^ (((row & 3) << 2) | ((row >> 2) & 3))); }
__device__ __forceinline__ unsigned offkpe(unsigned row, unsigned ch) { return 128u * row + 16u * (ch ^ ((row >> 1) & 7)); }
__device__ __forceinline__ unsigned offP(unsigned rho, unsigned ch) { return 64u * rho + 16u * (ch ^ ((rho >> 2) & 3)); }
struct SAttnParams { const float *cckv, *ckpe; const int* pt; const bf16 *QA, *WUKS, *CKVNS, *KPE; float *OPART, *ML; };

__device__ __forceinline__ void sattn_unit(const Frame& F, const SAttnParams& P, const int b, const int sp) {
    LAS unsigned char* lds = F.lds;
    int tid = F.tid; asm volatile("" : "+v"(tid));
    const int lane = tid & 63, w = F.wave, hh = lane >> 5, l31 = lane & 31, l15 = lane & 15, g = lane >> 4;
    {
        const int h = w;
        bf16x8 qa[4];
#pragma unroll
        for (int ks = 0; ks < 4; ++ks) qa[ks] = *(const bf16x8*)(P.QA + (size_t)(ROW_S + b * 8 + (l15 & 7)) * 1536 + h * 192 + 32 * ks + 8 * g);
        const bf16* wk = P.WUKS + ((size_t)h * 512 + l15) * 128 + 8 * g;
        for (int rb = 0; rb < 32; ++rb) {
            f32x4 acc = (f32x4){0.f, 0.f, 0.f, 0.f};
#pragma unroll
            for (int ks = 0; ks < 4; ++ks) { const bf16x8 bw = *(const bf16x8*)(wk + (size_t)rb * 16 * 128 + 32 * ks); acc = __builtin_amdgcn_mfma_f32_16x16x32_bf16(qa[ks], bw, acc, 0, 0, 0); }
            if (g < 2) {
#pragma unroll
                for (int e = 0; e < 4; ++e) *(LAS bf16*)(lds + SA_QL + ((h * 8 + 4 * g + e) * 576 + 16 * rb + l15) * 2) = (bf16)(cvt_pk_bf16(acc[e], 0.f) & 0xffffu);
            }
        }
        { const int rho = tid >> 3, c8 = tid & 7; const int hq = rho >> 3, j = rho & 7;
          *(LAS u32x4*)(lds + SA_QL + (rho * 576 + 512 + 8 * c8) * 2) = *(const u32x4*)(P.QA + (size_t)(ROW_S + b * 8 + j) * 1536 + hq * 192 + 128 + 8 * c8); }
    }
    __syncthreads();
#ifdef DBG_QLAT
    { bf16* dbg = (bf16*)((unsigned char*)P.OPART - WS_OPART + WS_U) + (size_t)(b * NSPLIT + sp) * 64 * 576;
      for (int i = tid; i < 64 * 576 / 8; i += NTHR) *(u32x4*)(dbg + i * 8) = *(const LAS u32x4*)(lds + SA_QL + i * 16); }
#endif
    const int kb = w & 1, rb = w >> 1;
    bf16x8 qb[18];
#pragma unroll
    for (int s = 0; s < 18; ++s) qb[s] = *(const LAS bf16x8*)(lds + SA_QL + ((16 * rb + l15) * 576 + 32 * s + 8 * g) * 2);
    __syncthreads();
    f32x16 o[2][2];
#pragma unroll
    for (int i = 0; i < 2; ++i)
#pragma unroll
        for (int j = 0; j < 2; ++j) o[i][j] = (f32x16){};
    const int srho = tid >> 3, skg = tid & 7;
    float m = -1e30f, l = 0.f;
    constexpr float SC = SM_SCALE * LOG2E;
    f32x4 cr[8], kr;
    auto issue = [&](int it) {
        const int page = 16 * sp + (it >> 2); const unsigned phys = (unsigned)P.pt[b * NPAGES + page]; const unsigned key0 = phys * PAGE + (unsigned)(it & 3) * 32u;
        const char* cbase = (const char*)P.cckv; const char* kbase = (const char*)P.ckpe;
#pragma unroll
        for (int i = 0; i < 4; ++i) { const unsigned off = ((key0 + (tid >> 6) + 8 * i) * KVL + 8 * (tid & 63)) * 4u; cr[2 * i] = *(const f32x4*)(cbase + off); cr[2 * i + 1] = *(const f32x4*)(cbase + off + 16); }
        kr = *(const f32x4*)(kbase + ((key0 + (tid >> 4)) * QKR + 4 * (tid & 15)) * 4u);
    };
    auto commit = [&](int buf) {
#pragma unroll
        for (int i = 0; i < 4; ++i) *(LAS u32x4*)(lds + SA_CKV0 + buf * SA_CKVB + off1024((tid >> 6) + 8 * i, tid & 63)) = pg8::pack8(cr[2 * i], cr[2 * i + 1]);
        u32x2 wv; wv.x = cvt_pk_bf16(kr[0], kr[1]); wv.y = cvt_pk_bf16(kr[2], kr[3]);
        *(LAS u32x2*)(lds + SA_KPE0 + buf * SA_KPEB + offkpe(tid >> 4, (tid & 15) >> 1) + 8 * (tid & 1)) = wv;
    };
    const int trq = l15 >> 2, trp = lane & 3, trblk = g & 1;
    unsigned sa4[4], ka2[2], va4[2][2], pa2[2];
    { const unsigned a = l15 & 3u, c = (l15 >> 2) & 3u, e = (l15 >> 1) & 7u, f = (l31 >> 2) & 3u, clo = 2u * trblk + (trp >> 1);
#pragma unroll
      for (int v = 0; v < 4; ++v) sa4[v] = 1024u * (16u * kb + l15) + 16u * ((unsigned)g ^ c) + 64u * ((unsigned)v ^ a);
#pragma unroll
      for (int s2 = 0; s2 < 2; ++s2) { ka2[s2] = offkpe(16u * kb + l15, 4u * s2 + g); pa2[s2] = offP(l31, 2u * s2 + hh); }
#pragma unroll
      for (int t = 0; t < 2; ++t)
#pragma unroll
          for (int db = 0; db < 2; ++db) va4[t][db] = 1024u * (8u * hh + 4u * t + trq) + 8u * (trp & 1) + 16u * (clo ^ ((2u * hh + t) & 3u)) + 64u * (((2u * (w & 1) + db) ^ (unsigned)trq)) + 256u * (w >> 1); }
    auto compute = [&](const int buf, const bool newtile) {
        {
            const LAS unsigned char* Cb = lds + SA_CKV0 + buf * SA_CKVB; const LAS unsigned char* Kb = lds + SA_KPE0 + buf * SA_KPEB;
            f32x4 acc = (f32x4){0.f, 0.f, 0.f, 0.f};
#pragma unroll
            for (int s = 0; s < 16; ++s) { const bf16x8 a = *(const LAS bf16x8*)(Cb + sa4[s & 3] + 256 * (s >> 2)); acc = __builtin_amdgcn_mfma_f32_16x16x32_bf16(a, qb[s], acc, 0, 0, 0);
                if ((s & 3) == 3) __builtin_amdgcn_sched_barrier(0); }
#pragma unroll
            for (int s = 0; s < 2; ++s) { const bf16x8 a = *(const LAS bf16x8*)(Kb + ka2[s]); acc = __builtin_amdgcn_mfma_f32_16x16x32_bf16(a, qb[16 + s], acc, 0, 0, 0); }
            *(LAS f32x4*)(lds + SA_SB + ((16 * rb + l15) * 36 + 16 * kb + 4 * g) * 4) = acc;
        }
        __syncthreads();
        {
            f32x4 v = *(const LAS f32x4*)(lds + SA_SB + (srho * 36 + 4 * skg) * 4) * SC;
            if (newtile) {
#pragma unroll
                for (int e = 0; e < 4; ++e) if (4 * skg + e > (srho & 7)) v[e] = -3e38f;
            }
            float tm = fmaxf(fmaxf(v[0], v[1]), fmaxf(v[2], v[3]));
            tm = fmaxf(tm, __shfl_xor(tm, 1)); tm = fmaxf(tm, __shfl_xor(tm, 2)); tm = fmaxf(tm, __shfl_xor(tm, 4));
            const float mn = fmaxf(m, tm), alpha = fast_exp2(m - mn); m = mn;
#pragma unroll
            for (int e = 0; e < 4; ++e) v[e] = fast_exp2(v[e] - mn);
            float ps = (v[0] + v[1]) + (v[2] + v[3]);
            ps += __shfl_xor(ps, 1); ps += __shfl_xor(ps, 2); ps += __shfl_xor(ps, 4);
            l = l * alpha + ps;
            u32x2 wv; wv.x = cvt_pk_bf16(v[0], v[1]); wv.y = cvt_pk_bf16(v[2], v[3]);
            *(LAS u32x2*)(lds + SA_PB + offP(srho, skg >> 1) + 8 * (skg & 1)) = wv;
            if (skg == 0) *(LAS float*)(lds + SA_AL + srho * 4) = alpha;
        }
    };
    auto pv = [&](const int buf) {
        const LAS unsigned char* Cb = lds + SA_CKV0 + buf * SA_CKVB;
        const float a0 = *(const LAS float*)(lds + SA_AL + l31 * 4), a1 = *(const LAS float*)(lds + SA_AL + (32 + l31) * 4);
#pragma unroll
        for (int db = 0; db < 2; ++db) { o[db][0] = o[db][0] * a0; o[db][1] = o[db][1] * a1; }
#pragma unroll
        for (int s2 = 0; s2 < 2; ++s2) {
            const bf16x8 pb0 = *(const LAS bf16x8*)(lds + SA_PB + pa2[s2]), pb1 = *(const LAS bf16x8*)(lds + SA_PB + pa2[s2] + 2048);
#pragma unroll
            for (int db = 0; db < 2; ++db) {
                const s16x4 t0 = __builtin_amdgcn_ds_read_tr16_b64_v4i16((LAS s16x4*)(Cb + va4[0][db] + 16384 * s2));
                const s16x4 t1 = __builtin_amdgcn_ds_read_tr16_b64_v4i16((LAS s16x4*)(Cb + va4[1][db] + 16384 * s2));
                bf16x8 vf; vf[0] = t0[0]; vf[1] = t0[1]; vf[2] = t0[2]; vf[3] = t0[3]; vf[4] = t1[0]; vf[5] = t1[1]; vf[6] = t1[2]; vf[7] = t1[3];
                o[db][0] = __builtin_amdgcn_mfma_f32_32x32x16_bf16(vf, pb0, o[db][0], 0, 0, 0);
                o[db][1] = __builtin_amdgcn_mfma_f32_32x32x16_bf16(vf, pb1, o[db][1], 0, 0, 0); } }
    };
    constexpr int NT = (PAST / NSPLIT) / 32;
    issue(0); commit(0); issue(1); __syncthreads();
#pragma nounroll
    for (int it = 0; it < NT; ++it) {
        const int buf = it & 1;
        compute(buf, false);
        if (it + 1 < NT) { commit(buf ^ 1); if (it + 2 < NT) issue(it + 2); }
        __syncthreads();
        pv(buf);
    }
    if (sp == NSPLIT - 1) {
        __syncthreads();
        { const char* wsb = (const char*)P.KPE - WS_KPE;
#pragma nounroll
          for (int i = tid; i < 32 * 64; i += NTHR) { const int key = i >> 6, ch = i & 63; u32x4 v = (u32x4){0u, 0u, 0u, 0u}; if (key < DS) v = *(const u32x4*)(wsb + ((unsigned)WS_CKVNS + (unsigned)(((b * DS + key) * KVL + 8 * ch) * 2)));
            *(LAS u32x4*)(lds + SA_CKV0 + off1024(key, ch)) = v; }
          if (tid < 32 * 8) { const int key = tid >> 3, ch = tid & 7; u32x4 v = (u32x4){0u, 0u, 0u, 0u}; if (key < DS) v = *(const u32x4*)(wsb + ((unsigned)WS_KPE + (unsigned)(((ROW_S + b * DS + key) * 64 + 8 * ch) * 2)));
            *(LAS u32x4*)(lds + SA_KPE0 + offkpe(key, ch)) = v; } }
        __syncthreads();
        compute(0, true);
        __syncthreads();
        pv(0);
    }
    float* op = P.OPART + ((size_t)(b * NSPLIT + sp) * 64) * KVL;
#pragma unroll
    for (int db = 0; db < 2; ++db)
#pragma unroll
        for (int rbk = 0; rbk < 2; ++rbk)
#pragma unroll
            for (int rq = 0; rq < 4; ++rq) *(f32x4*)(op + (size_t)(32 * rbk + l31) * KVL + 64 * w + 32 * db + 8 * rq + 4 * hh) = (f32x4){o[db][rbk][4 * rq], o[db][rbk][4 * rq + 1], o[db][rbk][4 * rq + 2], o[db][rbk][4 * rq + 3]};
    if (skg == 0) *(f32x2*)(P.ML + ((size_t)(b * NSPLIT + sp) * 64 + srho) * 2) = (f32x2){m, l};
    __syncthreads();
}

struct SCombParams { const float *OPART, *ML, *w_uv; bf16* O; };
__device__ __forceinline__ void scomb_unit(const Frame& F, const SCombParams& P, const int b, const int h) {
    LAS float* OL = (LAS float*)F.lds;
    int tid = F.tid; asm volatile("" : "+v"(tid));
    {
        const int r = tid;
#pragma unroll
        for (int j = 0; j < 8; ++j) { const int rho = h * 8 + j; float mm[NSPLIT], ll[NSPLIT], M = -3e38f;
#pragma unroll
            for (int s = 0; s < NSPLIT; ++s) { const f32x2 v = *(const f32x2*)(P.ML + ((size_t)(b * NSPLIT + s) * 64 + rho) * 2); mm[s] = v.x; ll[s] = v.y; M = fmaxf(M, v.x); }
            float L = 0.f, acc = 0.f;
#pragma unroll
            for (int s = 0; s < NSPLIT; ++s) { const float wgt = fast_exp2(mm[s] - M); L += wgt * ll[s]; acc += wgt * P.OPART[((size_t)(b * NSPLIT + s) * 64 + rho) * KVL + r]; }
            OL[j * 512 + r] = acc / L; }
    }
    __syncthreads();
    {
        const int d = tid & 127, jg = tid >> 7; float a0 = 0.f, a1 = 0.f;
        const float* wp = P.w_uv + h * 128 + d;
#pragma unroll 8
        for (int r = 0; r < 512; ++r) { const float wv = wp[(size_t)r * 1024]; a0 += OL[(2 * jg) * 512 + r] * wv; a1 += OL[(2 * jg + 1) * 512 + r] * wv; }
        P.O[(size_t)(ROW_S + b * 8 + 2 * jg) * D + h * 128 + d] = (bf16)(cvt_pk_bf16(a0, 0.f) & 0xffffu);
        P.O[(size_t)(ROW_S + b * 8 + 2 * jg + 1) * D + h * 128 + d] = (bf16)(cvt_pk_bf16(a1, 0.f) & 0xffffu);
    }
    __syncthreads();
}
__device__ __forceinline__ void thin_ckv_conv(const Frame& F, const Args& args) {
    unsigned char* ws = F.ws; float* out = F.out;
    const int gw = F.vcu * NWAVES + F.wave, NGW = F.G * NWAVES, lane = F.lane;
    const bf16* CKVR = (const bf16*)(ws + WS_CKVR); const float* SSQ = (const float*)(ws + WS_SSQKV); const bf16* RX = (const bf16*)(ws + WS_RX);
    const f32x4 g0 = *(const f32x4*)(IN_F(I_KVG) + 8 * lane), g1 = *(const f32x4*)(IN_F(I_KVG) + 8 * lane + 4);
    for (int row = gw; row < ROW_M + NMETA; row += NGW) {
        const f32x4 s0 = *(const f32x4*)(SSQ + (size_t)row * 8), s1 = *(const f32x4*)(SSQ + (size_t)row * 8 + 4);
        const float ss = ((s0[0] + s0[1]) + (s0[2] + s0[3])) + ((s1[0] + s1[1]) + (s1[2] + s1[3]));
        const float rstd = 1.0f / sqrtf(ss * (1.0f / KVL) + EPS);
        f32x4 v0, v1; pg8::unpack8(*(const u32x4*)(CKVR + (size_t)row * KVL + 8 * lane), v0, v1);
        v0 = v0 * rstd * g0; v1 = v1 * rstd * g1;
        if (row < ROW_S) { float* o = out + O_PCKV + ((size_t)(row >> 11) * TP + NMETA + (row & (SEQ - 1))) * KVL + 8 * lane; *(f32x4*)o = v0; *(f32x4*)(o + 4) = v1; }
        else if (row < ROW_M) { float* o = out + O_SCKV + (size_t)(row - ROW_S) * KVL + 8 * lane; *(f32x4*)o = v0; *(f32x4*)(o + 4) = v1;
            *(u32x4*)((bf16*)(ws + WS_CKVNS) + (size_t)(row - ROW_S) * KVL + 8 * lane) = pg8::pack8(v0, v1); }
        else { for (int b = 0; b < NB; ++b) { float* o = out + O_PCKV + ((size_t)b * TP + (row - ROW_M)) * KVL + 8 * lane; *(f32x4*)o = v0; *(f32x4*)(o + 4) = v1; } }
    }
    for (int i = gw; i < NB * 3 + DB * 3; i += NGW) {
        int srow; float* o;
        if (i < NB * 3) { const int b = i / 3, k = i % 3; srow = b * SEQ + SEQ - 3 + k; o = out + O_PCONV + (size_t)i * D; }
        else { const int q = i - NB * 3, b = q / 3, k = q % 3; srow = ROW_S + b * DS + DS - 3 + k; o = out + O_SCONV + (size_t)q * D; }
#pragma unroll
        for (int j = 0; j < 2; ++j) { f32x4 v0, v1; pg8::unpack8(*(const u32x4*)(RX + (size_t)srow * D + 8 * (lane + 64 * j)), v0, v1); *(f32x4*)(o + 8 * (lane + 64 * j)) = v0; *(f32x4*)(o + 8 * (lane + 64 * j) + 4) = v1; }
    }
}

constexpr int NPHASES = 11;
__global__ void __launch_bounds__(NTHR, 2) hawk_fwd(Args args) {
    extern __shared__ __attribute__((aligned(16))) unsigned char lds_raw[];
    Frame F;
    F.lds = (LAS unsigned char*)lds_raw; F.MISC = (volatile LAS unsigned*)(F.lds + MISC_OFF);
    F.tid = threadIdx.x; F.lane = F.tid & 63; F.wave = __builtin_amdgcn_readfirstlane(F.tid >> 6);
    F.G = gridDim.x; { const int bx = blockIdx.x; F.vcu = (F.G % 8 == 0) ? (bx % 8) * (F.G / 8) + bx / 8 : bx; }
    F.out = args.out; F.ws = args.ws; F.ctl = (unsigned*)(args.ws + WS_CTL);
    unsigned char* ws = args.ws;
    for (int u = F.tid; u < 64; u += NTHR) ((LAS unsigned*)(F.lds + MISC_OFF))[u] = 0u;
    __syncthreads();
#if MK_PER_PHASE
#define GRID_BAR() do { } while (0)
#else
    XcdBarrier bar = xcd_barrier_post((unsigned*)F.ctl + CW_BAR, F.MISC + 8);
#define GRID_BAR() xcd_barrier(bar)
#endif
    const int lo = args.ph_lo, hi = args.ph_hi;
#ifndef PH_MASK
#define PH_MASK 0x7ff
#endif
#define IN(k) ((((PH_MASK) >> (k)) & 1) && lo <= (k) && (k) < hi)
#define SEAM(k) do { if (IN(k) && IN((k) + 1)) GRID_BAR(); } while (0)
    const int G = F.G, bx = blockIdx.x;

    if (IN(0)) { p0_prologue(F, args); }
    SEAM(0);
    if (IN(1)) {
        pg8::TileSched S; S.init(ws + WS_H, ws + WS_WIN, D, 66, 22, G, bx);
        pg8::EpiWin E{(bf16*)(ws + WS_RX), (bf16*)(ws + WS_GRG), (bf16*)(ws + WS_CQ), (bf16*)(ws + WS_CKVR), (bf16*)(ws + WS_G), (bf16*)(ws + WS_KPE), (float*)(ws + WS_SSQQ), (float*)(ws + WS_SSQKV),
                      IN_F(I_BGATE), (const float*)(ws + WS_ROPEC), (const float*)(ws + WS_ROPES), F.out};
        pg8::gemm_phase<pg8::EpiWin, pg8::TileSched, true, true>(F.lds, D, S, E);
    }
    SEAM(1);
    const RgParams RGP{(const bf16*)(ws + WS_RX), (const bf16*)(ws + WS_GRG), (const bf16*)(ws + WS_WAX), (bf16*)(ws + WS_HRG), IN_F(I_CONVW), IN_F(I_CONVB), IN_F(I_BA), IN_F(I_BX),
                       (const float*)(ws + WS_SPL), IN_F(I_SCONV), IN_F(I_SRG), (float*)(ws + WS_SEG), F.out};
    if (IN(2)) {
        for (int u = F.vcu; u < 192; u += G) rg_unit<0>(F, RGP, u / 24, (u / 3) % 8, u % 3);
        { pg8::TileSched S; S.init(ws + WS_CQ, ws + WS_WQ, QL, 65, 6, G, bx);
          pg8::EpiQ E{(bf16*)(ws + WS_QA), (const float*)(ws + WS_SSQQ), (const float*)(ws + WS_ROPEC), (const float*)(ws + WS_ROPES)};
          pg8::gemm_phase<pg8::EpiQ, pg8::TileSched, true, true>(F.lds, QL, S, E); }
        { pg8::TileSched S; S.init(ws + WS_CKVR, ws + WS_WKV, KVL, 65, 8, G, bx ^ 0xF8, 64, 1);
          pg8::EpiKV E{(bf16*)(ws + WS_KN), (bf16*)(ws + WS_V), (const float*)(ws + WS_SSQKV)};
          pg8::gemm_phase<pg8::EpiKV, pg8::TileSched, true, true>(F.lds, KVL, S, E); }
        thin_ckv_conv(F, args);
    }
    SEAM(2);
    if (IN(3)) {
        const PAttnParams PA{(const bf16*)(ws + WS_QA), (const bf16*)(ws + WS_KN), (const bf16*)(ws + WS_KPE), (const bf16*)(ws + WS_V), (bf16*)(ws + WS_O)};
        const SAttnParams SA{IN_F(I_CCKV), IN_F(I_CKPE), (const int*)args.in[I_PT], (const bf16*)(ws + WS_QA), (const bf16*)(ws + WS_WUKS), (const bf16*)(ws + WS_CKVNS), (const bf16*)(ws + WS_KPE),
                             (float*)(ws + WS_OPART), (float*)(ws + WS_ML)};
        const bool sfirst = (F.vcu & 1) == 0;
#ifndef P3_MASK
#define P3_MASK 7
#endif
#pragma nounroll
        for (int ph = 0; ph < 2; ++ph) {
            if ((ph == 0) == sfirst) { if (P3_MASK & 1) for (int u = F.vcu; u < DB * NSPLIT; u += G) sattn_unit(F, SA, u / NSPLIT, u % NSPLIT); }
            else { if (P3_MASK & 2) for (int u = F.vcu; u < 256; u += G) { const int bh = u >> 2; pattn_unit(F, PA, bh >> 3, bh & 7, u & 3); } }
        }
        if (P3_MASK & 4) for (int u = F.vcu; u < 256; u += G) rg_unit<1>(F, RGP, u >> 5, (u >> 2) & 7, u & 3);
        if (P3_MASK & 4) for (int u = F.vcu; u < 32; u += G) rg_unit<2>(F, RGP, u >> 3, u & 7, 0);
    }
    SEAM(3);
    if (IN(4)) {
        const SCombParams SC{(const float*)(ws + WS_OPART), (const float*)(ws + WS_ML), IN_F(I_WUV), (bf16*)(ws + WS_O)};
        for (int u = F.vcu; u < DB * NH; u += G) scomb_unit(F, SC, u >> 3, u & 7);
    }
    SEAM(4);
    if (IN(5)) {
        { pg8::TileSched S; S.init(ws + WS_HRG, ws + WS_WBRR, D, 65, 4, G, bx); pg8::EpiZ<0> E{(bf16*)(ws + WS_MIX), (const bf16*)(ws + WS_G)};
          pg8::gemm_phase<pg8::EpiZ<0>, pg8::TileSched, true, true>(F.lds, D, S, E); }
        { pg8::TileSched S; S.init(ws + WS_O, ws + WS_WBRM, D, 65, 4, G, bx); pg8::EpiZ<1> E{(bf16*)(ws + WS_MIX), (const bf16*)(ws + WS_G)};
          pg8::gemm_phase<pg8::EpiZ<1>, pg8::TileSched, true, true>(F.lds, D, S, E); }
    }
    SEAM(5);
    if (IN(6)) {
        pg8::TileSched S; S.init(ws + WS_MIX, ws + WS_WO, D, 65, 4, G, bx); pg8::EpiRes E{(float*)(ws + WS_PRE), (const bf16*)(ws + WS_H), nullptr};
        pg8::gemm_phase<pg8::EpiRes, pg8::TileSched, true, true>(F.lds, D, S, E);
    }
    SEAM(6);
    if (IN(7)) {
        const int gw = F.vcu * NWAVES + F.wave, NGW = G * NWAVES;
        for (int row = gw; row < ROW_M; row += NGW) ln_row((const float*)(ws + WS_PRE) + (size_t)row * D, IN_F(I_LN1G), IN_F(I_LN1B), (bf16*)(ws + WS_X1) + (size_t)row * D, nullptr, F.lane);
    }
    SEAM(7);
    if (IN(8)) {
        pg8::TileSched S; S.init(ws + WS_X1, ws + WS_WUP, D, 65, 16, G, bx); pg8::EpiUp E{(bf16*)(ws + WS_U), IN_F(I_BUP)};
        pg8::gemm_phase<pg8::EpiUp, pg8::TileSched, true, true>(F.lds, D, S, E);
    }
    SEAM(8);
    if (IN(9)) {
        pg8::TileSched S; S.init(ws + WS_U, ws + WS_WDN, DFF, 65, 4, G, bx); pg8::EpiRes E{(float*)(ws + WS_PRE), (const bf16*)(ws + WS_X1), IN_F(I_BDN)};
        pg8::gemm_phase<pg8::EpiRes, pg8::TileSched, true, true>(F.lds, DFF, S, E);
    }
    SEAM(9);
    if (IN(10)) {
        const int gw = F.vcu * NWAVES + F.wave, NGW = G * NWAVES;
        for (int row = gw; row < ROW_M; row += NGW) { float* o = row < ROW_S ? F.out + O_YP + (size_t)row * D : F.out + O_YS + (size_t)(row - ROW_S) * D;
            ln_row((const float*)(ws + WS_PRE) + (size_t)row * D, IN_F(I_LN2G), IN_F(I_LN2B), nullptr, o, F.lane); }
    }
#ifdef DBG_DUMP_OFF
    if (lo == 99) {
#ifdef DBG_DUMP_F32
        const float* srcf = (const float*)(ws + (size_t)(DBG_DUMP_OFF));
        for (size_t i = (size_t)F.vcu * NTHR + F.tid; i < (size_t)(DBG_DUMP_F32) / 4; i += (size_t)G * NTHR) *(f32x4*)(F.out + i * 4) = *(const f32x4*)(srcf + i * 4);
#else
#ifndef DBG_DUMP_N
#define DBG_DUMP_N ((size_t)ROW_M * D)
#endif
        const bf16* src = (const bf16*)(ws + (size_t)(DBG_DUMP_OFF));
        for (size_t i = (size_t)F.vcu * NTHR + F.tid; i < (size_t)(DBG_DUMP_N) / 8; i += (size_t)G * NTHR) { f32x4 v0, v1; pg8::unpack8(*(const u32x4*)(src + i * 8), v0, v1); *(f32x4*)(F.out + i * 8) = v0; *(f32x4*)(F.out + i * 8 + 4) = v1; }
#endif
    }
#endif
#undef IN
#undef SEAM
}

extern "C" void kernel_launch(void* const* d_in, const int* in_sizes, int n_in, void* d_out, int out_size, void* d_ws, size_t ws_size, hipStream_t stream) {
    static int grid = 0;
    if (grid == 0) {
        if (n_in != 35 || out_size != (int)O_END || ws_size < WS_END) { fprintf(stderr, "kernel_launch: unexpected shapes (n_in %d, out %d, ws %zu, need %zu)\n", n_in, out_size, ws_size, (size_t)WS_END); grid = -1; return; }
        int dev = 0, cus = 0, per_cu = 0;
        if (hipGetDevice(&dev) != hipSuccess || hipDeviceGetAttribute(&cus, hipDeviceAttributeMultiprocessorCount, dev) != hipSuccess) { grid = -1; return; }
        if (hipFuncSetAttribute((const void*)hawk_fwd, hipFuncAttributeMaxDynamicSharedMemorySize, LDS_BYTES) != hipSuccess) { fprintf(stderr, "kernel_launch: hipFuncSetAttribute failed\n"); grid = -1; return; }
        if (hipOccupancyMaxActiveBlocksPerMultiprocessor(&per_cu, (const void*)hawk_fwd, NTHR, LDS_BYTES) != hipSuccess || per_cu < 1) fprintf(stderr, "kernel_launch: occupancy query reports %d\n", per_cu);
        (void)hipGetLastError();
        grid = cus;
    }
    if (grid < 0) return;
    if (hipMemsetAsync((char*)d_ws + WS_CTL, 0, CTL_BYTES, stream) != hipSuccess) return;
    Args a{};
    for (int i = 0; i < 35; ++i) a.in[i] = d_in[i];
    a.out = (float*)d_out; a.ws = (unsigned char*)d_ws;
#if MK_PER_PHASE
#ifndef DBG_LAST_PHASE
#define DBG_LAST_PHASE (NPHASES - 1)
#endif
    if (DBG_LAST_PHASE < NPHASES - 1) (void)hipMemsetAsync(d_out, 0, (size_t)out_size * 4, stream);
    for (int p = 0; p <= DBG_LAST_PHASE; ++p) { a.ph_lo = p; a.ph_hi = p + 1; hipLaunchKernelGGL(hawk_fwd, dim3(grid), dim3(NTHR), LDS_BYTES, stream, a); }
#ifdef DBG_DUMP_OFF
    a.ph_lo = 99; a.ph_hi = 100; hipLaunchKernelGGL(hawk_fwd, dim3(grid), dim3(NTHR), LDS_BYTES, stream, a);
#endif
#else
    a.ph_lo = 0; a.ph_hi = NPHASES;
    hipLaunchKernelGGL(hawk_fwd, dim3(grid), dim3(NTHR), LDS_BYTES, stream, a);
#endif
}
```

```cpp
#include <hip/hip_runtime.h>
#include <cstdio>
#include <cstdint>

#ifndef MK_PER_PHASE
#define MK_PER_PHASE 0
#endif

#define GAS __attribute__((address_space(1)))
#define LAS __attribute__((address_space(3)))
typedef unsigned short bf16;
typedef short bf16x8 __attribute__((ext_vector_type(8)));
typedef short s16x4 __attribute__((ext_vector_type(4)));
typedef float f32x2 __attribute__((ext_vector_type(2)));
typedef float f32x4 __attribute__((ext_vector_type(4)));
typedef float f32x16 __attribute__((ext_vector_type(16)));
typedef unsigned u32x2 __attribute__((ext_vector_type(2)));
typedef unsigned u32x4 __attribute__((ext_vector_type(4)));

constexpr int D = 1024, NB = 8, SEQ = 2048, NMETA = 16, TP = SEQ + NMETA;
constexpr int DB = 32, DS = 8, PAST = 16384, PAGE = 128, NPAGES = PAST / PAGE;
constexpr int NH = 8, QKN = 128, QKR = 64, VH = 128, KVL = 512, QL = 768, DFF = 4096;
constexpr int NIN = 5440, NINP = 5632;
constexpr int ROW_S = NB * SEQ;
constexpr int ROW_M = ROW_S + DB * DS;
constexpr int R = 16896;
constexpr float EPS = 1e-5f;
constexpr float DN_ALPHA = 1.189207115002721f;
constexpr float SM_SCALE = 0.07216878364870322f;
constexpr float LOG2E = 1.4426950408889634f;
constexpr int NROPE = TP + DS;
constexpr int NSPLIT = 8;

constexpr size_t O_YP = 0, O_YS = O_YP + (size_t)NB * SEQ * D, O_PCKV = O_YS + (size_t)DB * DS * D, O_PKPE = O_PCKV + (size_t)NB * TP * KVL,
    O_PCONV = O_PKPE + (size_t)NB * TP * QKR, O_PH = O_PCONV + (size_t)NB * 3 * D, O_SCKV = O_PH + (size_t)NB * D, O_SKPE = O_SCKV + (size_t)DB * DS * KVL,
    O_SCONV = O_SKPE + (size_t)DB * DS * QKR, O_SH = O_SCONV + (size_t)DB * 3 * D, O_END = O_SH + (size_t)DB * D;
static_assert(O_END == 26861568, "output size");

constexpr size_t al256(size_t x) { return (x + 255) & ~(size_t)255; }
constexpr size_t WS_CTL = 0, CTL_BYTES = 1u << 20;
constexpr size_t WS_WIN = CTL_BYTES;
constexpr size_t WS_WQ = WS_WIN + al256((size_t)NINP * D * 2);
constexpr size_t WS_WKV = WS_WQ + al256((size_t)1536 * QL * 2);
constexpr size_t WS_WBRR = WS_WKV + al256((size_t)2048 * KVL * 2);
constexpr size_t WS_WBRM = WS_WBRR + al256((size_t)D * D * 2);
constexpr size_t WS_WO = WS_WBRM + al256((size_t)D * D * 2);
constexpr size_t WS_WUP = WS_WO + al256((size_t)D * D * 2);
constexpr size_t WS_WDN = WS_WUP + al256((size_t)DFF * D * 2);
constexpr size_t WS_WAX = WS_WDN + al256((size_t)DFF * D * 2);
constexpr size_t WS_WUKS = WS_WAX + al256((size_t)8 * 256 * 128 * 2);
constexpr size_t WS_ROPEC = WS_WUKS + al256((size_t)8 * 512 * 128 * 2);
constexpr size_t WS_ROPES = WS_ROPEC + al256((size_t)NROPE * 32 * 4);
constexpr size_t WS_SPL = WS_ROPES + al256((size_t)NROPE * 32 * 4);
constexpr size_t WS_H = WS_SPL + al256(4096);
constexpr size_t WS_RX = WS_H + al256((size_t)R * D * 2);
constexpr size_t WS_GRG = WS_RX + al256((size_t)R * D * 2);
constexpr size_t WS_CQ = WS_GRG + al256((size_t)R * D * 2);
constexpr size_t WS_CKVR = WS_CQ + al256((size_t)R * QL * 2);
constexpr size_t WS_G = WS_CKVR + al256((size_t)R * KVL * 2);
constexpr size_t WS_KPE = WS_G + al256((size_t)R * 2048 * 2);
constexpr size_t WS_SSQQ = WS_KPE + al256((size_t)R * 64 * 2);
constexpr size_t WS_SSQKV = WS_SSQQ + al256((size_t)R * 12 * 4);
constexpr size_t WS_QA = WS_SSQKV + al256((size_t)R * 8 * 4);
constexpr size_t WS_KN = WS_QA + al256((size_t)R * 1536 * 2);
constexpr size_t WS_V = WS_KN + al256((size_t)R * D * 2);
constexpr size_t WS_CKVNS = WS_V + al256((size_t)R * D * 2);
constexpr size_t WS_SEG = WS_CKVNS + al256((size_t)256 * KVL * 2);
constexpr size_t WS_HRG = WS_SEG + al256((size_t)8 * 3 * 1024 * 2 * 4);
constexpr size_t WS_O = WS_HRG + al256((size_t)R * D * 2);
constexpr size_t WS_OPART = WS_O + al256((size_t)R * D * 2);
constexpr size_t WS_ML = WS_OPART + al256((size_t)DB * NSPLIT * 64 * 512 * 4);
constexpr size_t WS_MIX = WS_ML + al256((size_t)DB * NSPLIT * 64 * 2 * 4);
constexpr size_t WS_PRE = WS_MIX + al256((size_t)R * D * 2);
constexpr size_t WS_X1 = WS_PRE + al256((size_t)R * D * 4);
constexpr size_t WS_U = WS_X1 + al256((size_t)R * D * 2);
constexpr size_t WS_END = WS_U + al256((size_t)R * DFF * 2);
static_assert(WS_END < (1ull << 32), "32-bit workspace offsets");

constexpr int CW_BAR = 4096;

constexpr int LDS_BYTES = 147456;
constexpr int MISC_OFF = 135168;
constexpr int NWAVES = 8, NTHR = 512;

__device__ __forceinline__ float bf2f(unsigned short b) { return __uint_as_float(((unsigned)b) << 16); }
__device__ __forceinline__ float bflo(unsigned w) { return __uint_as_float(w << 16); }
__device__ __forceinline__ float bfhi(unsigned w) { return __uint_as_float(w & 0xffff0000u); }
typedef __bf16 bf16x2_t __attribute__((ext_vector_type(2)));
__device__ __forceinline__ unsigned cvt_pk_bf16(float lo, float hi) { const f32x2 v = {lo, hi}; return __builtin_bit_cast(unsigned, __builtin_convertvector(v, bf16x2_t)); }
__device__ __forceinline__ float fast_exp2(float x) { return __builtin_amdgcn_exp2f(x); }
__device__ __forceinline__ float fast_rcp(float x) { return __builtin_amdgcn_rcpf(x); }
__device__ __forceinline__ float sigmoidf_(float x) { return fast_rcp(1.0f + fast_exp2(-x * LOG2E)); }
__device__ __forceinline__ float gelu_tanh(float x) { const float y = 0.7978845608028654f * (x + 0.044715f * x * x * x); return x * fast_rcp(1.0f + fast_exp2(-2.0f * LOG2E * y)); }
__device__ __forceinline__ float wave_sum(float v) {
#pragma unroll
    for (int o = 1; o < 64; o <<= 1) v += __shfl_xor(v, o);
    return v;
}
#define LDS_WAIT() asm volatile("s_waitcnt lgkmcnt(0)" ::: "memory")
#define VM_WAIT() asm volatile("s_waitcnt vmcnt(0)" ::: "memory")
namespace pg8 {
#define PG8_LAS __attribute__((address_space(3)))
constexpr int BM = 256, BK = 64, HALF = 128, HTB = HALF * BK * 2  , STAGE_BYTES = 8 * HTB, NXCD = 8, WGM = 8;
__host__ __device__ __forceinline__ int lds_byte(int r, int c) { const int st = (r >> 4) * 2 + (c >> 5), rr = r & 15, cc = c & 31, ob = rr * 64 + cc * 2; return st * 1024 + (ob ^ (((ob >> 9) & 1) << 5)); }
__host__ __device__ __forceinline__ void stage_rc(int b, int& R, int& C) { const int st = b / 1024, sb = b % 1024, swz = sb ^ (((sb >> 9) & 1) << 5); R = (st >> 1) * 16 + swz / 64; C = (st & 1) * 32 + (swz % 64) / 2; }
__host__ __device__ __forceinline__ int perm32(int rho) { const int n = rho >> 4, i = rho & 15; return 8 * (i >> 2) + 4 * n + (i & 3); }

struct Unit { const char* A; const char* B; int pm, pn; };

struct TileSched {
    const char* A; const char* B; size_t aT, bT; int nM, nN, nwg, G, c, rm_from, rm_add;
    __device__ __forceinline__ void init(const void* A_, const void* B_, int K, int nM_, int nN_, int G_, int c_, int rm_from_ = 1 << 30, int rm_add_ = 0) {
        A = (const char*)A_; B = (const char*)B_; aT = (size_t)BM * K * 2; bT = aT; nM = nM_; nN = nN_; nwg = nM * nN; G = G_; c = c_; rm_from = rm_from_; rm_add = rm_add_; }
    __device__ __forceinline__ bool next(int i, Unit& u) const {
        const long L = (long)i * G + c; if (L >= nwg) return false;
        int wgid = (int)L; { const int q = nwg / NXCD, r = nwg % NXCD, xcd = wgid % NXCD, off = wgid / NXCD; wgid = (xcd < r ? xcd * (q + 1) : r * (q + 1) + (xcd - r) * q) + off; }
        const int nig = WGM * nN, gid = wgid / nig, fm = gid * WGM, gsz = (nM - fm) < WGM ? (nM - fm) : WGM;
        int pm = fm + ((wgid % nig) % gsz); const int pn = (wgid % nig) / gsz; if (pm >= rm_from) pm += rm_add;
        u.pm = pm; u.pn = pn; u.A = A + (size_t)pm * aT; u.B = B + (size_t)pn * bT; return true;
    }
    __device__ __forceinline__ void a_ready(const Unit&) const {}
    __device__ __forceinline__ void done(const Unit&) const {}
};
template <class Epi, class Sched, bool ALIGN_EPI = false, bool SP2 = false>
__device__ __forceinline__ void gemm_phase(PG8_LAS unsigned char* lds, const int K, const Sched& S, const Epi& E) {
    const int tid = threadIdx.x, wid = __builtin_amdgcn_readfirstlane(tid >> 6), lane = tid & 63, wr = wid >> 2, wc = wid & 3, fr = lane & 15, fq = lane >> 4;
    const int nt = K / BK;
    unsigned voffA[2], voffB[2];
#pragma unroll
    for (int i = 0; i < 2; ++i) { int R, C; stage_rc(tid * 16 + i * 8192, R, C); const int Rb = Epi::PERM ? ((R & ~31) + perm32(R & 31)) : R;
        voffA[i] = (unsigned)(R * K + C) * 2u; voffB[i] = (unsigned)(Rb * K + C) * 2u; }
    const size_t kstep = (size_t)(BK * 2);
    const size_t hstep = (size_t)HALF * K * 2;
    const unsigned ldsw = (unsigned)wid * 1024u;
    const int aoff = lds_byte(wr * 64 + fr, fq * 8), boff = lds_byte(wc * 32 + fr, fq * 8);
#define PG8_SA(b, h) (((b) * 2 + (h)) * HTB)
#define PG8_SB(b, h) ((4 + (b) * 2 + (h)) * HTB)
#define PG8_STAGE(bufoff, gbase, voff) do { _Pragma("unroll") for (int _i = 0; _i < 2; ++_i) \
        __builtin_amdgcn_global_load_lds((const unsigned*)((const char*)(gbase) + (voff)[_i]), (PG8_LAS unsigned*)(lds + (bufoff) + ldsw + _i * 8192), 16, 0, 0); } while (0)
#define PG8_LDA(dst, b, h) do { _Pragma("unroll") for (int m = 0; m < 4; ++m) _Pragma("unroll") for (int k = 0; k < 2; ++k) dst[m][k] = *(const PG8_LAS bf16x8*)(lds + PG8_SA(b, h) + aoff + m * 2048 + k * 1024); } while (0)
#define PG8_LDB(dst, b, h) do { _Pragma("unroll") for (int n = 0; n < 2; ++n) _Pragma("unroll") for (int k = 0; k < 2; ++k) dst[n][k] = *(const PG8_LAS bf16x8*)(lds + PG8_SB(b, h) + boff + n * 2048 + k * 1024); } while (0)
#define PG8_MMA(ai, bj, At, Bt) do { __builtin_amdgcn_s_setprio(1); _Pragma("unroll") for (int m = 0; m < 4; ++m) _Pragma("unroll") for (int n = 0; n < 2; ++n) _Pragma("unroll") for (int k = 0; k < 2; ++k) \
        acc[ai][bj][m][n] = __builtin_amdgcn_mfma_f32_16x16x32_bf16(Bt[n][k], At[m][k], acc[ai][bj][m][n], 0, 0, 0); __builtin_amdgcn_s_setprio(0); } while (0)
#define PG8_WAIT_V(n) asm volatile("s_waitcnt vmcnt(" #n ")" ::: "memory")
#define PG8_WAIT_L(n) asm volatile("s_waitcnt lgkmcnt(" #n ")" ::: "memory")
#define PG8_BAR __builtin_amdgcn_s_barrier()
#define PG8_SCHED __builtin_amdgcn_sched_barrier(0)
    Unit cur, nxt; int ui = 0;
    if (!S.next(0, cur)) return;
    f32x4 acc[2][2][4][2];
#pragma unroll
    for (int a = 0; a < 2; ++a)
#pragma unroll
        for (int b = 0; b < 2; ++b)
#pragma unroll
            for (int m = 0; m < 4; ++m)
#pragma unroll
                for (int n = 0; n < 2; ++n) acc[a][b][m][n] = (f32x4){0.f, 0.f, 0.f, 0.f};
    bf16x8 At[4][2], B0[2][2], B1[2][2];
    const char* cA = cur.A; const char* cB = cur.B;
    S.a_ready(cur);
    if constexpr (SP2) {
        PG8_STAGE(PG8_SB(0, 0), cB, voffB); PG8_STAGE(PG8_SB(0, 1), cB + hstep, voffB); PG8_STAGE(PG8_SA(0, 0), cA, voffA); PG8_STAGE(PG8_SA(0, 1), cA + hstep, voffA);
        if (wr == 1) PG8_BAR;
        PG8_WAIT_V(2); PG8_BAR;
        PG8_STAGE(PG8_SB(1, 0), cB + kstep, voffB); PG8_STAGE(PG8_SA(1, 0), cA + kstep, voffA); PG8_STAGE(PG8_SB(1, 1), cB + hstep + kstep, voffB);
        PG8_WAIT_V(6); PG8_BAR;
    } else {
        PG8_STAGE(PG8_SB(0, 0), cB, voffB); PG8_STAGE(PG8_SA(0, 0), cA, voffA); PG8_STAGE(PG8_SB(0, 1), cB + hstep, voffB); PG8_STAGE(PG8_SA(0, 1), cA + hstep, voffA);
        if (wr == 1) PG8_BAR;
        PG8_WAIT_V(4); PG8_BAR;
        PG8_STAGE(PG8_SB(1, 0), cB + kstep, voffB); PG8_STAGE(PG8_SA(1, 0), cA + kstep, voffA); PG8_STAGE(PG8_SB(1, 1), cB + hstep + kstep, voffB);
        PG8_WAIT_V(6); PG8_BAR;
    }
    for (;;) {
        const bool has_next = S.next(ui + 1, nxt);
        const char* nA = has_next ? nxt.A : cA; const char* nB = has_next ? nxt.B : cB;
        for (int t = 0; t < nt; t += 2) {
            const bool last = (t == nt - 2);
            const char* a1 = cA + (size_t)(t + 1) * kstep;
            const char* a2 = last ? nA : cA + (size_t)(t + 2) * kstep; const char* b2 = last ? nB : cB + (size_t)(t + 2) * kstep;
            const char* a3 = a2 + kstep; const char* b3 = b2 + kstep;
            if (last && has_next) S.a_ready(nxt);
            if constexpr (SP2) {
            PG8_LDB(B0, 0, 0); PG8_LDB(B1, 0, 1); PG8_SCHED; PG8_LDA(At, 0, 0); PG8_STAGE(PG8_SA(1, 1), a1 + hstep, voffA);
            PG8_WAIT_V(8); PG8_WAIT_L(0); PG8_BAR; PG8_MMA(0, 0, At, B0); PG8_MMA(0, 1, At, B1); PG8_BAR; PG8_SCHED;
            PG8_LDA(At, 0, 1); PG8_STAGE(PG8_SB(0, 0), b2, voffB); PG8_STAGE(PG8_SB(0, 1), b2 + hstep, voffB); PG8_STAGE(PG8_SA(0, 0), a2, voffA);
            PG8_WAIT_V(8); PG8_WAIT_L(0); PG8_BAR; PG8_MMA(1, 0, At, B0); PG8_MMA(1, 1, At, B1); PG8_BAR; PG8_SCHED;
            PG8_LDB(B0, 1, 0); PG8_LDB(B1, 1, 1); PG8_SCHED; PG8_LDA(At, 1, 0); PG8_STAGE(PG8_SA(0, 1), a2 + hstep, voffA);
            PG8_WAIT_V(8); PG8_WAIT_L(0); PG8_BAR; PG8_MMA(0, 0, At, B0); PG8_MMA(0, 1, At, B1); PG8_BAR; PG8_SCHED;
            PG8_LDA(At, 1, 1); PG8_STAGE(PG8_SB(1, 0), b3, voffB); PG8_STAGE(PG8_SB(1, 1), b3 + hstep, voffB); PG8_STAGE(PG8_SA(1, 0), a3, voffA);
            PG8_WAIT_V(8); PG8_WAIT_L(0); PG8_BAR; PG8_MMA(1, 0, At, B0); PG8_MMA(1, 1, At, B1); PG8_BAR; PG8_SCHED;
            } else {
            PG8_LDB(B0, 0, 0); PG8_SCHED; PG8_LDA(At, 0, 0); PG8_STAGE(PG8_SA(1, 1), a1 + hstep, voffA);
            PG8_WAIT_L(8); PG8_BAR; PG8_WAIT_L(0); PG8_MMA(0, 0, At, B0); PG8_BAR; PG8_SCHED;
            PG8_LDB(B1, 0, 1); PG8_STAGE(PG8_SB(0, 0), b2, voffB);
            PG8_BAR; PG8_WAIT_L(0); PG8_MMA(0, 1, At, B1); PG8_BAR;
            PG8_LDA(At, 0, 1); PG8_STAGE(PG8_SA(0, 0), a2, voffA);
            PG8_BAR; PG8_WAIT_L(0); PG8_MMA(1, 0, At, B0); PG8_BAR; PG8_SCHED;
            PG8_STAGE(PG8_SB(0, 1), b2 + hstep, voffB);
            PG8_WAIT_V(6); PG8_BAR; PG8_MMA(1, 1, At, B1); PG8_BAR;
            PG8_LDB(B0, 1, 0); PG8_SCHED; PG8_LDA(At, 1, 0); PG8_STAGE(PG8_SA(0, 1), a2 + hstep, voffA);
            PG8_WAIT_L(8); PG8_BAR; PG8_WAIT_L(0); PG8_MMA(0, 0, At, B0); PG8_BAR; PG8_SCHED;
            PG8_LDB(B1, 1, 1); PG8_STAGE(PG8_SB(1, 0), b3, voffB);
            PG8_BAR; PG8_WAIT_L(0); PG8_MMA(0, 1, At, B1); PG8_BAR;
            PG8_LDA(At, 1, 1); PG8_STAGE(PG8_SA(1, 0), a3, voffA);
            PG8_BAR; PG8_WAIT_L(0); PG8_MMA(1, 0, At, B0); PG8_BAR; PG8_SCHED;
            PG8_STAGE(PG8_SB(1, 1), b3 + hstep, voffB);
            PG8_WAIT_V(6); PG8_BAR; PG8_MMA(1, 1, At, B1); PG8_BAR;
            }
        }
        if constexpr (ALIGN_EPI) { if (wr == 0) PG8_BAR; }
        if constexpr (!Epi::AFTER_DRAIN) { E(acc, cur, wr, wc, fr, fq); S.done(cur); }
        if (!has_next) break;
#pragma unroll
        for (int a = 0; a < 2; ++a)
#pragma unroll
            for (int b = 0; b < 2; ++b)
#pragma unroll
                for (int m = 0; m < 4; ++m)
#pragma unroll
                    for (int n = 0; n < 2; ++n) acc[a][b][m][n] = (f32x4){0.f, 0.f, 0.f, 0.f};
        cur = nxt; cA = nA; cB = nB; ++ui;
        if constexpr (ALIGN_EPI) { if (wr == 1) PG8_BAR; }
    }
    PG8_WAIT_V(0);
    if constexpr (!ALIGN_EPI) { if (wr == 0) PG8_BAR; }
    PG8_BAR;
    if constexpr (Epi::AFTER_DRAIN) { E.fused(acc, cur, wr, wc, fr, fq, lds, wid, lane); S.done(cur); }
#undef PG8_SA
#undef PG8_SB
#undef PG8_STAGE
#undef PG8_LDA
#undef PG8_LDB
#undef PG8_MMA
#undef PG8_WAIT_V
#undef PG8_WAIT_L
#undef PG8_BAR
#undef PG8_SCHED
}
}
#define RLX_AGENT __ATOMIC_RELAXED, __HIP_MEMORY_SCOPE_AGENT
#define XB_TMO      128
#define XB_XCNT(j)  (256  + 64 * (j))
#define XB_XSUB(j)  (1280 + 64 * (j))
#define XB_XGEN(j)  (2304 + 64 * (j))
#define XB_TOP      3328
#define XB_TOPGEN   3392
#define XCD_BAR_WORDS 3456
#define XB_SPIN_CAP (1u << 18)

__device__ __forceinline__ unsigned xb_ld(unsigned* p)              { return __hip_atomic_load(p, __ATOMIC_RELAXED, __HIP_MEMORY_SCOPE_AGENT); }
__device__ __forceinline__ unsigned xb_add(unsigned* p, unsigned v) { return __hip_atomic_fetch_add(p, v, __ATOMIC_RELAXED, __HIP_MEMORY_SCOPE_AGENT); }
__device__ __forceinline__ unsigned xb_xcc_id() { return (unsigned)__builtin_amdgcn_s_getreg((3 << 11) | 20) & 0xFu; }
#define XB_SPIN(cond, bar) do { unsigned _sp = 0; while (cond) { __builtin_amdgcn_s_sleep(1); \
    if ((++_sp & 255u) == 0u) { if (xb_ld(&(bar)[XB_TMO])) break; if (_sp > XB_SPIN_CAP) { atomicAdd(&(bar)[XB_TMO], 1u); break; } } } } while (0)

struct XcdBarrier {
    unsigned* bar; unsigned x;
    volatile LAS unsigned* st;
};

__device__ __forceinline__ XcdBarrier xcd_barrier_post(unsigned* bar, volatile LAS unsigned* st) {
    XcdBarrier b; b.bar = bar; b.x = xb_xcc_id(); b.st = st;
    if (threadIdx.x == 0) (void)xb_add(&bar[XB_XCNT(b.x)], 1u);
    return b;
}
__device__ __forceinline__ void xcd_barrier_complete(unsigned* bar, unsigned x, unsigned& nloc, unsigned& nx) {
    const unsigned G = gridDim.x * gridDim.y * gridDim.z;
    unsigned sum, cnt, mine, sp = 0u;
    for (;;) {
        sum = 0u; cnt = 0u; mine = 0u;
#pragma unroll
        for (unsigned j = 0; j < 16; ++j) { const unsigned c = xb_ld(&bar[XB_XCNT(j)]); sum += c; cnt += (c > 0u) ? 1u : 0u; mine = (j == x) ? c : mine; }
        if (sum == G) break;
        __builtin_amdgcn_s_sleep(1);
        if ((++sp & 255u) == 0u) { if (xb_ld(&bar[XB_TMO])) break; if (sp > XB_SPIN_CAP) { atomicAdd(&bar[XB_TMO], 1u); break; } }
    }
    nloc = mine > 0u ? mine : 1u; nx = cnt > 0u ? cnt : 1u;
}

__device__ __forceinline__ void xcd_barrier(const XcdBarrier& b) {
    asm volatile("s_waitcnt vmcnt(0)" ::: "memory");
    __syncthreads();
    if (threadIdx.x == 0) {
        unsigned* bar = b.bar;
        __builtin_amdgcn_s_waitcnt(0);
        unsigned nloc = b.st[0], nx = b.st[1];
        if (nloc == 0u) { xcd_barrier_complete(bar, b.x, nloc, nx); b.st[0] = nloc; b.st[1] = nx; }
        const unsigned old = xb_add(&bar[XB_XSUB(b.x)], 1u);
        const unsigned gen = old / nloc;
        if (old + 1u == (gen + 1u) * nloc) {
            __builtin_amdgcn_fence(__ATOMIC_RELEASE, "agent");
            asm volatile("s_waitcnt vmcnt(0)" ::: "memory");
            const unsigned og = xb_add(&bar[XB_TOP], 1u);
            const unsigned tg = og / nx;
            if (og + 1u == (tg + 1u) * nx) xb_add(&bar[XB_TOPGEN], 1u);
            else XB_SPIN(xb_ld(&bar[XB_TOPGEN]) == tg, bar);
            __builtin_amdgcn_fence(__ATOMIC_ACQUIRE, "agent");
            xb_add(&bar[XB_XGEN(b.x)], 1u);
            asm volatile("s_waitcnt vmcnt(0)" ::: "memory");
        } else {
            XB_SPIN(xb_ld(&bar[XB_XGEN(b.x)]) == gen, bar);
            __builtin_amdgcn_fence(__ATOMIC_ACQUIRE, "agent");
            asm volatile("s_waitcnt vmcnt(0)" ::: "memory");
        }
    }
    __syncthreads();
}

__device__ __forceinline__ int rope_idx_of_row(int row) {
    if (row < ROW_S) return NMETA + (row & (SEQ - 1));
    if (row < ROW_M) return TP + ((row - ROW_S) & (DS - 1));
    if (row < ROW_M + NMETA) return row - ROW_M;
    return -1;
}
namespace pg8 {
#define EPI_ROWS(ai, m) (row0 + (ai) * HALF + (m) * 16)
__device__ __forceinline__ u32x4 pack8(const f32x4 v0, const f32x4 v1) { u32x4 w; w.x = cvt_pk_bf16(v0[0], v0[1]); w.y = cvt_pk_bf16(v0[2], v0[3]); w.z = cvt_pk_bf16(v1[0], v1[1]); w.w = cvt_pk_bf16(v1[2], v1[3]); return w; }
__device__ __forceinline__ void unpack8(const u32x4 w, f32x4& v0, f32x4& v1) { v0 = (f32x4){bflo(w.x), bfhi(w.x), bflo(w.y), bfhi(w.y)}; v1 = (f32x4){bflo(w.z), bfhi(w.z), bflo(w.w), bfhi(w.w)}; }

struct EpiWin {
    static constexpr bool PERM = true, AFTER_DRAIN = false;
    bf16 *RX, *GRG, *CQ, *CKVR, *G, *KPE; float *SSQQ, *SSQKV; const float* b_gate; const float *ropec, *ropes; float* out;
    __device__ __forceinline__ void operator()(const f32x4 (&acc)[2][2][4][2], const Unit& u, int wr, int wc, int fr, int fq) const {
        const int pn = u.pn, row0 = u.pm * BM + wr * 64 + fr, cw = wc * 32 + 8 * fq;
        if (pn < 4 || (pn >= 8 && pn < 13)) {
            bf16* base; int ld, colt, nslot = 0, slot0 = 0; float* ssq = nullptr;
            if (pn < 4) { base = RX; ld = D; colt = pn * BM; }
            else if (pn < 11) { base = CQ; ld = QL; colt = (pn - 8) * BM; ssq = SSQQ; nslot = 12; slot0 = (pn - 8) * 4 + wc; }
            else { base = CKVR; ld = KVL; colt = (pn - 11) * BM; ssq = SSQKV; nslot = 8; slot0 = (pn - 11) * 4 + wc; }
#pragma unroll
            for (int ai = 0; ai < 2; ++ai)
#pragma unroll
                for (int m = 0; m < 4; ++m) { const int row = EPI_ROWS(ai, m); float s = 0.f;
#pragma unroll
                    for (int bj = 0; bj < 2; ++bj) { const f32x4 v0 = acc[ai][bj][m][0], v1 = acc[ai][bj][m][1];
                        *(u32x4*)(base + (size_t)row * ld + colt + bj * HALF + cw) = pack8(v0, v1);
                        s += (v0[0] * v0[0] + v0[1] * v0[1]) + (v0[2] * v0[2] + v0[3] * v0[3]) + (v1[0] * v1[0] + v1[1] * v1[1]) + (v1[2] * v1[2] + v1[3] * v1[3]); }
                    if (ssq) { s += __shfl_xor(s, 16); s += __shfl_xor(s, 32); if (fq == 0) ssq[(size_t)row * nslot + slot0] = s; } }
        } else if (pn < 8) {
            const int colt = (pn - 4) * BM;
#pragma unroll
            for (int ai = 0; ai < 2; ++ai)
#pragma unroll
                for (int m = 0; m < 4; ++m) { const int row = EPI_ROWS(ai, m);
#pragma unroll
                    for (int bj = 0; bj < 2; ++bj) { f32x4 v0 = acc[ai][bj][m][0], v1 = acc[ai][bj][m][1];
#pragma unroll
                        for (int j = 0; j < 4; ++j) { v0[j] = gelu_tanh(v0[j]); v1[j] = gelu_tanh(v1[j]); }
                        *(u32x4*)(GRG + (size_t)row * D + colt + bj * HALF + cw) = pack8(v0, v1); } }
        } else if (pn < 21) {
            const int colt = (pn - 13) * BM;
            f32x4 bv[2][2];
#pragma unroll
            for (int bj = 0; bj < 2; ++bj)
#pragma unroll
                for (int n = 0; n < 2; ++n) bv[bj][n] = *(const f32x4*)(b_gate + colt + bj * HALF + cw + 4 * n);
#pragma unroll
            for (int ai = 0; ai < 2; ++ai)
#pragma unroll
                for (int m = 0; m < 4; ++m) { const int row = EPI_ROWS(ai, m);
#pragma unroll
                    for (int bj = 0; bj < 2; ++bj) { f32x4 v0 = acc[ai][bj][m][0] + bv[bj][0], v1 = acc[ai][bj][m][1] + bv[bj][1];
#pragma unroll
                        for (int j = 0; j < 4; ++j) { v0[j] = sigmoidf_(v0[j]); v1[j] = sigmoidf_(v1[j]); }
                        *(u32x4*)(G + (size_t)row * 2048 + colt + bj * HALF + cw) = pack8(v0, v1); } }
        } else if (wc == 0) {
#pragma unroll
            for (int ai = 0; ai < 2; ++ai)
#pragma unroll
                for (int m = 0; m < 4; ++m) { const int row = EPI_ROWS(ai, m); const int pi = rope_idx_of_row(row);
                    if (pi >= 0) {
#pragma unroll
                        for (int n = 0; n < 2; ++n) { const int i0 = 8 * fq + 4 * n;
                            const f32x4 cs = *(const f32x4*)(ropec + pi * 32 + i0), sn = *(const f32x4*)(ropes + pi * 32 + i0);
                            const f32x4 x1 = acc[ai][0][m][n], x2 = acc[ai][1][m][n];
                            const f32x4 o1 = x1 * cs - x2 * sn, o2 = x1 * sn + x2 * cs;
                            u32x2 w1, w2; w1.x = cvt_pk_bf16(o1[0], o1[1]); w1.y = cvt_pk_bf16(o1[2], o1[3]); w2.x = cvt_pk_bf16(o2[0], o2[1]); w2.y = cvt_pk_bf16(o2[2], o2[3]);
                            *(u32x2*)(KPE + (size_t)row * 64 + i0) = w1; *(u32x2*)(KPE + (size_t)row * 64 + 32 + i0) = w2;
                            if (row < ROW_S) { float* o = out + O_PKPE + ((size_t)(row >> 11) * TP + pi) * 64 + i0; *(f32x4*)o = o1; *(f32x4*)(o + 32) = o2; }
                            else if (row < ROW_M) { float* o = out + O_SKPE + (size_t)(row - ROW_S) * 64 + i0; *(f32x4*)o = o1; *(f32x4*)(o + 32) = o2; }
                            else {
#pragma unroll
                                for (int b = 0; b < NB; ++b) { float* o = out + O_PKPE + ((size_t)b * TP + pi) * 64 + i0; *(f32x4*)o = o1; *(f32x4*)(o + 32) = o2; } } } } }
        }
    }
};
struct EpiQ {
    static constexpr bool PERM = true, AFTER_DRAIN = false;
    bf16* QA; const float* SSQQ; const float *ropec, *ropes;
    __device__ __forceinline__ void operator()(const f32x4 (&acc)[2][2][4][2], const Unit& u, int wr, int wc, int fr, int fq) const {
        const int pn = u.pn, row0 = u.pm * BM + wr * 64 + fr, cw = wc * 32 + 8 * fq;
#pragma unroll
        for (int ai = 0; ai < 2; ++ai)
#pragma unroll
            for (int m = 0; m < 4; ++m) { const int row = EPI_ROWS(ai, m);
                const f32x4 s0 = *(const f32x4*)(SSQQ + (size_t)row * 12), s1 = *(const f32x4*)(SSQQ + (size_t)row * 12 + 4), s2 = *(const f32x4*)(SSQQ + (size_t)row * 12 + 8);
                const float ss = ((s0[0] + s0[1]) + (s0[2] + s0[3])) + ((s1[0] + s1[1]) + (s1[2] + s1[3])) + ((s2[0] + s2[1]) + (s2[2] + s2[3]));
                const float rstd = 1.0f / sqrtf(ss * (1.0f / QL) + EPS);
                if (pn < 4) {
#pragma unroll
                    for (int bj = 0; bj < 2; ++bj) { const int h = pn * 2 + bj;
                        *(u32x4*)(QA + (size_t)row * 1536 + h * 192 + cw) = pack8(acc[ai][bj][m][0] * rstd, acc[ai][bj][m][1] * rstd); }
                } else {
                    const int h = (pn - 4) * 4 + wc; int pi = rope_idx_of_row(row); if (pi < 0) pi = 0;
#pragma unroll
                    for (int n = 0; n < 2; ++n) { const int i0 = 8 * fq + 4 * n;
                        const f32x4 cs = *(const f32x4*)(ropec + pi * 32 + i0), sn = *(const f32x4*)(ropes + pi * 32 + i0);
                        const f32x4 x1 = acc[ai][0][m][n] * rstd, x2 = acc[ai][1][m][n] * rstd;
                        const f32x4 o1 = x1 * cs - x2 * sn, o2 = x1 * sn + x2 * cs;
                        u32x2 w1, w2; w1.x = cvt_pk_bf16(o1[0], o1[1]); w1.y = cvt_pk_bf16(o1[2], o1[3]); w2.x = cvt_pk_bf16(o2[0], o2[1]); w2.y = cvt_pk_bf16(o2[2], o2[3]);
                        *(u32x2*)(QA + (size_t)row * 1536 + h * 192 + 128 + i0) = w1; *(u32x2*)(QA + (size_t)row * 1536 + h * 192 + 160 + i0) = w2; }
                } }
    }
};
struct EpiKV {
    static constexpr bool PERM = true, AFTER_DRAIN = false;
    bf16 *KN, *V; const float* SSQKV;
    __device__ __forceinline__ void operator()(const f32x4 (&acc)[2][2][4][2], const Unit& u, int wr, int wc, int fr, int fq) const {
        const int pn = u.pn, row0 = u.pm * BM + wr * 64 + fr, cw = wc * 32 + 8 * fq;
        bf16* base = pn < 4 ? KN : V; const int colt = (pn & 3) * BM;
#pragma unroll
        for (int ai = 0; ai < 2; ++ai)
#pragma unroll
            for (int m = 0; m < 4; ++m) { const int row = EPI_ROWS(ai, m);
                const f32x4 s0 = *(const f32x4*)(SSQKV + (size_t)row * 8), s1 = *(const f32x4*)(SSQKV + (size_t)row * 8 + 4);
                const float ss = ((s0[0] + s0[1]) + (s0[2] + s0[3])) + ((s1[0] + s1[1]) + (s1[2] + s1[3]));
                const float rstd = 1.0f / sqrtf(ss * (1.0f / KVL) + EPS);
#pragma unroll
                for (int bj = 0; bj < 2; ++bj) *(u32x4*)(base + (size_t)row * D + colt + bj * HALF + cw) = pack8(acc[ai][bj][m][0] * rstd, acc[ai][bj][m][1] * rstd); }
    }
};
template <int MODE> struct EpiZ {
    static constexpr bool PERM = true, AFTER_DRAIN = false;
    bf16* MIX; const bf16* G;
    __device__ __forceinline__ void operator()(const f32x4 (&acc)[2][2][4][2], const Unit& u, int wr, int wc, int fr, int fq) const {
        const int row0 = u.pm * BM + wr * 64 + fr, col0 = u.pn * BM + wc * 32 + 8 * fq;
#pragma unroll
        for (int ai = 0; ai < 2; ++ai)
#pragma unroll
            for (int m = 0; m < 4; ++m) { const int row = EPI_ROWS(ai, m);
#pragma unroll
                for (int bj = 0; bj < 2; ++bj) { const int col = col0 + bj * HALF;
                    f32x4 g0, g1; unpack8(*(const u32x4*)(G + (size_t)row * 2048 + MODE * D + col), g0, g1);
                    f32x4 v0 = acc[ai][bj][m][0] * g0, v1 = acc[ai][bj][m][1] * g1;
                    if (MODE == 1) { f32x4 t0, t1; unpack8(*(const u32x4*)(MIX + (size_t)row * D + col), t0, t1); v0 += t0; v1 += t1; }
                    *(u32x4*)(MIX + (size_t)row * D + col) = pack8(v0, v1); } }
    }
};
struct EpiRes {
    static constexpr bool PERM = false, AFTER_DRAIN = false;
    float* OUT; const bf16* RES; const float* bias;
    __device__ __forceinline__ void operator()(const f32x4 (&acc)[2][2][4][2], const Unit& u, int wr, int wc, int fr, int fq) const {
        const int row0 = u.pm * BM + wr * 64 + fr, col0 = u.pn * BM + wc * 32 + 4 * fq;
        f32x4 bv[2][2];
#pragma unroll
        for (int bj = 0; bj < 2; ++bj)
#pragma unroll
            for (int n = 0; n < 2; ++n) bv[bj][n] = bias ? *(const f32x4*)(bias + col0 + bj * HALF + n * 16) : (f32x4){0.f, 0.f, 0.f, 0.f};
#pragma unroll
        for (int ai = 0; ai < 2; ++ai)
#pragma unroll
            for (int m = 0; m < 4; ++m) { const size_t ro = (size_t)EPI_ROWS(ai, m) * D + col0;
#pragma unroll
                for (int bj = 0; bj < 2; ++bj)
#pragma unroll
                    for (int n = 0; n < 2; ++n) { const u32x2 w = *(const u32x2*)(RES + ro + bj * HALF + n * 16);
                        const f32x4 r = (f32x4){bflo(w.x), bfhi(w.x), bflo(w.y), bfhi(w.y)};
                        *(f32x4*)(OUT + ro + bj * HALF + n * 16) = r * DN_ALPHA + acc[ai][bj][m][n] + bv[bj][n]; } }
    }
};
struct EpiUp {
    static constexpr bool PERM = true, AFTER_DRAIN = false;
    bf16* U; const float* bias;
    __device__ __forceinline__ void operator()(const f32x4 (&acc)[2][2][4][2], const Unit& u, int wr, int wc, int fr, int fq) const {
        const int row0 = u.pm * BM + wr * 64 + fr, col0 = u.pn * BM + wc * 32 + 8 * fq;
        f32x4 bv[2][2];
#pragma unroll
        for (int bj = 0; bj < 2; ++bj)
#pragma unroll
            for (int n = 0; n < 2; ++n) bv[bj][n] = *(const f32x4*)(bias + col0 + bj * HALF + 4 * n);
#pragma unroll
        for (int ai = 0; ai < 2; ++ai)
#pragma unroll
            for (int m = 0; m < 4; ++m) { const int row = EPI_ROWS(ai, m);
#pragma unroll
                for (int bj = 0; bj < 2; ++bj) { f32x4 v0 = acc[ai][bj][m][0] + bv[bj][0], v1 = acc[ai][bj][m][1] + bv[bj][1];
#pragma unroll
                    for (int j = 0; j < 4; ++j) { const float a = fmaxf(v0[j], 0.f), b = fmaxf(v1[j], 0.f); v0[j] = a * a; v1[j] = b * b; }
                    *(u32x4*)(U + (size_t)row * DFF + col0 + bj * HALF) = pack8(v0, v1); } }
    }
};
#undef EPI_ROWS
}
struct Frame {
    LAS unsigned char* lds;
    volatile LAS unsigned* MISC;
    unsigned* ctl;
    int tid, lane, wave, vcu, G;
    const void* const* in;
    float* out; unsigned char* ws;
};
struct Args { const void* in[35]; float* out; unsigned char* ws; int ph_lo, ph_hi; };
#define IN_F(i) ((const float*)args.in[i])
enum { I_XP = 0, I_XS, I_CCKV, I_CKPE, I_PT, I_SCONV, I_SRG, I_META, I_LNG, I_LNB, I_WIN, I_BGATE, I_CONVW, I_CONVB, I_WA, I_BA, I_WX, I_BX, I_LAM, I_WBRR,
       I_QG, I_WUQ, I_KVG, I_WUK, I_WUV, I_WBRM, I_WO, I_LN1G, I_LN1B, I_WUP, I_BUP, I_WDN, I_BDN, I_LN2G, I_LN2B };

__device__ __forceinline__ void tr_item(const float* src, size_t ldn, int scol0, bf16* dst, int dK, int drow0, int k0, const float* kscale, LAS float* scr, int lane) {
    if (scol0 >= 0) {
#pragma unroll 8
        for (int i = 0; i < 32; ++i) { const int kk = 2 * i + (lane >> 5); scr[kk * 33 + (lane & 31)] = src[(size_t)(k0 + kk) * ldn + scol0 + (lane & 31)]; }
    } else {
#pragma unroll 8
        for (int i = 0; i < 32; ++i) { const int kk = 2 * i + (lane >> 5); scr[kk * 33 + (lane & 31)] = 0.f; }
    }
    LDS_WAIT(); asm volatile("" ::: "memory");
    const int c = lane & 7;
    float ks[8];
#pragma unroll
    for (int e = 0; e < 8; ++e) ks[e] = kscale ? kscale[k0 + 8 * c + e] : 1.0f;
#pragma unroll
    for (int j = 0; j < 4; ++j) { const int n = (lane >> 3) + 8 * j; const LAS float* s = scr + (8 * c) * 33 + n;
        u32x4 o; o.x = cvt_pk_bf16(s[0 * 33] * ks[0], s[1 * 33] * ks[1]); o.y = cvt_pk_bf16(s[2 * 33] * ks[2], s[3 * 33] * ks[3]);
        o.z = cvt_pk_bf16(s[4 * 33] * ks[4], s[5 * 33] * ks[5]); o.w = cvt_pk_bf16(s[6 * 33] * ks[6], s[7 * 33] * ks[7]);
        *(u32x4*)(dst + (size_t)(drow0 + n) * dK + k0 + 8 * c) = o; }
    LDS_WAIT(); asm volatile("" ::: "memory");
}
__device__ __forceinline__ void ln_row(const float* xrow, const float* g, const float* b, bf16* obf, float* of32, int lane) {
    const f32x4* xr = (const f32x4*)xrow + lane;
    f32x4 v[4]; float s = 0.f;
#pragma unroll
    for (int j = 0; j < 4; ++j) { v[j] = xr[64 * j]; s += (v[j].x + v[j].y) + (v[j].z + v[j].w); }
    const float mean = wave_sum(s) * (1.f / D); float s2 = 0.f;
#pragma unroll
    for (int j = 0; j < 4; ++j) { v[j] = v[j] - mean; s2 += (v[j].x * v[j].x + v[j].y * v[j].y) + (v[j].z * v[j].z + v[j].w * v[j].w); }
    const float rstd = 1.f / sqrtf(wave_sum(s2) * (1.f / D) + EPS);
#pragma unroll
    for (int j = 0; j < 4; ++j) { const f32x4 gg = ((const f32x4*)g)[lane + 64 * j], bb = ((const f32x4*)b)[lane + 64 * j]; const f32x4 y = v[j] * rstd * gg + bb;
        if (obf) { u32x2 w; w.x = cvt_pk_bf16(y.x, y.y); w.y = cvt_pk_bf16(y.z, y.w); ((u32x2*)obf)[lane + 64 * j] = w; }
        if (of32) ((f32x4*)of32)[lane + 64 * j] = y; }
}
__device__ __forceinline__ const float* src_row(const float* xp, const float* xs, const float* meta, int row) {
    if (row < ROW_S) return xp + (size_t)row * D;
    if (row < ROW_M) return xs + (size_t)(row - ROW_S) * D;
    if (row < ROW_M + NMETA) return meta + (size_t)(row - ROW_M) * D;
    return nullptr;
}
__device__ __forceinline__ void p0_prologue(const Frame& F, const Args& args) {
    unsigned char* ws = F.ws;
    LAS float* scr = (LAS float*)(F.lds + F.wave * 16384);
    const int gw = F.vcu * NWAVES + F.wave, NGW = F.G * NWAVES, lane = F.lane;
    constexpr int I_1 = 16 * (NINP / 32), I_2 = 12 * 48, I_3 = 8 * 32, I_4 = 8 * 32, I_5 = 16 * 32, I_8 = 16 * 128, I_9 = 64 * 32, I_10 = 8 * 8;
    constexpr int NITEMS = I_1 + I_2 + I_3 + I_4 + 3 * I_5 + I_8 + I_9 + 2 * I_10;
    for (int it = gw; it < NITEMS; it += NGW) {
        int r = it;
        if (r < I_1) { const int nb = r % (NINP / 32), kb = r / (NINP / 32), n0 = 32 * nb; int sc;
            if (n0 < 3328) sc = n0; else if (n0 < 5376) sc = n0 + 64; else { const int w = n0 - 5376; sc = (w == 0) ? 3328 : (w == 128 ? 3360 : -1); }
            tr_item(IN_F(I_WIN), NIN, sc, (bf16*)(ws + WS_WIN), D, n0, 64 * kb, nullptr, scr, lane); continue; } r -= I_1;
        if (r < I_2) { const int nb = r % 48, kb = r / 48, n0 = 32 * nb; int sc;
            if (n0 < 1024) sc = (n0 >> 7) * 192 + (n0 & 127);
            else { const int w = n0 - 1024, tt = w >> 8, wi = w & 255, half = wi >> 7, hh = (wi & 127) >> 5; sc = (4 * tt + hh) * 192 + 128 + 32 * half; }
            tr_item(IN_F(I_WUQ), 1536, sc, (bf16*)(ws + WS_WQ), QL, n0, 64 * kb, IN_F(I_QG), scr, lane); continue; } r -= I_2;
        if (r < I_3) { const int nb = r % 32, kb = r / 32; tr_item(IN_F(I_WUK), 1024, 32 * nb, (bf16*)(ws + WS_WKV), KVL, 32 * nb, 64 * kb, IN_F(I_KVG), scr, lane); continue; } r -= I_3;
        if (r < I_4) { const int nb = r % 32, kb = r / 32; tr_item(IN_F(I_WUV), 1024, 32 * nb, (bf16*)(ws + WS_WKV), KVL, 1024 + 32 * nb, 64 * kb, IN_F(I_KVG), scr, lane); continue; } r -= I_4;
        if (r < I_5) { const int nb = r % 32, kb = r / 32; tr_item(IN_F(I_WBRR), D, 32 * nb, (bf16*)(ws + WS_WBRR), D, 32 * nb, 64 * kb, nullptr, scr, lane); continue; } r -= I_5;
        if (r < I_5) { const int nb = r % 32, kb = r / 32; tr_item(IN_F(I_WBRM), D, 32 * nb, (bf16*)(ws + WS_WBRM), D, 32 * nb, 64 * kb, nullptr, scr, lane); continue; } r -= I_5;
        if (r < I_5) { const int nb = r % 32, kb = r / 32; tr_item(IN_F(I_WO), D, 32 * nb, (bf16*)(ws + WS_WO), D, 32 * nb, 64 * kb, nullptr, scr, lane); continue; } r -= I_5;
        if (r < I_8) { const int nb = r % 128, kb = r / 128; tr_item(IN_F(I_WUP), DFF, 32 * nb, (bf16*)(ws + WS_WUP), D, 32 * nb, 64 * kb, nullptr, scr, lane); continue; } r -= I_8;
        if (r < I_9) { const int nb = r % 32, kb = r / 32; tr_item(IN_F(I_WDN), D, 32 * nb, (bf16*)(ws + WS_WDN), DFF, 32 * nb, 64 * kb, nullptr, scr, lane); continue; } r -= I_9;
        if (r < I_10) { const int blk = r >> 3, nb = r & 3, kb = (r >> 2) & 1; tr_item(IN_F(I_WA) + (size_t)blk * 128 * 128, 128, 32 * nb, (bf16*)(ws + WS_WAX), 128, blk * 256 + 32 * nb, 64 * kb, nullptr, scr, lane); continue; } r -= I_10;
        { const int blk = r >> 3, nb = r & 3, kb = (r >> 2) & 1; tr_item(IN_F(I_WX) + (size_t)blk * 128 * 128, 128, 32 * nb, (bf16*)(ws + WS_WAX), 128, blk * 256 + 128 + 32 * nb, 64 * kb, nullptr, scr, lane); }
    }
    const int gt = F.vcu * NTHR + F.tid, NGT = F.G * NTHR;
    for (int i = gt; i < 8 * 512 * 16; i += NGT) { const int c8 = i & 15, r = (i >> 4) & 511, h = i >> 13;
        const f32x4 a = *(const f32x4*)(IN_F(I_WUK) + (size_t)r * 1024 + h * 128 + c8 * 8), b = *(const f32x4*)(IN_F(I_WUK) + (size_t)r * 1024 + h * 128 + c8 * 8 + 4);
        *(u32x4*)((bf16*)(ws + WS_WUKS) + ((size_t)h * 512 + r) * 128 + c8 * 8) = pg8::pack8(a, b); }
    for (int i = gt; i < NROPE * 32; i += NGT) { const int pi = i >> 5, k = i & 31; const int pos = pi < TP ? pi : PAST + (pi - TP);
        double pw = 1.0; for (int j = 0; j < k; ++j) pw *= 1.3335214321633240;
        const float inv = 1.0f / (float)pw; const float ang = (float)pos * inv; const double a = (double)ang;
        const double n2 = __builtin_rint(a * 0.15915494309189535); const double r = (a - n2 * 6.283185307179586) - n2 * 2.4492935982947064e-16;
        const double q = __builtin_rint(r * 0.6366197723675814); const double t = (r - q * 1.5707963267948966) - q * 6.123233995736766e-17; const int qi = ((int)q) & 3;
        const double t2 = t * t;
        const double st = t * (1.0 + t2 * (-1.0 / 6 + t2 * (1.0 / 120 + t2 * (-1.0 / 5040 + t2 * (1.0 / 362880 + t2 * (-1.0 / 39916800 + t2 * (1.0 / 6227020800.0)))))));
        const double ct = 1.0 + t2 * (-0.5 + t2 * (1.0 / 24 + t2 * (-1.0 / 720 + t2 * (1.0 / 40320 + t2 * (-1.0 / 3628800 + t2 * (1.0 / 479001600.0 + t2 * (-1.0 / 87178291200.0)))))));
        const double cv = qi == 0 ? ct : (qi == 1 ? -st : (qi == 2 ? -ct : st)), sv = qi == 0 ? st : (qi == 1 ? ct : (qi == 2 ? -st : -ct));
        ((float*)(ws + WS_ROPEC))[i] = (float)cv; ((float*)(ws + WS_ROPES))[i] = (float)sv; }
    for (int i = gt; i < D; i += NGT) { const float l = IN_F(I_LAM)[i]; ((float*)(ws + WS_SPL))[i] = (l > 0.f) ? log1pf(expf(-l)) : (-l + log1pf(expf(l))); }
    for (int m = gw; m < R; m += NGW) { const float* s = src_row(IN_F(I_XP), IN_F(I_XS), IN_F(I_META), m); bf16* o = (bf16*)(ws + WS_H) + (size_t)m * D;
        if (s) ln_row(s, IN_F(I_LNG), IN_F(I_LNB), o, nullptr, lane);
        else { for (int j = 0; j < 2; ++j) ((u32x4*)o)[lane + 64 * j] = (u32x4){0u, 0u, 0u, 0u}; } }
}
constexpr int RG_XC = 0;
constexpr int RG_XF = 16384;
constexpr int RG_AB = RG_XF + 64 * 132 * 4;
constexpr int RG_SUM = RG_AB + 64 * 132 * 4;
constexpr int RG_END = RG_SUM + 4 * 128 * 2 * 4;
static_assert(RG_END <= MISC_OFF, "rg lds");
__device__ __forceinline__ unsigned off256(unsigned row, unsigned ch) { return 256u * row + 16u * (ch ^ (((row & 3) << 2) | ((row >> 2) & 3))); }

struct RgParams {
    const bf16 *RX, *GRG, *WAX; bf16* HRG; const float *conv_w, *conv_b, *ba, *bx, *spl, *state_conv, *state_rg; float* SEG; float* out;
};
__device__ __forceinline__ int prompt_row(int b, int p) { return p < NMETA ? ROW_M + p : b * SEQ + (p - NMETA); }

template <int MODE>
__device__ __forceinline__ void rg_unit(const Frame& F, const RgParams& P, const int b  , const int n, const int seg) {
    LAS unsigned char* lds = F.lds;
    int tid = F.tid; asm volatile("" : "+v"(tid));
    const int lane = tid & 63, wave = F.wave;
    const int cb = wave & 3, tb = wave >> 2, hh = lane >> 5, l31 = lane & 31;
    bf16x8 wfa[8], wfx[8];
    { const bf16* wa = P.WAX + ((size_t)n * 256 + 32 * cb + l31) * 128 + 8 * hh; const bf16* wx = wa + 128 * 128;
#pragma unroll
      for (int ks = 0; ks < 8; ++ks) { wfa[ks] = *(const bf16x8*)(wa + 16 * ks); wfx[ks] = *(const bf16x8*)(wx + 16 * ks); } }
    const int cg_e = n * 128 + 32 * cb + l31;
    const float ba_c = P.ba[cg_e], bx_c = P.bx[cg_e], spl8 = -8.0f * P.spl[cg_e] * LOG2E;
    const int sc_c = tid & 127, sc_q = tid >> 7, cg_s = n * 128 + sc_c;
    const int cv_tp = tid >> 4, cv_c8 = tid & 15, cg_v = n * 128 + 8 * cv_c8;
    float cw[4][8], cbias[8];
#pragma unroll
    for (int k = 0; k < 4; ++k) { const f32x4 a = *(const f32x4*)(P.conv_w + k * D + cg_v), c = *(const f32x4*)(P.conv_w + k * D + cg_v + 4);
#pragma unroll
        for (int e = 0; e < 4; ++e) { cw[k][e] = a[e]; cw[k][4 + e] = c[e]; } }
    { const f32x4 a = *(const f32x4*)(P.conv_b + cg_v), c = *(const f32x4*)(P.conv_b + cg_v + 4);
#pragma unroll
      for (int e = 0; e < 4; ++e) { cbias[e] = a[e]; cbias[4 + e] = c[e]; } }
    float hc = 0.f, cA = 1.f;
    if (MODE == 1) { for (int s2 = 0; s2 < seg; ++s2) { const f32x2 sv = *(const f32x2*)(P.SEG + (((size_t)b * 3 + s2) * D + cg_s) * 2); hc = sv.x * hc + sv.y; } }
    const int nchunks = (MODE == 2) ? 1 : (seg == 0 ? 9 : 8);
    for (int ch = 0; ch < nchunks; ++ch) {
        int p0 = 0, nvalid = 64;
        if (MODE != 2) { if (seg == 0) { if (ch == 0) { p0 = 0; nvalid = NMETA; } else p0 = NMETA + 64 * (ch - 1); } else p0 = NMETA + 512 * seg + 64 * ch; }
        {
            float x[5][8];
            if (MODE != 2) {
#pragma unroll
                for (int r = 0; r < 5; ++r) { const int p = p0 + 2 * cv_tp - 3 + r;
                    u32x4 w = (u32x4){0u, 0u, 0u, 0u};
                    if (p >= 0) w = *(const u32x4*)(P.RX + (size_t)prompt_row(b, p < TP ? p : TP - 1) * D + cg_v);
                    x[r][0] = bflo(w.x); x[r][1] = bfhi(w.x); x[r][2] = bflo(w.y); x[r][3] = bfhi(w.y); x[r][4] = bflo(w.z); x[r][5] = bfhi(w.z); x[r][6] = bflo(w.w); x[r][7] = bfhi(w.w); }
            }
            if (MODE == 2) {
#pragma unroll
                for (int t = 0; t < 2; ++t) { const int row = 2 * cv_tp + t, j = row & 7, bb = 8 * b + (row >> 3);
                    float acc[8];
#pragma unroll
                    for (int e = 0; e < 8; ++e) acc[e] = cbias[e];
#pragma unroll
                    for (int k = 0; k < 4; ++k) { const int xi = j + k; float xv[8];
                        if (xi < 3) { const f32x4 a = *(const f32x4*)(P.state_conv + ((size_t)bb * 3 + xi) * D + cg_v), c = *(const f32x4*)(P.state_conv + ((size_t)bb * 3 + xi) * D + cg_v + 4);
#pragma unroll
                            for (int e = 0; e < 4; ++e) { xv[e] = a[e]; xv[4 + e] = c[e]; } }
                        else { const u32x4 w = *(const u32x4*)(P.RX + (size_t)(ROW_S + bb * 8 + xi - 3) * D + cg_v);
#pragma unroll
                            for (int e = 0; e < 4; ++e) { const unsigned ww = e == 0 ? w.x : e == 1 ? w.y : e == 2 ? w.z : w.w; xv[2 * e] = bflo(ww); xv[2 * e + 1] = bfhi(ww); } }
#pragma unroll
                        for (int e = 0; e < 8; ++e) acc[e] += xv[e] * cw[k][e]; }
                    *(LAS f32x4*)(lds + RG_XF + (row * 132 + 8 * cv_c8) * 4) = (f32x4){acc[0], acc[1], acc[2], acc[3]};
                    *(LAS f32x4*)(lds + RG_XF + (row * 132 + 8 * cv_c8 + 4) * 4) = (f32x4){acc[4], acc[5], acc[6], acc[7]};
                    u32x4 o; o.x = cvt_pk_bf16(acc[0], acc[1]); o.y = cvt_pk_bf16(acc[2], acc[3]); o.z = cvt_pk_bf16(acc[4], acc[5]); o.w = cvt_pk_bf16(acc[6], acc[7]);
                    *(LAS u32x4*)(lds + RG_XC + off256(row, cv_c8)) = o; }
            } else {
#pragma unroll
                for (int t = 0; t < 2; ++t) { const int row = 2 * cv_tp + t;
                    float acc[8];
#pragma unroll
                    for (int e = 0; e < 8; ++e) acc[e] = cbias[e] + x[t][e] * cw[0][e] + x[t + 1][e] * cw[1][e] + x[t + 2][e] * cw[2][e] + x[t + 3][e] * cw[3][e];
                    *(LAS f32x4*)(lds + RG_XF + (row * 132 + 8 * cv_c8) * 4) = (f32x4){acc[0], acc[1], acc[2], acc[3]};
                    *(LAS f32x4*)(lds + RG_XF + (row * 132 + 8 * cv_c8 + 4) * 4) = (f32x4){acc[4], acc[5], acc[6], acc[7]};
                    u32x4 o; o.x = cvt_pk_bf16(acc[0], acc[1]); o.y = cvt_pk_bf16(acc[2], acc[3]); o.z = cvt_pk_bf16(acc[4], acc[5]); o.w = cvt_pk_bf16(acc[6], acc[7]);
                    *(LAS u32x4*)(lds + RG_XC + off256(row, cv_c8)) = o; }
            }
        }
        __syncthreads();
        f32x16 ga = {}, gx = {};
#pragma unroll
        for (int ks = 0; ks < 8; ++ks) { const bf16x8 af = *(const LAS bf16x8*)(lds + RG_XC + off256(32 * tb + l31, 2 * ks + hh));
            ga = __builtin_amdgcn_mfma_f32_32x32x16_bf16(af, wfa[ks], ga, 0, 0, 0); gx = __builtin_amdgcn_mfma_f32_32x32x16_bf16(af, wfx[ks], gx, 0, 0, 0); }
#pragma unroll
        for (int r = 0; r < 16; ++r) { const int tok = 32 * tb + (r & 3) + 8 * (r >> 2) + 4 * hh; LAS float* xf = (LAS float*)(lds + RG_XF) + tok * 132 + 32 * cb + l31; LAS float* ab = (LAS float*)(lds + RG_AB) + tok * 132 + 32 * cb + l31;
            const float rr = sigmoidf_(ga[r] + ba_c), ii = sigmoidf_(gx[r] + bx_c);
            float a = fast_exp2(rr * spl8); float u = sqrtf(fmaxf(1.0f - a * a, 0.f)) * ii * (*xf);
            if (tok >= nvalid) { a = 1.f; u = 0.f; }
            *ab = a; *xf = u; }
        __syncthreads();
        if (MODE == 2) {
#pragma unroll
            for (int t2 = 0; t2 < 2; ++t2) { const int bb = 8 * b + 2 * sc_q + t2; float h = P.state_rg[(size_t)bb * D + cg_s];
#pragma unroll
                for (int j = 0; j < 8; ++j) { const int row = 16 * sc_q + 8 * t2 + j; LAS float* ab = (LAS float*)(lds + RG_AB) + row * 132 + sc_c; const float u = ((LAS float*)(lds + RG_XF))[row * 132 + sc_c];
                    h = (*ab) * h + u; *ab = h; }
                P.out[O_SH + (size_t)bb * D + cg_s] = h; }
            __syncthreads();
        } else {
            float A = 1.f, Hh = 0.f;
#pragma unroll
            for (int i = 0; i < 16; ++i) { const int row = 16 * sc_q + i; const float a = ((LAS float*)(lds + RG_AB))[row * 132 + sc_c], u = ((LAS float*)(lds + RG_XF))[row * 132 + sc_c]; Hh = a * Hh + u; A *= a; }
            *(LAS f32x2*)(lds + RG_SUM + (sc_q * 128 + sc_c) * 8) = (f32x2){A, Hh};
            __syncthreads();
            float hin = hc, hend = hc, Aend = 1.f;
#pragma unroll
            for (int q = 0; q < 4; ++q) { const f32x2 sv = *(LAS f32x2*)(lds + RG_SUM + (q * 128 + sc_c) * 8); if (q < sc_q) hin = sv.x * hin + sv.y; hend = sv.x * hend + sv.y; Aend *= sv.x; }
            hc = hend; cA *= Aend;
            if (MODE == 1) {
                float h = hin;
#pragma unroll
                for (int i = 0; i < 16; ++i) { const int row = 16 * sc_q + i; LAS float* ab = (LAS float*)(lds + RG_AB) + row * 132 + sc_c; const float u = ((LAS float*)(lds + RG_XF))[row * 132 + sc_c]; h = (*ab) * h + u; *ab = h; }
                __syncthreads();
            }
        }
        if (MODE != 0) {
#pragma unroll
            for (int t = 0; t < 2; ++t) { const int row = 2 * cv_tp + t; int grow;
                if (MODE == 2) grow = ROW_S + 64 * b + row; else { const int p = p0 + row; grow = prompt_row(b, p < TP ? p : TP - 1); }
                if (MODE == 2 || (row < nvalid && p0 >= NMETA)) {
                    const f32x4 h0 = *(const LAS f32x4*)(lds + RG_AB + (row * 132 + 8 * cv_c8) * 4), h1 = *(const LAS f32x4*)(lds + RG_AB + (row * 132 + 8 * cv_c8 + 4) * 4);
                    f32x4 g0, g1; pg8::unpack8(*(const u32x4*)(P.GRG + (size_t)grow * D + cg_v), g0, g1);
                    *(u32x4*)(P.HRG + (size_t)grow * D + cg_v) = pg8::pack8(h0 * g0, h1 * g1); } }
        }
        if (MODE == 0) __syncthreads();
    }
    if (MODE == 0) { if (sc_q == 0) *(f32x2*)(P.SEG + (((size_t)b * 3 + seg) * D + cg_s) * 2) = (f32x2){cA, hc}; }
    if (MODE == 1 && seg == 3) { if (sc_q == 0) P.out[O_PH + (size_t)b * D + cg_s] = hc; }
    __syncthreads();
}
constexpr int SK_PART = 0;
template <int KW  >
__device__ __forceinline__ void skinny_partial(const Frame& F, const bf16* __restrict__ A, const int lda, const bf16* __restrict__ Bt, const int ldb, const int r0, const int c0, const int lane, float& v0, float& v1) {
    LAS unsigned char* lds = F.lds;
    const int w = F.wave, hh = lane >> 5, l31 = lane & 31;
    const bf16* ap = A + (size_t)(r0 + l31) * lda + w * (KW * 16) + 8 * hh;
    const bf16* bp = Bt + (size_t)(c0 + l31) * ldb + w * (KW * 16) + 8 * hh;
    f32x16 acc = (f32x16){};
    constexpr int CH = KW < 8 ? KW : 8;
#pragma unroll 1
    for (int s0 = 0; s0 < KW; s0 += CH) {
        bf16x8 af[CH], bfr[CH];
#pragma unroll
        for (int s = 0; s < CH; ++s) { af[s] = *(const bf16x8*)(ap + 16 * (s0 + s)); bfr[s] = *(const bf16x8*)(bp + 16 * (s0 + s)); }
#pragma unroll
        for (int s = 0; s < CH; ++s) acc = __builtin_amdgcn_mfma_f32_32x32x16_bf16(bfr[s], af[s], acc, 0, 0, 0);
    }
    __syncthreads();
#pragma unroll
    for (int r = 0; r < 16; ++r) *(LAS float*)(lds + SK_PART + ((w * 16 + r) * 64 + lane) * 4) = acc[r];
    __syncthreads();
    const int t = F.tid, ln = t & 63, rg = 2 * (t >> 6);
    float s0 = 0.f, s1 = 0.f;
#pragma unroll
    for (int ww = 0; ww < 8; ++ww) { s0 += *(const LAS float*)(lds + SK_PART + ((ww * 16 + rg) * 64 + ln) * 4); s1 += *(const LAS float*)(lds + SK_PART + ((ww * 16 + rg + 1) * 64 + ln) * 4); }
    v0 = s0; v1 = s1;
}
__device__ __forceinline__ void skinny_coord(const int tid, int& row, int& col) { const int ln = tid & 63, rg = 2 * (tid >> 6); row = ln & 31; col = (rg & 3) + 8 * (rg >> 2) + 4 * (ln >> 5); }
constexpr int PA_KB = 64 * 384, PA_VB = 64 * 256;
constexpr int PA_K0 = 0, PA_V0 = 2 * PA_KB, PA_END = PA_V0 + 2 * PA_VB;
static_assert(PA_END <= MISC_OFF, "prompt attention lds");
__device__ __forceinline__ unsigned offK384(unsigned row, unsigned ch) { return 384u * row + 16u * (ch ^ ((row >> 1) & 7)); }
struct PAttnParams { const bf16 *QA, *KN, *KPE, *V; bf16* O; };

__device__ __forceinline__ void pattn_unit(const Frame& F, const PAttnParams& P, const int b, const int h, const int x) {
    LAS unsigned char* lds = F.lds;
    int lane = F.lane; asm volatile("" : "+v"(lane));
    const int w = F.wave, hh = lane >> 5, l31 = lane & 31;
#pragma nounroll
    for (int half = 0; half < 2; ++half) {
    const int xb = half ? 7 - x : x;
    const int tq = 256 * xb + 32 * w + l31;
    const size_t qrow = (size_t)b * SEQ + tq;
    bf16x8 qf[12];
#pragma unroll
    for (int s = 0; s < 12; ++s) qf[s] = *(const bf16x8*)(P.QA + qrow * 1536 + h * 192 + 16 * s + 8 * hh);
    f32x16 o[4];
#pragma unroll
    for (int i = 0; i < 4; ++i) o[i] = (f32x16){};
    float m = -1e30f, l = 0.f;
    const int ntiles = 1 + 4 * (xb + 1);
    unsigned ksrc[3], kstep[3], vsrc[2];
    const char* wsb = (const char*)P.KN - WS_KN;
#pragma unroll
    for (int i = 0; i < 3; ++i) { const unsigned pos = 1024u * (w + 8 * i) + 16u * lane, row = pos / 384u, chp = (pos % 384u) >> 4, ch = chp ^ ((row >> 1) & 7u);
        if (ch < 16) { ksrc[i] = (unsigned)WS_KN + (row * D + h * 128 + 8 * ch) * 2u; kstep[i] = D * 2; } else { ksrc[i] = (unsigned)WS_KPE + (row * 64 + 8 * (ch - 16)) * 2u; kstep[i] = 64 * 2; } }
#pragma unroll
    for (int i = 0; i < 2; ++i) { const unsigned pos = 1024u * (w + 8 * i) + 16u * lane, row = pos >> 8, chp = (pos & 255u) >> 4, ch = chp ^ (((row & 3) << 2) | ((row >> 2) & 3));
        vsrc[i] = (unsigned)WS_V + (row * D + h * 128 + 8 * ch) * 2u; }
    auto issue = [&](int it, int buf) {
        const unsigned row0 = it == 0 ? (unsigned)ROW_M : (unsigned)(b * SEQ + 64 * (it - 1));
#pragma unroll
        for (int i = 0; i < 3; ++i) __builtin_amdgcn_global_load_lds((const unsigned*)(wsb + (ksrc[i] + row0 * kstep[i])), (LAS unsigned*)(lds + PA_K0 + buf * PA_KB + 1024 * (w + 8 * i)), 16, 0, 0);
#pragma unroll
        for (int i = 0; i < 2; ++i) __builtin_amdgcn_global_load_lds((const unsigned*)(wsb + (vsrc[i] + row0 * (unsigned)(D * 2))), (LAS unsigned*)(lds + PA_V0 + buf * PA_VB + 1024 * (w + 8 * i)), 16, 0, 0);
    };
    issue(0, 0); VM_WAIT(); __syncthreads();
    constexpr float SC = SM_SCALE * LOG2E;
    const int trq = (lane & 15) >> 2, trp = lane & 3, trblk = (lane >> 4) & 1;
    unsigned kb4[4], vb8[2][4];
    { const unsigned sw = (l31 >> 1) & 7u, a = sw >> 1, c = sw & 1u;
#pragma unroll
      for (int v = 0; v < 4; ++v) kb4[v] = 384u * l31 + 16u * ((unsigned)hh ^ c) + 32u * ((unsigned)v ^ a);
      const unsigned clo = 2u * trblk + (trp >> 1);
#pragma unroll
      for (int t = 0; t < 2; ++t)
#pragma unroll
          for (int db = 0; db < 4; ++db) vb8[t][db] = 256u * (4u * hh + trq) + 8u * (trp & 1) + 16u * (clo ^ ((2u * t + hh) & 3u)) + 64u * ((unsigned)db ^ (unsigned)trq); }
#pragma nounroll
    for (int it = 0; it < ntiles; ++it) {
        const int buf = it & 1;
        if (it + 1 < ntiles) issue(it + 1, buf ^ 1);
        const int qmin = 256 * xb + 32 * w; const bool skip = (it > 0) && (64 * (it - 1) > qmin + 31);
        const int lim0 = (it == 0) ? NMETA : tq - 64 * (it - 1) + 1, lim1 = (it == 0) ? 0 : lim0 - 32;
        if (!skip) {
            f32x16 p0 = (f32x16){}, p1 = (f32x16){};
            const LAS unsigned char* Kb = lds + PA_K0 + buf * PA_KB;
#pragma unroll
            for (int sg = 0; sg < 6; ++sg) {
#pragma unroll
                for (int s = 2 * sg; s < 2 * sg + 2; ++s) { const bf16x8 a0 = *(const LAS bf16x8*)(Kb + kb4[s & 3] + 128 * (s >> 2)), a1 = *(const LAS bf16x8*)(Kb + kb4[s & 3] + 12288 + 128 * (s >> 2));
                    p0 = __builtin_amdgcn_mfma_f32_32x32x16_bf16(a0, qf[s], p0, 0, 0, 0); p1 = __builtin_amdgcn_mfma_f32_32x32x16_bf16(a1, qf[s], p1, 0, 0, 0); }
                __builtin_amdgcn_sched_barrier(0); }
            float pmax = -3e38f;
#pragma unroll
            for (int r = 0; r < 16; ++r) { const int kl = (r & 3) + 8 * (r >> 2) + 4 * hh;
                float x0 = p0[r] * SC, x1 = p1[r] * SC;
                x0 = kl < lim0 ? x0 : -3e38f; x1 = kl < lim1 ? x1 : -3e38f;
                p0[r] = x0; p1[r] = x1; pmax = fmaxf(pmax, fmaxf(x0, x1)); }
            pmax = fmaxf(pmax, __shfl_xor(pmax, 32));
            const float mn = fmaxf(m, pmax), alpha = fast_exp2(m - mn); m = mn;
            float ps = 0.f;
#pragma unroll
            for (int r = 0; r < 16; ++r) { p0[r] = fast_exp2(p0[r] - mn); p1[r] = fast_exp2(p1[r] - mn); ps += p0[r] + p1[r]; }
            l = l * alpha + ps;
#pragma unroll
            for (int i = 0; i < 4; ++i) o[i] = o[i] * alpha;
            const LAS unsigned char* Vb = lds + PA_V0 + buf * PA_VB;
#pragma unroll
            for (int kb = 0; kb < 2; ++kb)
#pragma unroll
                for (int s2 = 0; s2 < 2; ++s2) {
                    bf16x8 pf; { const f32x16& pp = kb ? p1 : p0; u32x4 t; t.x = cvt_pk_bf16(pp[8 * s2 + 0], pp[8 * s2 + 1]); t.y = cvt_pk_bf16(pp[8 * s2 + 2], pp[8 * s2 + 3]); t.z = cvt_pk_bf16(pp[8 * s2 + 4], pp[8 * s2 + 5]); t.w = cvt_pk_bf16(pp[8 * s2 + 6], pp[8 * s2 + 7]); pf = __builtin_bit_cast(bf16x8, t); }
#pragma unroll
                    for (int db = 0; db < 4; ++db) {
                        const s16x4 t0 = __builtin_amdgcn_ds_read_tr16_b64_v4i16((LAS s16x4*)(Vb + vb8[0][db] + 256 * (32 * kb + 16 * s2)));
                        const s16x4 t1 = __builtin_amdgcn_ds_read_tr16_b64_v4i16((LAS s16x4*)(Vb + vb8[1][db] + 256 * (32 * kb + 16 * s2 + 8)));
                        bf16x8 vf; vf[0] = t0[0]; vf[1] = t0[1]; vf[2] = t0[2]; vf[3] = t0[3]; vf[4] = t1[0]; vf[5] = t1[1]; vf[6] = t1[2]; vf[7] = t1[3];
                        o[db] = __builtin_amdgcn_mfma_f32_32x32x16_bf16(vf, pf, o[db], 0, 0, 0); }
                    __builtin_amdgcn_sched_barrier(0); }
        }
        VM_WAIT(); __syncthreads();
    }
    l += __shfl_xor(l, 32);
    const float il = 1.0f / l;
    bf16* orow = P.O + qrow * D + h * 128;
#pragma unroll
    for (int db = 0; db < 4; ++db)
#pragma unroll
        for (int rq = 0; rq < 4; ++rq) { u32x2 wv; wv.x = cvt_pk_bf16(o[db][4 * rq] * il, o[db][4 * rq + 1] * il); wv.y = cvt_pk_bf16(o[db][4 * rq + 2] * il, o[db][4 * rq + 3] * il);
            *(u32x2*)(orow + 32 * db + 8 * rq + 4 * hh) = wv; }
    __syncthreads();
    }
}
constexpr int SA_CKVB = 32 * 1024, SA_KPEB = 32 * 128;
constexpr int SA_CKV0 = 0, SA_KPE0 = 2 * SA_CKVB, SA_SB = SA_KPE0 + 2 * SA_KPEB, SA_PB = SA_SB + 64 * 36 * 4, SA_AL = SA_PB + 64 * 64, SA_END = SA_AL + 256;
constexpr int SA_QL = 0;
static_assert(64 * 576 * 2 <= SA_SB && SA_END <= MISC_OFF, "sample attention lds");
__device__ __forceinline__ unsigned off1024(unsigned row, unsigned ch) { return 1024u * row + 16u * (ch ^ (((row & 3) << 2) | ((row >> 2) & 3))); }
__device__ __forceinline__ unsigned offkpe(unsigned row, unsigned ch) { return 128u * row + 16u * (ch ^ ((row >> 1) & 7)); }
__device__ __forceinline__ unsigned offP(unsigned rho, unsigned ch) { return 64u * rho + 16u * (ch ^ ((rho >> 2) & 3)); }
struct SAttnParams { const float *cckv, *ckpe; const int* pt; const bf16 *QA, *WUKS, *CKVNS, *KPE; float *OPART, *ML; };

__device__ __forceinline__ void sattn_unit(const Frame& F, const SAttnParams& P, const int b, const int sp) {
    LAS unsigned char* lds = F.lds;
    int tid = F.tid; asm volatile("" : "+v"(tid));
    const int lane = tid & 63, w = F.wave, hh = lane >> 5, l31 = lane & 31, l15 = lane & 15, g = lane >> 4;
    {
        const int h = w;
        bf16x8 qa[4];
#pragma unroll
        for (int ks = 0; ks < 4; ++ks) qa[ks] = *(const bf16x8*)(P.QA + (size_t)(ROW_S + b * 8 + (l15 & 7)) * 1536 + h * 192 + 32 * ks + 8 * g);
        const bf16* wk = P.WUKS + ((size_t)h * 512 + l15) * 128 + 8 * g;
        for (int rb = 0; rb < 32; ++rb) {
            f32x4 acc = (f32x4){0.f, 0.f, 0.f, 0.f};
#pragma unroll
            for (int ks = 0; ks < 4; ++ks) { const bf16x8 bw = *(const bf16x8*)(wk + (size_t)rb * 16 * 128 + 32 * ks); acc = __builtin_amdgcn_mfma_f32_16x16x32_bf16(qa[ks], bw, acc, 0, 0, 0); }
            if (g < 2) {
#pragma unroll
                for (int e = 0; e < 4; ++e) *(LAS bf16*)(lds + SA_QL + ((h * 8 + 4 * g + e) * 576 + 16 * rb + l15) * 2) = (bf16)(cvt_pk_bf16(acc[e], 0.f) & 0xffffu);
            }
        }
        { const int rho = tid >> 3, c8 = tid & 7; const int hq = rho >> 3, j = rho & 7;
          *(LAS u32x4*)(lds + SA_QL + (rho * 576 + 512 + 8 * c8) * 2) = *(const u32x4*)(P.QA + (size_t)(ROW_S + b * 8 + j) * 1536 + hq * 192 + 128 + 8 * c8); }
    }
    __syncthreads();
#ifdef DBG_QLAT
    { bf16* dbg = (bf16*)((unsigned char*)P.OPART - WS_OPART + WS_U) + (size_t)(b * NSPLIT + sp) * 64 * 576;
      for (int i = tid; i < 64 * 576 / 8; i += NTHR) *(u32x4*)(dbg + i * 8) = *(const LAS u32x4*)(lds + SA_QL + i * 16); }
#endif
    const int kb = w & 1, rb = w >> 1;
    bf16x8 qb[18];
#pragma unroll
    for (int s = 0; s < 18; ++s) qb[s] = *(const LAS bf16x8*)(lds + SA_QL + ((16 * rb + l15) * 576 + 32 * s + 8 * g) * 2);
    __syncthreads();
    f32x16 o[2][2];
#pragma unroll
    for (int i = 0; i < 2; ++i)
#pragma unroll
        for (int j = 0; j < 2; ++j) o[i][j] = (f32x16){};
    const int srho = tid >> 3, skg = tid & 7;
    float m = -1e30f, l = 0.f;
    constexpr float SC = SM_SCALE * LOG2E;
    f32x4 cr[8], kr;
    auto issue = [&](int it) {
        const int page = 16 * sp + (it >> 2); const unsigned phys = (unsigned)P.pt[b * NPAGES + page]; const unsigned key0 = phys * PAGE + (unsigned)(it & 3) * 32u;
        const char* cbase = (const char*)P.cckv; const char* kbase = (const char*)P.ckpe;
#pragma unroll
        for (int i = 0; i < 4; ++i) { const unsigned off = ((key0 + (tid >> 6) + 8 * i) * KVL + 8 * (tid & 63)) * 4u; cr[2 * i] = *(const f32x4*)(cbase + off); cr[2 * i + 1] = *(const f32x4*)(cbase + off + 16); }
        kr = *(const f32x4*)(kbase + ((key0 + (tid >> 4)) * QKR + 4 * (tid & 15)) * 4u);
    };
    auto commit = [&](int buf) {
#pragma unroll
        for (int i = 0; i < 4; ++i) *(LAS u32x4*)(lds + SA_CKV0 + buf * SA_CKVB + off1024((tid >> 6) + 8 * i, tid & 63)) = pg8::pack8(cr[2 * i], cr[2 * i + 1]);
        u32x2 wv; wv.x = cvt_pk_bf16(kr[0], kr[1]); wv.y = cvt_pk_bf16(kr[2], kr[3]);
        *(LAS u32x2*)(lds + SA_KPE0 + buf * SA_KPEB + offkpe(tid >> 4, (tid & 15) >> 1) + 8 * (tid & 1)) = wv;
    };
    const int trq = l15 >> 2, trp = lane & 3, trblk = g & 1;
    unsigned sa4[4], ka2[2], va4[2][2], pa2[2];
    { const unsigned a = l15 & 3u, c = (l15 >> 2) & 3u, e = (l15 >> 1) & 7u, f = (l31 >> 2) & 3u, clo = 2u * trblk + (trp >> 1);
#pragma unroll
      for (int v = 0; v < 4; ++v) sa4[v] = 1024u * (16u * kb + l15) + 16u * ((unsigned)g ^ c) + 64u * ((unsigned)v ^ a);
#pragma unroll
      for (int s2 = 0; s2 < 2; ++s2) { ka2[s2] = offkpe(16u * kb + l15, 4u * s2 + g); pa2[s2] = offP(l31, 2u * s2 + hh); }
#pragma unroll
      for (int t = 0; t < 2; ++t)
#pragma unroll
          for (int db = 0; db < 2; ++db) va4[t][db] = 1024u * (8u * hh + 4u * t + trq) + 8u * (trp & 1) + 16u * (clo ^ ((2u * hh + t) & 3u)) + 64u * (((2u * (w & 1) + db) ^ (unsigned)trq)) + 256u * (w >> 1); }
    auto compute = [&](const int buf, const bool newtile) {
        {
            const LAS unsigned char* Cb = lds + SA_CKV0 + buf * SA_CKVB; const LAS unsigned char* Kb = lds + SA_KPE0 + buf * SA_KPEB;
            f32x4 acc = (f32x4){0.f, 0.f, 0.f, 0.f};
#pragma unroll
            for (int s = 0; s < 16; ++s) { const bf16x8 a = *(const LAS bf16x8*)(Cb + sa4[s & 3] + 256 * (s >> 2)); acc = __builtin_amdgcn_mfma_f32_16x16x32_bf16(a, qb[s], acc, 0, 0, 0);
                if ((s & 3) == 3) __builtin_amdgcn_sched_barrier(0); }
#pragma unroll
            for (int s = 0; s < 2; ++s) { const bf16x8 a = *(const LAS bf16x8*)(Kb + ka2[s]); acc = __builtin_amdgcn_mfma_f32_16x16x32_bf16(a, qb[16 + s], acc, 0, 0, 0); }
            *(LAS f32x4*)(lds + SA_SB + ((16 * rb + l15) * 36 + 16 * kb + 4 * g) * 4) = acc;
        }
        __syncthreads();
        {
            f32x4 v = *(const LAS f32x4*)(lds + SA_SB + (srho * 36 + 4 * skg) * 4) * SC;
            if (newtile) {
#pragma unroll
                for (int e = 0; e < 4; ++e) if (4 * skg + e > (srho & 7)) v[e] = -3e38f;
            }
            float tm = fmaxf(fmaxf(v[0], v[1]), fmaxf(v[2], v[3]));
            tm = fmaxf(tm, __shfl_xor(tm, 1)); tm = fmaxf(tm, __shfl_xor(tm, 2)); tm = fmaxf(tm, __shfl_xor(tm, 4));
            const float mn = fmaxf(m, tm), alpha = fast_exp2(m - mn); m = mn;
#pragma unroll
            for (int e = 0; e < 4; ++e) v[e] = fast_exp2(v[e] - mn);
            float ps = (v[0] + v[1]) + (v[2] + v[3]);
            ps += __shfl_xor(ps, 1); ps += __shfl_xor(ps, 2); ps += __shfl_xor(ps, 4);
            l = l * alpha + ps;
            u32x2 wv; wv.x = cvt_pk_bf16(v[0], v[1]); wv.y = cvt_pk_bf16(v[2], v[3]);
            *(LAS u32x2*)(lds + SA_PB + offP(srho, skg >> 1) + 8 * (skg & 1)) = wv;
            if (skg == 0) *(LAS float*)(lds + SA_AL + srho * 4) = alpha;
        }
    };
    auto pv = [&](const int buf) {
        const LAS unsigned char* Cb = lds + SA_CKV0 + buf * SA_CKVB;
        const float a0 = *(const LAS float*)(lds + SA_AL + l31 * 4), a1 = *(const LAS float*)(lds + SA_AL + (32 + l31) * 4);
#pragma unroll
        for (int db = 0; db < 2; ++db) { o[db][0] = o[db][0] * a0; o[db][1] = o[db][1] * a1; }
#pragma unroll
        for (int s2 = 0; s2 < 2; ++s2) {
            const bf16x8 pb0 = *(const LAS bf16x8*)(lds + SA_PB + pa2[s2]), pb1 = *(const LAS bf16x8*)(lds + SA_PB + pa2[s2] + 2048);
#pragma unroll
            for (int db = 0; db < 2; ++db) {
                const s16x4 t0 = __builtin_amdgcn_ds_read_tr16_b64_v4i16((LAS s16x4*)(Cb + va4[0][db] + 16384 * s2));
                const s16x4 t1 = __builtin_amdgcn_ds_read_tr16_b64_v4i16((LAS s16x4*)(Cb + va4[1][db] + 16384 * s2));
                bf16x8 vf; vf[0] = t0[0]; vf[1] = t0[1]; vf[2] = t0[2]; vf[3] = t0[3]; vf[4] = t1[0]; vf[5] = t1[1]; vf[6] = t1[2]; vf[7] = t1[3];
                o[db][0] = __builtin_amdgcn_mfma_f32_32x32x16_bf16(vf, pb0, o[db][0], 0, 0, 0);
                o[db][1] = __builtin_amdgcn_mfma_f32_32x32x16_bf16(vf, pb1, o[db][1], 0, 0, 0); } }
    };
    constexpr int NT = (PAST / NSPLIT) / 32;
    issue(0); commit(0); issue(1); __syncthreads();
#pragma nounroll
    for (int it = 0; it < NT; ++it) {
        const int buf = it & 1;
        compute(buf, false);
        if (it + 1 < NT) { commit(buf ^ 1); if (it + 2 < NT) issue(it + 2); }
        __syncthreads();
        pv(buf);
    }
    if (sp == NSPLIT - 1) {
        __syncthreads();
        { const char* wsb = (const char*)P.KPE - WS_KPE;
#pragma nounroll
          for (int i = tid; i < 32 * 64; i += NTHR) { const int key = i >> 6, ch = i & 63; u32x4 v = (u32x4){0u, 0u, 0u, 0u}; if (key < DS) v = *(const u32x4*)(wsb + ((unsigned)WS_CKVNS + (unsigned)(((b * DS + key) * KVL + 8 * ch) * 2)));
            *(LAS u32x4*)(lds + SA_CKV0 + off1024(key, ch)) = v; }
          if (tid < 32 * 8) { const int key = tid >> 3, ch = tid & 7; u32x4 v = (u32x4){0u, 0u, 0u, 0u}; if (key < DS) v = *(const u32x4*)(wsb + ((unsigned)WS_KPE + (unsigned)(((ROW_S + b * DS + key) * 64 + 8 * ch) * 2)));
            *(LAS u32x4*)(lds + SA_KPE0 + offkpe(key, ch)) = v; } }
        __syncthreads();
        compute(0, true);
        __syncthreads();
        pv(0);
    }
    float* op = P.OPART + ((size_t)(b * NSPLIT + sp) * 64) * KVL;
#pragma unroll
    for (int db = 0; db < 2; ++db)
#pragma unroll
        for (int rbk = 0; rbk < 2; ++rbk)
#pragma unroll
            for (int rq = 0; rq < 4; ++rq) *(f32x4*)(op + (size_t)(32 * rbk + l31) * KVL + 64 * w + 32 * db + 8 * rq + 4 * hh) = (f32x4){o[db][rbk][4 * rq], o[db][rbk][4 * rq + 1], o[db][rbk][4 * rq + 2], o[db][rbk][4 * rq + 3]};
    if (skg == 0) *(f32x2*)(P.ML + ((size_t)(b * NSPLIT + sp) * 64 + srho) * 2) = (f32x2){m, l};
    __syncthreads();
}

struct SCombParams { const float *OPART, *ML, *w_uv; bf16* O; };
__device__ __forceinline__ void scomb_unit(const Frame& F, const SCombParams& P, const int b, const int h) {
    LAS float* OL = (LAS float*)F.lds;
    int tid = F.tid; asm volatile("" : "+v"(tid));
    {
        const int r = tid;
#pragma unroll
        for (int j = 0; j < 8; ++j) { const int rho = h * 8 + j; float mm[NSPLIT], ll[NSPLIT], M = -3e38f;
#pragma unroll
            for (int s = 0; s < NSPLIT; ++s) { const f32x2 v = *(const f32x2*)(P.ML + ((size_t)(b * NSPLIT + s) * 64 + rho) * 2); mm[s] = v.x; ll[s] = v.y; M = fmaxf(M, v.x); }
            float L = 0.f, acc = 0.f;
#pragma unroll
            for (int s = 0; s < NSPLIT; ++s) { const float wgt = fast_exp2(mm[s] - M); L += wgt * ll[s]; acc += wgt * P.OPART[((size_t)(b * NSPLIT + s) * 64 + rho) * KVL + r]; }
            OL[j * 512 + r] = acc / L; }
    }
    __syncthreads();
    {
        const int d = tid & 127, jg = tid >> 7; float a0 = 0.f, a1 = 0.f;
        const float* wp = P.w_uv + h * 128 + d;
#pragma unroll 8
        for (int r = 0; r < 512; ++r) { const float wv = wp[(size_t)r * 1024]; a0 += OL[(2 * jg) * 512 + r] * wv; a1 += OL[(2 * jg + 1) * 512 + r] * wv; }
        P.O[(size_t)(ROW_S + b * 8 + 2 * jg) * D + h * 128 + d] = (bf16)(cvt_pk_bf16(a0, 0.f) & 0xffffu);
        P.O[(size_t)(ROW_S + b * 8 + 2 * jg + 1) * D + h * 128 + d] = (bf16)(cvt_pk_bf16(a1, 0.f) & 0xffffu);
    }
    __syncthreads();
}
__device__ __forceinline__ void thin_ckv_conv(const Frame& F, const Args& args) {
    unsigned char* ws = F.ws; float* out = F.out;
    const int gw = F.vcu * NWAVES + F.wave, NGW = F.G * NWAVES, lane = F.lane;
    const bf16* CKVR = (const bf16*)(ws + WS_CKVR); const float* SSQ = (const float*)(ws + WS_SSQKV); const bf16* RX = (const bf16*)(ws + WS_RX);
    const f32x4 g0 = *(const f32x4*)(IN_F(I_KVG) + 8 * lane), g1 = *(const f32x4*)(IN_F(I_KVG) + 8 * lane + 4);
    for (int row = gw; row < ROW_M + NMETA; row += NGW) {
        const f32x4 s0 = *(const f32x4*)(SSQ + (size_t)row * 8), s1 = *(const f32x4*)(SSQ + (size_t)row * 8 + 4);
        const float ss = ((s0[0] + s0[1]) + (s0[2] + s0[3])) + ((s1[0] + s1[1]) + (s1[2] + s1[3]));
        const float rstd = 1.0f / sqrtf(ss * (1.0f / KVL) + EPS);
        f32x4 v0, v1; pg8::unpack8(*(const u32x4*)(CKVR + (size_t)row * KVL + 8 * lane), v0, v1);
        v0 = v0 * rstd * g0; v1 = v1 * rstd * g1;
        if (row < ROW_S) { float* o = out + O_PCKV + ((size_t)(row >> 11) * TP + NMETA + (row & (SEQ - 1))) * KVL + 8 * lane; *(f32x4*)o = v0; *(f32x4*)(o + 4) = v1; }
        else if (row < ROW_M) { float* o = out + O_SCKV + (size_t)(row - ROW_S) * KVL + 8 * lane; *(f32x4*)o = v0; *(f32x4*)(o + 4) = v1;
            *(u32x4*)((bf16*)(ws + WS_CKVNS) + (size_t)(row - ROW_S) * KVL + 8 * lane) = pg8::pack8(v0, v1); }
        else { for (int b = 0; b < NB; ++b) { float* o = out + O_PCKV + ((size_t)b * TP + (row - ROW_M)) * KVL + 8 * lane; *(f32x4*)o = v0; *(f32x4*)(o + 4) = v1; } }
    }
    for (int i = gw; i < NB * 3 + DB * 3; i += NGW) {
        int srow; float* o;
        if (i < NB * 3) { const int b = i / 3, k = i % 3; srow = b * SEQ + SEQ - 3 + k; o = out + O_PCONV + (size_t)i * D; }
        else { const int q = i - NB * 3, b = q / 3, k = q % 3; srow = ROW_S + b * DS + DS - 3 + k; o = out + O_SCONV + (size_t)q * D; }
#pragma unroll
        for (int j = 0; j < 2; ++j) { f32x4 v0, v1; pg8::unpack8(*(const u32x4*)(RX + (size_t)srow * D + 8 * (lane + 64 * j)), v0, v1); *(f32x4*)(o + 8 * (lane + 64 * j)) = v0; *(f32x4*)(o + 8 * (lane + 64 * j) + 4) = v1; }
    }
}

constexpr int NPHASES = 11;
__global__ void __launch_bounds__(NTHR, 2) hawk_fwd(Args args) {
    extern __shared__ __attribute__((aligned(16))) unsigned char lds_raw[];
    Frame F;
    F.lds = (LAS unsigned char*)lds_raw; F.MISC = (volatile LAS unsigned*)(F.lds + MISC_OFF);
    F.tid = threadIdx.x; F.lane = F.tid & 63; F.wave = __builtin_amdgcn_readfirstlane(F.tid >> 6);
    F.G = gridDim.x; { const int bx = blockIdx.x; F.vcu = (F.G % 8 == 0) ? (bx % 8) * (F.G / 8) + bx / 8 : bx; }
    F.out = args.out; F.ws = args.ws; F.ctl = (unsigned*)(args.ws + WS_CTL);
    unsigned char* ws = args.ws;
    for (int u = F.tid; u < 64; u += NTHR) ((LAS unsigned*)(F.lds + MISC_OFF))[u] = 0u;
    __syncthreads();
#if MK_PER_PHASE
#define GRID_BAR() do { } while (0)
#else
    XcdBarrier bar = xcd_barrier_post((unsigned*)F.ctl + CW_BAR, F.MISC + 8);
#define GRID_BAR() xcd_barrier(bar)
#endif
    const int lo = args.ph_lo, hi = args.ph_hi;
#ifndef PH_MASK
#define PH_MASK 0x7ff
#endif
#define IN(k) ((((PH_MASK) >> (k)) & 1) && lo <= (k) && (k) < hi)
#ifndef DUP_MASK
#define DUP_MASK 0
#endif
#ifndef P3DUP
#define P3DUP 0
#endif
#define REP(k) for (int rep_ = 0; rep_ < 1 + (((DUP_MASK) >> (k)) & 1); ++rep_)
#define SEAM(k) do { if (IN(k) && IN((k) + 1)) GRID_BAR(); } while (0)
    const int G = F.G, bx = blockIdx.x;

    if (IN(0)) REP(0) { p0_prologue(F, args); }
    SEAM(0);
    if (IN(1)) REP(1) {
        pg8::TileSched S; S.init(ws + WS_H, ws + WS_WIN, D, 66, 22, G, bx);
        pg8::EpiWin E{(bf16*)(ws + WS_RX), (bf16*)(ws + WS_GRG), (bf16*)(ws + WS_CQ), (bf16*)(ws + WS_CKVR), (bf16*)(ws + WS_G), (bf16*)(ws + WS_KPE), (float*)(ws + WS_SSQQ), (float*)(ws + WS_SSQKV),
                      IN_F(I_BGATE), (const float*)(ws + WS_ROPEC), (const float*)(ws + WS_ROPES), F.out};
        pg8::gemm_phase<pg8::EpiWin, pg8::TileSched, true, true>(F.lds, D, S, E);
    }
    SEAM(1);
    const RgParams RGP{(const bf16*)(ws + WS_RX), (const bf16*)(ws + WS_GRG), (const bf16*)(ws + WS_WAX), (bf16*)(ws + WS_HRG), IN_F(I_CONVW), IN_F(I_CONVB), IN_F(I_BA), IN_F(I_BX),
                       (const float*)(ws + WS_SPL), IN_F(I_SCONV), IN_F(I_SRG), (float*)(ws + WS_SEG), F.out};
    if (IN(2)) REP(2) {
        for (int u = F.vcu; u < 192; u += G) rg_unit<0>(F, RGP, u / 24, (u / 3) % 8, u % 3);
        { pg8::TileSched S; S.init(ws + WS_CQ, ws + WS_WQ, QL, 64, 6, G, bx);
          pg8::EpiQ E{(bf16*)(ws + WS_QA), (const float*)(ws + WS_SSQQ), (const float*)(ws + WS_ROPEC), (const float*)(ws + WS_ROPES)};
          pg8::gemm_phase<pg8::EpiQ, pg8::TileSched, true, true>(F.lds, QL, S, E); }
        { pg8::TileSched S; S.init(ws + WS_CKVR, ws + WS_WKV, KVL, 64, 8, G, bx ^ 0xF8);
          pg8::EpiKV E{(bf16*)(ws + WS_KN), (bf16*)(ws + WS_V), (const float*)(ws + WS_SSQKV)};
          pg8::gemm_phase<pg8::EpiKV, pg8::TileSched, true, true>(F.lds, KVL, S, E); }
        {
            int lane_ = F.lane; asm volatile("" : "+v"(lane_));
            int trow, tcol; skinny_coord(F.tid, trow, tcol);
            const bf16* CQs = (const bf16*)(ws + WS_CQ); const bf16* WQs = (const bf16*)(ws + WS_WQ); bf16* QAs = (bf16*)(ws + WS_QA); const float* SQ = (const float*)(ws + WS_SSQQ);
            for (int u = F.vcu; u < 8 * 40 + 64; u += G) {
                if (u < 8 * 40) {
                    const int rt = u / 40, ci = u % 40, r0 = ROW_S + 32 * rt, row = r0 + trow;
                    float ss = 0.f;
#pragma unroll
                    for (int i = 0; i < 12; ++i) ss += SQ[(size_t)row * 12 + i];
                    const float rstd = 1.0f / sqrtf(ss * (1.0f / QL) + EPS);
                    if (ci < 32) { float v0, v1; skinny_partial<6>(F, CQs, QL, WQs, QL, r0, 32 * ci, lane_, v0, v1);
                        const int col = 32 * ci + tcol, h = col >> 7, d = col & 127;
                        *(unsigned*)(QAs + (size_t)row * 1536 + h * 192 + d) = cvt_pk_bf16(v0 * rstd, v1 * rstd); }
                    else { const int h = ci - 32, c1 = 1024 + 256 * (h >> 2) + 32 * (h & 3); float a0, a1, b0, b1;
                        skinny_partial<6>(F, CQs, QL, WQs, QL, r0, c1, lane_, a0, a1); skinny_partial<6>(F, CQs, QL, WQs, QL, r0, c1 + 128, lane_, b0, b1);
                        const int pi = rope_idx_of_row(row); const float* rc = (const float*)(ws + WS_ROPEC) + pi * 32 + tcol; const float* rs = (const float*)(ws + WS_ROPES) + pi * 32 + tcol;
                        a0 *= rstd; a1 *= rstd; b0 *= rstd; b1 *= rstd;
                        *(unsigned*)(QAs + (size_t)row * 1536 + h * 192 + 128 + tcol) = cvt_pk_bf16(a0 * rc[0] - b0 * rs[0], a1 * rc[1] - b1 * rs[1]);
                        *(unsigned*)(QAs + (size_t)row * 1536 + h * 192 + 160 + tcol) = cvt_pk_bf16(a0 * rs[0] + b0 * rc[0], a1 * rs[1] + b1 * rc[1]); }
                } else {
                    const int ci = u - 8 * 40, row = ROW_M + trow; float v0, v1;
                    skinny_partial<4>(F, (const bf16*)(ws + WS_CKVR), KVL, (const bf16*)(ws + WS_WKV), KVL, ROW_M, 32 * ci, lane_, v0, v1);
                    const float* SK = (const float*)(ws + WS_SSQKV) + (size_t)row * 8; const float ss = ((SK[0] + SK[1]) + (SK[2] + SK[3])) + ((SK[4] + SK[5]) + (SK[6] + SK[7]));
                    const float rstd = 1.0f / sqrtf(ss * (1.0f / KVL) + EPS); const int col = 32 * ci + tcol;
                    bf16* dst = col < 1024 ? (bf16*)(ws + WS_KN) + (size_t)row * D + col : (bf16*)(ws + WS_V) + (size_t)row * D + (col - 1024);
                    *(unsigned*)dst = cvt_pk_bf16(v0 * rstd, v1 * rstd); }
            }
            __syncthreads();
        }
        thin_ckv_conv(F, args);
    }
    SEAM(2);
    if (IN(3)) {
        const PAttnParams PA{(const bf16*)(ws + WS_QA), (const bf16*)(ws + WS_KN), (const bf16*)(ws + WS_KPE), (const bf16*)(ws + WS_V), (bf16*)(ws + WS_O)};
        const SAttnParams SA{IN_F(I_CCKV), IN_F(I_CKPE), (const int*)args.in[I_PT], (const bf16*)(ws + WS_QA), (const bf16*)(ws + WS_WUKS), (const bf16*)(ws + WS_CKVNS), (const bf16*)(ws + WS_KPE),
                             (float*)(ws + WS_OPART), (float*)(ws + WS_ML)};
        const bool sfirst = (F.vcu & 1) == 0;
#ifndef P3_MASK
#define P3_MASK 7
#endif
#pragma nounroll
        for (int ph = 0; ph < 2; ++ph) {
            if ((ph == 0) == sfirst) { if (P3_MASK & 1) for (int r3 = 0; r3 < 1 + (P3DUP & 1); ++r3) for (int u = F.vcu; u < DB * NSPLIT; u += G) sattn_unit(F, SA, u / NSPLIT, u % NSPLIT); }
            else { if (P3_MASK & 2) for (int r3 = 0; r3 < 1 + ((P3DUP >> 1) & 1); ++r3) for (int u = F.vcu; u < 256; u += G) { const int bh = u >> 2; pattn_unit(F, PA, bh >> 3, bh & 7, u & 3); } }
        }
        if (P3_MASK & 4) for (int r3 = 0; r3 < 1 + ((P3DUP >> 2) & 1); ++r3) for (int u = F.vcu; u < 256; u += G) rg_unit<1>(F, RGP, u >> 5, (u >> 2) & 7, u & 3);
        if (P3_MASK & 4) for (int u = F.vcu; u < 32; u += G) rg_unit<2>(F, RGP, u >> 3, u & 7, 0);
    }
    SEAM(3);
    if (IN(4)) REP(4) {
        const SCombParams SC{(const float*)(ws + WS_OPART), (const float*)(ws + WS_ML), IN_F(I_WUV), (bf16*)(ws + WS_O)};
        for (int u = F.vcu; u < DB * NH; u += G) scomb_unit(F, SC, u >> 3, u & 7);
    }
    SEAM(4);
    if (IN(5)) REP(5) {
        { pg8::TileSched S; S.init(ws + WS_HRG, ws + WS_WBRR, D, 64, 4, G, bx); pg8::EpiZ<0> E{(bf16*)(ws + WS_MIX), (const bf16*)(ws + WS_G)};
          pg8::gemm_phase<pg8::EpiZ<0>, pg8::TileSched, true, true>(F.lds, D, S, E); }
        { pg8::TileSched S; S.init(ws + WS_O, ws + WS_WBRM, D, 64, 4, G, bx); pg8::EpiZ<1> E{(bf16*)(ws + WS_MIX), (const bf16*)(ws + WS_G)};
          pg8::gemm_phase<pg8::EpiZ<1>, pg8::TileSched, true, true>(F.lds, D, S, E); }
        {
            int lane_ = F.lane; asm volatile("" : "+v"(lane_));
            int trow, tcol; skinny_coord(F.tid, trow, tcol);
            for (int u = F.vcu; u < 8 * 32; u += G) { const int r0 = ROW_S + 32 * (u >> 5), c0 = 32 * (u & 31), row = r0 + trow, col = c0 + tcol; float a0, a1, b0, b1;
                skinny_partial<8>(F, (const bf16*)(ws + WS_HRG), D, (const bf16*)(ws + WS_WBRR), D, r0, c0, lane_, a0, a1);
                skinny_partial<8>(F, (const bf16*)(ws + WS_O), D, (const bf16*)(ws + WS_WBRM), D, r0, c0, lane_, b0, b1);
                const unsigned gr = *(const unsigned*)((const bf16*)(ws + WS_G) + (size_t)row * 2048 + col), gm = *(const unsigned*)((const bf16*)(ws + WS_G) + (size_t)row * 2048 + D + col);
                *(unsigned*)((bf16*)(ws + WS_MIX) + (size_t)row * D + col) = cvt_pk_bf16(bflo(gr) * a0 + bflo(gm) * b0, bfhi(gr) * a1 + bfhi(gm) * b1); }
            __syncthreads();
        }
    }
    SEAM(5);
    if (IN(6)) REP(6) {
        pg8::TileSched S; S.init(ws + WS_MIX, ws + WS_WO, D, 64, 4, G, bx); pg8::EpiRes E{(float*)(ws + WS_PRE), (const bf16*)(ws + WS_H), nullptr};
        pg8::gemm_phase<pg8::EpiRes, pg8::TileSched, true, true>(F.lds, D, S, E);
        {   int lane_ = F.lane; asm volatile("" : "+v"(lane_));
            int trow, tcol; skinny_coord(F.tid, trow, tcol);
            for (int u = F.vcu; u < 8 * 32; u += G) { const int r0 = ROW_S + 32 * (u >> 5), c0 = 32 * (u & 31), row = r0 + trow, col = c0 + tcol; float a0, a1;
                skinny_partial<8>(F, (const bf16*)(ws + WS_MIX), D, (const bf16*)(ws + WS_WO), D, r0, c0, lane_, a0, a1);
                const unsigned hv = *(const unsigned*)((const bf16*)(ws + WS_H) + (size_t)row * D + col);
                *(f32x2*)((float*)(ws + WS_PRE) + (size_t)row * D + col) = (f32x2){DN_ALPHA * bflo(hv) + a0, DN_ALPHA * bfhi(hv) + a1}; }
            __syncthreads();
        }
    }
    SEAM(6);
    if (IN(7)) REP(7) {
        const int gw = F.vcu * NWAVES + F.wave, NGW = G * NWAVES;
        for (int row = gw; row < ROW_M; row += NGW) ln_row((const float*)(ws + WS_PRE) + (size_t)row * D, IN_F(I_LN1G), IN_F(I_LN1B), (bf16*)(ws + WS_X1) + (size_t)row * D, nullptr, F.lane);
    }
    SEAM(7);
    if (IN(8)) REP(8) {
        pg8::TileSched S; S.init(ws + WS_X1, ws + WS_WUP, D, 64, 16, G, bx); pg8::EpiUp E{(bf16*)(ws + WS_U), IN_F(I_BUP)};
        pg8::gemm_phase<pg8::EpiUp, pg8::TileSched, true, true>(F.lds, D, S, E);
        {   int lane_ = F.lane; asm volatile("" : "+v"(lane_));
            int trow, tcol; skinny_coord(F.tid, trow, tcol);
            for (int u = F.vcu; u < 8 * 128; u += G) { const int r0 = ROW_S + 32 * (u >> 7), c0 = 32 * (u & 127), row = r0 + trow, col = c0 + tcol; float a0, a1;
                skinny_partial<8>(F, (const bf16*)(ws + WS_X1), D, (const bf16*)(ws + WS_WUP), D, r0, c0, lane_, a0, a1);
                a0 = fmaxf(a0 + IN_F(I_BUP)[col], 0.f); a1 = fmaxf(a1 + IN_F(I_BUP)[col + 1], 0.f);
                *(unsigned*)((bf16*)(ws + WS_U) + (size_t)row * DFF + col) = cvt_pk_bf16(a0 * a0, a1 * a1); }
            __syncthreads();
        }
    }
    SEAM(8);
    if (IN(9)) REP(9) {
        pg8::TileSched S; S.init(ws + WS_U, ws + WS_WDN, DFF, 64, 4, G, bx); pg8::EpiRes E{(float*)(ws + WS_PRE), (const bf16*)(ws + WS_X1), IN_F(I_BDN)};
        pg8::gemm_phase<pg8::EpiRes, pg8::TileSched, true, true>(F.lds, DFF, S, E);
        {   int lane_ = F.lane; asm volatile("" : "+v"(lane_));
            int trow, tcol; skinny_coord(F.tid, trow, tcol);
            for (int u = F.vcu; u < 8 * 32; u += G) { const int r0 = ROW_S + 32 * (u >> 5), c0 = 32 * (u & 31), row = r0 + trow, col = c0 + tcol; float a0, a1;
                skinny_partial<32>(F, (const bf16*)(ws + WS_U), DFF, (const bf16*)(ws + WS_WDN), DFF, r0, c0, lane_, a0, a1);
                const unsigned xv = *(const unsigned*)((const bf16*)(ws + WS_X1) + (size_t)row * D + col);
                *(f32x2*)((float*)(ws + WS_PRE) + (size_t)row * D + col) = (f32x2){DN_ALPHA * bflo(xv) + a0 + IN_F(I_BDN)[col], DN_ALPHA * bfhi(xv) + a1 + IN_F(I_BDN)[col + 1]}; }
            __syncthreads();
        }
    }
    SEAM(9);
    if (IN(10)) REP(10) {
        const int gw = F.vcu * NWAVES + F.wave, NGW = G * NWAVES;
        for (int row = gw; row < ROW_M; row += NGW) { float* o = row < ROW_S ? F.out + O_YP + (size_t)row * D : F.out + O_YS + (size_t)(row - ROW_S) * D;
            ln_row((const float*)(ws + WS_PRE) + (size_t)row * D, IN_F(I_LN2G), IN_F(I_LN2B), nullptr, o, F.lane); }
    }
#ifdef DBG_DUMP_OFF
    if (lo == 99) {
#ifdef DBG_DUMP_F32
        const float* srcf = (const float*)(ws + (size_t)(DBG_DUMP_OFF));
        for (size_t i = (size_t)F.vcu * NTHR + F.tid; i < (size_t)(DBG_DUMP_F32) / 4; i += (size_t)G * NTHR) *(f32x4*)(F.out + i * 4) = *(const f32x4*)(srcf + i * 4);
#else
#ifndef DBG_DUMP_N
#define DBG_DUMP_N ((size_t)ROW_M * D)
#endif
        const bf16* src = (const bf16*)(ws + (size_t)(DBG_DUMP_OFF));
        for (size_t i = (size_t)F.vcu * NTHR + F.tid; i < (size_t)(DBG_DUMP_N) / 8; i += (size_t)G * NTHR) { f32x4 v0, v1; pg8::unpack8(*(const u32x4*)(src + i * 8), v0, v1); *(f32x4*)(F.out + i * 8) = v0; *(f32x4*)(F.out + i * 8 + 4) = v1; }
#endif
    }
#endif
#undef IN
#undef SEAM
}

extern "C" void kernel_launch(void* const* d_in, const int* in_sizes, int n_in, void* d_out, int out_size, void* d_ws, size_t ws_size, hipStream_t stream) {
    static int grid = 0;
    if (grid == 0) {
        if (n_in != 35 || out_size != (int)O_END || ws_size < WS_END) { fprintf(stderr, "kernel_launch: unexpected shapes (n_in %d, out %d, ws %zu, need %zu)\n", n_in, out_size, ws_size, (size_t)WS_END); grid = -1; return; }
        int dev = 0, cus = 0, per_cu = 0;
        if (hipGetDevice(&dev) != hipSuccess || hipDeviceGetAttribute(&cus, hipDeviceAttributeMultiprocessorCount, dev) != hipSuccess) { grid = -1; return; }
        if (hipFuncSetAttribute((const void*)hawk_fwd, hipFuncAttributeMaxDynamicSharedMemorySize, LDS_BYTES) != hipSuccess) { fprintf(stderr, "kernel_launch: hipFuncSetAttribute failed\n"); grid = -1; return; }
        if (hipOccupancyMaxActiveBlocksPerMultiprocessor(&per_cu, (const void*)hawk_fwd, NTHR, LDS_BYTES) != hipSuccess || per_cu < 1) fprintf(stderr, "kernel_launch: occupancy query reports %d\n", per_cu);
        (void)hipGetLastError();
        grid = cus;
    }
    if (grid < 0) return;
    if (hipMemsetAsync((char*)d_ws + WS_CTL, 0, CTL_BYTES, stream) != hipSuccess) return;
    Args a{};
    for (int i = 0; i < 35; ++i) a.in[i] = d_in[i];
    a.out = (float*)d_out; a.ws = (unsigned char*)d_ws;
#if MK_PER_PHASE
#ifndef DBG_LAST_PHASE
#define DBG_LAST_PHASE (NPHASES - 1)
#endif
    if (DBG_LAST_PHASE < NPHASES - 1) (void)hipMemsetAsync(d_out, 0, (size_t)out_size * 4, stream);
    for (int p = 0; p <= DBG_LAST_PHASE; ++p) { a.ph_lo = p; a.ph_hi = p + 1; hipLaunchKernelGGL(hawk_fwd, dim3(grid), dim3(NTHR), LDS_BYTES, stream, a); }
#ifdef DBG_DUMP_OFF
    a.ph_lo = 99; a.ph_hi = 100; hipLaunchKernelGGL(hawk_fwd, dim3(grid), dim3(NTHR), LDS_BYTES, stream, a);
#endif
#else
    a.ph_lo = 0; a.ph_hi = NPHASES;
    hipLaunchKernelGGL(hawk_fwd, dim3(grid), dim3(NTHR), LDS_BYTES, stream, a);
#endif
}
```

```cpp
#include <hip/hip_runtime.h>
#include <cstdio>
#include <cstdint>

#ifndef MK_PER_PHASE
#define MK_PER_PHASE 0
#endif

#define GAS __attribute__((address_space(1)))
#define LAS __attribute__((address_space(3)))
typedef unsigned short bf16;
typedef short bf16x8 __attribute__((ext_vector_type(8)));
typedef short s16x4 __attribute__((ext_vector_type(4)));
typedef float f32x2 __attribute__((ext_vector_type(2)));
typedef float f32x4 __attribute__((ext_vector_type(4)));
typedef float f32x16 __attribute__((ext_vector_type(16)));
typedef unsigned u32x2 __attribute__((ext_vector_type(2)));
typedef unsigned u32x4 __attribute__((ext_vector_type(4)));

constexpr int D = 1024, NB = 8, SEQ = 2048, NMETA = 16, TP = SEQ + NMETA;
constexpr int DB = 32, DS = 8, PAST = 16384, PAGE = 128, NPAGES = PAST / PAGE;
constexpr int NH = 8, QKN = 128, QKR = 64, VH = 128, KVL = 512, QL = 768, DFF = 4096;
constexpr int NIN = 5440, NINP = 5632;
constexpr int ROW_S = NB * SEQ;
constexpr int ROW_M = ROW_S + DB * DS;
constexpr int R = 16896;
constexpr float EPS = 1e-5f;
constexpr float DN_ALPHA = 1.189207115002721f;
constexpr float SM_SCALE = 0.07216878364870322f;
constexpr float LOG2E = 1.4426950408889634f;
constexpr int NROPE = TP + DS;
constexpr int NSPLIT = 8;

constexpr size_t O_YP = 0, O_YS = O_YP + (size_t)NB * SEQ * D, O_PCKV = O_YS + (size_t)DB * DS * D, O_PKPE = O_PCKV + (size_t)NB * TP * KVL,
    O_PCONV = O_PKPE + (size_t)NB * TP * QKR, O_PH = O_PCONV + (size_t)NB * 3 * D, O_SCKV = O_PH + (size_t)NB * D, O_SKPE = O_SCKV + (size_t)DB * DS * KVL,
    O_SCONV = O_SKPE + (size_t)DB * DS * QKR, O_SH = O_SCONV + (size_t)DB * 3 * D, O_END = O_SH + (size_t)DB * D;
static_assert(O_END == 26861568, "output size");

constexpr size_t al256(size_t x) { return (x + 255) & ~(size_t)255; }
constexpr size_t WS_CTL = 0, CTL_BYTES = 1u << 20;
constexpr size_t WS_WIN = CTL_BYTES;
constexpr size_t WS_WQ = WS_WIN + al256((size_t)NINP * D * 2);
constexpr size_t WS_WKV = WS_WQ + al256((size_t)1536 * QL * 2);
constexpr size_t WS_WBRR = WS_WKV + al256((size_t)2048 * KVL * 2);
constexpr size_t WS_WBRM = WS_WBRR + al256((size_t)D * D * 2);
constexpr size_t WS_WO = WS_WBRM + al256((size_t)D * D * 2);
constexpr size_t WS_WUP = WS_WO + al256((size_t)D * D * 2);
constexpr size_t WS_WDN = WS_WUP + al256((size_t)DFF * D * 2);
constexpr size_t WS_WAX = WS_WDN + al256((size_t)DFF * D * 2);
constexpr size_t WS_WUKS = WS_WAX + al256((size_t)8 * 256 * 128 * 2);
constexpr size_t WS_ROPEC = WS_WUKS + al256((size_t)8 * 512 * 128 * 2);
constexpr size_t WS_ROPES = WS_ROPEC + al256((size_t)NROPE * 32 * 4);
constexpr size_t WS_SPL = WS_ROPES + al256((size_t)NROPE * 32 * 4);
constexpr size_t WS_H = WS_SPL + al256(4096);
constexpr size_t WS_RX = WS_H + al256((size_t)R * D * 2);
constexpr size_t WS_GRG = WS_RX + al256((size_t)R * D * 2);
constexpr size_t WS_CQ = WS_GRG + al256((size_t)R * D * 2);
constexpr size_t WS_CKVR = WS_CQ + al256((size_t)R * QL * 2);
constexpr size_t WS_G = WS_CKVR + al256((size_t)R * KVL * 2);
constexpr size_t WS_KPE = WS_G + al256((size_t)R * 2048 * 2);
constexpr size_t WS_SSQQ = WS_KPE + al256((size_t)R * 64 * 2);
constexpr size_t WS_SSQKV = WS_SSQQ + al256((size_t)R * 12 * 4);
constexpr size_t WS_QA = WS_SSQKV + al256((size_t)R * 8 * 4);
constexpr size_t WS_KN = WS_QA + al256((size_t)R * 1536 * 2);
constexpr size_t WS_V = WS_KN + al256((size_t)R * D * 2);
constexpr size_t WS_CKVNS = WS_V + al256((size_t)R * D * 2);
constexpr size_t WS_SEG = WS_CKVNS + al256((size_t)256 * KVL * 2);
constexpr size_t WS_HRG = WS_SEG + al256((size_t)8 * 3 * 1024 * 2 * 4);
constexpr size_t WS_O = WS_HRG + al256((size_t)R * D * 2);
constexpr size_t WS_OPART = WS_O + al256((size_t)R * D * 2);
constexpr size_t WS_ML = WS_OPART + al256((size_t)DB * NSPLIT * 64 * 512 * 4);
constexpr size_t WS_MIX = WS_ML + al256((size_t)DB * NSPLIT * 64 * 2 * 4);
constexpr size_t WS_PRE = WS_MIX + al256((size_t)R * D * 2);
constexpr size_t WS_X1 = WS_PRE + al256((size_t)R * D * 4);
constexpr size_t WS_U = WS_X1 + al256((size_t)R * D * 2);
constexpr size_t WS_END = WS_U + al256((size_t)R * DFF * 2);
static_assert(WS_END < (1ull << 32), "32-bit workspace offsets");

constexpr int CW_BAR = 4096;

constexpr int LDS_BYTES = 147456;
constexpr int MISC_OFF = 135168;
constexpr int NWAVES = 8, NTHR = 512;

__device__ __forceinline__ float bf2f(unsigned short b) { return __uint_as_float(((unsigned)b) << 16); }
__device__ __forceinline__ float bflo(unsigned w) { return __uint_as_float(w << 16); }
__device__ __forceinline__ float bfhi(unsigned w) { return __uint_as_float(w & 0xffff0000u); }
typedef __bf16 bf16x2_t __attribute__((ext_vector_type(2)));
__device__ __forceinline__ unsigned cvt_pk_bf16(float lo, float hi) { const f32x2 v = {lo, hi}; return __builtin_bit_cast(unsigned, __builtin_convertvector(v, bf16x2_t)); }
__device__ __forceinline__ float fast_exp2(float x) { return __builtin_amdgcn_exp2f(x); }
__device__ __forceinline__ float fast_rcp(float x) { return __builtin_amdgcn_rcpf(x); }
__device__ __forceinline__ float sigmoidf_(float x) { return fast_rcp(1.0f + fast_exp2(-x * LOG2E)); }
__device__ __forceinline__ float gelu_tanh(float x) { const float y = 0.7978845608028654f * (x + 0.044715f * x * x * x); return x * fast_rcp(1.0f + fast_exp2(-2.0f * LOG2E * y)); }
__device__ __forceinline__ float wave_sum(float v) {
#pragma unroll
    for (int o = 1; o < 64; o <<= 1) v += __shfl_xor(v, o);
    return v;
}
#define LDS_WAIT() asm volatile("s_waitcnt lgkmcnt(0)" ::: "memory")
#define VM_WAIT() asm volatile("s_waitcnt vmcnt(0)" ::: "memory")
namespace pg8 {
#define PG8_LAS __attribute__((address_space(3)))
constexpr int BM = 256, BK = 64, HALF = 128, HTB = HALF * BK * 2  , STAGE_BYTES = 8 * HTB, NXCD = 8, WGM = 8;
__host__ __device__ __forceinline__ int lds_byte(int r, int c) { const int st = (r >> 4) * 2 + (c >> 5), rr = r & 15, cc = c & 31, ob = rr * 64 + cc * 2; return st * 1024 + (ob ^ (((ob >> 9) & 1) << 5)); }
__host__ __device__ __forceinline__ void stage_rc(int b, int& R, int& C) { const int st = b / 1024, sb = b % 1024, swz = sb ^ (((sb >> 9) & 1) << 5); R = (st >> 1) * 16 + swz / 64; C = (st & 1) * 32 + (swz % 64) / 2; }
__host__ __device__ __forceinline__ int perm32(int rho) { const int n = rho >> 4, i = rho & 15; return 8 * (i >> 2) + 4 * n + (i & 3); }

struct Unit { const char* A; const char* B; int pm, pn; };

struct TileSched {
    const char* A; const char* B; size_t aT, bT; int nM, nN, nwg, G, c, rm_from, rm_add;
    __device__ __forceinline__ void init(const void* A_, const void* B_, int K, int nM_, int nN_, int G_, int c_, int rm_from_ = 1 << 30, int rm_add_ = 0) {
        A = (const char*)A_; B = (const char*)B_; aT = (size_t)BM * K * 2; bT = aT; nM = nM_; nN = nN_; nwg = nM * nN; G = G_; c = c_; rm_from = rm_from_; rm_add = rm_add_; }
    __device__ __forceinline__ bool next(int i, Unit& u) const {
        const long L = (long)i * G + c; if (L >= nwg) return false;
        int wgid = (int)L; { const int q = nwg / NXCD, r = nwg % NXCD, xcd = wgid % NXCD, off = wgid / NXCD; wgid = (xcd < r ? xcd * (q + 1) : r * (q + 1) + (xcd - r) * q) + off; }
        const int nig = WGM * nN, gid = wgid / nig, fm = gid * WGM, gsz = (nM - fm) < WGM ? (nM - fm) : WGM;
        int pm = fm + ((wgid % nig) % gsz); const int pn = (wgid % nig) / gsz; if (pm >= rm_from) pm += rm_add;
        u.pm = pm; u.pn = pn; u.A = A + (size_t)pm * aT; u.B = B + (size_t)pn * bT; return true;
    }
    __device__ __forceinline__ void a_ready(const Unit&) const {}
    __device__ __forceinline__ void done(const Unit&) const {}
};
template <class Epi, class Sched, bool ALIGN_EPI = false, bool SP2 = false>
__device__ __forceinline__ void gemm_phase(PG8_LAS unsigned char* lds, const int K, const Sched& S, const Epi& E) {
    const int tid = threadIdx.x, wid = __builtin_amdgcn_readfirstlane(tid >> 6), lane = tid & 63, wr = wid >> 2, wc = wid & 3, fr = lane & 15, fq = lane >> 4;
    const int nt = K / BK;
    unsigned voffA[2], voffB[2];
#pragma unroll
    for (int i = 0; i < 2; ++i) { int R, C; stage_rc(tid * 16 + i * 8192, R, C); const int Rb = Epi::PERM ? ((R & ~31) + perm32(R & 31)) : R;
        voffA[i] = (unsigned)(R * K + C) * 2u; voffB[i] = (unsigned)(Rb * K + C) * 2u; }
    const size_t kstep = (size_t)(BK * 2);
    const size_t hstep = (size_t)HALF * K * 2;
    const unsigned ldsw = (unsigned)wid * 1024u;
    const int aoff = lds_byte(wr * 64 + fr, fq * 8), boff = lds_byte(wc * 32 + fr, fq * 8);
#define PG8_SA(b, h) (((b) * 2 + (h)) * HTB)
#define PG8_SB(b, h) ((4 + (b) * 2 + (h)) * HTB)
#define PG8_STAGE(bufoff, gbase, voff) do { _Pragma("unroll") for (int _i = 0; _i < 2; ++_i) \
        __builtin_amdgcn_global_load_lds((const unsigned*)((const char*)(gbase) + (voff)[_i]), (PG8_LAS unsigned*)(lds + (bufoff) + ldsw + _i * 8192), 16, 0, 0); } while (0)
#define PG8_LDA(dst, b, h) do { _Pragma("unroll") for (int m = 0; m < 4; ++m) _Pragma("unroll") for (int k = 0; k < 2; ++k) dst[m][k] = *(const PG8_LAS bf16x8*)(lds + PG8_SA(b, h) + aoff + m * 2048 + k * 1024); } while (0)
#define PG8_LDB(dst, b, h) do { _Pragma("unroll") for (int n = 0; n < 2; ++n) _Pragma("unroll") for (int k = 0; k < 2; ++k) dst[n][k] = *(const PG8_LAS bf16x8*)(lds + PG8_SB(b, h) + boff + n * 2048 + k * 1024); } while (0)
#define PG8_MMA(ai, bj, At, Bt) do { __builtin_amdgcn_s_setprio(1); _Pragma("unroll") for (int m = 0; m < 4; ++m) _Pragma("unroll") for (int n = 0; n < 2; ++n) _Pragma("unroll") for (int k = 0; k < 2; ++k) \
        acc[ai][bj][m][n] = __builtin_amdgcn_mfma_f32_16x16x32_bf16(Bt[n][k], At[m][k], acc[ai][bj][m][n], 0, 0, 0); __builtin_amdgcn_s_setprio(0); } while (0)
#define PG8_WAIT_V(n) asm volatile("s_waitcnt vmcnt(" #n ")" ::: "memory")
#define PG8_WAIT_L(n) asm volatile("s_waitcnt lgkmcnt(" #n ")" ::: "memory")
#define PG8_BAR __builtin_amdgcn_s_barrier()
#define PG8_SCHED __builtin_amdgcn_sched_barrier(0)
    Unit cur, nxt; int ui = 0;
    if (!S.next(0, cur)) return;
    f32x4 acc[2][2][4][2];
#pragma unroll
    for (int a = 0; a < 2; ++a)
#pragma unroll
        for (int b = 0; b < 2; ++b)
#pragma unroll
            for (int m = 0; m < 4; ++m)
#pragma unroll
                for (int n = 0; n < 2; ++n) acc[a][b][m][n] = (f32x4){0.f, 0.f, 0.f, 0.f};
    bf16x8 At[4][2], B0[2][2], B1[2][2];
    const char* cA = cur.A; const char* cB = cur.B;
    S.a_ready(cur);
    if constexpr (SP2) {
        PG8_STAGE(PG8_SB(0, 0), cB, voffB); PG8_STAGE(PG8_SB(0, 1), cB + hstep, voffB); PG8_STAGE(PG8_SA(0, 0), cA, voffA); PG8_STAGE(PG8_SA(0, 1), cA + hstep, voffA);
        if (wr == 1) PG8_BAR;
        PG8_WAIT_V(2); PG8_BAR;
        PG8_STAGE(PG8_SB(1, 0), cB + kstep, voffB); PG8_STAGE(PG8_SA(1, 0), cA + kstep, voffA); PG8_STAGE(PG8_SB(1, 1), cB + hstep + kstep, voffB);
        PG8_WAIT_V(6); PG8_BAR;
    } else {
        PG8_STAGE(PG8_SB(0, 0), cB, voffB); PG8_STAGE(PG8_SA(0, 0), cA, voffA); PG8_STAGE(PG8_SB(0, 1), cB + hstep, voffB); PG8_STAGE(PG8_SA(0, 1), cA + hstep, voffA);
        if (wr == 1) PG8_BAR;
        PG8_WAIT_V(4); PG8_BAR;
        PG8_STAGE(PG8_SB(1, 0), cB + kstep, voffB); PG8_STAGE(PG8_SA(1, 0), cA + kstep, voffA); PG8_STAGE(PG8_SB(1, 1), cB + hstep + kstep, voffB);
        PG8_WAIT_V(6); PG8_BAR;
    }
    for (;;) {
        const bool has_next = S.next(ui + 1, nxt);
        const char* nA = has_next ? nxt.A : cA; const char* nB = has_next ? nxt.B : cB;
        for (int t = 0; t < nt; t += 2) {
            const bool last = (t == nt - 2);
            const char* a1 = cA + (size_t)(t + 1) * kstep;
            const char* a2 = last ? nA : cA + (size_t)(t + 2) * kstep; const char* b2 = last ? nB : cB + (size_t)(t + 2) * kstep;
            const char* a3 = a2 + kstep; const char* b3 = b2 + kstep;
            if (last && has_next) S.a_ready(nxt);
            if constexpr (SP2) {
            PG8_LDB(B0, 0, 0); PG8_LDB(B1, 0, 1); PG8_SCHED; PG8_LDA(At, 0, 0); PG8_STAGE(PG8_SA(1, 1), a1 + hstep, voffA);
            PG8_WAIT_V(8); PG8_WAIT_L(0); PG8_BAR; PG8_MMA(0, 0, At, B0); PG8_MMA(0, 1, At, B1); PG8_BAR; PG8_SCHED;
            PG8_LDA(At, 0, 1); PG8_STAGE(PG8_SB(0, 0), b2, voffB); PG8_STAGE(PG8_SB(0, 1), b2 + hstep, voffB); PG8_STAGE(PG8_SA(0, 0), a2, voffA);
            PG8_WAIT_V(8); PG8_WAIT_L(0); PG8_BAR; PG8_MMA(1, 0, At, B0); PG8_MMA(1, 1, At, B1); PG8_BAR; PG8_SCHED;
            PG8_LDB(B0, 1, 0); PG8_LDB(B1, 1, 1); PG8_SCHED; PG8_LDA(At, 1, 0); PG8_STAGE(PG8_SA(0, 1), a2 + hstep, voffA);
            PG8_WAIT_V(8); PG8_WAIT_L(0); PG8_BAR; PG8_MMA(0, 0, At, B0); PG8_MMA(0, 1, At, B1); PG8_BAR; PG8_SCHED;
            PG8_LDA(At, 1, 1); PG8_STAGE(PG8_SB(1, 0), b3, voffB); PG8_STAGE(PG8_SB(1, 1), b3 + hstep, voffB); PG8_STAGE(PG8_SA(1, 0), a3, voffA);
            PG8_WAIT_V(8); PG8_WAIT_L(0); PG8_BAR; PG8_MMA(1, 0, At, B0); PG8_MMA(1, 1, At, B1); PG8_BAR; PG8_SCHED;
            } else {
            PG8_LDB(B0, 0, 0); PG8_SCHED; PG8_LDA(At, 0, 0); PG8_STAGE(PG8_SA(1, 1), a1 + hstep, voffA);
            PG8_WAIT_L(8); PG8_BAR; PG8_WAIT_L(0); PG8_MMA(0, 0, At, B0); PG8_BAR; PG8_SCHED;
            PG8_LDB(B1, 0, 1); PG8_STAGE(PG8_SB(0, 0), b2, voffB);
            PG8_BAR; PG8_WAIT_L(0); PG8_MMA(0, 1, At, B1); PG8_BAR;
            PG8_LDA(At, 0, 1); PG8_STAGE(PG8_SA(0, 0), a2, voffA);
            PG8_BAR; PG8_WAIT_L(0); PG8_MMA(1, 0, At, B0); PG8_BAR; PG8_SCHED;
            PG8_STAGE(PG8_SB(0, 1), b2 + hstep, voffB);
            PG8_WAIT_V(6); PG8_BAR; PG8_MMA(1, 1, At, B1); PG8_BAR;
            PG8_LDB(B0, 1, 0); PG8_SCHED; PG8_LDA(At, 1, 0); PG8_STAGE(PG8_SA(0, 1), a2 + hstep, voffA);
            PG8_WAIT_L(8); PG8_BAR; PG8_WAIT_L(0); PG8_MMA(0, 0, At, B0); PG8_BAR; PG8_SCHED;
            PG8_LDB(B1, 1, 1); PG8_STAGE(PG8_SB(1, 0), b3, voffB);
            PG8_BAR; PG8_WAIT_L(0); PG8_MMA(0, 1, At, B1); PG8_BAR;
            PG8_LDA(At, 1, 1); PG8_STAGE(PG8_SA(1, 0), a3, voffA);
            PG8_BAR; PG8_WAIT_L(0); PG8_MMA(1, 0, At, B0); PG8_BAR; PG8_SCHED;
            PG8_STAGE(PG8_SB(1, 1), b3 + hstep, voffB);
            PG8_WAIT_V(6); PG8_BAR; PG8_MMA(1, 1, At, B1); PG8_BAR;
            }
        }
        if constexpr (ALIGN_EPI) { if (wr == 0) PG8_BAR; }
        if constexpr (!Epi::AFTER_DRAIN) { E(acc, cur, wr, wc, fr, fq); S.done(cur); }
        if (!has_next) break;
#pragma unroll
        for (int a = 0; a < 2; ++a)
#pragma unroll
            for (int b = 0; b < 2; ++b)
#pragma unroll
                for (int m = 0; m < 4; ++m)
#pragma unroll
                    for (int n = 0; n < 2; ++n) acc[a][b][m][n] = (f32x4){0.f, 0.f, 0.f, 0.f};
        cur = nxt; cA = nA; cB = nB; ++ui;
        if constexpr (ALIGN_EPI) { if (wr == 1) PG8_BAR; }
    }
    PG8_WAIT_V(0);
    if constexpr (!ALIGN_EPI) { if (wr == 0) PG8_BAR; }
    PG8_BAR;
    if constexpr (Epi::AFTER_DRAIN) { E.fused(acc, cur, wr, wc, fr, fq, lds, wid, lane); S.done(cur); }
#undef PG8_SA
#undef PG8_SB
#undef PG8_STAGE
#undef PG8_LDA
#undef PG8_LDB
#undef PG8_MMA
#undef PG8_WAIT_V
#undef PG8_WAIT_L
#undef PG8_BAR
#undef PG8_SCHED
}
}
#define RLX_AGENT __ATOMIC_RELAXED, __HIP_MEMORY_SCOPE_AGENT
#define XB_TMO      128
#define XB_XCNT(j)  (256  + 64 * (j))
#define XB_XSUB(j)  (1280 + 64 * (j))
#define XB_XGEN(j)  (2304 + 64 * (j))
#define XB_TOP      3328
#define XB_TOPGEN   3392
#define XCD_BAR_WORDS 3456
#define XB_SPIN_CAP (1u << 18)

__device__ __forceinline__ unsigned xb_ld(unsigned* p)              { return __hip_atomic_load(p, __ATOMIC_RELAXED, __HIP_MEMORY_SCOPE_AGENT); }
__device__ __forceinline__ unsigned xb_add(unsigned* p, unsigned v) { return __hip_atomic_fetch_add(p, v, __ATOMIC_RELAXED, __HIP_MEMORY_SCOPE_AGENT); }
__device__ __forceinline__ unsigned xb_xcc_id() { return (unsigned)__builtin_amdgcn_s_getreg((3 << 11) | 20) & 0xFu; }
#define XB_SPIN(cond, bar) do { unsigned _sp = 0; while (cond) { __builtin_amdgcn_s_sleep(1); \
    if ((++_sp & 255u) == 0u) { if (xb_ld(&(bar)[XB_TMO])) break; if (_sp > XB_SPIN_CAP) { atomicAdd(&(bar)[XB_TMO], 1u); break; } } } } while (0)

struct XcdBarrier {
    unsigned* bar; unsigned x;
    volatile LAS unsigned* st;
};

__device__ __forceinline__ XcdBarrier xcd_barrier_post(unsigned* bar, volatile LAS unsigned* st) {
    XcdBarrier b; b.bar = bar; b.x = xb_xcc_id(); b.st = st;
    if (threadIdx.x == 0) (void)xb_add(&bar[XB_XCNT(b.x)], 1u);
    return b;
}
__device__ __forceinline__ void xcd_barrier_complete(unsigned* bar, unsigned x, unsigned& nloc, unsigned& nx) {
    const unsigned G = gridDim.x * gridDim.y * gridDim.z;
    unsigned sum, cnt, mine, sp = 0u;
    for (;;) {
        sum = 0u; cnt = 0u; mine = 0u;
#pragma unroll
        for (unsigned j = 0; j < 16; ++j) { const unsigned c = xb_ld(&bar[XB_XCNT(j)]); sum += c; cnt += (c > 0u) ? 1u : 0u; mine = (j == x) ? c : mine; }
        if (sum == G) break;
        __builtin_amdgcn_s_sleep(1);
        if ((++sp & 255u) == 0u) { if (xb_ld(&bar[XB_TMO])) break; if (sp > XB_SPIN_CAP) { atomicAdd(&bar[XB_TMO], 1u); break; } }
    }
    nloc = mine > 0u ? mine : 1u; nx = cnt > 0u ? cnt : 1u;
}

__device__ __forceinline__ void xcd_barrier(const XcdBarrier& b) {
    asm volatile("s_waitcnt vmcnt(0)" ::: "memory");
    __syncthreads();
    if (threadIdx.x == 0) {
        unsigned* bar = b.bar;
        __builtin_amdgcn_s_waitcnt(0);
        unsigned nloc = b.st[0], nx = b.st[1];
        if (nloc == 0u) { xcd_barrier_complete(bar, b.x, nloc, nx); b.st[0] = nloc; b.st[1] = nx; }
        const unsigned old = xb_add(&bar[XB_XSUB(b.x)], 1u);
        const unsigned gen = old / nloc;
        if (old + 1u == (gen + 1u) * nloc) {
            __builtin_amdgcn_fence(__ATOMIC_RELEASE, "agent");
            asm volatile("s_waitcnt vmcnt(0)" ::: "memory");
            const unsigned og = xb_add(&bar[XB_TOP], 1u);
            const unsigned tg = og / nx;
            if (og + 1u == (tg + 1u) * nx) xb_add(&bar[XB_TOPGEN], 1u);
            else XB_SPIN(xb_ld(&bar[XB_TOPGEN]) == tg, bar);
            __builtin_amdgcn_fence(__ATOMIC_ACQUIRE, "agent");
            xb_add(&bar[XB_XGEN(b.x)], 1u);
            asm volatile("s_waitcnt vmcnt(0)" ::: "memory");
        } else {
            XB_SPIN(xb_ld(&bar[XB_XGEN(b.x)]) == gen, bar);
            __builtin_amdgcn_fence(__ATOMIC_ACQUIRE, "agent");
            asm volatile("s_waitcnt vmcnt(0)" ::: "memory");
        }
    }
    __syncthreads();
}

__device__ __forceinline__ int rope_idx_of_row(int row) {
    if (row < ROW_S) return NMETA + (row & (SEQ - 1));
    if (row < ROW_M) return TP + ((row - ROW_S) & (DS - 1));
    if (row < ROW_M + NMETA) return row - ROW_M;
    return -1;
}
namespace pg8 {
#define EPI_ROWS(ai, m) (row0 + (ai) * HALF + (m) * 16)
__device__ __forceinline__ u32x4 pack8(const f32x4 v0, const f32x4 v1) { u32x4 w; w.x = cvt_pk_bf16(v0[0], v0[1]); w.y = cvt_pk_bf16(v0[2], v0[3]); w.z = cvt_pk_bf16(v1[0], v1[1]); w.w = cvt_pk_bf16(v1[2], v1[3]); return w; }
__device__ __forceinline__ void unpack8(const u32x4 w, f32x4& v0, f32x4& v1) { v0 = (f32x4){bflo(w.x), bfhi(w.x), bflo(w.y), bfhi(w.y)}; v1 = (f32x4){bflo(w.z), bfhi(w.z), bflo(w.w), bfhi(w.w)}; }

struct EpiWin {
    static constexpr bool PERM = true, AFTER_DRAIN = false;
    bf16 *RX, *GRG, *CQ, *CKVR, *G, *KPE; float *SSQQ, *SSQKV; const float* b_gate; const float *ropec, *ropes; float* out;
    __device__ __forceinline__ void operator()(const f32x4 (&acc)[2][2][4][2], const Unit& u, int wr, int wc, int fr, int fq) const {
        const int pn = u.pn, row0 = u.pm * BM + wr * 64 + fr, cw = wc * 32 + 8 * fq;
        if (pn < 4 || (pn >= 8 && pn < 13)) {
            bf16* base; int ld, colt, nslot = 0, slot0 = 0; float* ssq = nullptr;
            if (pn < 4) { base = RX; ld = D; colt = pn * BM; }
            else if (pn < 11) { base = CQ; ld = QL; colt = (pn - 8) * BM; ssq = SSQQ; nslot = 12; slot0 = (pn - 8) * 4 + wc; }
            else { base = CKVR; ld = KVL; colt = (pn - 11) * BM; ssq = SSQKV; nslot = 8; slot0 = (pn - 11) * 4 + wc; }
#pragma unroll
            for (int ai = 0; ai < 2; ++ai)
#pragma unroll
                for (int m = 0; m < 4; ++m) { const int row = EPI_ROWS(ai, m); float s = 0.f;
#pragma unroll
                    for (int bj = 0; bj < 2; ++bj) { const f32x4 v0 = acc[ai][bj][m][0], v1 = acc[ai][bj][m][1];
                        *(u32x4*)(base + (size_t)row * ld + colt + bj * HALF + cw) = pack8(v0, v1);
                        s += (v0[0] * v0[0] + v0[1] * v0[1]) + (v0[2] * v0[2] + v0[3] * v0[3]) + (v1[0] * v1[0] + v1[1] * v1[1]) + (v1[2] * v1[2] + v1[3] * v1[3]); }
                    if (ssq) { s += __shfl_xor(s, 16); s += __shfl_xor(s, 32); if (fq == 0) ssq[(size_t)row * nslot + slot0] = s; } }
        } else if (pn < 8) {
            const int colt = (pn - 4) * BM;
#pragma unroll
            for (int ai = 0; ai < 2; ++ai)
#pragma unroll
                for (int m = 0; m < 4; ++m) { const int row = EPI_ROWS(ai, m);
#pragma unroll
                    for (int bj = 0; bj < 2; ++bj) { f32x4 v0 = acc[ai][bj][m][0], v1 = acc[ai][bj][m][1];
#pragma unroll
                        for (int j = 0; j < 4; ++j) { v0[j] = gelu_tanh(v0[j]); v1[j] = gelu_tanh(v1[j]); }
                        *(u32x4*)(GRG + (size_t)row * D + colt + bj * HALF + cw) = pack8(v0, v1); } }
        } else if (pn < 21) {
            const int colt = (pn - 13) * BM;
            f32x4 bv[2][2];
#pragma unroll
            for (int bj = 0; bj < 2; ++bj)
#pragma unroll
                for (int n = 0; n < 2; ++n) bv[bj][n] = *(const f32x4*)(b_gate + colt + bj * HALF + cw + 4 * n);
#pragma unroll
            for (int ai = 0; ai < 2; ++ai)
#pragma unroll
                for (int m = 0; m < 4; ++m) { const int row = EPI_ROWS(ai, m);
#pragma unroll
                    for (int bj = 0; bj < 2; ++bj) { f32x4 v0 = acc[ai][bj][m][0] + bv[bj][0], v1 = acc[ai][bj][m][1] + bv[bj][1];
#pragma unroll
                        for (int j = 0; j < 4; ++j) { v0[j] = sigmoidf_(v0[j]); v1[j] = sigmoidf_(v1[j]); }
                        *(u32x4*)(G + (size_t)row * 2048 + colt + bj * HALF + cw) = pack8(v0, v1); } }
        } else if (wc == 0) {
#pragma unroll
            for (int ai = 0; ai < 2; ++ai)
#pragma unroll
                for (int m = 0; m < 4; ++m) { const int row = EPI_ROWS(ai, m); const int pi = rope_idx_of_row(row);
                    if (pi >= 0) {
#pragma unroll
                        for (int n = 0; n < 2; ++n) { const int i0 = 8 * fq + 4 * n;
                            const f32x4 cs = *(const f32x4*)(ropec + pi * 32 + i0), sn = *(const f32x4*)(ropes + pi * 32 + i0);
                            const f32x4 x1 = acc[ai][0][m][n], x2 = acc[ai][1][m][n];
                            const f32x4 o1 = x1 * cs - x2 * sn, o2 = x1 * sn + x2 * cs;
                            u32x2 w1, w2; w1.x = cvt_pk_bf16(o1[0], o1[1]); w1.y = cvt_pk_bf16(o1[2], o1[3]); w2.x = cvt_pk_bf16(o2[0], o2[1]); w2.y = cvt_pk_bf16(o2[2], o2[3]);
                            *(u32x2*)(KPE + (size_t)row * 64 + i0) = w1; *(u32x2*)(KPE + (size_t)row * 64 + 32 + i0) = w2;
                            if (row < ROW_S) { float* o = out + O_PKPE + ((size_t)(row >> 11) * TP + pi) * 64 + i0; *(f32x4*)o = o1; *(f32x4*)(o + 32) = o2; }
                            else if (row < ROW_M) { float* o = out + O_SKPE + (size_t)(row - ROW_S) * 64 + i0; *(f32x4*)o = o1; *(f32x4*)(o + 32) = o2; }
                            else {
#pragma unroll
                                for (int b = 0; b < NB; ++b) { float* o = out + O_PKPE + ((size_t)b * TP + pi) * 64 + i0; *(f32x4*)o = o1; *(f32x4*)(o + 32) = o2; } } } } }
        }
    }
};
struct EpiQ {
    static constexpr bool PERM = true, AFTER_DRAIN = false;
    bf16* QA; const float* SSQQ; const float *ropec, *ropes;
    __device__ __forceinline__ void operator()(const f32x4 (&acc)[2][2][4][2], const Unit& u, int wr, int wc, int fr, int fq) const {
        const int pn = u.pn, row0 = u.pm * BM + wr * 64 + fr, cw = wc * 32 + 8 * fq;
#pragma unroll
        for (int ai = 0; ai < 2; ++ai)
#pragma unroll
            for (int m = 0; m < 4; ++m) { const int row = EPI_ROWS(ai, m);
                const f32x4 s0 = *(const f32x4*)(SSQQ + (size_t)row * 12), s1 = *(const f32x4*)(SSQQ + (size_t)row * 12 + 4), s2 = *(const f32x4*)(SSQQ + (size_t)row * 12 + 8);
                const float ss = ((s0[0] + s0[1]) + (s0[2] + s0[3])) + ((s1[0] + s1[1]) + (s1[2] + s1[3])) + ((s2[0] + s2[1]) + (s2[2] + s2[3]));
                const float rstd = 1.0f / sqrtf(ss * (1.0f / QL) + EPS);
                if (pn < 4) {
#pragma unroll
                    for (int bj = 0; bj < 2; ++bj) { const int h = pn * 2 + bj;
                        *(u32x4*)(QA + (size_t)row * 1536 + h * 192 + cw) = pack8(acc[ai][bj][m][0] * rstd, acc[ai][bj][m][1] * rstd); }
                } else {
                    const int h = (pn - 4) * 4 + wc; int pi = rope_idx_of_row(row); if (pi < 0) pi = 0;
#pragma unroll
                    for (int n = 0; n < 2; ++n) { const int i0 = 8 * fq + 4 * n;
                        const f32x4 cs = *(const f32x4*)(ropec + pi * 32 + i0), sn = *(const f32x4*)(ropes + pi * 32 + i0);
                        const f32x4 x1 = acc[ai][0][m][n] * rstd, x2 = acc[ai][1][m][n] * rstd;
                        const f32x4 o1 = x1 * cs - x2 * sn, o2 = x1 * sn + x2 * cs;
                        u32x2 w1, w2; w1.x = cvt_pk_bf16(o1[0], o1[1]); w1.y = cvt_pk_bf16(o1[2], o1[3]); w2.x = cvt_pk_bf16(o2[0], o2[1]); w2.y = cvt_pk_bf16(o2[2], o2[3]);
                        *(u32x2*)(QA + (size_t)row * 1536 + h * 192 + 128 + i0) = w1; *(u32x2*)(QA + (size_t)row * 1536 + h * 192 + 160 + i0) = w2; }
                } }
    }
};
struct EpiKV {
    static constexpr bool PERM = true, AFTER_DRAIN = false;
    bf16 *KN, *V; const float* SSQKV;
    __device__ __forceinline__ void operator()(const f32x4 (&acc)[2][2][4][2], const Unit& u, int wr, int wc, int fr, int fq) const {
        const int pn = u.pn, row0 = u.pm * BM + wr * 64 + fr, cw = wc * 32 + 8 * fq;
        bf16* base = pn < 4 ? KN : V; const int colt = (pn & 3) * BM;
#pragma unroll
        for (int ai = 0; ai < 2; ++ai)
#pragma unroll
            for (int m = 0; m < 4; ++m) { const int row = EPI_ROWS(ai, m);
                const f32x4 s0 = *(const f32x4*)(SSQKV + (size_t)row * 8), s1 = *(const f32x4*)(SSQKV + (size_t)row * 8 + 4);
                const float ss = ((s0[0] + s0[1]) + (s0[2] + s0[3])) + ((s1[0] + s1[1]) + (s1[2] + s1[3]));
                const float rstd = 1.0f / sqrtf(ss * (1.0f / KVL) + EPS);
#pragma unroll
                for (int bj = 0; bj < 2; ++bj) *(u32x4*)(base + (size_t)row * D + colt + bj * HALF + cw) = pack8(acc[ai][bj][m][0] * rstd, acc[ai][bj][m][1] * rstd); }
    }
};
template <int MODE> struct EpiZ {
    static constexpr bool PERM = true, AFTER_DRAIN = false;
    bf16* MIX; const bf16* G;
    __device__ __forceinline__ void operator()(const f32x4 (&acc)[2][2][4][2], const Unit& u, int wr, int wc, int fr, int fq) const {
        const int row0 = u.pm * BM + wr * 64 + fr, col0 = u.pn * BM + wc * 32 + 8 * fq;
#pragma unroll
        for (int ai = 0; ai < 2; ++ai)
#pragma unroll
            for (int m = 0; m < 4; ++m) { const int row = EPI_ROWS(ai, m);
#pragma unroll
                for (int bj = 0; bj < 2; ++bj) { const int col = col0 + bj * HALF;
                    f32x4 g0, g1; unpack8(*(const u32x4*)(G + (size_t)row * 2048 + MODE * D + col), g0, g1);
                    f32x4 v0 = acc[ai][bj][m][0] * g0, v1 = acc[ai][bj][m][1] * g1;
                    if (MODE == 1) { f32x4 t0, t1; unpack8(*(const u32x4*)(MIX + (size_t)row * D + col), t0, t1); v0 += t0; v1 += t1; }
                    *(u32x4*)(MIX + (size_t)row * D + col) = pack8(v0, v1); } }
    }
};
struct EpiRes {
    static constexpr bool PERM = false, AFTER_DRAIN = false;
    float* OUT; const bf16* RES; const float* bias;
    __device__ __forceinline__ void operator()(const f32x4 (&acc)[2][2][4][2], const Unit& u, int wr, int wc, int fr, int fq) const {
        const int row0 = u.pm * BM + wr * 64 + fr, col0 = u.pn * BM + wc * 32 + 4 * fq;
        f32x4 bv[2][2];
#pragma unroll
        for (int bj = 0; bj < 2; ++bj)
#pragma unroll
            for (int n = 0; n < 2; ++n) bv[bj][n] = bias ? *(const f32x4*)(bias + col0 + bj * HALF + n * 16) : (f32x4){0.f, 0.f, 0.f, 0.f};
#pragma unroll
        for (int ai = 0; ai < 2; ++ai)
#pragma unroll
            for (int m = 0; m < 4; ++m) { const size_t ro = (size_t)EPI_ROWS(ai, m) * D + col0;
#pragma unroll
                for (int bj = 0; bj < 2; ++bj)
#pragma unroll
                    for (int n = 0; n < 2; ++n) { const u32x2 w = *(const u32x2*)(RES + ro + bj * HALF + n * 16);
                        const f32x4 r = (f32x4){bflo(w.x), bfhi(w.x), bflo(w.y), bfhi(w.y)};
                        *(f32x4*)(OUT + ro + bj * HALF + n * 16) = r * DN_ALPHA + acc[ai][bj][m][n] + bv[bj][n]; } }
    }
};
struct EpiUp {
    static constexpr bool PERM = true, AFTER_DRAIN = false;
    bf16* U; const float* bias;
    __device__ __forceinline__ void operator()(const f32x4 (&acc)[2][2][4][2], const Unit& u, int wr, int wc, int fr, int fq) const {
        const int row0 = u.pm * BM + wr * 64 + fr, col0 = u.pn * BM + wc * 32 + 8 * fq;
        f32x4 bv[2][2];
#pragma unroll
        for (int bj = 0; bj < 2; ++bj)
#pragma unroll
            for (int n = 0; n < 2; ++n) bv[bj][n] = *(const f32x4*)(bias + col0 + bj * HALF + 4 * n);
#pragma unroll
        for (int ai = 0; ai < 2; ++ai)
#pragma unroll
            for (int m = 0; m < 4; ++m) { const int row = EPI_ROWS(ai, m);
#pragma unroll
                for (int bj = 0; bj < 2; ++bj) { f32x4 v0 = acc[ai][bj][m][0] + bv[bj][0], v1 = acc[ai][bj][m][1] + bv[bj][1];
#pragma unroll
                    for (int j = 0; j < 4; ++j) { const float a = fmaxf(v0[j], 0.f), b = fmaxf(v1[j], 0.f); v0[j] = a * a; v1[j] = b * b; }
                    *(u32x4*)(U + (size_t)row * DFF + col0 + bj * HALF) = pack8(v0, v1); } }
    }
};
#undef EPI_ROWS
}
struct Frame {
    LAS unsigned char* lds;
    volatile LAS unsigned* MISC;
    unsigned* ctl;
    int tid, lane, wave, vcu, G;
    const void* const* in;
    float* out; unsigned char* ws;
};
struct Args { const void* in[35]; float* out; unsigned char* ws; int ph_lo, ph_hi; };
#define IN_F(i) ((const float*)args.in[i])
enum { I_XP = 0, I_XS, I_CCKV, I_CKPE, I_PT, I_SCONV, I_SRG, I_META, I_LNG, I_LNB, I_WIN, I_BGATE, I_CONVW, I_CONVB, I_WA, I_BA, I_WX, I_BX, I_LAM, I_WBRR,
       I_QG, I_WUQ, I_KVG, I_WUK, I_WUV, I_WBRM, I_WO, I_LN1G, I_LN1B, I_WUP, I_BUP, I_WDN, I_BDN, I_LN2G, I_LN2B };

__device__ __forceinline__ void tr_item(const float* src, size_t ldn, int scol0, bf16* dst, int dK, int drow0, int k0, const float* kscale, LAS float* scr, int lane) {
    if (scol0 >= 0) {
#pragma unroll 8
        for (int i = 0; i < 32; ++i) { const int kk = 2 * i + (lane >> 5); scr[kk * 33 + (lane & 31)] = src[(size_t)(k0 + kk) * ldn + scol0 + (lane & 31)]; }
    } else {
#pragma unroll 8
        for (int i = 0; i < 32; ++i) { const int kk = 2 * i + (lane >> 5); scr[kk * 33 + (lane & 31)] = 0.f; }
    }
    LDS_WAIT(); asm volatile("" ::: "memory");
    const int c = lane & 7;
    float ks[8];
#pragma unroll
    for (int e = 0; e < 8; ++e) ks[e] = kscale ? kscale[k0 + 8 * c + e] : 1.0f;
#pragma unroll
    for (int j = 0; j < 4; ++j) { const int n = (lane >> 3) + 8 * j; const LAS float* s = scr + (8 * c) * 33 + n;
        u32x4 o; o.x = cvt_pk_bf16(s[0 * 33] * ks[0], s[1 * 33] * ks[1]); o.y = cvt_pk_bf16(s[2 * 33] * ks[2], s[3 * 33] * ks[3]);
        o.z = cvt_pk_bf16(s[4 * 33] * ks[4], s[5 * 33] * ks[5]); o.w = cvt_pk_bf16(s[6 * 33] * ks[6], s[7 * 33] * ks[7]);
        *(u32x4*)(dst + (size_t)(drow0 + n) * dK + k0 + 8 * c) = o; }
    LDS_WAIT(); asm volatile("" ::: "memory");
}
__device__ __forceinline__ void ln_row(const float* xrow, const float* g, const float* b, bf16* obf, float* of32, int lane) {
    const f32x4* xr = (const f32x4*)xrow + lane;
    f32x4 v[4]; float s = 0.f;
#pragma unroll
    for (int j = 0; j < 4; ++j) { v[j] = xr[64 * j]; s += (v[j].x + v[j].y) + (v[j].z + v[j].w); }
    const float mean = wave_sum(s) * (1.f / D); float s2 = 0.f;
#pragma unroll
    for (int j = 0; j < 4; ++j) { v[j] = v[j] - mean; s2 += (v[j].x * v[j].x + v[j].y * v[j].y) + (v[j].z * v[j].z + v[j].w * v[j].w); }
    const float rstd = 1.f / sqrtf(wave_sum(s2) * (1.f / D) + EPS);
#pragma unroll
    for (int j = 0; j < 4; ++j) { const f32x4 gg = ((const f32x4*)g)[lane + 64 * j], bb = ((const f32x4*)b)[lane + 64 * j]; const f32x4 y = v[j] * rstd * gg + bb;
        if (obf) { u32x2 w; w.x = cvt_pk_bf16(y.x, y.y); w.y = cvt_pk_bf16(y.z, y.w); ((u32x2*)obf)[lane + 64 * j] = w; }
        if (of32) ((f32x4*)of32)[lane + 64 * j] = y; }
}
__device__ __forceinline__ const float* src_row(const float* xp, const float* xs, const float* meta, int row) {
    if (row < ROW_S) return xp + (size_t)row * D;
    if (row < ROW_M) return xs + (size_t)(row - ROW_S) * D;
    if (row < ROW_M + NMETA) return meta + (size_t)(row - ROW_M) * D;
    return nullptr;
}
__device__ __forceinline__ void p0_prologue(const Frame& F, const Args& args) {
    unsigned char* ws = F.ws;
    LAS float* scr = (LAS float*)(F.lds + F.wave * 16384);
    const int gw = F.vcu * NWAVES + F.wave, NGW = F.G * NWAVES, lane = F.lane;
    constexpr int I_1 = 16 * (NINP / 32), I_2 = 12 * 48, I_3 = 8 * 32, I_4 = 8 * 32, I_5 = 16 * 32, I_8 = 16 * 128, I_9 = 64 * 32, I_10 = 8 * 8;
    constexpr int NITEMS = I_1 + I_2 + I_3 + I_4 + 3 * I_5 + I_8 + I_9 + 2 * I_10;
    for (int it = gw; it < NITEMS; it += NGW) {
        int r = it;
        if (r < I_1) { const int nb = r % (NINP / 32), kb = r / (NINP / 32), n0 = 32 * nb; int sc;
            if (n0 < 3328) sc = n0; else if (n0 < 5376) sc = n0 + 64; else { const int w = n0 - 5376; sc = (w == 0) ? 3328 : (w == 128 ? 3360 : -1); }
            tr_item(IN_F(I_WIN), NIN, sc, (bf16*)(ws + WS_WIN), D, n0, 64 * kb, nullptr, scr, lane); continue; } r -= I_1;
        if (r < I_2) { const int nb = r % 48, kb = r / 48, n0 = 32 * nb; int sc;
            if (n0 < 1024) sc = (n0 >> 7) * 192 + (n0 & 127);
            else { const int w = n0 - 1024, tt = w >> 8, wi = w & 255, half = wi >> 7, hh = (wi & 127) >> 5; sc = (4 * tt + hh) * 192 + 128 + 32 * half; }
            tr_item(IN_F(I_WUQ), 1536, sc, (bf16*)(ws + WS_WQ), QL, n0, 64 * kb, IN_F(I_QG), scr, lane); continue; } r -= I_2;
        if (r < I_3) { const int nb = r % 32, kb = r / 32; tr_item(IN_F(I_WUK), 1024, 32 * nb, (bf16*)(ws + WS_WKV), KVL, 32 * nb, 64 * kb, IN_F(I_KVG), scr, lane); continue; } r -= I_3;
        if (r < I_4) { const int nb = r % 32, kb = r / 32; tr_item(IN_F(I_WUV), 1024, 32 * nb, (bf16*)(ws + WS_WKV), KVL, 1024 + 32 * nb, 64 * kb, IN_F(I_KVG), scr, lane); continue; } r -= I_4;
        if (r < I_5) { const int nb = r % 32, kb = r / 32; tr_item(IN_F(I_WBRR), D, 32 * nb, (bf16*)(ws + WS_WBRR), D, 32 * nb, 64 * kb, nullptr, scr, lane); continue; } r -= I_5;
        if (r < I_5) { const int nb = r % 32, kb = r / 32; tr_item(IN_F(I_WBRM), D, 32 * nb, (bf16*)(ws + WS_WBRM), D, 32 * nb, 64 * kb, nullptr, scr, lane); continue; } r -= I_5;
        if (r < I_5) { const int nb = r % 32, kb = r / 32; tr_item(IN_F(I_WO), D, 32 * nb, (bf16*)(ws + WS_WO), D, 32 * nb, 64 * kb, nullptr, scr, lane); continue; } r -= I_5;
        if (r < I_8) { const int nb = r % 128, kb = r / 128; tr_item(IN_F(I_WUP), DFF, 32 * nb, (bf16*)(ws + WS_WUP), D, 32 * nb, 64 * kb, nullptr, scr, lane); continue; } r -= I_8;
        if (r < I_9) { const int nb = r % 32, kb = r / 32; tr_item(IN_F(I_WDN), D, 32 * nb, (bf16*)(ws + WS_WDN), DFF, 32 * nb, 64 * kb, nullptr, scr, lane); continue; } r -= I_9;
        if (r < I_10) { const int blk = r >> 3, nb = r & 3, kb = (r >> 2) & 1; tr_item(IN_F(I_WA) + (size_t)blk * 128 * 128, 128, 32 * nb, (bf16*)(ws + WS_WAX), 128, blk * 256 + 32 * nb, 64 * kb, nullptr, scr, lane); continue; } r -= I_10;
        { const int blk = r >> 3, nb = r & 3, kb = (r >> 2) & 1; tr_item(IN_F(I_WX) + (size_t)blk * 128 * 128, 128, 32 * nb, (bf16*)(ws + WS_WAX), 128, blk * 256 + 128 + 32 * nb, 64 * kb, nullptr, scr, lane); }
    }
    const int gt = F.vcu * NTHR + F.tid, NGT = F.G * NTHR;
    for (int i = gt; i < 8 * 512 * 16; i += NGT) { const int c8 = i & 15, r = (i >> 4) & 511, h = i >> 13;
        const f32x4 a = *(const f32x4*)(IN_F(I_WUK) + (size_t)r * 1024 + h * 128 + c8 * 8), b = *(const f32x4*)(IN_F(I_WUK) + (size_t)r * 1024 + h * 128 + c8 * 8 + 4);
        *(u32x4*)((bf16*)(ws + WS_WUKS) + ((size_t)h * 512 + r) * 128 + c8 * 8) = pg8::pack8(a, b); }
    for (int i = gt; i < NROPE * 32; i += NGT) { const int pi = i >> 5, k = i & 31; const int pos = pi < TP ? pi : PAST + (pi - TP);
        double pw = 1.0; for (int j = 0; j < k; ++j) pw *= 1.3335214321633240;
        const float inv = 1.0f / (float)pw; const float ang = (float)pos * inv; const double a = (double)ang;
        const double n2 = __builtin_rint(a * 0.15915494309189535); const double r = (a - n2 * 6.283185307179586) - n2 * 2.4492935982947064e-16;
        const double q = __builtin_rint(r * 0.6366197723675814); const double t = (r - q * 1.5707963267948966) - q * 6.123233995736766e-17; const int qi = ((int)q) & 3;
        const double t2 = t * t;
        const double st = t * (1.0 + t2 * (-1.0 / 6 + t2 * (1.0 / 120 + t2 * (-1.0 / 5040 + t2 * (1.0 / 362880 + t2 * (-1.0 / 39916800 + t2 * (1.0 / 6227020800.0)))))));
        const double ct = 1.0 + t2 * (-0.5 + t2 * (1.0 / 24 + t2 * (-1.0 / 720 + t2 * (1.0 / 40320 + t2 * (-1.0 / 3628800 + t2 * (1.0 / 479001600.0 + t2 * (-1.0 / 87178291200.0)))))));
        const double cv = qi == 0 ? ct : (qi == 1 ? -st : (qi == 2 ? -ct : st)), sv = qi == 0 ? st : (qi == 1 ? ct : (qi == 2 ? -st : -ct));
        ((float*)(ws + WS_ROPEC))[i] = (float)cv; ((float*)(ws + WS_ROPES))[i] = (float)sv; }
    for (int i = gt; i < D; i += NGT) { const float l = IN_F(I_LAM)[i]; ((float*)(ws + WS_SPL))[i] = (l > 0.f) ? log1pf(expf(-l)) : (-l + log1pf(expf(l))); }
    for (int m = gw; m < R; m += NGW) { const float* s = src_row(IN_F(I_XP), IN_F(I_XS), IN_F(I_META), m); bf16* o = (bf16*)(ws + WS_H) + (size_t)m * D;
        if (s) ln_row(s, IN_F(I_LNG), IN_F(I_LNB), o, nullptr, lane);
        else { for (int j = 0; j < 2; ++j) ((u32x4*)o)[lane + 64 * j] = (u32x4){0u, 0u, 0u, 0u}; } }
}
constexpr int RG_XC = 0;
constexpr int RG_XF = 16384;
constexpr int RG_AB = RG_XF + 64 * 132 * 4;
constexpr int RG_SUM = RG_AB + 64 * 132 * 4;
constexpr int RG_CW = RG_SUM + 4 * 128 * 2 * 4;
constexpr int RG_END = RG_CW + 5 * 128 * 4;
static_assert(RG_END <= MISC_OFF, "rg lds");
__device__ __forceinline__ unsigned off256(unsigned row, unsigned ch) { return 256u * row + 16u * (ch ^ (((row & 3) << 2) | ((row >> 2) & 3))); }

struct RgParams {
    const bf16 *RX, *GRG, *WAX; bf16* HRG; const float *conv_w, *conv_b, *ba, *bx, *spl, *state_conv, *state_rg; float* SEG; float* out;
};
__device__ __forceinline__ int prompt_row(int b, int p) { return p < NMETA ? ROW_M + p : b * SEQ + (p - NMETA); }

template <int MODE>
__device__ __forceinline__ void rg_unit(const Frame& F, const RgParams& P, const int b  , const int n, const int seg) {
    LAS unsigned char* lds = F.lds;
    int tid = F.tid; asm volatile("" : "+v"(tid));
    const int lane = tid & 63, wave = F.wave;
    const int cb = wave & 3, tb = wave >> 2, hh = lane >> 5, l31 = lane & 31;
    bf16x8 wfa[8], wfx[8];
    { const bf16* wa = P.WAX + ((size_t)n * 256 + 32 * cb + l31) * 128 + 8 * hh; const bf16* wx = wa + 128 * 128;
#pragma unroll
      for (int ks = 0; ks < 8; ++ks) { wfa[ks] = *(const bf16x8*)(wa + 16 * ks); wfx[ks] = *(const bf16x8*)(wx + 16 * ks); } }
    const int cg_e = n * 128 + 32 * cb + l31;
    const float ba_c = P.ba[cg_e], bx_c = P.bx[cg_e], spl8 = -8.0f * P.spl[cg_e] * LOG2E;
    const int sc_c = tid & 127, sc_q = tid >> 7, cg_s = n * 128 + sc_c;
    const int cv_tp = tid >> 4, cv_c8 = tid & 15, cg_v = n * 128 + 8 * cv_c8;
    if (tid < 5 * 32) { const int k = tid >> 5, c4 = (tid & 31) * 4; *(LAS f32x4*)(lds + RG_CW + (k * 128 + c4) * 4) = k < 4 ? *(const f32x4*)(P.conv_w + k * D + n * 128 + c4) : *(const f32x4*)(P.conv_b + n * 128 + c4); }
    __syncthreads();
    float hc = 0.f, cA = 1.f;
    if (MODE == 1) { for (int s2 = 0; s2 < seg; ++s2) { const f32x2 sv = *(const f32x2*)(P.SEG + (((size_t)b * 3 + s2) * D + cg_s) * 2); hc = sv.x * hc + sv.y; } }
    const int nchunks = (MODE == 2) ? 1 : (seg == 0 ? 9 : 8);
    auto chunk_p0 = [&](int ch) -> int { return seg == 0 ? (ch == 0 ? 0 : NMETA + 64 * (ch - 1)) : NMETA + 512 * seg + 64 * ch; };
    u32x4 xw[5], gw[2];
    auto load_x = [&](int ch) {
        const int p0n = chunk_p0(ch);
#pragma unroll
        for (int r = 0; r < 5; ++r) { const int p = p0n + 2 * cv_tp - 3 + r;
            xw[r] = (u32x4){0u, 0u, 0u, 0u};
            if (p >= 0) xw[r] = *(const u32x4*)(P.RX + (size_t)prompt_row(b, p < TP ? p : TP - 1) * D + cg_v); }
    };
    if (MODE != 2) load_x(0);
    for (int ch = 0; ch < nchunks; ++ch) {
        int p0 = 0, nvalid = 64;
        if (MODE != 2) { p0 = chunk_p0(ch); if (seg == 0 && ch == 0) nvalid = NMETA; }
        {
            float x[5][8], cw[4][8], cbias[8];
#pragma unroll
            for (int k = 0; k < 5; ++k) { const f32x4 a = *(const LAS f32x4*)(lds + RG_CW + (k * 128 + 8 * cv_c8) * 4), c = *(const LAS f32x4*)(lds + RG_CW + (k * 128 + 8 * cv_c8 + 4) * 4);
#pragma unroll
                for (int e = 0; e < 4; ++e) { if (k < 4) { cw[k][e] = a[e]; cw[k][4 + e] = c[e]; } else { cbias[e] = a[e]; cbias[4 + e] = c[e]; } } }
            if (MODE != 2) {
#pragma unroll
                for (int r = 0; r < 5; ++r) { const u32x4 w = xw[r];
                    x[r][0] = bflo(w.x); x[r][1] = bfhi(w.x); x[r][2] = bflo(w.y); x[r][3] = bfhi(w.y); x[r][4] = bflo(w.z); x[r][5] = bfhi(w.z); x[r][6] = bflo(w.w); x[r][7] = bfhi(w.w); }
                if (ch + 1 < nchunks) load_x(ch + 1);
            }
            if (MODE == 2) {
#pragma unroll
                for (int t = 0; t < 2; ++t) { const int row = 2 * cv_tp + t, j = row & 7, bb = 8 * b + (row >> 3);
                    float acc[8];
#pragma unroll
                    for (int e = 0; e < 8; ++e) acc[e] = cbias[e];
#pragma unroll
                    for (int k = 0; k < 4; ++k) { const int xi = j + k; float xv[8];
                        if (xi < 3) { const f32x4 a = *(const f32x4*)(P.state_conv + ((size_t)bb * 3 + xi) * D + cg_v), c = *(const f32x4*)(P.state_conv + ((size_t)bb * 3 + xi) * D + cg_v + 4);
#pragma unroll
                            for (int e = 0; e < 4; ++e) { xv[e] = a[e]; xv[4 + e] = c[e]; } }
                        else { const u32x4 w = *(const u32x4*)(P.RX + (size_t)(ROW_S + bb * 8 + xi - 3) * D + cg_v);
#pragma unroll
                            for (int e = 0; e < 4; ++e) { const unsigned ww = e == 0 ? w.x : e == 1 ? w.y : e == 2 ? w.z : w.w; xv[2 * e] = bflo(ww); xv[2 * e + 1] = bfhi(ww); } }
#pragma unroll
                        for (int e = 0; e < 8; ++e) acc[e] += xv[e] * cw[k][e]; }
                    *(LAS f32x4*)(lds + RG_XF + (row * 132 + 8 * cv_c8) * 4) = (f32x4){acc[0], acc[1], acc[2], acc[3]};
                    *(LAS f32x4*)(lds + RG_XF + (row * 132 + 8 * cv_c8 + 4) * 4) = (f32x4){acc[4], acc[5], acc[6], acc[7]};
                    u32x4 o; o.x = cvt_pk_bf16(acc[0], acc[1]); o.y = cvt_pk_bf16(acc[2], acc[3]); o.z = cvt_pk_bf16(acc[4], acc[5]); o.w = cvt_pk_bf16(acc[6], acc[7]);
                    *(LAS u32x4*)(lds + RG_XC + off256(row, cv_c8)) = o; }
            } else {
#pragma unroll
                for (int t = 0; t < 2; ++t) { const int row = 2 * cv_tp + t;
                    float acc[8];
#pragma unroll
                    for (int e = 0; e < 8; ++e) acc[e] = cbias[e] + x[t][e] * cw[0][e] + x[t + 1][e] * cw[1][e] + x[t + 2][e] * cw[2][e] + x[t + 3][e] * cw[3][e];
                    *(LAS f32x4*)(lds + RG_XF + (row * 132 + 8 * cv_c8) * 4) = (f32x4){acc[0], acc[1], acc[2], acc[3]};
                    *(LAS f32x4*)(lds + RG_XF + (row * 132 + 8 * cv_c8 + 4) * 4) = (f32x4){acc[4], acc[5], acc[6], acc[7]};
                    u32x4 o; o.x = cvt_pk_bf16(acc[0], acc[1]); o.y = cvt_pk_bf16(acc[2], acc[3]); o.z = cvt_pk_bf16(acc[4], acc[5]); o.w = cvt_pk_bf16(acc[6], acc[7]);
                    *(LAS u32x4*)(lds + RG_XC + off256(row, cv_c8)) = o; }
            }
        }
        __syncthreads();
        f32x16 ga = {}, gx = {};
#pragma unroll
        for (int ks = 0; ks < 8; ++ks) { const bf16x8 af = *(const LAS bf16x8*)(lds + RG_XC + off256(32 * tb + l31, 2 * ks + hh));
            ga = __builtin_amdgcn_mfma_f32_32x32x16_bf16(af, wfa[ks], ga, 0, 0, 0); gx = __builtin_amdgcn_mfma_f32_32x32x16_bf16(af, wfx[ks], gx, 0, 0, 0); }
#pragma unroll
        for (int r = 0; r < 16; ++r) { const int tok = 32 * tb + (r & 3) + 8 * (r >> 2) + 4 * hh; LAS float* xf = (LAS float*)(lds + RG_XF) + tok * 132 + 32 * cb + l31; LAS float* ab = (LAS float*)(lds + RG_AB) + tok * 132 + 32 * cb + l31;
            const float rr = sigmoidf_(ga[r] + ba_c), ii = sigmoidf_(gx[r] + bx_c);
            float a = fast_exp2(rr * spl8); float u = sqrtf(fmaxf(1.0f - a * a, 0.f)) * ii * (*xf);
            if (tok >= nvalid) { a = 1.f; u = 0.f; }
            *ab = a; *xf = u; }
        __syncthreads();
        if (MODE == 1) {
#pragma unroll
            for (int t = 0; t < 2; ++t) { const int p = p0 + 2 * cv_tp + t; gw[t] = *(const u32x4*)(P.GRG + (size_t)prompt_row(b, p < TP ? p : TP - 1) * D + cg_v); } }
        if (MODE == 2) {
#pragma unroll
            for (int t2 = 0; t2 < 2; ++t2) { const int bb = 8 * b + 2 * sc_q + t2; float h = P.state_rg[(size_t)bb * D + cg_s];
#pragma unroll
                for (int j = 0; j < 8; ++j) { const int row = 16 * sc_q + 8 * t2 + j; LAS float* ab = (LAS float*)(lds + RG_AB) + row * 132 + sc_c; const float u = ((LAS float*)(lds + RG_XF))[row * 132 + sc_c];
                    h = (*ab) * h + u; *ab = h; }
                P.out[O_SH + (size_t)bb * D + cg_s] = h; }
            __syncthreads();
        } else {
            float A = 1.f, Hh = 0.f, av[16], uv[16];
#pragma unroll
            for (int i = 0; i < 16; ++i) { const int row = 16 * sc_q + i; av[i] = ((LAS float*)(lds + RG_AB))[row * 132 + sc_c]; uv[i] = ((LAS float*)(lds + RG_XF))[row * 132 + sc_c]; }
#pragma unroll
            for (int i = 0; i < 16; ++i) { Hh = av[i] * Hh + uv[i]; A *= av[i]; }
            *(LAS f32x2*)(lds + RG_SUM + (sc_q * 128 + sc_c) * 8) = (f32x2){A, Hh};
            __syncthreads();
            float hin = hc, hend = hc, Aend = 1.f;
#pragma unroll
            for (int q = 0; q < 4; ++q) { const f32x2 sv = *(LAS f32x2*)(lds + RG_SUM + (q * 128 + sc_c) * 8); if (q < sc_q) hin = sv.x * hin + sv.y; hend = sv.x * hend + sv.y; Aend *= sv.x; }
            hc = hend; cA *= Aend;
            if (MODE == 1) {
                float h = hin;
#pragma unroll
                for (int i = 0; i < 16; ++i) { const int row = 16 * sc_q + i; h = av[i] * h + uv[i]; ((LAS float*)(lds + RG_AB))[row * 132 + sc_c] = h; }
                __syncthreads();
            }
        }
        if (MODE != 0) {
#pragma unroll
            for (int t = 0; t < 2; ++t) { const int row = 2 * cv_tp + t; int grow;
                if (MODE == 2) grow = ROW_S + 64 * b + row; else { const int p = p0 + row; grow = prompt_row(b, p < TP ? p : TP - 1); }
                if (MODE == 2 || (row < nvalid && p0 >= NMETA)) {
                    const f32x4 h0 = *(const LAS f32x4*)(lds + RG_AB + (row * 132 + 8 * cv_c8) * 4), h1 = *(const LAS f32x4*)(lds + RG_AB + (row * 132 + 8 * cv_c8 + 4) * 4);
                    f32x4 g0, g1; pg8::unpack8(MODE == 1 ? gw[t] : *(const u32x4*)(P.GRG + (size_t)grow * D + cg_v), g0, g1);
                    *(u32x4*)(P.HRG + (size_t)grow * D + cg_v) = pg8::pack8(h0 * g0, h1 * g1); } }
        }
        if (MODE == 0) __syncthreads();
    }
    if (MODE == 0) { if (sc_q == 0) *(f32x2*)(P.SEG + (((size_t)b * 3 + seg) * D + cg_s) * 2) = (f32x2){cA, hc}; }
    if (MODE == 1 && seg == 3) { if (sc_q == 0) P.out[O_PH + (size_t)b * D + cg_s] = hc; }
    __syncthreads();
}
constexpr int SK_PART = 0;
template <int KW  >
__device__ __forceinline__ void skinny_partial(const Frame& F, const bf16* __restrict__ A, const int lda, const bf16* __restrict__ Bt, const int ldb, const int r0, const int c0, const int lane, float& v0, float& v1) {
    LAS unsigned char* lds = F.lds;
    const int w = F.wave, hh = lane >> 5, l31 = lane & 31;
    const bf16* ap = A + (size_t)(r0 + l31) * lda + w * (KW * 16) + 8 * hh;
    const bf16* bp = Bt + (size_t)(c0 + l31) * ldb + w * (KW * 16) + 8 * hh;
    f32x16 acc = (f32x16){};
    constexpr int CH = KW < 8 ? KW : 8;
#pragma unroll 1
    for (int s0 = 0; s0 < KW; s0 += CH) {
        bf16x8 af[CH], bfr[CH];
#pragma unroll
        for (int s = 0; s < CH; ++s) { af[s] = *(const bf16x8*)(ap + 16 * (s0 + s)); bfr[s] = *(const bf16x8*)(bp + 16 * (s0 + s)); }
#pragma unroll
        for (int s = 0; s < CH; ++s) acc = __builtin_amdgcn_mfma_f32_32x32x16_bf16(bfr[s], af[s], acc, 0, 0, 0);
    }
    __syncthreads();
#pragma unroll
    for (int r = 0; r < 16; ++r) *(LAS float*)(lds + SK_PART + ((w * 16 + r) * 64 + lane) * 4) = acc[r];
    __syncthreads();
    const int t = F.tid, ln = t & 63, rg = 2 * (t >> 6);
    float s0 = 0.f, s1 = 0.f;
#pragma unroll
    for (int ww = 0; ww < 8; ++ww) { s0 += *(const LAS float*)(lds + SK_PART + ((ww * 16 + rg) * 64 + ln) * 4); s1 += *(const LAS float*)(lds + SK_PART + ((ww * 16 + rg + 1) * 64 + ln) * 4); }
    v0 = s0; v1 = s1;
}
__device__ __forceinline__ void skinny_coord(const int tid, int& row, int& col) { const int ln = tid & 63, rg = 2 * (tid >> 6); row = ln & 31; col = (rg & 3) + 8 * (rg >> 2) + 4 * (ln >> 5); }
constexpr int PA_KB = 64 * 384, PA_VB = 64 * 256;
constexpr int PA_K0 = 0, PA_V0 = 2 * PA_KB, PA_END = PA_V0 + 2 * PA_VB;
static_assert(PA_END <= MISC_OFF, "prompt attention lds");
__device__ __forceinline__ unsigned offK384(unsigned row, unsigned ch) { return 384u * row + 16u * (ch ^ ((row >> 1) & 7)); }
struct PAttnParams { const bf16 *QA, *KN, *KPE, *V; bf16* O; };

__device__ __forceinline__ void pattn_unit(const Frame& F, const PAttnParams& P, const int b, const int h, const int x) {
    LAS unsigned char* lds = F.lds;
    int lane = F.lane; asm volatile("" : "+v"(lane));
    const int w = F.wave, hh = lane >> 5, l31 = lane & 31;
#pragma nounroll
    for (int half = 0; half < 2; ++half) {
    const int xb = half ? 7 - x : x;
    const int tq = 256 * xb + 32 * w + l31;
    const size_t qrow = (size_t)b * SEQ + tq;
    bf16x8 qf[12];
#pragma unroll
    for (int s = 0; s < 12; ++s) qf[s] = *(const bf16x8*)(P.QA + qrow * 1536 + h * 192 + 16 * s + 8 * hh);
    f32x16 o[4];
#pragma unroll
    for (int i = 0; i < 4; ++i) o[i] = (f32x16){};
    float m = -1e30f, l = 0.f;
    const int ntiles = 1 + 4 * (xb + 1);
    unsigned ksrc[3], kstep[3], vsrc[2];
    const char* wsb = (const char*)P.KN - WS_KN;
#pragma unroll
    for (int i = 0; i < 3; ++i) { const unsigned pos = 1024u * (w + 8 * i) + 16u * lane, row = pos / 384u, chp = (pos % 384u) >> 4, ch = chp ^ ((row >> 1) & 7u);
        if (ch < 16) { ksrc[i] = (unsigned)WS_KN + (row * D + h * 128 + 8 * ch) * 2u; kstep[i] = D * 2; } else { ksrc[i] = (unsigned)WS_KPE + (row * 64 + 8 * (ch - 16)) * 2u; kstep[i] = 64 * 2; } }
#pragma unroll
    for (int i = 0; i < 2; ++i) { const unsigned pos = 1024u * (w + 8 * i) + 16u * lane, row = pos >> 8, chp = (pos & 255u) >> 4, ch = chp ^ (((row & 3) << 2) | ((row >> 2) & 3));
        vsrc[i] = (unsigned)WS_V + (row * D + h * 128 + 8 * ch) * 2u; }
    auto issue = [&](int it, int buf) {
        const unsigned row0 = it == 0 ? (unsigned)ROW_M : (unsigned)(b * SEQ + 64 * (it - 1));
#pragma unroll
        for (int i = 0; i < 3; ++i) __builtin_amdgcn_global_load_lds((const unsigned*)(wsb + (ksrc[i] + row0 * kstep[i])), (LAS unsigned*)(lds + PA_K0 + buf * PA_KB + 1024 * (w + 8 * i)), 16, 0, 0);
#pragma unroll
        for (int i = 0; i < 2; ++i) __builtin_amdgcn_global_load_lds((const unsigned*)(wsb + (vsrc[i] + row0 * (unsigned)(D * 2))), (LAS unsigned*)(lds + PA_V0 + buf * PA_VB + 1024 * (w + 8 * i)), 16, 0, 0);
    };
    issue(0, 0); VM_WAIT(); __syncthreads();
    constexpr float SC = SM_SCALE * LOG2E;
    const int trq = (lane & 15) >> 2, trp = lane & 3, trblk = (lane >> 4) & 1;
    unsigned kb4[4], vb8[2][4];
    { const unsigned sw = (l31 >> 1) & 7u, a = sw >> 1, c = sw & 1u;
#pragma unroll
      for (int v = 0; v < 4; ++v) kb4[v] = 384u * l31 + 16u * ((unsigned)hh ^ c) + 32u * ((unsigned)v ^ a);
      const unsigned clo = 2u * trblk + (trp >> 1);
#pragma unroll
      for (int t = 0; t < 2; ++t)
#pragma unroll
          for (int db = 0; db < 4; ++db) vb8[t][db] = 256u * (4u * hh + trq) + 8u * (trp & 1) + 16u * (clo ^ ((2u * t + hh) & 3u)) + 64u * ((unsigned)db ^ (unsigned)trq); }
#pragma nounroll
    for (int it = 0; it < ntiles; ++it) {
        const int buf = it & 1;
        if (it + 1 < ntiles) issue(it + 1, buf ^ 1);
        const int qmin = 256 * xb + 32 * w; const bool skip = (it > 0) && (64 * (it - 1) > qmin + 31);
        const int lim0 = (it == 0) ? NMETA : tq - 64 * (it - 1) + 1, lim1 = (it == 0) ? 0 : lim0 - 32;
        if (!skip) {
            f32x16 p0 = (f32x16){}, p1 = (f32x16){};
            const LAS unsigned char* Kb = lds + PA_K0 + buf * PA_KB;
#pragma unroll
            for (int sg = 0; sg < 6; ++sg) {
#pragma unroll
                for (int s = 2 * sg; s < 2 * sg + 2; ++s) { const bf16x8 a0 = *(const LAS bf16x8*)(Kb + kb4[s & 3] + 128 * (s >> 2)), a1 = *(const LAS bf16x8*)(Kb + kb4[s & 3] + 12288 + 128 * (s >> 2));
                    p0 = __builtin_amdgcn_mfma_f32_32x32x16_bf16(a0, qf[s], p0, 0, 0, 0); p1 = __builtin_amdgcn_mfma_f32_32x32x16_bf16(a1, qf[s], p1, 0, 0, 0); }
                __builtin_amdgcn_sched_barrier(0); }
            float pmax = -3e38f;
#pragma unroll
            for (int r = 0; r < 16; ++r) { const int kl = (r & 3) + 8 * (r >> 2) + 4 * hh;
                float x0 = p0[r] * SC, x1 = p1[r] * SC;
                x0 = kl < lim0 ? x0 : -3e38f; x1 = kl < lim1 ? x1 : -3e38f;
                p0[r] = x0; p1[r] = x1; pmax = fmaxf(pmax, fmaxf(x0, x1)); }
            pmax = fmaxf(pmax, __shfl_xor(pmax, 32));
            const float mn = fmaxf(m, pmax), alpha = fast_exp2(m - mn); m = mn;
            float ps = 0.f;
#pragma unroll
            for (int r = 0; r < 16; ++r) { p0[r] = fast_exp2(p0[r] - mn); p1[r] = fast_exp2(p1[r] - mn); ps += p0[r] + p1[r]; }
            l = l * alpha + ps;
#pragma unroll
            for (int i = 0; i < 4; ++i) o[i] = o[i] * alpha;
            const LAS unsigned char* Vb = lds + PA_V0 + buf * PA_VB;
#pragma unroll
            for (int kb = 0; kb < 2; ++kb)
#pragma unroll
                for (int s2 = 0; s2 < 2; ++s2) {
                    bf16x8 pf; { const f32x16& pp = kb ? p1 : p0; u32x4 t; t.x = cvt_pk_bf16(pp[8 * s2 + 0], pp[8 * s2 + 1]); t.y = cvt_pk_bf16(pp[8 * s2 + 2], pp[8 * s2 + 3]); t.z = cvt_pk_bf16(pp[8 * s2 + 4], pp[8 * s2 + 5]); t.w = cvt_pk_bf16(pp[8 * s2 + 6], pp[8 * s2 + 7]); pf = __builtin_bit_cast(bf16x8, t); }
#pragma unroll
                    for (int db = 0; db < 4; ++db) {
                        const s16x4 t0 = __builtin_amdgcn_ds_read_tr16_b64_v4i16((LAS s16x4*)(Vb + vb8[0][db] + 256 * (32 * kb + 16 * s2)));
                        const s16x4 t1 = __builtin_amdgcn_ds_read_tr16_b64_v4i16((LAS s16x4*)(Vb + vb8[1][db] + 256 * (32 * kb + 16 * s2 + 8)));
                        bf16x8 vf; vf[0] = t0[0]; vf[1] = t0[1]; vf[2] = t0[2]; vf[3] = t0[3]; vf[4] = t1[0]; vf[5] = t1[1]; vf[6] = t1[2]; vf[7] = t1[3];
                        o[db] = __builtin_amdgcn_mfma_f32_32x32x16_bf16(vf, pf, o[db], 0, 0, 0); }
                    __builtin_amdgcn_sched_barrier(0); }
        }
        VM_WAIT(); __syncthreads();
    }
    l += __shfl_xor(l, 32);
    const float il = 1.0f / l;
    bf16* orow = P.O + qrow * D + h * 128;
#pragma unroll
    for (int db = 0; db < 4; ++db)
#pragma unroll
        for (int rq = 0; rq < 4; ++rq) { u32x2 wv; wv.x = cvt_pk_bf16(o[db][4 * rq] * il, o[db][4 * rq + 1] * il); wv.y = cvt_pk_bf16(o[db][4 * rq + 2] * il, o[db][4 * rq + 3] * il);
            *(u32x2*)(orow + 32 * db + 8 * rq + 4 * hh) = wv; }
    __syncthreads();
    }
}
constexpr int SA_CKVB = 32 * 1024, SA_KPEB = 32 * 128;
constexpr int SA_CKV0 = 0, SA_KPE0 = 2 * SA_CKVB, SA_SB = SA_KPE0 + 2 * SA_KPEB, SA_PB = SA_SB + 64 * 36 * 4, SA_AL = SA_PB + 64 * 64, SA_END = SA_AL + 256;
constexpr int SA_QL = 0;
static_assert(64 * 576 * 2 <= SA_SB && SA_END <= MISC_OFF, "sample attention lds");
__device__ __forceinline__ unsigned off1024(unsigned row, unsigned ch) { return 1024u * row + 16u * (ch ^ (((row & 3) << 2) | ((row >> 2) & 3))); }
__device__ __forceinline__ unsigned offkpe(unsigned row, unsigned ch) { return 128u * row + 16u * (ch ^ ((row >> 1) & 7)); }
__device__ __forceinline__ unsigned offP(unsigned rho, unsigned ch) { return 64u * rho + 16u * (ch ^ ((rho >> 2) & 3)); }
struct SAttnParams { const float *cckv, *ckpe; const int* pt; const bf16 *QA, *WUKS, *CKVNS, *KPE; float *OPART, *ML; };

__device__ __forceinline__ void sattn_unit(const Frame& F, const SAttnParams& P, const int b, const int sp) {
    LAS unsigned char* lds = F.lds;
    int tid = F.tid; asm volatile("" : "+v"(tid));
    const int lane = tid & 63, w = F.wave, hh = lane >> 5, l31 = lane & 31, l15 = lane & 15, g = lane >> 4;
    {
        const int h = w;
        bf16x8 qa[4];
#pragma unroll
        for (int ks = 0; ks < 4; ++ks) qa[ks] = *(const bf16x8*)(P.QA + (size_t)(ROW_S + b * 8 + (l15 & 7)) * 1536 + h * 192 + 32 * ks + 8 * g);
        const bf16* wk = P.WUKS + ((size_t)h * 512 + l15) * 128 + 8 * g;
        for (int rb = 0; rb < 32; ++rb) {
            f32x4 acc = (f32x4){0.f, 0.f, 0.f, 0.f};
#pragma unroll
            for (int ks = 0; ks < 4; ++ks) { const bf16x8 bw = *(const bf16x8*)(wk + (size_t)rb * 16 * 128 + 32 * ks); acc = __builtin_amdgcn_mfma_f32_16x16x32_bf16(qa[ks], bw, acc, 0, 0, 0); }
            if (g < 2) {
#pragma unroll
                for (int e = 0; e < 4; ++e) *(LAS bf16*)(lds + SA_QL + ((h * 8 + 4 * g + e) * 576 + 16 * rb + l15) * 2) = (bf16)(cvt_pk_bf16(acc[e], 0.f) & 0xffffu);
            }
        }
        { const int rho = tid >> 3, c8 = tid & 7; const int hq = rho >> 3, j = rho & 7;
          *(LAS u32x4*)(lds + SA_QL + (rho * 576 + 512 + 8 * c8) * 2) = *(const u32x4*)(P.QA + (size_t)(ROW_S + b * 8 + j) * 1536 + hq * 192 + 128 + 8 * c8); }
    }
    __syncthreads();
#ifdef DBG_QLAT
    { bf16* dbg = (bf16*)((unsigned char*)P.OPART - WS_OPART + WS_U) + (size_t)(b * NSPLIT + sp) * 64 * 576;
      for (int i = tid; i < 64 * 576 / 8; i += NTHR) *(u32x4*)(dbg + i * 8) = *(const LAS u32x4*)(lds + SA_QL + i * 16); }
#endif
    const int kb = w & 1, rb = w >> 1;
    bf16x8 qb[18];
#pragma unroll
    for (int s = 0; s < 18; ++s) qb[s] = *(const LAS bf16x8*)(lds + SA_QL + ((16 * rb + l15) * 576 + 32 * s + 8 * g) * 2);
    __syncthreads();
    f32x16 o[2][2];
#pragma unroll
    for (int i = 0; i < 2; ++i)
#pragma unroll
        for (int j = 0; j < 2; ++j) o[i][j] = (f32x16){};
    const int srho = tid >> 3, skg = tid & 7;
    float m = -1e30f, l = 0.f;
    constexpr float SC = SM_SCALE * LOG2E;
    f32x4 cr[8], kr;
    auto issue = [&](int it) {
        const int page = 16 * sp + (it >> 2); const unsigned phys = (unsigned)P.pt[b * NPAGES + page]; const unsigned key0 = phys * PAGE + (unsigned)(it & 3) * 32u;
        const char* cbase = (const char*)P.cckv; const char* kbase = (const char*)P.ckpe;
#pragma unroll
        for (int i = 0; i < 4; ++i) { const unsigned off = ((key0 + (tid >> 6) + 8 * i) * KVL + 8 * (tid & 63)) * 4u; cr[2 * i] = *(const f32x4*)(cbase + off); cr[2 * i + 1] = *(const f32x4*)(cbase + off + 16); }
        kr = *(const f32x4*)(kbase + ((key0 + (tid >> 4)) * QKR + 4 * (tid & 15)) * 4u);
    };
    auto commit = [&](int buf) {
#pragma unroll
        for (int i = 0; i < 4; ++i) *(LAS u32x4*)(lds + SA_CKV0 + buf * SA_CKVB + off1024((tid >> 6) + 8 * i, tid & 63)) = pg8::pack8(cr[2 * i], cr[2 * i + 1]);
        u32x2 wv; wv.x = cvt_pk_bf16(kr[0], kr[1]); wv.y = cvt_pk_bf16(kr[2], kr[3]);
        *(LAS u32x2*)(lds + SA_KPE0 + buf * SA_KPEB + offkpe(tid >> 4, (tid & 15) >> 1) + 8 * (tid & 1)) = wv;
    };
    const int trq = l15 >> 2, trp = lane & 3, trblk = g & 1;
    unsigned sa4[4], ka2[2], va4[2][2], pa2[2];
    { const unsigned a = l15 & 3u, c = (l15 >> 2) & 3u, e = (l15 >> 1) & 7u, f = (l31 >> 2) & 3u, clo = 2u * trblk + (trp >> 1);
#pragma unroll
      for (int v = 0; v < 4; ++v) sa4[v] = 1024u * (16u * kb + l15) + 16u * ((unsigned)g ^ c) + 64u * ((unsigned)v ^ a);
#pragma unroll
      for (int s2 = 0; s2 < 2; ++s2) { ka2[s2] = offkpe(16u * kb + l15, 4u * s2 + g); pa2[s2] = offP(l31, 2u * s2 + hh); }
#pragma unroll
      for (int t = 0; t < 2; ++t)
#pragma unroll
          for (int db = 0; db < 2; ++db) va4[t][db] = 1024u * (8u * hh + 4u * t + trq) + 8u * (trp & 1) + 16u * (clo ^ ((2u * hh + t) & 3u)) + 64u * (((2u * (w & 1) + db) ^ (unsigned)trq)) + 256u * (w >> 1); }
    auto compute = [&](const int buf, const bool newtile) {
        {
            const LAS unsigned char* Cb = lds + SA_CKV0 + buf * SA_CKVB; const LAS unsigned char* Kb = lds + SA_KPE0 + buf * SA_KPEB;
            f32x4 acc = (f32x4){0.f, 0.f, 0.f, 0.f};
#pragma unroll
            for (int s = 0; s < 16; ++s) { const bf16x8 a = *(const LAS bf16x8*)(Cb + sa4[s & 3] + 256 * (s >> 2)); acc = __builtin_amdgcn_mfma_f32_16x16x32_bf16(a, qb[s], acc, 0, 0, 0);
                if ((s & 3) == 3) __builtin_amdgcn_sched_barrier(0); }
#pragma unroll
            for (int s = 0; s < 2; ++s) { const bf16x8 a = *(const LAS bf16x8*)(Kb + ka2[s]); acc = __builtin_amdgcn_mfma_f32_16x16x32_bf16(a, qb[16 + s], acc, 0, 0, 0); }
            *(LAS f32x4*)(lds + SA_SB + ((16 * rb + l15) * 36 + 16 * kb + 4 * g) * 4) = acc;
        }
        __syncthreads();
        {
            f32x4 v = *(const LAS f32x4*)(lds + SA_SB + (srho * 36 + 4 * skg) * 4) * SC;
            if (newtile) {
#pragma unroll
                for (int e = 0; e < 4; ++e) if (4 * skg + e > (srho & 7)) v[e] = -3e38f;
            }
            float tm = fmaxf(fmaxf(v[0], v[1]), fmaxf(v[2], v[3]));
            tm = fmaxf(tm, __shfl_xor(tm, 1)); tm = fmaxf(tm, __shfl_xor(tm, 2)); tm = fmaxf(tm, __shfl_xor(tm, 4));
            const float mn = fmaxf(m, tm), alpha = fast_exp2(m - mn); m = mn;
#pragma unroll
            for (int e = 0; e < 4; ++e) v[e] = fast_exp2(v[e] - mn);
            float ps = (v[0] + v[1]) + (v[2] + v[3]);
            ps += __shfl_xor(ps, 1); ps += __shfl_xor(ps, 2); ps += __shfl_xor(ps, 4);
            l = l * alpha + ps;
            u32x2 wv; wv.x = cvt_pk_bf16(v[0], v[1]); wv.y = cvt_pk_bf16(v[2], v[3]);
            *(LAS u32x2*)(lds + SA_PB + offP(srho, skg >> 1) + 8 * (skg & 1)) = wv;
            if (skg == 0) *(LAS float*)(lds + SA_AL + srho * 4) = alpha;
        }
    };
    auto pv = [&](const int buf) {
        const LAS unsigned char* Cb = lds + SA_CKV0 + buf * SA_CKVB;
        const float a0 = *(const LAS float*)(lds + SA_AL + l31 * 4), a1 = *(const LAS float*)(lds + SA_AL + (32 + l31) * 4);
#pragma unroll
        for (int db = 0; db < 2; ++db) { o[db][0] = o[db][0] * a0; o[db][1] = o[db][1] * a1; }
#pragma unroll
        for (int s2 = 0; s2 < 2; ++s2) {
            const bf16x8 pb0 = *(const LAS bf16x8*)(lds + SA_PB + pa2[s2]), pb1 = *(const LAS bf16x8*)(lds + SA_PB + pa2[s2] + 2048);
#pragma unroll
            for (int db = 0; db < 2; ++db) {
                const s16x4 t0 = __builtin_amdgcn_ds_read_tr16_b64_v4i16((LAS s16x4*)(Cb + va4[0][db] + 16384 * s2));
                const s16x4 t1 = __builtin_amdgcn_ds_read_tr16_b64_v4i16((LAS s16x4*)(Cb + va4[1][db] + 16384 * s2));
                bf16x8 vf; vf[0] = t0[0]; vf[1] = t0[1]; vf[2] = t0[2]; vf[3] = t0[3]; vf[4] = t1[0]; vf[5] = t1[1]; vf[6] = t1[2]; vf[7] = t1[3];
                o[db][0] = __builtin_amdgcn_mfma_f32_32x32x16_bf16(vf, pb0, o[db][0], 0, 0, 0);
                o[db][1] = __builtin_amdgcn_mfma_f32_32x32x16_bf16(vf, pb1, o[db][1], 0, 0, 0); } }
    };
    constexpr int NT = (PAST / NSPLIT) / 32;
    issue(0); commit(0); issue(1); __syncthreads();
#pragma nounroll
    for (int it = 0; it < NT; ++it) {
        const int buf = it & 1;
        compute(buf, false);
        if (it + 1 < NT) { commit(buf ^ 1); if (it + 2 < NT) issue(it + 2); }
        __syncthreads();
        pv(buf);
    }
    if (sp == NSPLIT - 1) {
        __syncthreads();
        { const char* wsb = (const char*)P.KPE - WS_KPE;
#pragma nounroll
          for (int i = tid; i < 32 * 64; i += NTHR) { const int key = i >> 6, ch = i & 63; u32x4 v = (u32x4){0u, 0u, 0u, 0u}; if (key < DS) v = *(const u32x4*)(wsb + ((unsigned)WS_CKVNS + (unsigned)(((b * DS + key) * KVL + 8 * ch) * 2)));
            *(LAS u32x4*)(lds + SA_CKV0 + off1024(key, ch)) = v; }
          if (tid < 32 * 8) { const int key = tid >> 3, ch = tid & 7; u32x4 v = (u32x4){0u, 0u, 0u, 0u}; if (key < DS) v = *(const u32x4*)(wsb + ((unsigned)WS_KPE + (unsigned)(((ROW_S + b * DS + key) * 64 + 8 * ch) * 2)));
            *(LAS u32x4*)(lds + SA_KPE0 + offkpe(key, ch)) = v; } }
        __syncthreads();
        compute(0, true);
        __syncthreads();
        pv(0);
    }
    float* op = P.OPART + ((size_t)(b * NSPLIT + sp) * 64) * KVL;
#pragma unroll
    for (int db = 0; db < 2; ++db)
#pragma unroll
        for (int rbk = 0; rbk < 2; ++rbk)
#pragma unroll
            for (int rq = 0; rq < 4; ++rq) *(f32x4*)(op + (size_t)(32 * rbk + l31) * KVL + 64 * w + 32 * db + 8 * rq + 4 * hh) = (f32x4){o[db][rbk][4 * rq], o[db][rbk][4 * rq + 1], o[db][rbk][4 * rq + 2], o[db][rbk][4 * rq + 3]};
    if (skg == 0) *(f32x2*)(P.ML + ((size_t)(b * NSPLIT + sp) * 64 + srho) * 2) = (f32x2){m, l};
    __syncthreads();
}

struct SCombParams { const float *OPART, *ML, *w_uv; bf16* O; };
__device__ __forceinline__ void scomb_unit(const Frame& F, const SCombParams& P, const int b, const int h) {
    LAS float* OL = (LAS float*)F.lds;
    int tid = F.tid; asm volatile("" : "+v"(tid));
    {
        const int r = tid;
#pragma unroll
        for (int j = 0; j < 8; ++j) { const int rho = h * 8 + j; float mm[NSPLIT], ll[NSPLIT], M = -3e38f;
#pragma unroll
            for (int s = 0; s < NSPLIT; ++s) { const f32x2 v = *(const f32x2*)(P.ML + ((size_t)(b * NSPLIT + s) * 64 + rho) * 2); mm[s] = v.x; ll[s] = v.y; M = fmaxf(M, v.x); }
            float L = 0.f, acc = 0.f;
#pragma unroll
            for (int s = 0; s < NSPLIT; ++s) { const float wgt = fast_exp2(mm[s] - M); L += wgt * ll[s]; acc += wgt * P.OPART[((size_t)(b * NSPLIT + s) * 64 + rho) * KVL + r]; }
            OL[j * 512 + r] = acc / L; }
    }
    __syncthreads();
    {
        const int d = tid & 127, rq = tid >> 7; float acc[8];
#pragma unroll
        for (int j = 0; j < 8; ++j) acc[j] = 0.f;
        const float* wp = P.w_uv + (size_t)(128 * rq) * 1024 + h * 128 + d;
#pragma unroll 16
        for (int r = 0; r < 128; ++r) { const float wv = wp[(size_t)r * 1024];
#pragma unroll
            for (int j = 0; j < 8; ++j) acc[j] += OL[j * 512 + 128 * rq + r] * wv; }
        LAS float* PT = OL + 8 * 512;
#pragma unroll
        for (int j = 0; j < 8; ++j) PT[(rq * 8 + j) * 128 + d] = acc[j];
        __syncthreads();
        const int j = tid >> 6, d2 = (tid & 63) * 2;
        const float o0 = (PT[(0 * 8 + j) * 128 + d2] + PT[(1 * 8 + j) * 128 + d2]) + (PT[(2 * 8 + j) * 128 + d2] + PT[(3 * 8 + j) * 128 + d2]);
        const float o1 = (PT[(0 * 8 + j) * 128 + d2 + 1] + PT[(1 * 8 + j) * 128 + d2 + 1]) + (PT[(2 * 8 + j) * 128 + d2 + 1] + PT[(3 * 8 + j) * 128 + d2 + 1]);
        *(unsigned*)(P.O + (size_t)(ROW_S + b * 8 + j) * D + h * 128 + d2) = cvt_pk_bf16(o0, o1);
    }
    __syncthreads();
}
__device__ __forceinline__ void thin_ckv_conv(const Frame& F, const Args& args) {
    unsigned char* ws = F.ws; float* out = F.out;
    const int gw = F.vcu * NWAVES + F.wave, NGW = F.G * NWAVES, lane = F.lane;
    const bf16* CKVR = (const bf16*)(ws + WS_CKVR); const float* SSQ = (const float*)(ws + WS_SSQKV); const bf16* RX = (const bf16*)(ws + WS_RX);
    const f32x4 g0 = *(const f32x4*)(IN_F(I_KVG) + 8 * lane), g1 = *(const f32x4*)(IN_F(I_KVG) + 8 * lane + 4);
    for (int row = gw; row < ROW_M + NMETA; row += NGW) {
        const f32x4 s0 = *(const f32x4*)(SSQ + (size_t)row * 8), s1 = *(const f32x4*)(SSQ + (size_t)row * 8 + 4);
        const float ss = ((s0[0] + s0[1]) + (s0[2] + s0[3])) + ((s1[0] + s1[1]) + (s1[2] + s1[3]));
        const float rstd = 1.0f / sqrtf(ss * (1.0f / KVL) + EPS);
        f32x4 v0, v1; pg8::unpack8(*(const u32x4*)(CKVR + (size_t)row * KVL + 8 * lane), v0, v1);
        v0 = v0 * rstd * g0; v1 = v1 * rstd * g1;
        if (row < ROW_S) { float* o = out + O_PCKV + ((size_t)(row >> 11) * TP + NMETA + (row & (SEQ - 1))) * KVL + 8 * lane; *(f32x4*)o = v0; *(f32x4*)(o + 4) = v1; }
        else if (row < ROW_M) { float* o = out + O_SCKV + (size_t)(row - ROW_S) * KVL + 8 * lane; *(f32x4*)o = v0; *(f32x4*)(o + 4) = v1;
            *(u32x4*)((bf16*)(ws + WS_CKVNS) + (size_t)(row - ROW_S) * KVL + 8 * lane) = pg8::pack8(v0, v1); }
        else { for (int b = 0; b < NB; ++b) { float* o = out + O_PCKV + ((size_t)b * TP + (row - ROW_M)) * KVL + 8 * lane; *(f32x4*)o = v0; *(f32x4*)(o + 4) = v1; } }
    }
    for (int i = gw; i < NB * 3 + DB * 3; i += NGW) {
        int srow; float* o;
        if (i < NB * 3) { const int b = i / 3, k = i % 3; srow = b * SEQ + SEQ - 3 + k; o = out + O_PCONV + (size_t)i * D; }
        else { const int q = i - NB * 3, b = q / 3, k = q % 3; srow = ROW_S + b * DS + DS - 3 + k; o = out + O_SCONV + (size_t)q * D; }
#pragma unroll
        for (int j = 0; j < 2; ++j) { f32x4 v0, v1; pg8::unpack8(*(const u32x4*)(RX + (size_t)srow * D + 8 * (lane + 64 * j)), v0, v1); *(f32x4*)(o + 8 * (lane + 64 * j)) = v0; *(f32x4*)(o + 8 * (lane + 64 * j) + 4) = v1; }
    }
}

constexpr int NPHASES = 11;
__global__ void __launch_bounds__(NTHR, 2) hawk_fwd(Args args) {
    extern __shared__ __attribute__((aligned(16))) unsigned char lds_raw[];
    Frame F;
    F.lds = (LAS unsigned char*)lds_raw; F.MISC = (volatile LAS unsigned*)(F.lds + MISC_OFF);
    F.tid = threadIdx.x; F.lane = F.tid & 63; F.wave = __builtin_amdgcn_readfirstlane(F.tid >> 6);
    F.G = gridDim.x; { const int bx = blockIdx.x; F.vcu = (F.G % 8 == 0) ? (bx % 8) * (F.G / 8) + bx / 8 : bx; }
    F.out = args.out; F.ws = args.ws; F.ctl = (unsigned*)(args.ws + WS_CTL);
    unsigned char* ws = args.ws;
    for (int u = F.tid; u < 64; u += NTHR) ((LAS unsigned*)(F.lds + MISC_OFF))[u] = 0u;
    __syncthreads();
#if MK_PER_PHASE
#define GRID_BAR() do { } while (0)
#else
    XcdBarrier bar = xcd_barrier_post((unsigned*)F.ctl + CW_BAR, F.MISC + 8);
#define GRID_BAR() xcd_barrier(bar)
#endif
    const int lo = args.ph_lo, hi = args.ph_hi;
#ifndef PH_MASK
#define PH_MASK 0x7ff
#endif
#define IN(k) ((((PH_MASK) >> (k)) & 1) && lo <= (k) && (k) < hi)
#ifndef DUP_MASK
#define DUP_MASK 0
#endif
#ifndef P3DUP
#define P3DUP 0
#endif
#define REP(k) for (int rep_ = 0; rep_ < 1 + (((DUP_MASK) >> (k)) & 1); ++rep_)
#define SEAM(k) do { if (IN(k) && IN((k) + 1)) GRID_BAR(); F.tid = threadIdx.x; F.lane = F.tid & 63; } while (0)
    const int G = F.G, bx = blockIdx.x;

    if (IN(0)) REP(0) { p0_prologue(F, args); }
    SEAM(0);
    if (IN(1)) REP(1) {
        pg8::TileSched S; S.init(ws + WS_H, ws + WS_WIN, D, 66, 22, G, bx);
        pg8::EpiWin E{(bf16*)(ws + WS_RX), (bf16*)(ws + WS_GRG), (bf16*)(ws + WS_CQ), (bf16*)(ws + WS_CKVR), (bf16*)(ws + WS_G), (bf16*)(ws + WS_KPE), (float*)(ws + WS_SSQQ), (float*)(ws + WS_SSQKV),
                      IN_F(I_BGATE), (const float*)(ws + WS_ROPEC), (const float*)(ws + WS_ROPES), F.out};
        pg8::gemm_phase<pg8::EpiWin, pg8::TileSched, true, true>(F.lds, D, S, E);
    }
    SEAM(1);
    const RgParams RGP{(const bf16*)(ws + WS_RX), (const bf16*)(ws + WS_GRG), (const bf16*)(ws + WS_WAX), (bf16*)(ws + WS_HRG), IN_F(I_CONVW), IN_F(I_CONVB), IN_F(I_BA), IN_F(I_BX),
                       (const float*)(ws + WS_SPL), IN_F(I_SCONV), IN_F(I_SRG), (float*)(ws + WS_SEG), F.out};
    if (IN(2)) REP(2) {
        for (int u = F.vcu; u < 192; u += G) rg_unit<0>(F, RGP, u / 24, (u / 3) % 8, u % 3);
        { pg8::TileSched S; S.init(ws + WS_CQ, ws + WS_WQ, QL, 64, 6, G, bx);
          pg8::EpiQ E{(bf16*)(ws + WS_QA), (const float*)(ws + WS_SSQQ), (const float*)(ws + WS_ROPEC), (const float*)(ws + WS_ROPES)};
          pg8::gemm_phase<pg8::EpiQ, pg8::TileSched, true, true>(F.lds, QL, S, E); }
        { pg8::TileSched S; S.init(ws + WS_CKVR, ws + WS_WKV, KVL, 64, 8, G, bx ^ 0xF8);
          pg8::EpiKV E{(bf16*)(ws + WS_KN), (bf16*)(ws + WS_V), (const float*)(ws + WS_SSQKV)};
          pg8::gemm_phase<pg8::EpiKV, pg8::TileSched, true, true>(F.lds, KVL, S, E); }
        {
            int lane_ = F.lane; asm volatile("" : "+v"(lane_));
            int trow, tcol; skinny_coord(F.tid, trow, tcol);
            const bf16* CQs = (const bf16*)(ws + WS_CQ); const bf16* WQs = (const bf16*)(ws + WS_WQ); bf16* QAs = (bf16*)(ws + WS_QA); const float* SQ = (const float*)(ws + WS_SSQQ);
            for (int u = F.vcu; u < 8 * 40 + 64; u += G) {
                if (u < 8 * 40) {
                    const int rt = u / 40, ci = u % 40, r0 = ROW_S + 32 * rt, row = r0 + trow;
                    float ss = 0.f;
#pragma unroll
                    for (int i = 0; i < 12; ++i) ss += SQ[(size_t)row * 12 + i];
                    const float rstd = 1.0f / sqrtf(ss * (1.0f / QL) + EPS);
                    if (ci < 32) { float v0, v1; skinny_partial<6>(F, CQs, QL, WQs, QL, r0, 32 * ci, lane_, v0, v1);
                        const int col = 32 * ci + tcol, h = col >> 7, d = col & 127;
                        *(unsigned*)(QAs + (size_t)row * 1536 + h * 192 + d) = cvt_pk_bf16(v0 * rstd, v1 * rstd); }
                    else { const int h = ci - 32, c1 = 1024 + 256 * (h >> 2) + 32 * (h & 3); float a0, a1, b0, b1;
                        skinny_partial<6>(F, CQs, QL, WQs, QL, r0, c1, lane_, a0, a1); skinny_partial<6>(F, CQs, QL, WQs, QL, r0, c1 + 128, lane_, b0, b1);
                        const int pi = rope_idx_of_row(row); const float* rc = (const float*)(ws + WS_ROPEC) + pi * 32 + tcol; const float* rs = (const float*)(ws + WS_ROPES) + pi * 32 + tcol;
                        a0 *= rstd; a1 *= rstd; b0 *= rstd; b1 *= rstd;
                        *(unsigned*)(QAs + (size_t)row * 1536 + h * 192 + 128 + tcol) = cvt_pk_bf16(a0 * rc[0] - b0 * rs[0], a1 * rc[1] - b1 * rs[1]);
                        *(unsigned*)(QAs + (size_t)row * 1536 + h * 192 + 160 + tcol) = cvt_pk_bf16(a0 * rs[0] + b0 * rc[0], a1 * rs[1] + b1 * rc[1]); }
                } else {
                    const int ci = u - 8 * 40, row = ROW_M + trow; float v0, v1;
                    skinny_partial<4>(F, (const bf16*)(ws + WS_CKVR), KVL, (const bf16*)(ws + WS_WKV), KVL, ROW_M, 32 * ci, lane_, v0, v1);
                    const float* SK = (const float*)(ws + WS_SSQKV) + (size_t)row * 8; const float ss = ((SK[0] + SK[1]) + (SK[2] + SK[3])) + ((SK[4] + SK[5]) + (SK[6] + SK[7]));
                    const float rstd = 1.0f / sqrtf(ss * (1.0f / KVL) + EPS); const int col = 32 * ci + tcol;
                    bf16* dst = col < 1024 ? (bf16*)(ws + WS_KN) + (size_t)row * D + col : (bf16*)(ws + WS_V) + (size_t)row * D + (col - 1024);
                    *(unsigned*)dst = cvt_pk_bf16(v0 * rstd, v1 * rstd); }
            }
            __syncthreads();
        }
        thin_ckv_conv(F, args);
    }
    SEAM(2);
    if (IN(3)) {
        const PAttnParams PA{(const bf16*)(ws + WS_QA), (const bf16*)(ws + WS_KN), (const bf16*)(ws + WS_KPE), (const bf16*)(ws + WS_V), (bf16*)(ws + WS_O)};
        const SAttnParams SA{IN_F(I_CCKV), IN_F(I_CKPE), (const int*)args.in[I_PT], (const bf16*)(ws + WS_QA), (const bf16*)(ws + WS_WUKS), (const bf16*)(ws + WS_CKVNS), (const bf16*)(ws + WS_KPE),
                             (float*)(ws + WS_OPART), (float*)(ws + WS_ML)};
        const bool sfirst = (F.vcu & 1) == 0;
#ifndef P3_MASK
#define P3_MASK 7
#endif
#pragma nounroll
        for (int ph = 0; ph < 2; ++ph) {
            if ((ph == 0) == sfirst) { if (P3_MASK & 1) for (int r3 = 0; r3 < 1 + (P3DUP & 1); ++r3) for (int u = F.vcu; u < DB * NSPLIT; u += G) sattn_unit(F, SA, u / NSPLIT, u % NSPLIT); }
            else { if (P3_MASK & 2) for (int r3 = 0; r3 < 1 + ((P3DUP >> 1) & 1); ++r3) for (int u = F.vcu; u < 256; u += G) { const int bh = u >> 2; pattn_unit(F, PA, bh >> 3, bh & 7, u & 3); } }
        }
        if (P3_MASK & 4) for (int r3 = 0; r3 < 1 + ((P3DUP >> 2) & 1); ++r3) for (int u = F.vcu; u < 256; u += G) rg_unit<1>(F, RGP, u >> 5, (u >> 2) & 7, u & 3);
        if (P3_MASK & 4) for (int u = F.vcu; u < 32; u += G) rg_unit<2>(F, RGP, u >> 3, u & 7, 0);
    }
    SEAM(3);
    if (IN(4)) REP(4) {
        const SCombParams SC{(const float*)(ws + WS_OPART), (const float*)(ws + WS_ML), IN_F(I_WUV), (bf16*)(ws + WS_O)};
        for (int u = F.vcu; u < DB * NH; u += G) scomb_unit(F, SC, u >> 3, u & 7);
    }
    SEAM(4);
    if (IN(5)) REP(5) {
        { pg8::TileSched S; S.init(ws + WS_HRG, ws + WS_WBRR, D, 64, 4, G, bx); pg8::EpiZ<0> E{(bf16*)(ws + WS_MIX), (const bf16*)(ws + WS_G)};
          pg8::gemm_phase<pg8::EpiZ<0>, pg8::TileSched, true, true>(F.lds, D, S, E); }
        { pg8::TileSched S; S.init(ws + WS_O, ws + WS_WBRM, D, 64, 4, G, bx); pg8::EpiZ<1> E{(bf16*)(ws + WS_MIX), (const bf16*)(ws + WS_G)};
          pg8::gemm_phase<pg8::EpiZ<1>, pg8::TileSched, true, true>(F.lds, D, S, E); }
        {
            int lane_ = F.lane; asm volatile("" : "+v"(lane_));
            int trow, tcol; skinny_coord(F.tid, trow, tcol);
            for (int u = F.vcu; u < 8 * 32; u += G) { const int r0 = ROW_S + 32 * (u >> 5), c0 = 32 * (u & 31), row = r0 + trow, col = c0 + tcol; float a0, a1, b0, b1;
                skinny_partial<8>(F, (const bf16*)(ws + WS_HRG), D, (const bf16*)(ws + WS_WBRR), D, r0, c0, lane_, a0, a1);
                skinny_partial<8>(F, (const bf16*)(ws + WS_O), D, (const bf16*)(ws + WS_WBRM), D, r0, c0, lane_, b0, b1);
                const unsigned gr = *(const unsigned*)((const bf16*)(ws + WS_G) + (size_t)row * 2048 + col), gm = *(const unsigned*)((const bf16*)(ws + WS_G) + (size_t)row * 2048 + D + col);
                *(unsigned*)((bf16*)(ws + WS_MIX) + (size_t)row * D + col) = cvt_pk_bf16(bflo(gr) * a0 + bflo(gm) * b0, bfhi(gr) * a1 + bfhi(gm) * b1); }
            __syncthreads();
        }
    }
    SEAM(5);
    if (IN(6)) REP(6) {
        pg8::TileSched S; S.init(ws + WS_MIX, ws + WS_WO, D, 64, 4, G, bx); pg8::EpiRes E{(float*)(ws + WS_PRE), (const bf16*)(ws + WS_H), nullptr};
        pg8::gemm_phase<pg8::EpiRes, pg8::TileSched, true, true>(F.lds, D, S, E);
        {   int lane_ = F.lane; asm volatile("" : "+v"(lane_));
            int trow, tcol; skinny_coord(F.tid, trow, tcol);
            for (int u = F.vcu; u < 8 * 32; u += G) { const int r0 = ROW_S + 32 * (u >> 5), c0 = 32 * (u & 31), row = r0 + trow, col = c0 + tcol; float a0, a1;
                skinny_partial<8>(F, (const bf16*)(ws + WS_MIX), D, (const bf16*)(ws + WS_WO), D, r0, c0, lane_, a0, a1);
                const unsigned hv = *(const unsigned*)((const bf16*)(ws + WS_H) + (size_t)row * D + col);
                *(f32x2*)((float*)(ws + WS_PRE) + (size_t)row * D + col) = (f32x2){DN_ALPHA * bflo(hv) + a0, DN_ALPHA * bfhi(hv) + a1}; }
            __syncthreads();
        }
    }
    SEAM(6);
    if (IN(7)) REP(7) {
        const int gw = F.vcu * NWAVES + F.wave, NGW = G * NWAVES;
        for (int row = gw; row < ROW_M; row += NGW) ln_row((const float*)(ws + WS_PRE) + (size_t)row * D, IN_F(I_LN1G), IN_F(I_LN1B), (bf16*)(ws + WS_X1) + (size_t)row * D, nullptr, F.lane);
    }
    SEAM(7);
    if (IN(8)) REP(8) {
        pg8::TileSched S; S.init(ws + WS_X1, ws + WS_WUP, D, 64, 16, G, bx); pg8::EpiUp E{(bf16*)(ws + WS_U), IN_F(I_BUP)};
        pg8::gemm_phase<pg8::EpiUp, pg8::TileSched, true, true>(F.lds, D, S, E);
        {   int lane_ = F.lane; asm volatile("" : "+v"(lane_));
            int trow, tcol; skinny_coord(F.tid, trow, tcol);
            for (int u = F.vcu; u < 8 * 128; u += G) { const int r0 = ROW_S + 32 * (u >> 7), c0 = 32 * (u & 127), row = r0 + trow, col = c0 + tcol; float a0, a1;
                skinny_partial<8>(F, (const bf16*)(ws + WS_X1), D, (const bf16*)(ws + WS_WUP), D, r0, c0, lane_, a0, a1);
                a0 = fmaxf(a0 + IN_F(I_BUP)[col], 0.f); a1 = fmaxf(a1 + IN_F(I_BUP)[col + 1], 0.f);
                *(unsigned*)((bf16*)(ws + WS_U) + (size_t)row * DFF + col) = cvt_pk_bf16(a0 * a0, a1 * a1); }
            __syncthreads();
        }
    }
    SEAM(8);
    if (IN(9)) REP(9) {
        pg8::TileSched S; S.init(ws + WS_U, ws + WS_WDN, DFF, 64, 4, G, bx); pg8::EpiRes E{(float*)(ws + WS_PRE), (const bf16*)(ws + WS_X1), IN_F(I_BDN)};
        pg8::gemm_phase<pg8::EpiRes, pg8::TileSched, true, true>(F.lds, DFF, S, E);
        {   int lane_ = F.lane; asm volatile("" : "+v"(lane_));
            int trow, tcol; skinny_coord(F.tid, trow, tcol);
            for (int u = F.vcu; u < 8 * 32; u += G) { const int r0 = ROW_S + 32 * (u >> 5), c0 = 32 * (u & 31), row = r0 + trow, col = c0 + tcol; float a0, a1;
                skinny_partial<32>(F, (const bf16*)(ws + WS_U), DFF, (const bf16*)(ws + WS_WDN), DFF, r0, c0, lane_, a0, a1);
                const unsigned xv = *(const unsigned*)((const bf16*)(ws + WS_X1) + (size_t)row * D + col);
                *(f32x2*)((float*)(ws + WS_PRE) + (size_t)row * D + col) = (f32x2){DN_ALPHA * bflo(xv) + a0 + IN_F(I_BDN)[col], DN_ALPHA * bfhi(xv) + a1 + IN_F(I_BDN)[col + 1]}; }
            __syncthreads();
        }
    }
    SEAM(9);
    if (IN(10)) REP(10) {
        const int gw = F.vcu * NWAVES + F.wave, NGW = G * NWAVES;
        for (int row = gw; row < ROW_M; row += NGW) { float* o = row < ROW_S ? F.out + O_YP + (size_t)row * D : F.out + O_YS + (size_t)(row - ROW_S) * D;
            ln_row((const float*)(ws + WS_PRE) + (size_t)row * D, IN_F(I_LN2G), IN_F(I_LN2B), nullptr, o, F.lane); }
    }
#ifdef DBG_DUMP_OFF
    if (lo == 99) {
#ifdef DBG_DUMP_F32
        const float* srcf = (const float*)(ws + (size_t)(DBG_DUMP_OFF));
        for (size_t i = (size_t)F.vcu * NTHR + F.tid; i < (size_t)(DBG_DUMP_F32) / 4; i += (size_t)G * NTHR) *(f32x4*)(F.out + i * 4) = *(const f32x4*)(srcf + i * 4);
#else
#ifndef DBG_DUMP_N
#define DBG_DUMP_N ((size_t)ROW_M * D)
#endif
        const bf16* src = (const bf16*)(ws + (size_t)(DBG_DUMP_OFF));
        for (size_t i = (size_t)F.vcu * NTHR + F.tid; i < (size_t)(DBG_DUMP_N) / 8; i += (size_t)G * NTHR) { f32x4 v0, v1; pg8::unpack8(*(const u32x4*)(src + i * 8), v0, v1); *(f32x4*)(F.out + i * 8) = v0; *(f32x4*)(F.out + i * 8 + 4) = v1; }
#endif
    }
#endif
#undef IN
#undef SEAM
}

extern "C" void kernel_launch(void* const* d_in, const int* in_sizes, int n_in, void* d_out, int out_size, void* d_ws, size_t ws_size, hipStream_t stream) {
    static int grid = 0;
    if (grid == 0) {
        if (n_in != 35 || out_size != (int)O_END || ws_size < WS_END) { fprintf(stderr, "kernel_launch: unexpected shapes (n_in %d, out %d, ws %zu, need %zu)\n", n_in, out_size, ws_size, (size_t)WS_END); grid = -1; return; }
        int dev = 0, cus = 0, per_cu = 0;
        if (hipGetDevice(&dev) != hipSuccess || hipDeviceGetAttribute(&cus, hipDeviceAttributeMultiprocessorCount, dev) != hipSuccess) { grid = -1; return; }
        if (hipFuncSetAttribute((const void*)hawk_fwd, hipFuncAttributeMaxDynamicSharedMemorySize, LDS_BYTES) != hipSuccess) { fprintf(stderr, "kernel_launch: hipFuncSetAttribute failed\n"); grid = -1; return; }
        if (hipOccupancyMaxActiveBlocksPerMultiprocessor(&per_cu, (const void*)hawk_fwd, NTHR, LDS_BYTES) != hipSuccess || per_cu < 1) fprintf(stderr, "kernel_launch: occupancy query reports %d\n", per_cu);
        (void)hipGetLastError();
        grid = cus;
    }
    if (grid < 0) return;
    if (hipMemsetAsync((char*)d_ws + WS_CTL, 0, CTL_BYTES, stream) != hipSuccess) return;
    Args a{};
    for (int i = 0; i < 35; ++i) a.in[i] = d_in[i];
    a.out = (float*)d_out; a.ws = (unsigned char*)d_ws;
#if MK_PER_PHASE
#ifndef DBG_LAST_PHASE
#define DBG_LAST_PHASE (NPHASES - 1)
#endif
    if (DBG_LAST_PHASE < NPHASES - 1) (void)hipMemsetAsync(d_out, 0, (size_t)out_size * 4, stream);
    for (int p = 0; p <= DBG_LAST_PHASE; ++p) { a.ph_lo = p; a.ph_hi = p + 1; hipLaunchKernelGGL(hawk_fwd, dim3(grid), dim3(NTHR), LDS_BYTES, stream, a); }
#ifdef DBG_DUMP_OFF
    a.ph_lo = 99; a.ph_hi = 100; hipLaunchKernelGGL(hawk_fwd, dim3(grid), dim3(NTHR), LDS_BYTES, stream, a);
#endif
#else
    a.ph_lo = 0; a.ph_hi = NPHASES;
    hipLaunchKernelGGL(hawk_fwd, dim3(grid), dim3(NTHR), LDS_BYTES, stream, a);
#endif
}
```

```cpp
#include <hip/hip_runtime.h>
#include <cstdio>
#include <cstdint>

#ifndef MK_PER_PHASE
#define MK_PER_PHASE 0
#endif

#define GAS __attribute__((address_space(1)))
#define LAS __attribute__((address_space(3)))
typedef unsigned short bf16;
typedef short bf16x8 __attribute__((ext_vector_type(8)));
typedef short s16x4 __attribute__((ext_vector_type(4)));
typedef float f32x2 __attribute__((ext_vector_type(2)));
typedef float f32x4 __attribute__((ext_vector_type(4)));
typedef float f32x16 __attribute__((ext_vector_type(16)));
typedef unsigned u32x2 __attribute__((ext_vector_type(2)));
typedef unsigned u32x4 __attribute__((ext_vector_type(4)));

constexpr int D = 1024, NB = 8, SEQ = 2048, NMETA = 16, TP = SEQ + NMETA;
constexpr int DB = 32, DS = 8, PAST = 16384, PAGE = 128, NPAGES = PAST / PAGE;
constexpr int NH = 8, QKN = 128, QKR = 64, VH = 128, KVL = 512, QL = 768, DFF = 4096;
constexpr int NIN = 5440, NINP = 5632;
constexpr int ROW_S = NB * SEQ;
constexpr int ROW_M = ROW_S + DB * DS;
constexpr int R = 16896;
constexpr float EPS = 1e-5f;
constexpr float DN_ALPHA = 1.189207115002721f;
constexpr float SM_SCALE = 0.07216878364870322f;
constexpr float LOG2E = 1.4426950408889634f;
constexpr int NROPE = TP + DS;
constexpr int NSPLIT = 8;

constexpr size_t O_YP = 0, O_YS = O_YP + (size_t)NB * SEQ * D, O_PCKV = O_YS + (size_t)DB * DS * D, O_PKPE = O_PCKV + (size_t)NB * TP * KVL,
    O_PCONV = O_PKPE + (size_t)NB * TP * QKR, O_PH = O_PCONV + (size_t)NB * 3 * D, O_SCKV = O_PH + (size_t)NB * D, O_SKPE = O_SCKV + (size_t)DB * DS * KVL,
    O_SCONV = O_SKPE + (size_t)DB * DS * QKR, O_SH = O_SCONV + (size_t)DB * 3 * D, O_END = O_SH + (size_t)DB * D;
static_assert(O_END == 26861568, "output size");

constexpr size_t al256(size_t x) { return (x + 255) & ~(size_t)255; }
constexpr size_t WS_CTL = 0, CTL_BYTES = 1u << 20;
constexpr size_t WS_WIN = CTL_BYTES;
constexpr size_t WS_WQ = WS_WIN + al256((size_t)NINP * D * 2);
constexpr size_t WS_WKV = WS_WQ + al256((size_t)1536 * QL * 2);
constexpr size_t WS_WBRR = WS_WKV + al256((size_t)2048 * KVL * 2);
constexpr size_t WS_WBRM = WS_WBRR + al256((size_t)D * D * 2);
constexpr size_t WS_WO = WS_WBRM + al256((size_t)D * D * 2);
constexpr size_t WS_WUP = WS_WO + al256((size_t)D * D * 2);
constexpr size_t WS_WDN = WS_WUP + al256((size_t)DFF * D * 2);
constexpr size_t WS_WAX = WS_WDN + al256((size_t)DFF * D * 2);
constexpr size_t WS_WUKS = WS_WAX + al256((size_t)8 * 256 * 128 * 2);
constexpr size_t WS_ROPEC = WS_WUKS + al256((size_t)8 * 512 * 128 * 2);
constexpr size_t WS_ROPES = WS_ROPEC + al256((size_t)NROPE * 32 * 4);
constexpr size_t WS_SPL = WS_ROPES + al256((size_t)NROPE * 32 * 4);
constexpr size_t WS_H = WS_SPL + al256(4096);
constexpr size_t WS_RX = WS_H + al256((size_t)R * D * 2);
constexpr size_t WS_GRG = WS_RX + al256((size_t)R * D * 2);
constexpr size_t WS_CQ = WS_GRG + al256((size_t)R * D * 2);
constexpr size_t WS_CKVR = WS_CQ + al256((size_t)R * QL * 2);
constexpr size_t WS_G = WS_CKVR + al256((size_t)R * KVL * 2);
constexpr size_t WS_KPE = WS_G + al256((size_t)R * 2048 * 2);
constexpr size_t WS_SSQQ = WS_KPE + al256((size_t)R * 64 * 2);
constexpr size_t WS_SSQKV = WS_SSQQ + al256((size_t)R * 12 * 4);
constexpr size_t WS_QA = WS_SSQKV + al256((size_t)R * 8 * 4);
constexpr size_t WS_KN = WS_QA + al256((size_t)R * 1536 * 2);
constexpr size_t WS_V = WS_KN + al256((size_t)R * D * 2);
constexpr size_t WS_CKVNS = WS_V + al256((size_t)R * D * 2);
constexpr size_t WS_SEG = WS_CKVNS + al256((size_t)256 * KVL * 2);
constexpr size_t WS_HRG = WS_SEG + al256((size_t)8 * 3 * 1024 * 2 * 4);
constexpr size_t WS_O = WS_HRG + al256((size_t)R * D * 2);
constexpr size_t WS_OPART = WS_O + al256((size_t)R * D * 2);
constexpr size_t WS_ML = WS_OPART + al256((size_t)DB * NSPLIT * 64 * 512 * 4);
constexpr size_t WS_MIX = WS_ML + al256((size_t)DB * NSPLIT * 64 * 2 * 4);
constexpr size_t WS_PRE = WS_MIX + al256((size_t)R * D * 2);
constexpr size_t WS_X1 = WS_PRE + al256((size_t)R * D * 4);
constexpr size_t WS_U = WS_X1 + al256((size_t)R * D * 2);
constexpr size_t WS_END = WS_U + al256((size_t)R * DFF * 2);
static_assert(WS_END < (1ull << 32), "32-bit workspace offsets");

constexpr int CW_BAR = 4096;

constexpr int LDS_BYTES = 147456;
constexpr int MISC_OFF = 135168;
constexpr int NWAVES = 8, NTHR = 512;

__device__ __forceinline__ float bf2f(unsigned short b) { return __uint_as_float(((unsigned)b) << 16); }
__device__ __forceinline__ float bflo(unsigned w) { return __uint_as_float(w << 16); }
__device__ __forceinline__ float bfhi(unsigned w) { return __uint_as_float(w & 0xffff0000u); }
typedef __bf16 bf16x2_t __attribute__((ext_vector_type(2)));
__device__ __forceinline__ unsigned cvt_pk_bf16(float lo, float hi) { const f32x2 v = {lo, hi}; return __builtin_bit_cast(unsigned, __builtin_convertvector(v, bf16x2_t)); }
__device__ __forceinline__ float fast_exp2(float x) { return __builtin_amdgcn_exp2f(x); }
__device__ __forceinline__ float fast_rcp(float x) { return __builtin_amdgcn_rcpf(x); }
__device__ __forceinline__ float sigmoidf_(float x) { return fast_rcp(1.0f + fast_exp2(-x * LOG2E)); }
__device__ __forceinline__ float gelu_tanh(float x) { const float y = 0.7978845608028654f * (x + 0.044715f * x * x * x); return x * fast_rcp(1.0f + fast_exp2(-2.0f * LOG2E * y)); }
__device__ __forceinline__ float wave_sum(float v) {
#pragma unroll
    for (int o = 1; o < 64; o <<= 1) v += __shfl_xor(v, o);
    return v;
}
#define LDS_WAIT() asm volatile("s_waitcnt lgkmcnt(0)" ::: "memory")
#define VM_WAIT() asm volatile("s_waitcnt vmcnt(0)" ::: "memory")
namespace pg8 {
#define PG8_LAS __attribute__((address_space(3)))
constexpr int BM = 256, BK = 64, HALF = 128, HTB = HALF * BK * 2  , STAGE_BYTES = 8 * HTB, NXCD = 8, WGM = 8;
__host__ __device__ __forceinline__ int lds_byte(int r, int c) { const int st = (r >> 4) * 2 + (c >> 5), rr = r & 15, cc = c & 31, ob = rr * 64 + cc * 2; return st * 1024 + (ob ^ (((ob >> 9) & 1) << 5)); }
__host__ __device__ __forceinline__ void stage_rc(int b, int& R, int& C) { const int st = b / 1024, sb = b % 1024, swz = sb ^ (((sb >> 9) & 1) << 5); R = (st >> 1) * 16 + swz / 64; C = (st & 1) * 32 + (swz % 64) / 2; }
__host__ __device__ __forceinline__ int perm32(int rho) { const int n = rho >> 4, i = rho & 15; return 8 * (i >> 2) + 4 * n + (i & 3); }

struct Unit { const char* A; const char* B; int pm, pn; };

struct TileSched {
    const char* A; const char* B; size_t aT, bT; int nM, nN, nwg, G, c, rm_from, rm_add;
    __device__ __forceinline__ void init(const void* A_, const void* B_, int K, int nM_, int nN_, int G_, int c_, int rm_from_ = 1 << 30, int rm_add_ = 0) {
        A = (const char*)A_; B = (const char*)B_; aT = (size_t)BM * K * 2; bT = aT; nM = nM_; nN = nN_; nwg = nM * nN; G = G_; c = c_; rm_from = rm_from_; rm_add = rm_add_; }
    __device__ __forceinline__ bool next(int i, Unit& u) const {
        const long L = (long)i * G + c; if (L >= nwg) return false;
        int wgid = (int)L; { const int q = nwg / NXCD, r = nwg % NXCD, xcd = wgid % NXCD, off = wgid / NXCD; wgid = (xcd < r ? xcd * (q + 1) : r * (q + 1) + (xcd - r) * q) + off; }
        const int nig = WGM * nN, gid = wgid / nig, fm = gid * WGM, gsz = (nM - fm) < WGM ? (nM - fm) : WGM;
        int pm = fm + ((wgid % nig) % gsz); const int pn = (wgid % nig) / gsz; if (pm >= rm_from) pm += rm_add;
        u.pm = pm; u.pn = pn; u.A = A + (size_t)pm * aT; u.B = B + (size_t)pn * bT; return true;
    }
    __device__ __forceinline__ void a_ready(const Unit&) const {}
    __device__ __forceinline__ void done(const Unit&) const {}
};
template <class Epi, class Sched, bool ALIGN_EPI = false, bool SP2 = false>
__device__ __forceinline__ void gemm_phase(PG8_LAS unsigned char* lds, const int K, const Sched& S, const Epi& E) {
    const int tid = threadIdx.x, wid = __builtin_amdgcn_readfirstlane(tid >> 6), lane = tid & 63, wr = wid >> 2, wc = wid & 3, fr = lane & 15, fq = lane >> 4;
    const int nt = K / BK;
    unsigned voffA[2], voffB[2];
#pragma unroll
    for (int i = 0; i < 2; ++i) { int R, C; stage_rc(tid * 16 + i * 8192, R, C); const int Rb = Epi::PERM ? ((R & ~31) + perm32(R & 31)) : R;
        voffA[i] = (unsigned)(R * K + C) * 2u; voffB[i] = (unsigned)(Rb * K + C) * 2u; }
    const size_t kstep = (size_t)(BK * 2);
    const size_t hstep = (size_t)HALF * K * 2;
    const unsigned ldsw = (unsigned)wid * 1024u;
    const int aoff = lds_byte(wr * 64 + fr, fq * 8), boff = lds_byte(wc * 32 + fr, fq * 8);
#define PG8_SA(b, h) (((b) * 2 + (h)) * HTB)
#define PG8_SB(b, h) ((4 + (b) * 2 + (h)) * HTB)
#define PG8_STAGE(bufoff, gbase, voff) do { _Pragma("unroll") for (int _i = 0; _i < 2; ++_i) \
        __builtin_amdgcn_global_load_lds((const unsigned*)((const char*)(gbase) + (voff)[_i]), (PG8_LAS unsigned*)(lds + (bufoff) + ldsw + _i * 8192), 16, 0, 0); } while (0)
#define PG8_LDA(dst, b, h) do { _Pragma("unroll") for (int m = 0; m < 4; ++m) _Pragma("unroll") for (int k = 0; k < 2; ++k) dst[m][k] = *(const PG8_LAS bf16x8*)(lds + PG8_SA(b, h) + aoff + m * 2048 + k * 1024); } while (0)
#define PG8_LDB(dst, b, h) do { _Pragma("unroll") for (int n = 0; n < 2; ++n) _Pragma("unroll") for (int k = 0; k < 2; ++k) dst[n][k] = *(const PG8_LAS bf16x8*)(lds + PG8_SB(b, h) + boff + n * 2048 + k * 1024); } while (0)
#define PG8_MMA(ai, bj, At, Bt) do { __builtin_amdgcn_s_setprio(1); _Pragma("unroll") for (int m = 0; m < 4; ++m) _Pragma("unroll") for (int n = 0; n < 2; ++n) _Pragma("unroll") for (int k = 0; k < 2; ++k) \
        acc[ai][bj][m][n] = __builtin_amdgcn_mfma_f32_16x16x32_bf16(Bt[n][k], At[m][k], acc[ai][bj][m][n], 0, 0, 0); __builtin_amdgcn_s_setprio(0); } while (0)
#define PG8_WAIT_V(n) asm volatile("s_waitcnt vmcnt(" #n ")" ::: "memory")
#define PG8_WAIT_L(n) asm volatile("s_waitcnt lgkmcnt(" #n ")" ::: "memory")
#define PG8_BAR __builtin_amdgcn_s_barrier()
#define PG8_SCHED __builtin_amdgcn_sched_barrier(0)
    Unit cur, nxt; int ui = 0;
    if (!S.next(0, cur)) return;
    f32x4 acc[2][2][4][2];
#pragma unroll
    for (int a = 0; a < 2; ++a)
#pragma unroll
        for (int b = 0; b < 2; ++b)
#pragma unroll
            for (int m = 0; m < 4; ++m)
#pragma unroll
                for (int n = 0; n < 2; ++n) acc[a][b][m][n] = (f32x4){0.f, 0.f, 0.f, 0.f};
    bf16x8 At[4][2], B0[2][2], B1[2][2];
    const char* cA = cur.A; const char* cB = cur.B;
    S.a_ready(cur);
    if constexpr (SP2) {
        PG8_STAGE(PG8_SB(0, 0), cB, voffB); PG8_STAGE(PG8_SB(0, 1), cB + hstep, voffB); PG8_STAGE(PG8_SA(0, 0), cA, voffA); PG8_STAGE(PG8_SA(0, 1), cA + hstep, voffA);
        if (wr == 1) PG8_BAR;
        PG8_WAIT_V(2); PG8_BAR;
        PG8_STAGE(PG8_SB(1, 0), cB + kstep, voffB); PG8_STAGE(PG8_SA(1, 0), cA + kstep, voffA); PG8_STAGE(PG8_SB(1, 1), cB + hstep + kstep, voffB);
        PG8_WAIT_V(6); PG8_BAR;
    } else {
        PG8_STAGE(PG8_SB(0, 0), cB, voffB); PG8_STAGE(PG8_SA(0, 0), cA, voffA); PG8_STAGE(PG8_SB(0, 1), cB + hstep, voffB); PG8_STAGE(PG8_SA(0, 1), cA + hstep, voffA);
        if (wr == 1) PG8_BAR;
        PG8_WAIT_V(4); PG8_BAR;
        PG8_STAGE(PG8_SB(1, 0), cB + kstep, voffB); PG8_STAGE(PG8_SA(1, 0), cA + kstep, voffA); PG8_STAGE(PG8_SB(1, 1), cB + hstep + kstep, voffB);
        PG8_WAIT_V(6); PG8_BAR;
    }
    for (;;) {
        const bool has_next = S.next(ui + 1, nxt);
        const char* nA = has_next ? nxt.A : cA; const char* nB = has_next ? nxt.B : cB;
        for (int t = 0; t < nt; t += 2) {
            const bool last = (t == nt - 2);
            const char* a1 = cA + (size_t)(t + 1) * kstep;
            const char* a2 = last ? nA : cA + (size_t)(t + 2) * kstep; const char* b2 = last ? nB : cB + (size_t)(t + 2) * kstep;
            const char* a3 = a2 + kstep; const char* b3 = b2 + kstep;
            if (last && has_next) S.a_ready(nxt);
            if constexpr (SP2) {
            PG8_LDB(B0, 0, 0); PG8_LDB(B1, 0, 1); PG8_SCHED; PG8_LDA(At, 0, 0); PG8_STAGE(PG8_SA(1, 1), a1 + hstep, voffA);
            PG8_WAIT_V(8); PG8_WAIT_L(0); PG8_BAR; PG8_MMA(0, 0, At, B0); PG8_MMA(0, 1, At, B1); PG8_BAR; PG8_SCHED;
            PG8_LDA(At, 0, 1); PG8_STAGE(PG8_SB(0, 0), b2, voffB); PG8_STAGE(PG8_SB(0, 1), b2 + hstep, voffB); PG8_STAGE(PG8_SA(0, 0), a2, voffA);
            PG8_WAIT_V(8); PG8_WAIT_L(0); PG8_BAR; PG8_MMA(1, 0, At, B0); PG8_MMA(1, 1, At, B1); PG8_BAR; PG8_SCHED;
            PG8_LDB(B0, 1, 0); PG8_LDB(B1, 1, 1); PG8_SCHED; PG8_LDA(At, 1, 0); PG8_STAGE(PG8_SA(0, 1), a2 + hstep, voffA);
            PG8_WAIT_V(8); PG8_WAIT_L(0); PG8_BAR; PG8_MMA(0, 0, At, B0); PG8_MMA(0, 1, At, B1); PG8_BAR; PG8_SCHED;
            PG8_LDA(At, 1, 1); PG8_STAGE(PG8_SB(1, 0), b3, voffB); PG8_STAGE(PG8_SB(1, 1), b3 + hstep, voffB); PG8_STAGE(PG8_SA(1, 0), a3, voffA);
            PG8_WAIT_V(8); PG8_WAIT_L(0); PG8_BAR; PG8_MMA(1, 0, At, B0); PG8_MMA(1, 1, At, B1); PG8_BAR; PG8_SCHED;
            } else {
            PG8_LDB(B0, 0, 0); PG8_SCHED; PG8_LDA(At, 0, 0); PG8_STAGE(PG8_SA(1, 1), a1 + hstep, voffA);
            PG8_WAIT_L(8); PG8_BAR; PG8_WAIT_L(0); PG8_MMA(0, 0, At, B0); PG8_BAR; PG8_SCHED;
            PG8_LDB(B1, 0, 1); PG8_STAGE(PG8_SB(0, 0), b2, voffB);
            PG8_BAR; PG8_WAIT_L(0); PG8_MMA(0, 1, At, B1); PG8_BAR;
            PG8_LDA(At, 0, 1); PG8_STAGE(PG8_SA(0, 0), a2, voffA);
            PG8_BAR; PG8_WAIT_L(0); PG8_MMA(1, 0, At, B0); PG8_BAR; PG8_SCHED;
            PG8_STAGE(PG8_SB(0, 1), b2 + hstep, voffB);
            PG8_WAIT_V(6); PG8_BAR; PG8_MMA(1, 1, At, B1); PG8_BAR;
            PG8_LDB(B0, 1, 0); PG8_SCHED; PG8_LDA(At, 1, 0); PG8_STAGE(PG8_SA(0, 1), a2 + hstep, voffA);
            PG8_WAIT_L(8); PG8_BAR; PG8_WAIT_L(0); PG8_MMA(0, 0, At, B0); PG8_BAR; PG8_SCHED;
            PG8_LDB(B1, 1, 1); PG8_STAGE(PG8_SB(1, 0), b3, voffB);
            PG8_BAR; PG8_WAIT_L(0); PG8_MMA(0, 1, At, B1); PG8_BAR;
            PG8_LDA(At, 1, 1); PG8_STAGE(PG8_SA(1, 0), a3, voffA);
            PG8_BAR; PG8_WAIT_L(0); PG8_MMA(1, 0, At, B0); PG8_BAR; PG8_SCHED;
            PG8_STAGE(PG8_SB(1, 1), b3 + hstep, voffB);
            PG8_WAIT_V(6); PG8_BAR; PG8_MMA(1, 1, At, B1); PG8_BAR;
            }
        }
        if constexpr (ALIGN_EPI) { if (wr == 0) PG8_BAR; }
        if constexpr (!Epi::AFTER_DRAIN) { E(acc, cur, wr, wc, fr, fq); S.done(cur); }
        if (!has_next) break;
#pragma unroll
        for (int a = 0; a < 2; ++a)
#pragma unroll
            for (int b = 0; b < 2; ++b)
#pragma unroll
                for (int m = 0; m < 4; ++m)
#pragma unroll
                    for (int n = 0; n < 2; ++n) acc[a][b][m][n] = (f32x4){0.f, 0.f, 0.f, 0.f};
        cur = nxt; cA = nA; cB = nB; ++ui;
        if constexpr (ALIGN_EPI) { if (wr == 1) PG8_BAR; }
    }
    PG8_WAIT_V(0);
    if constexpr (!ALIGN_EPI) { if (wr == 0) PG8_BAR; }
    PG8_BAR;
    if constexpr (Epi::AFTER_DRAIN) { E.fused(acc, cur, wr, wc, fr, fq, lds, wid, lane); S.done(cur); }
#undef PG8_SA
#undef PG8_SB
#undef PG8_STAGE
#undef PG8_LDA
#undef PG8_LDB
#undef PG8_MMA
#undef PG8_WAIT_V
#undef PG8_WAIT_L
#undef PG8_BAR
#undef PG8_SCHED
}
}
#define RLX_AGENT __ATOMIC_RELAXED, __HIP_MEMORY_SCOPE_AGENT
#define XB_TMO      128
#define XB_XCNT(j)  (256  + 64 * (j))
#define XB_XSUB(j)  (1280 + 64 * (j))
#define XB_XGEN(j)  (2304 + 64 * (j))
#define XB_TOP      3328
#define XB_TOPGEN   3392
#define XCD_BAR_WORDS 3456
#define XB_SPIN_CAP (1u << 18)

__device__ __forceinline__ unsigned xb_ld(unsigned* p)              { return __hip_atomic_load(p, __ATOMIC_RELAXED, __HIP_MEMORY_SCOPE_AGENT); }
__device__ __forceinline__ unsigned xb_add(unsigned* p, unsigned v) { return __hip_atomic_fetch_add(p, v, __ATOMIC_RELAXED, __HIP_MEMORY_SCOPE_AGENT); }
__device__ __forceinline__ unsigned xb_xcc_id() { return (unsigned)__builtin_amdgcn_s_getreg((3 << 11) | 20) & 0xFu; }
#define XB_SPIN(cond, bar) do { unsigned _sp = 0; while (cond) { __builtin_amdgcn_s_sleep(1); \
    if ((++_sp & 255u) == 0u) { if (xb_ld(&(bar)[XB_TMO])) break; if (_sp > XB_SPIN_CAP) { atomicAdd(&(bar)[XB_TMO], 1u); break; } } } } while (0)

struct XcdBarrier {
    unsigned* bar; unsigned x;
    volatile LAS unsigned* st;
};

__device__ __forceinline__ XcdBarrier xcd_barrier_post(unsigned* bar, volatile LAS unsigned* st) {
    XcdBarrier b; b.bar = bar; b.x = xb_xcc_id(); b.st = st;
    if (threadIdx.x == 0) (void)xb_add(&bar[XB_XCNT(b.x)], 1u);
    return b;
}
__device__ __forceinline__ void xcd_barrier_complete(unsigned* bar, unsigned x, unsigned& nloc, unsigned& nx) {
    const unsigned G = gridDim.x * gridDim.y * gridDim.z;
    unsigned sum, cnt, mine, sp = 0u;
    for (;;) {
        sum = 0u; cnt = 0u; mine = 0u;
#pragma unroll
        for (unsigned j = 0; j < 16; ++j) { const unsigned c = xb_ld(&bar[XB_XCNT(j)]); sum += c; cnt += (c > 0u) ? 1u : 0u; mine = (j == x) ? c : mine; }
        if (sum == G) break;
        __builtin_amdgcn_s_sleep(1);
        if ((++sp & 255u) == 0u) { if (xb_ld(&bar[XB_TMO])) break; if (sp > XB_SPIN_CAP) { atomicAdd(&bar[XB_TMO], 1u); break; } }
    }
    nloc = mine > 0u ? mine : 1u; nx = cnt > 0u ? cnt : 1u;
}

__device__ __forceinline__ void xcd_barrier(const XcdBarrier& b) {
    asm volatile("s_waitcnt vmcnt(0)" ::: "memory");
    __syncthreads();
    if (threadIdx.x == 0) {
        unsigned* bar = b.bar;
        __builtin_amdgcn_s_waitcnt(0);
        unsigned nloc = b.st[0], nx = b.st[1];
        if (nloc == 0u) { xcd_barrier_complete(bar, b.x, nloc, nx); b.st[0] = nloc; b.st[1] = nx; }
        const unsigned old = xb_add(&bar[XB_XSUB(b.x)], 1u);
        const unsigned gen = old / nloc;
        if (old + 1u == (gen + 1u) * nloc) {
            __builtin_amdgcn_fence(__ATOMIC_RELEASE, "agent");
            asm volatile("s_waitcnt vmcnt(0)" ::: "memory");
            const unsigned og = xb_add(&bar[XB_TOP], 1u);
            const unsigned tg = og / nx;
            if (og + 1u == (tg + 1u) * nx) xb_add(&bar[XB_TOPGEN], 1u);
            else XB_SPIN(xb_ld(&bar[XB_TOPGEN]) == tg, bar);
            __builtin_amdgcn_fence(__ATOMIC_ACQUIRE, "agent");
            xb_add(&bar[XB_XGEN(b.x)], 1u);
            asm volatile("s_waitcnt vmcnt(0)" ::: "memory");
        } else {
            XB_SPIN(xb_ld(&bar[XB_XGEN(b.x)]) == gen, bar);
            __builtin_amdgcn_fence(__ATOMIC_ACQUIRE, "agent");
            asm volatile("s_waitcnt vmcnt(0)" ::: "memory");
        }
    }
    __syncthreads();
}

__device__ __forceinline__ int rope_idx_of_row(int row) {
    if (row < ROW_S) return NMETA + (row & (SEQ - 1));
    if (row < ROW_M) return TP + ((row - ROW_S) & (DS - 1));
    if (row < ROW_M + NMETA) return row - ROW_M;
    return -1;
}
namespace pg8 {
#define EPI_ROWS(ai, m) (row0 + (ai) * HALF + (m) * 16)
__device__ __forceinline__ u32x4 pack8(const f32x4 v0, const f32x4 v1) { u32x4 w; w.x = cvt_pk_bf16(v0[0], v0[1]); w.y = cvt_pk_bf16(v0[2], v0[3]); w.z = cvt_pk_bf16(v1[0], v1[1]); w.w = cvt_pk_bf16(v1[2], v1[3]); return w; }
__device__ __forceinline__ void unpack8(const u32x4 w, f32x4& v0, f32x4& v1) { v0 = (f32x4){bflo(w.x), bfhi(w.x), bflo(w.y), bfhi(w.y)}; v1 = (f32x4){bflo(w.z), bfhi(w.z), bflo(w.w), bfhi(w.w)}; }

struct EpiWin {
    static constexpr bool PERM = true, AFTER_DRAIN = false;
    bf16 *RX, *GRG, *CQ, *CKVR, *G, *KPE; float *SSQQ, *SSQKV; const float* b_gate; const float *ropec, *ropes; float* out;
    __device__ __forceinline__ void operator()(const f32x4 (&acc)[2][2][4][2], const Unit& u, int wr, int wc, int fr, int fq) const {
        const int pn = u.pn, row0 = u.pm * BM + wr * 64 + fr, cw = wc * 32 + 8 * fq;
        if (pn < 4 || (pn >= 8 && pn < 13)) {
            bf16* base; int ld, colt, nslot = 0, slot0 = 0; float* ssq = nullptr;
            if (pn < 4) { base = RX; ld = D; colt = pn * BM; }
            else if (pn < 11) { base = CQ; ld = QL; colt = (pn - 8) * BM; ssq = SSQQ; nslot = 12; slot0 = (pn - 8) * 4 + wc; }
            else { base = CKVR; ld = KVL; colt = (pn - 11) * BM; ssq = SSQKV; nslot = 8; slot0 = (pn - 11) * 4 + wc; }
#pragma unroll
            for (int ai = 0; ai < 2; ++ai)
#pragma unroll
                for (int m = 0; m < 4; ++m) { const int row = EPI_ROWS(ai, m); float s = 0.f;
#pragma unroll
                    for (int bj = 0; bj < 2; ++bj) { const f32x4 v0 = acc[ai][bj][m][0], v1 = acc[ai][bj][m][1];
                        *(u32x4*)(base + (size_t)row * ld + colt + bj * HALF + cw) = pack8(v0, v1);
                        s += (v0[0] * v0[0] + v0[1] * v0[1]) + (v0[2] * v0[2] + v0[3] * v0[3]) + (v1[0] * v1[0] + v1[1] * v1[1]) + (v1[2] * v1[2] + v1[3] * v1[3]); }
                    if (ssq) { s += __shfl_xor(s, 16); s += __shfl_xor(s, 32); if (fq == 0) ssq[(size_t)row * nslot + slot0] = s; } }
        } else if (pn < 8) {
            const int colt = (pn - 4) * BM;
#pragma unroll
            for (int ai = 0; ai < 2; ++ai)
#pragma unroll
                for (int m = 0; m < 4; ++m) { const int row = EPI_ROWS(ai, m);
#pragma unroll
                    for (int bj = 0; bj < 2; ++bj) { f32x4 v0 = acc[ai][bj][m][0], v1 = acc[ai][bj][m][1];
#pragma unroll
                        for (int j = 0; j < 4; ++j) { v0[j] = gelu_tanh(v0[j]); v1[j] = gelu_tanh(v1[j]); }
                        *(u32x4*)(GRG + (size_t)row * D + colt + bj * HALF + cw) = pack8(v0, v1); } }
        } else if (pn < 21) {
            const int colt = (pn - 13) * BM;
            f32x4 bv[2][2];
#pragma unroll
            for (int bj = 0; bj < 2; ++bj)
#pragma unroll
                for (int n = 0; n < 2; ++n) bv[bj][n] = *(const f32x4*)(b_gate + colt + bj * HALF + cw + 4 * n);
#pragma unroll
            for (int ai = 0; ai < 2; ++ai)
#pragma unroll
                for (int m = 0; m < 4; ++m) { const int row = EPI_ROWS(ai, m);
#pragma unroll
                    for (int bj = 0; bj < 2; ++bj) { f32x4 v0 = acc[ai][bj][m][0] + bv[bj][0], v1 = acc[ai][bj][m][1] + bv[bj][1];
#pragma unroll
                        for (int j = 0; j < 4; ++j) { v0[j] = sigmoidf_(v0[j]); v1[j] = sigmoidf_(v1[j]); }
                        *(u32x4*)(G + (size_t)row * 2048 + colt + bj * HALF + cw) = pack8(v0, v1); } }
        } else if (wc == 0) {
#pragma unroll
            for (int ai = 0; ai < 2; ++ai)
#pragma unroll
                for (int m = 0; m < 4; ++m) { const int row = EPI_ROWS(ai, m); const int pi = rope_idx_of_row(row);
                    if (pi >= 0) {
#pragma unroll
                        for (int n = 0; n < 2; ++n) { const int i0 = 8 * fq + 4 * n;
                            const f32x4 cs = *(const f32x4*)(ropec + pi * 32 + i0), sn = *(const f32x4*)(ropes + pi * 32 + i0);
                            const f32x4 x1 = acc[ai][0][m][n], x2 = acc[ai][1][m][n];
                            const f32x4 o1 = x1 * cs - x2 * sn, o2 = x1 * sn + x2 * cs;
                            u32x2 w1, w2; w1.x = cvt_pk_bf16(o1[0], o1[1]); w1.y = cvt_pk_bf16(o1[2], o1[3]); w2.x = cvt_pk_bf16(o2[0], o2[1]); w2.y = cvt_pk_bf16(o2[2], o2[3]);
                            *(u32x2*)(KPE + (size_t)row * 64 + i0) = w1; *(u32x2*)(KPE + (size_t)row * 64 + 32 + i0) = w2;
                            if (row < ROW_S) { float* o = out + O_PKPE + ((size_t)(row >> 11) * TP + pi) * 64 + i0; *(f32x4*)o = o1; *(f32x4*)(o + 32) = o2; }
                            else if (row < ROW_M) { float* o = out + O_SKPE + (size_t)(row - ROW_S) * 64 + i0; *(f32x4*)o = o1; *(f32x4*)(o + 32) = o2; }
                            else {
#pragma unroll
                                for (int b = 0; b < NB; ++b) { float* o = out + O_PKPE + ((size_t)b * TP + pi) * 64 + i0; *(f32x4*)o = o1; *(f32x4*)(o + 32) = o2; } } } } }
        }
    }
};
struct EpiQ {
    static constexpr bool PERM = true, AFTER_DRAIN = false;
    bf16* QA; const float* SSQQ; const float *ropec, *ropes;
    __device__ __forceinline__ void operator()(const f32x4 (&acc)[2][2][4][2], const Unit& u, int wr, int wc, int fr, int fq) const {
        const int pn = u.pn, row0 = u.pm * BM + wr * 64 + fr, cw = wc * 32 + 8 * fq;
#pragma unroll
        for (int ai = 0; ai < 2; ++ai)
#pragma unroll
            for (int m = 0; m < 4; ++m) { const int row = EPI_ROWS(ai, m);
                const f32x4 s0 = *(const f32x4*)(SSQQ + (size_t)row * 12), s1 = *(const f32x4*)(SSQQ + (size_t)row * 12 + 4), s2 = *(const f32x4*)(SSQQ + (size_t)row * 12 + 8);
                const float ss = ((s0[0] + s0[1]) + (s0[2] + s0[3])) + ((s1[0] + s1[1]) + (s1[2] + s1[3])) + ((s2[0] + s2[1]) + (s2[2] + s2[3]));
                const float rstd = 1.0f / sqrtf(ss * (1.0f / QL) + EPS);
                if (pn < 4) {
#pragma unroll
                    for (int bj = 0; bj < 2; ++bj) { const int h = pn * 2 + bj;
                        *(u32x4*)(QA + (size_t)row * 1536 + h * 192 + cw) = pack8(acc[ai][bj][m][0] * rstd, acc[ai][bj][m][1] * rstd); }
                } else {
                    const int h = (pn - 4) * 4 + wc; int pi = rope_idx_of_row(row); if (pi < 0) pi = 0;
#pragma unroll
                    for (int n = 0; n < 2; ++n) { const int i0 = 8 * fq + 4 * n;
                        const f32x4 cs = *(const f32x4*)(ropec + pi * 32 + i0), sn = *(const f32x4*)(ropes + pi * 32 + i0);
                        const f32x4 x1 = acc[ai][0][m][n] * rstd, x2 = acc[ai][1][m][n] * rstd;
                        const f32x4 o1 = x1 * cs - x2 * sn, o2 = x1 * sn + x2 * cs;
                        u32x2 w1, w2; w1.x = cvt_pk_bf16(o1[0], o1[1]); w1.y = cvt_pk_bf16(o1[2], o1[3]); w2.x = cvt_pk_bf16(o2[0], o2[1]); w2.y = cvt_pk_bf16(o2[2], o2[3]);
                        *(u32x2*)(QA + (size_t)row * 1536 + h * 192 + 128 + i0) = w1; *(u32x2*)(QA + (size_t)row * 1536 + h * 192 + 160 + i0) = w2; }
                } }
    }
};
struct EpiKV {
    static constexpr bool PERM = true, AFTER_DRAIN = false;
    bf16 *KN, *V; const float* SSQKV;
    __device__ __forceinline__ void operator()(const f32x4 (&acc)[2][2][4][2], const Unit& u, int wr, int wc, int fr, int fq) const {
        const int pn = u.pn, row0 = u.pm * BM + wr * 64 + fr, cw = wc * 32 + 8 * fq;
        bf16* base = pn < 4 ? KN : V; const int colt = (pn & 3) * BM;
#pragma unroll
        for (int ai = 0; ai < 2; ++ai)
#pragma unroll
            for (int m = 0; m < 4; ++m) { const int row = EPI_ROWS(ai, m);
                const f32x4 s0 = *(const f32x4*)(SSQKV + (size_t)row * 8), s1 = *(const f32x4*)(SSQKV + (size_t)row * 8 + 4);
                const float ss = ((s0[0] + s0[1]) + (s0[2] + s0[3])) + ((s1[0] + s1[1]) + (s1[2] + s1[3]));
                const float rstd = 1.0f / sqrtf(ss * (1.0f / KVL) + EPS);
#pragma unroll
                for (int bj = 0; bj < 2; ++bj) *(u32x4*)(base + (size_t)row * D + colt + bj * HALF + cw) = pack8(acc[ai][bj][m][0] * rstd, acc[ai][bj][m][1] * rstd); }
    }
};
template <int MODE> struct EpiZ {
    static constexpr bool PERM = true, AFTER_DRAIN = false;
    bf16* MIX; const bf16* G;
    __device__ __forceinline__ void operator()(const f32x4 (&acc)[2][2][4][2], const Unit& u, int wr, int wc, int fr, int fq) const {
        const int row0 = u.pm * BM + wr * 64 + fr, col0 = u.pn * BM + wc * 32 + 8 * fq;
#pragma unroll
        for (int ai = 0; ai < 2; ++ai)
#pragma unroll
            for (int m = 0; m < 4; ++m) { const int row = EPI_ROWS(ai, m);
#pragma unroll
                for (int bj = 0; bj < 2; ++bj) { const int col = col0 + bj * HALF;
                    f32x4 g0, g1; unpack8(*(const u32x4*)(G + (size_t)row * 2048 + MODE * D + col), g0, g1);
                    f32x4 v0 = acc[ai][bj][m][0] * g0, v1 = acc[ai][bj][m][1] * g1;
                    if (MODE == 1) { f32x4 t0, t1; unpack8(*(const u32x4*)(MIX + (size_t)row * D + col), t0, t1); v0 += t0; v1 += t1; }
                    *(u32x4*)(MIX + (size_t)row * D + col) = pack8(v0, v1); } }
    }
};
struct EpiRes {
    static constexpr bool PERM = false, AFTER_DRAIN = false;
    float* OUT; const bf16* RES; const float* bias;
    __device__ __forceinline__ void operator()(const f32x4 (&acc)[2][2][4][2], const Unit& u, int wr, int wc, int fr, int fq) const {
        const int row0 = u.pm * BM + wr * 64 + fr, col0 = u.pn * BM + wc * 32 + 4 * fq;
        f32x4 bv[2][2];
#pragma unroll
        for (int bj = 0; bj < 2; ++bj)
#pragma unroll
            for (int n = 0; n < 2; ++n) bv[bj][n] = bias ? *(const f32x4*)(bias + col0 + bj * HALF + n * 16) : (f32x4){0.f, 0.f, 0.f, 0.f};
#pragma unroll
        for (int ai = 0; ai < 2; ++ai)
#pragma unroll
            for (int m = 0; m < 4; ++m) { const size_t ro = (size_t)EPI_ROWS(ai, m) * D + col0;
#pragma unroll
                for (int bj = 0; bj < 2; ++bj)
#pragma unroll
                    for (int n = 0; n < 2; ++n) { const u32x2 w = *(const u32x2*)(RES + ro + bj * HALF + n * 16);
                        const f32x4 r = (f32x4){bflo(w.x), bfhi(w.x), bflo(w.y), bfhi(w.y)};
                        *(f32x4*)(OUT + ro + bj * HALF + n * 16) = r * DN_ALPHA + acc[ai][bj][m][n] + bv[bj][n]; } }
    }
};
struct EpiUp {
    static constexpr bool PERM = true, AFTER_DRAIN = false;
    bf16* U; const float* bias;
    __device__ __forceinline__ void operator()(const f32x4 (&acc)[2][2][4][2], const Unit& u, int wr, int wc, int fr, int fq) const {
        const int row0 = u.pm * BM + wr * 64 + fr, col0 = u.pn * BM + wc * 32 + 8 * fq;
        f32x4 bv[2][2];
#pragma unroll
        for (int bj = 0; bj < 2; ++bj)
#pragma unroll
            for (int n = 0; n < 2; ++n) bv[bj][n] = *(const f32x4*)(bias + col0 + bj * HALF + 4 * n);
#pragma unroll
        for (int ai = 0; ai < 2; ++ai)
#pragma unroll
            for (int m = 0; m < 4; ++m) { const int row = EPI_ROWS(ai, m);
#pragma unroll
                for (int bj = 0; bj < 2; ++bj) { f32x4 v0 = acc[ai][bj][m][0] + bv[bj][0], v1 = acc[ai][bj][m][1] + bv[bj][1];
#pragma unroll
                    for (int j = 0; j < 4; ++j) { const float a = fmaxf(v0[j], 0.f), b = fmaxf(v1[j], 0.f); v0[j] = a * a; v1[j] = b * b; }
                    *(u32x4*)(U + (size_t)row * DFF + col0 + bj * HALF) = pack8(v0, v1); } }
    }
};
#undef EPI_ROWS
}
struct Frame {
    LAS unsigned char* lds;
    volatile LAS unsigned* MISC;
    unsigned* ctl;
    int tid, lane, wave, vcu, G;
    const void* const* in;
    float* out; unsigned char* ws;
};
struct Args { const void* in[35]; float* out; unsigned char* ws; int ph_lo, ph_hi; };
#define IN_F(i) ((const float*)args.in[i])
enum { I_XP = 0, I_XS, I_CCKV, I_CKPE, I_PT, I_SCONV, I_SRG, I_META, I_LNG, I_LNB, I_WIN, I_BGATE, I_CONVW, I_CONVB, I_WA, I_BA, I_WX, I_BX, I_LAM, I_WBRR,
       I_QG, I_WUQ, I_KVG, I_WUK, I_WUV, I_WBRM, I_WO, I_LN1G, I_LN1B, I_WUP, I_BUP, I_WDN, I_BDN, I_LN2G, I_LN2B };

__device__ __forceinline__ void tr_item(const float* src, size_t ldn, int scol0, bf16* dst, int dK, int drow0, int k0, const float* kscale, LAS float* scr, int lane) {
    if (scol0 >= 0) {
#pragma unroll 8
        for (int i = 0; i < 32; ++i) { const int kk = 2 * i + (lane >> 5); scr[kk * 33 + (lane & 31)] = src[(size_t)(k0 + kk) * ldn + scol0 + (lane & 31)]; }
    } else {
#pragma unroll 8
        for (int i = 0; i < 32; ++i) { const int kk = 2 * i + (lane >> 5); scr[kk * 33 + (lane & 31)] = 0.f; }
    }
    LDS_WAIT(); asm volatile("" ::: "memory");
    const int c = lane & 7;
    float ks[8];
#pragma unroll
    for (int e = 0; e < 8; ++e) ks[e] = kscale ? kscale[k0 + 8 * c + e] : 1.0f;
#pragma unroll
    for (int j = 0; j < 4; ++j) { const int n = (lane >> 3) + 8 * j; const LAS float* s = scr + (8 * c) * 33 + n;
        u32x4 o; o.x = cvt_pk_bf16(s[0 * 33] * ks[0], s[1 * 33] * ks[1]); o.y = cvt_pk_bf16(s[2 * 33] * ks[2], s[3 * 33] * ks[3]);
        o.z = cvt_pk_bf16(s[4 * 33] * ks[4], s[5 * 33] * ks[5]); o.w = cvt_pk_bf16(s[6 * 33] * ks[6], s[7 * 33] * ks[7]);
        *(u32x4*)(dst + (size_t)(drow0 + n) * dK + k0 + 8 * c) = o; }
    LDS_WAIT(); asm volatile("" ::: "memory");
}
__device__ __forceinline__ void ln_row(const float* xrow, const float* g, const float* b, bf16* obf, float* of32, int lane) {
    const f32x4* xr = (const f32x4*)xrow + lane;
    f32x4 v[4]; float s = 0.f;
#pragma unroll
    for (int j = 0; j < 4; ++j) { v[j] = xr[64 * j]; s += (v[j].x + v[j].y) + (v[j].z + v[j].w); }
    const float mean = wave_sum(s) * (1.f / D); float s2 = 0.f;
#pragma unroll
    for (int j = 0; j < 4; ++j) { v[j] = v[j] - mean; s2 += (v[j].x * v[j].x + v[j].y * v[j].y) + (v[j].z * v[j].z + v[j].w * v[j].w); }
    const float rstd = 1.f / sqrtf(wave_sum(s2) * (1.f / D) + EPS);
#pragma unroll
    for (int j = 0; j < 4; ++j) { const f32x4 gg = ((const f32x4*)g)[lane + 64 * j], bb = ((const f32x4*)b)[lane + 64 * j]; const f32x4 y = v[j] * rstd * gg + bb;
        if (obf) { u32x2 w; w.x = cvt_pk_bf16(y.x, y.y); w.y = cvt_pk_bf16(y.z, y.w); ((u32x2*)obf)[lane + 64 * j] = w; }
        if (of32) ((f32x4*)of32)[lane + 64 * j] = y; }
}
__device__ __forceinline__ const float* src_row(const float* xp, const float* xs, const float* meta, int row) {
    if (row < ROW_S) return xp + (size_t)row * D;
    if (row < ROW_M) return xs + (size_t)(row - ROW_S) * D;
    if (row < ROW_M + NMETA) return meta + (size_t)(row - ROW_M) * D;
    return nullptr;
}
__device__ __forceinline__ void p0_prologue(const Frame& F, const Args& args) {
    unsigned char* ws = F.ws;
    LAS float* scr = (LAS float*)(F.lds + F.wave * 16384);
    const int gw = F.vcu * NWAVES + F.wave, NGW = F.G * NWAVES, lane = F.lane;
    constexpr int I_1 = 16 * (NINP / 32), I_2 = 12 * 48, I_3 = 8 * 32, I_4 = 8 * 32, I_5 = 16 * 32, I_8 = 16 * 128, I_9 = 64 * 32, I_10 = 8 * 8;
    constexpr int NITEMS = I_1 + I_2 + I_3 + I_4 + 3 * I_5 + I_8 + I_9 + 2 * I_10;
    for (int it = gw; it < NITEMS; it += NGW) {
        int r = it;
        if (r < I_1) { const int nb = r % (NINP / 32), kb = r / (NINP / 32), n0 = 32 * nb; int sc;
            if (n0 < 3328) sc = n0; else if (n0 < 5376) sc = n0 + 64; else { const int w = n0 - 5376; sc = (w == 0) ? 3328 : (w == 128 ? 3360 : -1); }
            tr_item(IN_F(I_WIN), NIN, sc, (bf16*)(ws + WS_WIN), D, n0, 64 * kb, nullptr, scr, lane); continue; } r -= I_1;
        if (r < I_2) { const int nb = r % 48, kb = r / 48, n0 = 32 * nb; int sc;
            if (n0 < 1024) sc = (n0 >> 7) * 192 + (n0 & 127);
            else { const int w = n0 - 1024, tt = w >> 8, wi = w & 255, half = wi >> 7, hh = (wi & 127) >> 5; sc = (4 * tt + hh) * 192 + 128 + 32 * half; }
            tr_item(IN_F(I_WUQ), 1536, sc, (bf16*)(ws + WS_WQ), QL, n0, 64 * kb, IN_F(I_QG), scr, lane); continue; } r -= I_2;
        if (r < I_3) { const int nb = r % 32, kb = r / 32; tr_item(IN_F(I_WUK), 1024, 32 * nb, (bf16*)(ws + WS_WKV), KVL, 32 * nb, 64 * kb, IN_F(I_KVG), scr, lane); continue; } r -= I_3;
        if (r < I_4) { const int nb = r % 32, kb = r / 32; tr_item(IN_F(I_WUV), 1024, 32 * nb, (bf16*)(ws + WS_WKV), KVL, 1024 + 32 * nb, 64 * kb, IN_F(I_KVG), scr, lane); continue; } r -= I_4;
        if (r < I_5) { const int nb = r % 32, kb = r / 32; tr_item(IN_F(I_WBRR), D, 32 * nb, (bf16*)(ws + WS_WBRR), D, 32 * nb, 64 * kb, nullptr, scr, lane); continue; } r -= I_5;
        if (r < I_5) { const int nb = r % 32, kb = r / 32; tr_item(IN_F(I_WBRM), D, 32 * nb, (bf16*)(ws + WS_WBRM), D, 32 * nb, 64 * kb, nullptr, scr, lane); continue; } r -= I_5;
        if (r < I_5) { const int nb = r % 32, kb = r / 32; tr_item(IN_F(I_WO), D, 32 * nb, (bf16*)(ws + WS_WO), D, 32 * nb, 64 * kb, nullptr, scr, lane); continue; } r -= I_5;
        if (r < I_8) { const int nb = r % 128, kb = r / 128; tr_item(IN_F(I_WUP), DFF, 32 * nb, (bf16*)(ws + WS_WUP), D, 32 * nb, 64 * kb, nullptr, scr, lane); continue; } r -= I_8;
        if (r < I_9) { const int nb = r % 32, kb = r / 32; tr_item(IN_F(I_WDN), D, 32 * nb, (bf16*)(ws + WS_WDN), DFF, 32 * nb, 64 * kb, nullptr, scr, lane); continue; } r -= I_9;
        if (r < I_10) { const int blk = r >> 3, nb = r & 3, kb = (r >> 2) & 1; tr_item(IN_F(I_WA) + (size_t)blk * 128 * 128, 128, 32 * nb, (bf16*)(ws + WS_WAX), 128, blk * 256 + 32 * nb, 64 * kb, nullptr, scr, lane); continue; } r -= I_10;
        { const int blk = r >> 3, nb = r & 3, kb = (r >> 2) & 1; tr_item(IN_F(I_WX) + (size_t)blk * 128 * 128, 128, 32 * nb, (bf16*)(ws + WS_WAX), 128, blk * 256 + 128 + 32 * nb, 64 * kb, nullptr, scr, lane); }
    }
    const int gt = F.vcu * NTHR + F.tid, NGT = F.G * NTHR;
    for (int i = gt; i < 8 * 512 * 16; i += NGT) { const int c8 = i & 15, r = (i >> 4) & 511, h = i >> 13;
        const f32x4 a = *(const f32x4*)(IN_F(I_WUK) + (size_t)r * 1024 + h * 128 + c8 * 8), b = *(const f32x4*)(IN_F(I_WUK) + (size_t)r * 1024 + h * 128 + c8 * 8 + 4);
        *(u32x4*)((bf16*)(ws + WS_WUKS) + ((size_t)h * 512 + r) * 128 + c8 * 8) = pg8::pack8(a, b); }
    for (int i = gt; i < NROPE * 32; i += NGT) { const int pi = i >> 5, k = i & 31; const int pos = pi < TP ? pi : PAST + (pi - TP);
        double pw = 1.0; for (int j = 0; j < k; ++j) pw *= 1.3335214321633240;
        const float inv = 1.0f / (float)pw; const float ang = (float)pos * inv; const double a = (double)ang;
        const double n2 = __builtin_rint(a * 0.15915494309189535); const double r = (a - n2 * 6.283185307179586) - n2 * 2.4492935982947064e-16;
        const double q = __builtin_rint(r * 0.6366197723675814); const double t = (r - q * 1.5707963267948966) - q * 6.123233995736766e-17; const int qi = ((int)q) & 3;
        const double t2 = t * t;
        const double st = t * (1.0 + t2 * (-1.0 / 6 + t2 * (1.0 / 120 + t2 * (-1.0 / 5040 + t2 * (1.0 / 362880 + t2 * (-1.0 / 39916800 + t2 * (1.0 / 6227020800.0)))))));
        const double ct = 1.0 + t2 * (-0.5 + t2 * (1.0 / 24 + t2 * (-1.0 / 720 + t2 * (1.0 / 40320 + t2 * (-1.0 / 3628800 + t2 * (1.0 / 479001600.0 + t2 * (-1.0 / 87178291200.0)))))));
        const double cv = qi == 0 ? ct : (qi == 1 ? -st : (qi == 2 ? -ct : st)), sv = qi == 0 ? st : (qi == 1 ? ct : (qi == 2 ? -st : -ct));
        ((float*)(ws + WS_ROPEC))[i] = (float)cv; ((float*)(ws + WS_ROPES))[i] = (float)sv; }
    for (int i = gt; i < D; i += NGT) { const float l = IN_F(I_LAM)[i]; ((float*)(ws + WS_SPL))[i] = (l > 0.f) ? log1pf(expf(-l)) : (-l + log1pf(expf(l))); }
    for (int m = gw; m < R; m += NGW) { const float* s = src_row(IN_F(I_XP), IN_F(I_XS), IN_F(I_META), m); bf16* o = (bf16*)(ws + WS_H) + (size_t)m * D;
        if (s) ln_row(s, IN_F(I_LNG), IN_F(I_LNB), o, nullptr, lane);
        else { for (int j = 0; j < 2; ++j) ((u32x4*)o)[lane + 64 * j] = (u32x4){0u, 0u, 0u, 0u}; } }
}
constexpr int RG_XC = 0;
constexpr int RG_XF = 16384;
constexpr int RG_AB = RG_XF + 64 * 132 * 4;
constexpr int RG_SUM = RG_AB + 64 * 132 * 4;
constexpr int RG_CW = RG_SUM + 4 * 128 * 2 * 4;
constexpr int RG_END = RG_CW + 5 * 128 * 4;
static_assert(RG_END <= MISC_OFF, "rg lds");
__device__ __forceinline__ unsigned off256(unsigned row, unsigned ch) { return 256u * row + 16u * (ch ^ (((row & 3) << 2) | ((row >> 2) & 3))); }

struct RgParams {
    const bf16 *RX, *GRG, *WAX; bf16* HRG; const float *conv_w, *conv_b, *ba, *bx, *spl, *state_conv, *state_rg; float* SEG; float* out;
};
__device__ __forceinline__ int prompt_row(int b, int p) { return p < NMETA ? ROW_M + p : b * SEQ + (p - NMETA); }

template <int MODE>
__device__ __forceinline__ void rg_unit(const Frame& F, const RgParams& P, const int b  , const int n, const int seg) {
    LAS unsigned char* lds = F.lds;
    int tid = F.tid; asm volatile("" : "+v"(tid));
    const int lane = tid & 63, wave = F.wave;
    const int cb = wave & 3, tb = wave >> 2, hh = lane >> 5, l31 = lane & 31;
    bf16x8 wfa[8], wfx[8];
    { const bf16* wa = P.WAX + ((size_t)n * 256 + 32 * cb + l31) * 128 + 8 * hh; const bf16* wx = wa + 128 * 128;
#pragma unroll
      for (int ks = 0; ks < 8; ++ks) { wfa[ks] = *(const bf16x8*)(wa + 16 * ks); wfx[ks] = *(const bf16x8*)(wx + 16 * ks); } }
    const int cg_e = n * 128 + 32 * cb + l31;
    const float ba_c = P.ba[cg_e], bx_c = P.bx[cg_e], spl8 = -8.0f * P.spl[cg_e] * LOG2E;
    const int sc_c = tid & 127, sc_q = tid >> 7, cg_s = n * 128 + sc_c;
    const int cv_tp = tid >> 4, cv_c8 = tid & 15, cg_v = n * 128 + 8 * cv_c8;
    if (tid < 5 * 32) { const int k = tid >> 5, c4 = (tid & 31) * 4; *(LAS f32x4*)(lds + RG_CW + (k * 128 + c4) * 4) = k < 4 ? *(const f32x4*)(P.conv_w + k * D + n * 128 + c4) : *(const f32x4*)(P.conv_b + n * 128 + c4); }
    __syncthreads();
    float hc = 0.f, cA = 1.f;
    if (MODE == 1) { for (int s2 = 0; s2 < seg; ++s2) { const f32x2 sv = *(const f32x2*)(P.SEG + (((size_t)b * 3 + s2) * D + cg_s) * 2); hc = sv.x * hc + sv.y; } }
    const int nchunks = (MODE == 2) ? 1 : (seg == 0 ? 9 : 8);
    auto chunk_p0 = [&](int ch) -> int { return seg == 0 ? (ch == 0 ? 0 : NMETA + 64 * (ch - 1)) : NMETA + 512 * seg + 64 * ch; };
    u32x4 xw[5], gw[2];
    auto load_x = [&](int ch) {
        const int p0n = chunk_p0(ch);
#pragma unroll
        for (int r = 0; r < 5; ++r) { const int p = p0n + 2 * cv_tp - 3 + r;
            xw[r] = (u32x4){0u, 0u, 0u, 0u};
            if (p >= 0) xw[r] = *(const u32x4*)(P.RX + (size_t)prompt_row(b, p < TP ? p : TP - 1) * D + cg_v); }
    };
    if (MODE != 2) load_x(0);
    for (int ch = 0; ch < nchunks; ++ch) {
        int p0 = 0, nvalid = 64;
        if (MODE != 2) { p0 = chunk_p0(ch); if (seg == 0 && ch == 0) nvalid = NMETA; }
        {
            float x[5][8], cw[4][8], cbias[8];
#pragma unroll
            for (int k = 0; k < 5; ++k) { const f32x4 a = *(const LAS f32x4*)(lds + RG_CW + (k * 128 + 8 * cv_c8) * 4), c = *(const LAS f32x4*)(lds + RG_CW + (k * 128 + 8 * cv_c8 + 4) * 4);
#pragma unroll
                for (int e = 0; e < 4; ++e) { if (k < 4) { cw[k][e] = a[e]; cw[k][4 + e] = c[e]; } else { cbias[e] = a[e]; cbias[4 + e] = c[e]; } } }
            if (MODE != 2) {
#pragma unroll
                for (int r = 0; r < 5; ++r) { const u32x4 w = xw[r];
                    x[r][0] = bflo(w.x); x[r][1] = bfhi(w.x); x[r][2] = bflo(w.y); x[r][3] = bfhi(w.y); x[r][4] = bflo(w.z); x[r][5] = bfhi(w.z); x[r][6] = bflo(w.w); x[r][7] = bfhi(w.w); }
                if (ch + 1 < nchunks) load_x(ch + 1);
            }
            if (MODE == 2) {
#pragma unroll
                for (int t = 0; t < 2; ++t) { const int row = 2 * cv_tp + t, j = row & 7, bb = 8 * b + (row >> 3);
                    float acc[8];
#pragma unroll
                    for (int e = 0; e < 8; ++e) acc[e] = cbias[e];
#pragma unroll
                    for (int k = 0; k < 4; ++k) { const int xi = j + k; float xv[8];
                        if (xi < 3) { const f32x4 a = *(const f32x4*)(P.state_conv + ((size_t)bb * 3 + xi) * D + cg_v), c = *(const f32x4*)(P.state_conv + ((size_t)bb * 3 + xi) * D + cg_v + 4);
#pragma unroll
                            for (int e = 0; e < 4; ++e) { xv[e] = a[e]; xv[4 + e] = c[e]; } }
                        else { const u32x4 w = *(const u32x4*)(P.RX + (size_t)(ROW_S + bb * 8 + xi - 3) * D + cg_v);
#pragma unroll
                            for (int e = 0; e < 4; ++e) { const unsigned ww = e == 0 ? w.x : e == 1 ? w.y : e == 2 ? w.z : w.w; xv[2 * e] = bflo(ww); xv[2 * e + 1] = bfhi(ww); } }
#pragma unroll
                        for (int e = 0; e < 8; ++e) acc[e] += xv[e] * cw[k][e]; }
                    *(LAS f32x4*)(lds + RG_XF + (row * 132 + 8 * cv_c8) * 4) = (f32x4){acc[0], acc[1], acc[2], acc[3]};
                    *(LAS f32x4*)(lds + RG_XF + (row * 132 + 8 * cv_c8 + 4) * 4) = (f32x4){acc[4], acc[5], acc[6], acc[7]};
                    u32x4 o; o.x = cvt_pk_bf16(acc[0], acc[1]); o.y = cvt_pk_bf16(acc[2], acc[3]); o.z = cvt_pk_bf16(acc[4], acc[5]); o.w = cvt_pk_bf16(acc[6], acc[7]);
                    *(LAS u32x4*)(lds + RG_XC + off256(row, cv_c8)) = o; }
            } else {
#pragma unroll
                for (int t = 0; t < 2; ++t) { const int row = 2 * cv_tp + t;
                    float acc[8];
#pragma unroll
                    for (int e = 0; e < 8; ++e) acc[e] = cbias[e] + x[t][e] * cw[0][e] + x[t + 1][e] * cw[1][e] + x[t + 2][e] * cw[2][e] + x[t + 3][e] * cw[3][e];
                    *(LAS f32x4*)(lds + RG_XF + (row * 132 + 8 * cv_c8) * 4) = (f32x4){acc[0], acc[1], acc[2], acc[3]};
                    *(LAS f32x4*)(lds + RG_XF + (row * 132 + 8 * cv_c8 + 4) * 4) = (f32x4){acc[4], acc[5], acc[6], acc[7]};
                    u32x4 o; o.x = cvt_pk_bf16(acc[0], acc[1]); o.y = cvt_pk_bf16(acc[2], acc[3]); o.z = cvt_pk_bf16(acc[4], acc[5]); o.w = cvt_pk_bf16(acc[6], acc[7]);
                    *(LAS u32x4*)(lds + RG_XC + off256(row, cv_c8)) = o; }
            }
        }
        __syncthreads();
        f32x16 ga = {}, gx = {};
#pragma unroll
        for (int ks = 0; ks < 8; ++ks) { const bf16x8 af = *(const LAS bf16x8*)(lds + RG_XC + off256(32 * tb + l31, 2 * ks + hh));
            ga = __builtin_amdgcn_mfma_f32_32x32x16_bf16(af, wfa[ks], ga, 0, 0, 0); gx = __builtin_amdgcn_mfma_f32_32x32x16_bf16(af, wfx[ks], gx, 0, 0, 0); }
#pragma unroll
        for (int r = 0; r < 16; ++r) { const int tok = 32 * tb + (r & 3) + 8 * (r >> 2) + 4 * hh; LAS float* xf = (LAS float*)(lds + RG_XF) + tok * 132 + 32 * cb + l31; LAS float* ab = (LAS float*)(lds + RG_AB) + tok * 132 + 32 * cb + l31;
            const float rr = sigmoidf_(ga[r] + ba_c), ii = sigmoidf_(gx[r] + bx_c);
            float a = fast_exp2(rr * spl8); float u = sqrtf(fmaxf(1.0f - a * a, 0.f)) * ii * (*xf);
            if (tok >= nvalid) { a = 1.f; u = 0.f; }
            *ab = a; *xf = u; }
        __syncthreads();
        if (MODE == 1) {
#pragma unroll
            for (int t = 0; t < 2; ++t) { const int p = p0 + 2 * cv_tp + t; gw[t] = *(const u32x4*)(P.GRG + (size_t)prompt_row(b, p < TP ? p : TP - 1) * D + cg_v); } }
        if (MODE == 2) {
#pragma unroll
            for (int t2 = 0; t2 < 2; ++t2) { const int bb = 8 * b + 2 * sc_q + t2; float h = P.state_rg[(size_t)bb * D + cg_s];
#pragma unroll
                for (int j = 0; j < 8; ++j) { const int row = 16 * sc_q + 8 * t2 + j; LAS float* ab = (LAS float*)(lds + RG_AB) + row * 132 + sc_c; const float u = ((LAS float*)(lds + RG_XF))[row * 132 + sc_c];
                    h = (*ab) * h + u; *ab = h; }
                P.out[O_SH + (size_t)bb * D + cg_s] = h; }
            __syncthreads();
        } else {
            float A = 1.f, Hh = 0.f, av[16], uv[16];
#pragma unroll
            for (int i = 0; i < 16; ++i) { const int row = 16 * sc_q + i; av[i] = ((LAS float*)(lds + RG_AB))[row * 132 + sc_c]; uv[i] = ((LAS float*)(lds + RG_XF))[row * 132 + sc_c]; }
#pragma unroll
            for (int i = 0; i < 16; ++i) { Hh = av[i] * Hh + uv[i]; A *= av[i]; }
            *(LAS f32x2*)(lds + RG_SUM + (sc_q * 128 + sc_c) * 8) = (f32x2){A, Hh};
            __syncthreads();
            float hin = hc, hend = hc, Aend = 1.f;
#pragma unroll
            for (int q = 0; q < 4; ++q) { const f32x2 sv = *(LAS f32x2*)(lds + RG_SUM + (q * 128 + sc_c) * 8); if (q < sc_q) hin = sv.x * hin + sv.y; hend = sv.x * hend + sv.y; Aend *= sv.x; }
            hc = hend; cA *= Aend;
            if (MODE == 1) {
                float h = hin;
#pragma unroll
                for (int i = 0; i < 16; ++i) { const int row = 16 * sc_q + i; h = av[i] * h + uv[i]; ((LAS float*)(lds + RG_AB))[row * 132 + sc_c] = h; }
                __syncthreads();
            }
        }
        if (MODE != 0) {
#pragma unroll
            for (int t = 0; t < 2; ++t) { const int row = 2 * cv_tp + t; int grow;
                if (MODE == 2) grow = ROW_S + 64 * b + row; else { const int p = p0 + row; grow = prompt_row(b, p < TP ? p : TP - 1); }
                if (MODE == 2 || (row < nvalid && p0 >= NMETA)) {
                    const f32x4 h0 = *(const LAS f32x4*)(lds + RG_AB + (row * 132 + 8 * cv_c8) * 4), h1 = *(const LAS f32x4*)(lds + RG_AB + (row * 132 + 8 * cv_c8 + 4) * 4);
                    f32x4 g0, g1; pg8::unpack8(MODE == 1 ? gw[t] : *(const u32x4*)(P.GRG + (size_t)grow * D + cg_v), g0, g1);
                    *(u32x4*)(P.HRG + (size_t)grow * D + cg_v) = pg8::pack8(h0 * g0, h1 * g1); } }
        }
        if (MODE == 0) __syncthreads();
    }
    if (MODE == 0) { if (sc_q == 0) *(f32x2*)(P.SEG + (((size_t)b * 3 + seg) * D + cg_s) * 2) = (f32x2){cA, hc}; }
    if (MODE == 1 && seg == 3) { if (sc_q == 0) P.out[O_PH + (size_t)b * D + cg_s] = hc; }
    __syncthreads();
}
template <int K>
__device__ __forceinline__ void skinny_partial(const Frame& F, const bf16* __restrict__ A, const int lda, const bf16* __restrict__ Bt, const int ldb, const int r0, const int c0, const int lane, float& v0, float& v1) {
    LAS unsigned char* lds = F.lds;
    constexpr int KP = K > 1024 ? 1024 : K, NPASS = K / KP, RB = KP * 2  , SLAB = 32 * RB, NPW = KP / 128  , CPW = KP / 64  ;
    static_assert(K % KP == 0 && KP % 128 == 0 && 2 * SLAB <= MISC_OFF, "skinny shape");
    const int w = F.wave, hh = lane >> 5, l31 = lane & 31;
    f32x16 acc = (f32x16){};
    __syncthreads();
#pragma unroll 1
    for (int ps = 0; ps < NPASS; ++ps) {
#pragma unroll
        for (int i = 0; i < NPW; ++i) { const unsigned pos = 1024u * (w * NPW + i) + 16u * lane, row = pos / RB, chp = (pos % RB) >> 4, ch = chp ^ (row & 15u);
            __builtin_amdgcn_global_load_lds((const unsigned*)(A + (size_t)(r0 + row) * lda + ps * KP + 8 * ch), (LAS unsigned*)(lds + 1024 * (w * NPW + i)), 16, 0, 0);
            __builtin_amdgcn_global_load_lds((const unsigned*)(Bt + (size_t)(c0 + row) * ldb + ps * KP + 8 * ch), (LAS unsigned*)(lds + SLAB + 1024 * (w * NPW + i)), 16, 0, 0); }
        VM_WAIT(); __syncthreads();
#pragma unroll
        for (int s = 0; s < NPW; ++s) { const unsigned ch = (unsigned)(w * CPW + 2 * s + hh) ^ (unsigned)(l31 & 15);
            const bf16x8 af = *(const LAS bf16x8*)(lds + l31 * RB + 16 * ch), bfr = *(const LAS bf16x8*)(lds + SLAB + l31 * RB + 16 * ch);
            acc = __builtin_amdgcn_mfma_f32_32x32x16_bf16(bfr, af, acc, 0, 0, 0); }
        __syncthreads();
    }
#pragma unroll
    for (int r = 0; r < 16; ++r) *(LAS float*)(lds + ((w * 16 + r) * 64 + lane) * 4) = acc[r];
    __syncthreads();
    const int t = F.tid, ln = t & 63, rg = 2 * (t >> 6);
    float s0 = 0.f, s1 = 0.f;
#pragma unroll
    for (int ww = 0; ww < 8; ++ww) { s0 += *(const LAS float*)(lds + ((ww * 16 + rg) * 64 + ln) * 4); s1 += *(const LAS float*)(lds + ((ww * 16 + rg + 1) * 64 + ln) * 4); }
    v0 = s0; v1 = s1;
}
__device__ __forceinline__ void skinny_coord(const int tid, int& row, int& col) { const int ln = tid & 63, rg = 2 * (tid >> 6); row = ln & 31; col = (rg & 3) + 8 * (rg >> 2) + 4 * (ln >> 5); }
constexpr int PA_KB = 64 * 384, PA_VB = 64 * 256;
constexpr int PA_K0 = 0, PA_V0 = 2 * PA_KB, PA_END = PA_V0 + 2 * PA_VB;
static_assert(PA_END <= MISC_OFF, "prompt attention lds");
__device__ __forceinline__ unsigned offK384(unsigned row, unsigned ch) { return 384u * row + 16u * (ch ^ ((row >> 1) & 7)); }
struct PAttnParams { const bf16 *QA, *KN, *KPE, *V; bf16* O; };

__device__ __forceinline__ void pattn_unit(const Frame& F, const PAttnParams& P, const int b, const int h, const int x) {
    LAS unsigned char* lds = F.lds;
    int lane = F.lane; asm volatile("" : "+v"(lane));
    const int w = F.wave, hh = lane >> 5, l31 = lane & 31;
#pragma nounroll
    for (int half = 0; half < 2; ++half) {
    const int xb = half ? 7 - x : x;
    const int tq = 256 * xb + 32 * w + l31;
    const size_t qrow = (size_t)b * SEQ + tq;
    bf16x8 qf[12];
#pragma unroll
    for (int s = 0; s < 12; ++s) qf[s] = *(const bf16x8*)(P.QA + qrow * 1536 + h * 192 + 16 * s + 8 * hh);
    f32x16 o[4];
#pragma unroll
    for (int i = 0; i < 4; ++i) o[i] = (f32x16){};
    float m = -1e30f, l = 0.f;
    const int ntiles = 1 + 4 * (xb + 1);
    unsigned ksrc[3], kstep[3], vsrc[2];
    const char* wsb = (const char*)P.KN - WS_KN;
#pragma unroll
    for (int i = 0; i < 3; ++i) { const unsigned pos = 1024u * (w + 8 * i) + 16u * lane, row = pos / 384u, chp = (pos % 384u) >> 4, ch = chp ^ ((row >> 1) & 7u);
        if (ch < 16) { ksrc[i] = (unsigned)WS_KN + (row * D + h * 128 + 8 * ch) * 2u; kstep[i] = D * 2; } else { ksrc[i] = (unsigned)WS_KPE + (row * 64 + 8 * (ch - 16)) * 2u; kstep[i] = 64 * 2; } }
#pragma unroll
    for (int i = 0; i < 2; ++i) { const unsigned pos = 1024u * (w + 8 * i) + 16u * lane, row = pos >> 8, chp = (pos & 255u) >> 4, ch = chp ^ (((row & 3) << 2) | ((row >> 2) & 3));
        vsrc[i] = (unsigned)WS_V + (row * D + h * 128 + 8 * ch) * 2u; }
    auto issue = [&](int it, int buf) {
        const unsigned row0 = it == 0 ? (unsigned)ROW_M : (unsigned)(b * SEQ + 64 * (it - 1));
#pragma unroll
        for (int i = 0; i < 3; ++i) __builtin_amdgcn_global_load_lds((const unsigned*)(wsb + (ksrc[i] + row0 * kstep[i])), (LAS unsigned*)(lds + PA_K0 + buf * PA_KB + 1024 * (w + 8 * i)), 16, 0, 0);
#pragma unroll
        for (int i = 0; i < 2; ++i) __builtin_amdgcn_global_load_lds((const unsigned*)(wsb + (vsrc[i] + row0 * (unsigned)(D * 2))), (LAS unsigned*)(lds + PA_V0 + buf * PA_VB + 1024 * (w + 8 * i)), 16, 0, 0);
    };
    issue(0, 0); VM_WAIT(); __syncthreads();
    constexpr float SC = SM_SCALE * LOG2E;
    const int trq = (lane & 15) >> 2, trp = lane & 3, trblk = (lane >> 4) & 1;
    unsigned kb4[4], vb8[2][4];
    { const unsigned sw = (l31 >> 1) & 7u, a = sw >> 1, c = sw & 1u;
#pragma unroll
      for (int v = 0; v < 4; ++v) kb4[v] = 384u * l31 + 16u * ((unsigned)hh ^ c) + 32u * ((unsigned)v ^ a);
      const unsigned clo = 2u * trblk + (trp >> 1);
#pragma unroll
      for (int t = 0; t < 2; ++t)
#pragma unroll
          for (int db = 0; db < 4; ++db) vb8[t][db] = 256u * (4u * hh + trq) + 8u * (trp & 1) + 16u * (clo ^ ((2u * t + hh) & 3u)) + 64u * ((unsigned)db ^ (unsigned)trq); }
#pragma nounroll
    for (int it = 0; it < ntiles; ++it) {
        const int buf = it & 1;
        if (it + 1 < ntiles) issue(it + 1, buf ^ 1);
        const int qmin = 256 * xb + 32 * w; const bool skip = (it > 0) && (64 * (it - 1) > qmin + 31);
        const int lim0 = (it == 0) ? NMETA : tq - 64 * (it - 1) + 1, lim1 = (it == 0) ? 0 : lim0 - 32;
        if (!skip) {
            f32x16 p0 = (f32x16){}, p1 = (f32x16){};
            const LAS unsigned char* Kb = lds + PA_K0 + buf * PA_KB;
#pragma unroll
            for (int sg = 0; sg < 6; ++sg) {
#pragma unroll
                for (int s = 2 * sg; s < 2 * sg + 2; ++s) { const bf16x8 a0 = *(const LAS bf16x8*)(Kb + kb4[s & 3] + 128 * (s >> 2)), a1 = *(const LAS bf16x8*)(Kb + kb4[s & 3] + 12288 + 128 * (s >> 2));
                    p0 = __builtin_amdgcn_mfma_f32_32x32x16_bf16(a0, qf[s], p0, 0, 0, 0); p1 = __builtin_amdgcn_mfma_f32_32x32x16_bf16(a1, qf[s], p1, 0, 0, 0); }
                __builtin_amdgcn_sched_barrier(0); }
            float pmax = -3e38f;
#pragma unroll
            for (int r = 0; r < 16; ++r) { const int kl = (r & 3) + 8 * (r >> 2) + 4 * hh;
                float x0 = p0[r] * SC, x1 = p1[r] * SC;
                x0 = kl < lim0 ? x0 : -3e38f; x1 = kl < lim1 ? x1 : -3e38f;
                p0[r] = x0; p1[r] = x1; pmax = fmaxf(pmax, fmaxf(x0, x1)); }
            pmax = fmaxf(pmax, __shfl_xor(pmax, 32));
            const float mn = fmaxf(m, pmax), alpha = fast_exp2(m - mn); m = mn;
            float ps = 0.f;
#pragma unroll
            for (int r = 0; r < 16; ++r) { p0[r] = fast_exp2(p0[r] - mn); p1[r] = fast_exp2(p1[r] - mn); ps += p0[r] + p1[r]; }
            l = l * alpha + ps;
#pragma unroll
            for (int i = 0; i < 4; ++i) o[i] = o[i] * alpha;
            const LAS unsigned char* Vb = lds + PA_V0 + buf * PA_VB;
#pragma unroll
            for (int kb = 0; kb < 2; ++kb)
#pragma unroll
                for (int s2 = 0; s2 < 2; ++s2) {
                    bf16x8 pf; { const f32x16& pp = kb ? p1 : p0; u32x4 t; t.x = cvt_pk_bf16(pp[8 * s2 + 0], pp[8 * s2 + 1]); t.y = cvt_pk_bf16(pp[8 * s2 + 2], pp[8 * s2 + 3]); t.z = cvt_pk_bf16(pp[8 * s2 + 4], pp[8 * s2 + 5]); t.w = cvt_pk_bf16(pp[8 * s2 + 6], pp[8 * s2 + 7]); pf = __builtin_bit_cast(bf16x8, t); }
#pragma unroll
                    for (int db = 0; db < 4; ++db) {
                        const s16x4 t0 = __builtin_amdgcn_ds_read_tr16_b64_v4i16((LAS s16x4*)(Vb + vb8[0][db] + 256 * (32 * kb + 16 * s2)));
                        const s16x4 t1 = __builtin_amdgcn_ds_read_tr16_b64_v4i16((LAS s16x4*)(Vb + vb8[1][db] + 256 * (32 * kb + 16 * s2 + 8)));
                        bf16x8 vf; vf[0] = t0[0]; vf[1] = t0[1]; vf[2] = t0[2]; vf[3] = t0[3]; vf[4] = t1[0]; vf[5] = t1[1]; vf[6] = t1[2]; vf[7] = t1[3];
                        o[db] = __builtin_amdgcn_mfma_f32_32x32x16_bf16(vf, pf, o[db], 0, 0, 0); }
                    __builtin_amdgcn_sched_barrier(0); }
        }
        VM_WAIT(); __syncthreads();
    }
    l += __shfl_xor(l, 32);
    const float il = 1.0f / l;
    bf16* orow = P.O + qrow * D + h * 128;
#pragma unroll
    for (int db = 0; db < 4; ++db)
#pragma unroll
        for (int rq = 0; rq < 4; ++rq) { u32x2 wv; wv.x = cvt_pk_bf16(o[db][4 * rq] * il, o[db][4 * rq + 1] * il); wv.y = cvt_pk_bf16(o[db][4 * rq + 2] * il, o[db][4 * rq + 3] * il);
            *(u32x2*)(orow + 32 * db + 8 * rq + 4 * hh) = wv; }
    __syncthreads();
    }
}
constexpr int SA_CKVB = 32 * 1024, SA_KPEB = 32 * 128;
constexpr int SA_CKV0 = 0, SA_KPE0 = 2 * SA_CKVB, SA_SB = SA_KPE0 + 2 * SA_KPEB, SA_PB = SA_SB + 64 * 36 * 4, SA_AL = SA_PB + 64 * 64, SA_QL2 = SA_AL + 256, SA_END = SA_QL2 + 64 * 576;
constexpr int SA_QL = 0;
static_assert(64 * 576 * 2 <= SA_SB && SA_END <= MISC_OFF, "sample attention lds");
__device__ __forceinline__ unsigned off1024(unsigned row, unsigned ch) { return 1024u * row + 16u * (ch ^ (((row & 3) << 2) | ((row >> 2) & 3))); }
__device__ __forceinline__ unsigned offkpe(unsigned row, unsigned ch) { return 128u * row + 16u * (ch ^ ((row >> 1) & 7)); }
__device__ __forceinline__ unsigned offQ2(unsigned rho, unsigned ch) { return 576u * rho + 16u * (ch ^ ((rho >> 2) & 3)); }
__device__ __forceinline__ unsigned offP(unsigned rho, unsigned ch) { return 64u * rho + 16u * (ch ^ ((rho >> 2) & 3)); }
struct SAttnParams { const float *cckv, *ckpe; const int* pt; const bf16 *QA, *WUKS, *CKVNS, *KPE; float *OPART, *ML; };

__device__ __forceinline__ void sattn_unit(const Frame& F, const SAttnParams& P, const int b, const int sp) {
    LAS unsigned char* lds = F.lds;
    int tid = F.tid; asm volatile("" : "+v"(tid));
    const int lane = tid & 63, w = F.wave, hh = lane >> 5, l31 = lane & 31, l15 = lane & 15, g = lane >> 4;
    {
        const int h = w;
        bf16x8 qa[4];
#pragma unroll
        for (int ks = 0; ks < 4; ++ks) qa[ks] = *(const bf16x8*)(P.QA + (size_t)(ROW_S + b * 8 + (l15 & 7)) * 1536 + h * 192 + 32 * ks + 8 * g);
        const bf16* wk = P.WUKS + ((size_t)h * 512 + l15) * 128 + 8 * g;
        for (int rb = 0; rb < 32; ++rb) {
            f32x4 acc = (f32x4){0.f, 0.f, 0.f, 0.f};
#pragma unroll
            for (int ks = 0; ks < 4; ++ks) { const bf16x8 bw = *(const bf16x8*)(wk + (size_t)rb * 16 * 128 + 32 * ks); acc = __builtin_amdgcn_mfma_f32_16x16x32_bf16(qa[ks], bw, acc, 0, 0, 0); }
            if (g < 2) {
#pragma unroll
                for (int e = 0; e < 4; ++e) *(LAS bf16*)(lds + SA_QL + ((h * 8 + 4 * g + e) * 576 + 16 * rb + l15) * 2) = (bf16)(cvt_pk_bf16(acc[e], 0.f) & 0xffffu);
            }
        }
        { const int rho = tid >> 3, c8 = tid & 7; const int hq = rho >> 3, j = rho & 7;
          *(LAS u32x4*)(lds + SA_QL + (rho * 576 + 512 + 8 * c8) * 2) = *(const u32x4*)(P.QA + (size_t)(ROW_S + b * 8 + j) * 1536 + hq * 192 + 128 + 8 * c8); }
    }
    __syncthreads();
#ifdef DBG_QLAT
    { bf16* dbg = (bf16*)((unsigned char*)P.OPART - WS_OPART + WS_U) + (size_t)(b * NSPLIT + sp) * 64 * 576;
      for (int i = tid; i < 64 * 576 / 8; i += NTHR) *(u32x4*)(dbg + i * 8) = *(const LAS u32x4*)(lds + SA_QL + i * 16); }
#endif
    const int kb = w & 1, rb = w >> 1;
    bf16x8 qb[9];
#pragma unroll
    for (int s = 0; s < 9; ++s) qb[s] = *(const LAS bf16x8*)(lds + SA_QL + ((16 * rb + l15) * 576 + 32 * s + 8 * g) * 2);
    for (int i = tid; i < 64 * 36; i += NTHR) { const int rho = i / 36, c = i % 36; *(LAS u32x4*)(lds + SA_QL2 + offQ2(rho, c)) = *(const LAS u32x4*)(lds + SA_QL + (rho * 576 + 288 + 8 * c) * 2); }
    __syncthreads();
    const unsigned q2b = offQ2(16 * rb + l15, g);
    f32x16 o[2][2];
#pragma unroll
    for (int i = 0; i < 2; ++i)
#pragma unroll
        for (int j = 0; j < 2; ++j) o[i][j] = (f32x16){};
    const int srho = tid >> 3, skg = tid & 7;
    float m = -1e30f, l = 0.f;
    constexpr float SC = SM_SCALE * LOG2E;
    const int ptv = P.pt[b * NPAGES + 16 * sp + (lane & 15)];
    f32x4 crA[8], krA, crB[8], krB;
    auto issue = [&](int it, f32x4 (&cr)[8], f32x4& kr) {
        const unsigned phys = (unsigned)__builtin_amdgcn_readlane(ptv, it >> 2); const unsigned key0 = phys * PAGE + (unsigned)(it & 3) * 32u;
        const char* cbase = (const char*)P.cckv; const char* kbase = (const char*)P.ckpe;
#pragma unroll
        for (int i = 0; i < 4; ++i) { const unsigned off = ((key0 + (tid >> 6) + 8 * i) * KVL + 4 * (tid & 63)) * 4u; cr[2 * i] = *(const f32x4*)(cbase + off); cr[2 * i + 1] = *(const f32x4*)(cbase + off + 1024); }
        kr = *(const f32x4*)(kbase + ((key0 + (tid >> 4)) * QKR + 4 * (tid & 15)) * 4u);
    };
    auto commit = [&](int buf, const f32x4 (&cr)[8], const f32x4& kr) {
#pragma unroll
        for (int i = 0; i < 4; ++i)
#pragma unroll
            for (int hf = 0; hf < 2; ++hf) { const f32x4 v = cr[2 * i + hf]; u32x2 wv; wv.x = cvt_pk_bf16(v[0], v[1]); wv.y = cvt_pk_bf16(v[2], v[3]);
                *(LAS u32x2*)(lds + SA_CKV0 + buf * SA_CKVB + off1024((tid >> 6) + 8 * i, 32 * hf + ((tid & 63) >> 1)) + 8 * (tid & 1)) = wv; }
        u32x2 wv; wv.x = cvt_pk_bf16(kr[0], kr[1]); wv.y = cvt_pk_bf16(kr[2], kr[3]);
        *(LAS u32x2*)(lds + SA_KPE0 + buf * SA_KPEB + offkpe(tid >> 4, (tid & 15) >> 1) + 8 * (tid & 1)) = wv;
    };
    const int trq = l15 >> 2, trp = lane & 3, trblk = g & 1;
    unsigned sa4[4], ka2[2], va4[2][2], pa2[2];
    { const unsigned a = l15 & 3u, c = (l15 >> 2) & 3u, e = (l15 >> 1) & 7u, f = (l31 >> 2) & 3u, clo = 2u * trblk + (trp >> 1);
#pragma unroll
      for (int v = 0; v < 4; ++v) sa4[v] = 1024u * (16u * kb + l15) + 16u * ((unsigned)g ^ c) + 64u * ((unsigned)v ^ a);
#pragma unroll
      for (int s2 = 0; s2 < 2; ++s2) { ka2[s2] = offkpe(16u * kb + l15, 4u * s2 + g); pa2[s2] = offP(l31, 2u * s2 + hh); }
#pragma unroll
      for (int t = 0; t < 2; ++t)
#pragma unroll
          for (int db = 0; db < 2; ++db) va4[t][db] = 1024u * (8u * hh + 4u * t + trq) + 8u * (trp & 1) + 16u * (clo ^ ((2u * hh + t) & 3u)) + 64u * (((2u * (w & 1) + db) ^ (unsigned)trq)) + 256u * (w >> 1); }
    auto compute = [&](const int buf, const bool newtile) {
#ifdef SA_PROBE_SLEEP
        __builtin_amdgcn_s_sleep(SA_PROBE_SLEEP);
#endif
        {
            const LAS unsigned char* Cb = lds + SA_CKV0 + buf * SA_CKVB; const LAS unsigned char* Kb = lds + SA_KPE0 + buf * SA_KPEB;
            f32x4 acc = (f32x4){0.f, 0.f, 0.f, 0.f};
#pragma unroll
            for (int s = 0; s < 16; ++s) { const bf16x8 a = *(const LAS bf16x8*)(Cb + sa4[s & 3] + 256 * (s >> 2));
                const bf16x8 q = s < 9 ? qb[s < 9 ? s : 0] : *(const LAS bf16x8*)(lds + SA_QL2 + q2b + 64 * (s - 9));
                acc = __builtin_amdgcn_mfma_f32_16x16x32_bf16(a, q, acc, 0, 0, 0);
                if ((s & 3) == 3) __builtin_amdgcn_sched_barrier(0); }
#pragma unroll
            for (int s = 0; s < 2; ++s) { const bf16x8 a = *(const LAS bf16x8*)(Kb + ka2[s]); const bf16x8 q = *(const LAS bf16x8*)(lds + SA_QL2 + q2b + 64 * (7 + s));
                acc = __builtin_amdgcn_mfma_f32_16x16x32_bf16(a, q, acc, 0, 0, 0); }
            *(LAS f32x4*)(lds + SA_SB + ((16 * rb + l15) * 36 + 16 * kb + 4 * g) * 4) = acc;
        }
        __syncthreads();
        {
            f32x4 v = *(const LAS f32x4*)(lds + SA_SB + (srho * 36 + 4 * skg) * 4) * SC;
            if (newtile) {
#pragma unroll
                for (int e = 0; e < 4; ++e) if (4 * skg + e > (srho & 7)) v[e] = -3e38f;
            }
            float tm = fmaxf(fmaxf(v[0], v[1]), fmaxf(v[2], v[3]));
            tm = fmaxf(tm, __shfl_xor(tm, 1)); tm = fmaxf(tm, __shfl_xor(tm, 2)); tm = fmaxf(tm, __shfl_xor(tm, 4));
            const float mn = fmaxf(m, tm), alpha = fast_exp2(m - mn); m = mn;
#pragma unroll
            for (int e = 0; e < 4; ++e) v[e] = fast_exp2(v[e] - mn);
            float ps = (v[0] + v[1]) + (v[2] + v[3]);
            ps += __shfl_xor(ps, 1); ps += __shfl_xor(ps, 2); ps += __shfl_xor(ps, 4);
            l = l * alpha + ps;
            u32x2 wv; wv.x = cvt_pk_bf16(v[0], v[1]); wv.y = cvt_pk_bf16(v[2], v[3]);
            *(LAS u32x2*)(lds + SA_PB + offP(srho, skg >> 1) + 8 * (skg & 1)) = wv;
            if (skg == 0) *(LAS float*)(lds + SA_AL + srho * 4) = alpha;
        }
    };
    auto pv = [&](const int buf) {
        const LAS unsigned char* Cb = lds + SA_CKV0 + buf * SA_CKVB;
        const float a0 = *(const LAS float*)(lds + SA_AL + l31 * 4), a1 = *(const LAS float*)(lds + SA_AL + (32 + l31) * 4);
#pragma unroll
        for (int db = 0; db < 2; ++db) { o[db][0] = o[db][0] * a0; o[db][1] = o[db][1] * a1; }
#pragma unroll
        for (int s2 = 0; s2 < 2; ++s2) {
            const bf16x8 pb0 = *(const LAS bf16x8*)(lds + SA_PB + pa2[s2]), pb1 = *(const LAS bf16x8*)(lds + SA_PB + pa2[s2] + 2048);
#pragma unroll
            for (int db = 0; db < 2; ++db) {
                const s16x4 t0 = __builtin_amdgcn_ds_read_tr16_b64_v4i16((LAS s16x4*)(Cb + va4[0][db] + 16384 * s2));
                const s16x4 t1 = __builtin_amdgcn_ds_read_tr16_b64_v4i16((LAS s16x4*)(Cb + va4[1][db] + 16384 * s2));
                bf16x8 vf; vf[0] = t0[0]; vf[1] = t0[1]; vf[2] = t0[2]; vf[3] = t0[3]; vf[4] = t1[0]; vf[5] = t1[1]; vf[6] = t1[2]; vf[7] = t1[3];
                o[db][0] = __builtin_amdgcn_mfma_f32_32x32x16_bf16(vf, pb0, o[db][0], 0, 0, 0);
                o[db][1] = __builtin_amdgcn_mfma_f32_32x32x16_bf16(vf, pb1, o[db][1], 0, 0, 0); } }
    };
    constexpr int NT = (PAST / NSPLIT) / 32;
    issue(0, crA, krA); commit(0, crA, krA); issue(1, crB, krB); issue(2, crA, krA); __syncthreads();
#pragma nounroll
    for (int it = 0; it < NT; it += 2) {
        compute(0, false);
        commit(1, crB, krB); if (it + 3 < NT) issue(it + 3, crB, krB);
        __syncthreads();
        pv(0);
        compute(1, false);
        if (it + 2 < NT) { commit(0, crA, krA); if (it + 4 < NT) issue(it + 4, crA, krA); }
        __syncthreads();
        pv(1);
    }
    if (sp == NSPLIT - 1) {
        __syncthreads();
        { const char* wsb = (const char*)P.KPE - WS_KPE;
#pragma nounroll
          for (int i = tid; i < 32 * 64; i += NTHR) { const int key = i >> 6, ch = i & 63; u32x4 v = (u32x4){0u, 0u, 0u, 0u}; if (key < DS) v = *(const u32x4*)(wsb + ((unsigned)WS_CKVNS + (unsigned)(((b * DS + key) * KVL + 8 * ch) * 2)));
            *(LAS u32x4*)(lds + SA_CKV0 + off1024(key, ch)) = v; }
          if (tid < 32 * 8) { const int key = tid >> 3, ch = tid & 7; u32x4 v = (u32x4){0u, 0u, 0u, 0u}; if (key < DS) v = *(const u32x4*)(wsb + ((unsigned)WS_KPE + (unsigned)(((ROW_S + b * DS + key) * 64 + 8 * ch) * 2)));
            *(LAS u32x4*)(lds + SA_KPE0 + offkpe(key, ch)) = v; } }
        __syncthreads();
        compute(0, true);
        __syncthreads();
        pv(0);
    }
    float* op = P.OPART + ((size_t)(b * NSPLIT + sp) * 64) * KVL;
#pragma unroll
    for (int db = 0; db < 2; ++db)
#pragma unroll
        for (int rbk = 0; rbk < 2; ++rbk)
#pragma unroll
            for (int rq = 0; rq < 4; ++rq) *(f32x4*)(op + (size_t)(32 * rbk + l31) * KVL + 64 * w + 32 * db + 8 * rq + 4 * hh) = (f32x4){o[db][rbk][4 * rq], o[db][rbk][4 * rq + 1], o[db][rbk][4 * rq + 2], o[db][rbk][4 * rq + 3]};
    if (skg == 0) *(f32x2*)(P.ML + ((size_t)(b * NSPLIT + sp) * 64 + srho) * 2) = (f32x2){m, l};
    __syncthreads();
}

struct SCombParams { const float *OPART, *ML, *w_uv; bf16* O; };
__device__ __forceinline__ void scomb_unit(const Frame& F, const SCombParams& P, const int b, const int h) {
    LAS float* OL = (LAS float*)F.lds;
    int tid = F.tid; asm volatile("" : "+v"(tid));
    {
        const int r = tid;
#pragma unroll
        for (int j = 0; j < 8; ++j) { const int rho = h * 8 + j; float mm[NSPLIT], ll[NSPLIT], M = -3e38f;
#pragma unroll
            for (int s = 0; s < NSPLIT; ++s) { const f32x2 v = *(const f32x2*)(P.ML + ((size_t)(b * NSPLIT + s) * 64 + rho) * 2); mm[s] = v.x; ll[s] = v.y; M = fmaxf(M, v.x); }
            float L = 0.f, acc = 0.f;
#pragma unroll
            for (int s = 0; s < NSPLIT; ++s) { const float wgt = fast_exp2(mm[s] - M); L += wgt * ll[s]; acc += wgt * P.OPART[((size_t)(b * NSPLIT + s) * 64 + rho) * KVL + r]; }
            OL[j * 512 + r] = acc / L; }
    }
    __syncthreads();
    {
        const int d = tid & 127, rq = tid >> 7; float acc[8];
#pragma unroll
        for (int j = 0; j < 8; ++j) acc[j] = 0.f;
        const float* wp = P.w_uv + (size_t)(128 * rq) * 1024 + h * 128 + d;
#pragma unroll 16
        for (int r = 0; r < 128; ++r) { const float wv = wp[(size_t)r * 1024];
#pragma unroll
            for (int j = 0; j < 8; ++j) acc[j] += OL[j * 512 + 128 * rq + r] * wv; }
        LAS float* PT = OL + 8 * 512;
#pragma unroll
        for (int j = 0; j < 8; ++j) PT[(rq * 8 + j) * 128 + d] = acc[j];
        __syncthreads();
        const int j = tid >> 6, d2 = (tid & 63) * 2;
        const float o0 = (PT[(0 * 8 + j) * 128 + d2] + PT[(1 * 8 + j) * 128 + d2]) + (PT[(2 * 8 + j) * 128 + d2] + PT[(3 * 8 + j) * 128 + d2]);
        const float o1 = (PT[(0 * 8 + j) * 128 + d2 + 1] + PT[(1 * 8 + j) * 128 + d2 + 1]) + (PT[(2 * 8 + j) * 128 + d2 + 1] + PT[(3 * 8 + j) * 128 + d2 + 1]);
        *(unsigned*)(P.O + (size_t)(ROW_S + b * 8 + j) * D + h * 128 + d2) = cvt_pk_bf16(o0, o1);
    }
    __syncthreads();
}
__device__ __forceinline__ void thin_ckv_conv(const Frame& F, const Args& args) {
    unsigned char* ws = F.ws; float* out = F.out;
    const int gw = F.vcu * NWAVES + F.wave, NGW = F.G * NWAVES, lane = F.lane;
    const bf16* CKVR = (const bf16*)(ws + WS_CKVR); const float* SSQ = (const float*)(ws + WS_SSQKV); const bf16* RX = (const bf16*)(ws + WS_RX);
    const f32x4 g0 = *(const f32x4*)(IN_F(I_KVG) + 8 * lane), g1 = *(const f32x4*)(IN_F(I_KVG) + 8 * lane + 4);
    for (int row = gw; row < ROW_M + NMETA; row += NGW) {
        const f32x4 s0 = *(const f32x4*)(SSQ + (size_t)row * 8), s1 = *(const f32x4*)(SSQ + (size_t)row * 8 + 4);
        const float ss = ((s0[0] + s0[1]) + (s0[2] + s0[3])) + ((s1[0] + s1[1]) + (s1[2] + s1[3]));
        const float rstd = 1.0f / sqrtf(ss * (1.0f / KVL) + EPS);
        f32x4 v0, v1; pg8::unpack8(*(const u32x4*)(CKVR + (size_t)row * KVL + 8 * lane), v0, v1);
        v0 = v0 * rstd * g0; v1 = v1 * rstd * g1;
        if (row < ROW_S) { float* o = out + O_PCKV + ((size_t)(row >> 11) * TP + NMETA + (row & (SEQ - 1))) * KVL + 8 * lane; *(f32x4*)o = v0; *(f32x4*)(o + 4) = v1; }
        else if (row < ROW_M) { float* o = out + O_SCKV + (size_t)(row - ROW_S) * KVL + 8 * lane; *(f32x4*)o = v0; *(f32x4*)(o + 4) = v1;
            *(u32x4*)((bf16*)(ws + WS_CKVNS) + (size_t)(row - ROW_S) * KVL + 8 * lane) = pg8::pack8(v0, v1); }
        else { for (int b = 0; b < NB; ++b) { float* o = out + O_PCKV + ((size_t)b * TP + (row - ROW_M)) * KVL + 8 * lane; *(f32x4*)o = v0; *(f32x4*)(o + 4) = v1; } }
    }
    for (int i = gw; i < NB * 3 + DB * 3; i += NGW) {
        int srow; float* o;
        if (i < NB * 3) { const int b = i / 3, k = i % 3; srow = b * SEQ + SEQ - 3 + k; o = out + O_PCONV + (size_t)i * D; }
        else { const int q = i - NB * 3, b = q / 3, k = q % 3; srow = ROW_S + b * DS + DS - 3 + k; o = out + O_SCONV + (size_t)q * D; }
#pragma unroll
        for (int j = 0; j < 2; ++j) { f32x4 v0, v1; pg8::unpack8(*(const u32x4*)(RX + (size_t)srow * D + 8 * (lane + 64 * j)), v0, v1); *(f32x4*)(o + 8 * (lane + 64 * j)) = v0; *(f32x4*)(o + 8 * (lane + 64 * j) + 4) = v1; }
    }
}

constexpr int NPHASES = 11;
__global__ void __launch_bounds__(NTHR, 2) hawk_fwd(Args args) {
    extern __shared__ __attribute__((aligned(16))) unsigned char lds_raw[];
    Frame F;
    F.lds = (LAS unsigned char*)lds_raw; F.MISC = (volatile LAS unsigned*)(F.lds + MISC_OFF);
    F.tid = threadIdx.x; F.lane = F.tid & 63; F.wave = __builtin_amdgcn_readfirstlane(F.tid >> 6);
    F.G = gridDim.x; { const int bx = blockIdx.x; F.vcu = (F.G % 8 == 0) ? (bx % 8) * (F.G / 8) + bx / 8 : bx; }
    F.out = args.out; F.ws = args.ws; F.ctl = (unsigned*)(args.ws + WS_CTL);
    unsigned char* ws = args.ws;
    for (int u = F.tid; u < 64; u += NTHR) ((LAS unsigned*)(F.lds + MISC_OFF))[u] = 0u;
    __syncthreads();
#if MK_PER_PHASE
#define GRID_BAR() do { } while (0)
#else
    XcdBarrier bar = xcd_barrier_post((unsigned*)F.ctl + CW_BAR, F.MISC + 8);
#define GRID_BAR() xcd_barrier(bar)
#endif
    const int lo = args.ph_lo, hi = args.ph_hi;
#ifndef PH_MASK
#define PH_MASK 0x7ff
#endif
#define IN(k) ((((PH_MASK) >> (k)) & 1) && lo <= (k) && (k) < hi)
#ifndef DUP_MASK
#define DUP_MASK 0
#endif
#ifndef P3DUP
#define P3DUP 0
#endif
#define REP(k) _Pragma("nounroll") for (int rep_ = 0; rep_ < 1 + (((DUP_MASK) >> (k)) & 1); ++rep_)
#define SEAM(k) do { if (IN(k) && IN((k) + 1)) GRID_BAR(); F.tid = threadIdx.x; F.lane = F.tid & 63; } while (0)
    const int G = F.G, bx = blockIdx.x;

    if (IN(0)) REP(0) { p0_prologue(F, args); }
    SEAM(0);
    if (IN(1)) REP(1) {
        pg8::TileSched S; S.init(ws + WS_H, ws + WS_WIN, D, 66, 22, G, bx);
        pg8::EpiWin E{(bf16*)(ws + WS_RX), (bf16*)(ws + WS_GRG), (bf16*)(ws + WS_CQ), (bf16*)(ws + WS_CKVR), (bf16*)(ws + WS_G), (bf16*)(ws + WS_KPE), (float*)(ws + WS_SSQQ), (float*)(ws + WS_SSQKV),
                      IN_F(I_BGATE), (const float*)(ws + WS_ROPEC), (const float*)(ws + WS_ROPES), F.out};
        pg8::gemm_phase<pg8::EpiWin, pg8::TileSched, true, true>(F.lds, D, S, E);
    }
    SEAM(1);
    const RgParams RGP{(const bf16*)(ws + WS_RX), (const bf16*)(ws + WS_GRG), (const bf16*)(ws + WS_WAX), (bf16*)(ws + WS_HRG), IN_F(I_CONVW), IN_F(I_CONVB), IN_F(I_BA), IN_F(I_BX),
                       (const float*)(ws + WS_SPL), IN_F(I_SCONV), IN_F(I_SRG), (float*)(ws + WS_SEG), F.out};
    if (IN(2)) REP(2) {
        for (int u = F.vcu; u < 192; u += G) rg_unit<0>(F, RGP, u / 24, (u / 3) % 8, u % 3);
        { pg8::TileSched S; S.init(ws + WS_CQ, ws + WS_WQ, QL, 64, 6, G, bx);
          pg8::EpiQ E{(bf16*)(ws + WS_QA), (const float*)(ws + WS_SSQQ), (const float*)(ws + WS_ROPEC), (const float*)(ws + WS_ROPES)};
          pg8::gemm_phase<pg8::EpiQ, pg8::TileSched, true, true>(F.lds, QL, S, E); }
        { pg8::TileSched S; S.init(ws + WS_CKVR, ws + WS_WKV, KVL, 64, 8, G, bx ^ 0xF8);
          pg8::EpiKV E{(bf16*)(ws + WS_KN), (bf16*)(ws + WS_V), (const float*)(ws + WS_SSQKV)};
          pg8::gemm_phase<pg8::EpiKV, pg8::TileSched, true, true>(F.lds, KVL, S, E); }
        {
            int lane_ = F.lane; asm volatile("" : "+v"(lane_));
            int trow, tcol; skinny_coord(F.tid, trow, tcol);
            const bf16* CQs = (const bf16*)(ws + WS_CQ); const bf16* WQs = (const bf16*)(ws + WS_WQ); bf16* QAs = (bf16*)(ws + WS_QA); const float* SQ = (const float*)(ws + WS_SSQQ);
            for (int u = F.vcu; u < 8 * 40 + 64; u += G) {
                if (u < 8 * 40) {
                    const int rt = u / 40, ci = u % 40, r0 = ROW_S + 32 * rt, row = r0 + trow;
                    float ss = 0.f;
#pragma unroll
                    for (int i = 0; i < 12; ++i) ss += SQ[(size_t)row * 12 + i];
                    const float rstd = 1.0f / sqrtf(ss * (1.0f / QL) + EPS);
                    if (ci < 32) { float v0, v1; skinny_partial<768>(F, CQs, QL, WQs, QL, r0, 32 * ci, lane_, v0, v1);
                        const int col = 32 * ci + tcol, h = col >> 7, d = col & 127;
                        *(unsigned*)(QAs + (size_t)row * 1536 + h * 192 + d) = cvt_pk_bf16(v0 * rstd, v1 * rstd); }
                    else { const int h = ci - 32, c1 = 1024 + 256 * (h >> 2) + 32 * (h & 3); float a0, a1, b0, b1;
                        skinny_partial<768>(F, CQs, QL, WQs, QL, r0, c1, lane_, a0, a1); skinny_partial<768>(F, CQs, QL, WQs, QL, r0, c1 + 128, lane_, b0, b1);
                        const int pi = rope_idx_of_row(row); const float* rc = (const float*)(ws + WS_ROPEC) + pi * 32 + tcol; const float* rs = (const float*)(ws + WS_ROPES) + pi * 32 + tcol;
                        a0 *= rstd; a1 *= rstd; b0 *= rstd; b1 *= rstd;
                        *(unsigned*)(QAs + (size_t)row * 1536 + h * 192 + 128 + tcol) = cvt_pk_bf16(a0 * rc[0] - b0 * rs[0], a1 * rc[1] - b1 * rs[1]);
                        *(unsigned*)(QAs + (size_t)row * 1536 + h * 192 + 160 + tcol) = cvt_pk_bf16(a0 * rs[0] + b0 * rc[0], a1 * rs[1] + b1 * rc[1]); }
                } else {
                    const int ci = u - 8 * 40, row = ROW_M + trow; float v0, v1;
                    skinny_partial<512>(F, (const bf16*)(ws + WS_CKVR), KVL, (const bf16*)(ws + WS_WKV), KVL, ROW_M, 32 * ci, lane_, v0, v1);
                    const float* SK = (const float*)(ws + WS_SSQKV) + (size_t)row * 8; const float ss = ((SK[0] + SK[1]) + (SK[2] + SK[3])) + ((SK[4] + SK[5]) + (SK[6] + SK[7]));
                    const float rstd = 1.0f / sqrtf(ss * (1.0f / KVL) + EPS); const int col = 32 * ci + tcol;
                    bf16* dst = col < 1024 ? (bf16*)(ws + WS_KN) + (size_t)row * D + col : (bf16*)(ws + WS_V) + (size_t)row * D + (col - 1024);
                    *(unsigned*)dst = cvt_pk_bf16(v0 * rstd, v1 * rstd); }
            }
            __syncthreads();
        }
        thin_ckv_conv(F, args);
    }
    SEAM(2);
    if (IN(3)) {
        const PAttnParams PA{(const bf16*)(ws + WS_QA), (const bf16*)(ws + WS_KN), (const bf16*)(ws + WS_KPE), (const bf16*)(ws + WS_V), (bf16*)(ws + WS_O)};
        const SAttnParams SA{IN_F(I_CCKV), IN_F(I_CKPE), (const int*)args.in[I_PT], (const bf16*)(ws + WS_QA), (const bf16*)(ws + WS_WUKS), (const bf16*)(ws + WS_CKVNS), (const bf16*)(ws + WS_KPE),
                             (float*)(ws + WS_OPART), (float*)(ws + WS_ML)};
#ifndef SFIRST_ALL
        const bool sfirst = (F.vcu & 1) == 0;
#else
        const bool sfirst = true;
#endif
#ifndef P3_MASK
#define P3_MASK 7
#endif
#pragma nounroll
        for (int ph = 0; ph < 2; ++ph) {
            if ((ph == 0) == sfirst) { if (P3_MASK & 1) for (int r3 = 0; r3 < 1 + (P3DUP & 1); ++r3) for (int u = F.vcu; u < DB * NSPLIT; u += G) sattn_unit(F, SA, u / NSPLIT, u % NSPLIT); }
            else { if (P3_MASK & 2) for (int r3 = 0; r3 < 1 + ((P3DUP >> 1) & 1); ++r3) for (int u = F.vcu; u < 256; u += G) { const int bh = u >> 2; pattn_unit(F, PA, bh >> 3, bh & 7, u & 3); } }
        }
        if (P3_MASK & 4) for (int r3 = 0; r3 < 1 + ((P3DUP >> 2) & 1); ++r3) for (int u = F.vcu; u < 256; u += G) rg_unit<1>(F, RGP, u >> 5, (u >> 2) & 7, u & 3);
        if (P3_MASK & 4) for (int u = F.vcu; u < 32; u += G) rg_unit<2>(F, RGP, u >> 3, u & 7, 0);
    }
    SEAM(3);
    if (IN(4)) REP(4) {
        const SCombParams SC{(const float*)(ws + WS_OPART), (const float*)(ws + WS_ML), IN_F(I_WUV), (bf16*)(ws + WS_O)};
        for (int u = F.vcu; u < DB * NH; u += G) scomb_unit(F, SC, u >> 3, u & 7);
    }
    SEAM(4);
    if (IN(5)) REP(5) {
        { pg8::TileSched S; S.init(ws + WS_HRG, ws + WS_WBRR, D, 64, 4, G, bx); pg8::EpiZ<0> E{(bf16*)(ws + WS_MIX), (const bf16*)(ws + WS_G)};
          pg8::gemm_phase<pg8::EpiZ<0>, pg8::TileSched, true, true>(F.lds, D, S, E); }
        { pg8::TileSched S; S.init(ws + WS_O, ws + WS_WBRM, D, 64, 4, G, bx); pg8::EpiZ<1> E{(bf16*)(ws + WS_MIX), (const bf16*)(ws + WS_G)};
          pg8::gemm_phase<pg8::EpiZ<1>, pg8::TileSched, true, true>(F.lds, D, S, E); }
        {
            int lane_ = F.lane; asm volatile("" : "+v"(lane_));
            int trow, tcol; skinny_coord(F.tid, trow, tcol);
            for (int u = F.vcu; u < 8 * 32; u += G) { const int r0 = ROW_S + 32 * (u >> 5), c0 = 32 * (u & 31), row = r0 + trow, col = c0 + tcol; float a0, a1, b0, b1;
                skinny_partial<1024>(F, (const bf16*)(ws + WS_HRG), D, (const bf16*)(ws + WS_WBRR), D, r0, c0, lane_, a0, a1);
                skinny_partial<1024>(F, (const bf16*)(ws + WS_O), D, (const bf16*)(ws + WS_WBRM), D, r0, c0, lane_, b0, b1);
                const unsigned gr = *(const unsigned*)((const bf16*)(ws + WS_G) + (size_t)row * 2048 + col), gm = *(const unsigned*)((const bf16*)(ws + WS_G) + (size_t)row * 2048 + D + col);
                *(unsigned*)((bf16*)(ws + WS_MIX) + (size_t)row * D + col) = cvt_pk_bf16(bflo(gr) * a0 + bflo(gm) * b0, bfhi(gr) * a1 + bfhi(gm) * b1); }
            __syncthreads();
        }
    }
    SEAM(5);
    if (IN(6)) REP(6) {
        pg8::TileSched S; S.init(ws + WS_MIX, ws + WS_WO, D, 64, 4, G, bx); pg8::EpiRes E{(float*)(ws + WS_PRE), (const bf16*)(ws + WS_H), nullptr};
        pg8::gemm_phase<pg8::EpiRes, pg8::TileSched, true, true>(F.lds, D, S, E);
        {   int lane_ = F.lane; asm volatile("" : "+v"(lane_));
            int trow, tcol; skinny_coord(F.tid, trow, tcol);
            for (int u = F.vcu; u < 8 * 32; u += G) { const int r0 = ROW_S + 32 * (u >> 5), c0 = 32 * (u & 31), row = r0 + trow, col = c0 + tcol; float a0, a1;
                skinny_partial<1024>(F, (const bf16*)(ws + WS_MIX), D, (const bf16*)(ws + WS_WO), D, r0, c0, lane_, a0, a1);
                const unsigned hv = *(const unsigned*)((const bf16*)(ws + WS_H) + (size_t)row * D + col);
                *(f32x2*)((float*)(ws + WS_PRE) + (size_t)row * D + col) = (f32x2){DN_ALPHA * bflo(hv) + a0, DN_ALPHA * bfhi(hv) + a1}; }
            __syncthreads();
        }
    }
    SEAM(6);
    if (IN(7)) REP(7) {
        const int gw = F.vcu * NWAVES + F.wave, NGW = G * NWAVES;
        for (int row = gw; row < ROW_M; row += NGW) ln_row((const float*)(ws + WS_PRE) + (size_t)row * D, IN_F(I_LN1G), IN_F(I_LN1B), (bf16*)(ws + WS_X1) + (size_t)row * D, nullptr, F.lane);
    }
    SEAM(7);
    if (IN(8)) REP(8) {
        pg8::TileSched S; S.init(ws + WS_X1, ws + WS_WUP, D, 64, 16, G, bx); pg8::EpiUp E{(bf16*)(ws + WS_U), IN_F(I_BUP)};
        pg8::gemm_phase<pg8::EpiUp, pg8::TileSched, true, true>(F.lds, D, S, E);
        {   int lane_ = F.lane; asm volatile("" : "+v"(lane_));
            int trow, tcol; skinny_coord(F.tid, trow, tcol);
            for (int u = F.vcu; u < 8 * 128; u += G) { const int r0 = ROW_S + 32 * (u >> 7), c0 = 32 * (u & 127), row = r0 + trow, col = c0 + tcol; float a0, a1;
                skinny_partial<1024>(F, (const bf16*)(ws + WS_X1), D, (const bf16*)(ws + WS_WUP), D, r0, c0, lane_, a0, a1);
                a0 = fmaxf(a0 + IN_F(I_BUP)[col], 0.f); a1 = fmaxf(a1 + IN_F(I_BUP)[col + 1], 0.f);
                *(unsigned*)((bf16*)(ws + WS_U) + (size_t)row * DFF + col) = cvt_pk_bf16(a0 * a0, a1 * a1); }
            __syncthreads();
        }
    }
    SEAM(8);
    if (IN(9)) REP(9) {
        pg8::TileSched S; S.init(ws + WS_U, ws + WS_WDN, DFF, 64, 4, G, bx); pg8::EpiRes E{(float*)(ws + WS_PRE), (const bf16*)(ws + WS_X1), IN_F(I_BDN)};
        pg8::gemm_phase<pg8::EpiRes, pg8::TileSched, true, true>(F.lds, DFF, S, E);
        {   int lane_ = F.lane; asm volatile("" : "+v"(lane_));
            int trow, tcol; skinny_coord(F.tid, trow, tcol);
            for (int u = F.vcu; u < 8 * 32; u += G) { const int r0 = ROW_S + 32 * (u >> 5), c0 = 32 * (u & 31), row = r0 + trow, col = c0 + tcol; float a0, a1;
                skinny_partial<4096>(F, (const bf16*)(ws + WS_U), DFF, (const bf16*)(ws + WS_WDN), DFF, r0, c0, lane_, a0, a1);
                const unsigned xv = *(const unsigned*)((const bf16*)(ws + WS_X1) + (size_t)row * D + col);
                *(f32x2*)((float*)(ws + WS_PRE) + (size_t)row * D + col) = (f32x2){DN_ALPHA * bflo(xv) + a0 + IN_F(I_BDN)[col], DN_ALPHA * bfhi(xv) + a1 + IN_F(I_BDN)[col + 1]}; }
            __syncthreads();
        }
    }
    SEAM(9);
    if (IN(10)) REP(10) {
        const int gw = F.vcu * NWAVES + F.wave, NGW = G * NWAVES;
        for (int row = gw; row < ROW_M; row += NGW) { float* o = row < ROW_S ? F.out + O_YP + (size_t)row * D : F.out + O_YS + (size_t)(row - ROW_S) * D;
            ln_row((const float*)(ws + WS_PRE) + (size_t)row * D, IN_F(I_LN2G), IN_F(I_LN2B), nullptr, o, F.lane); }
    }
#ifdef DBG_DUMP_OFF
    if (lo == 99) {
#ifdef DBG_DUMP_F32
        const float* srcf = (const float*)(ws + (size_t)(DBG_DUMP_OFF));
        for (size_t i = (size_t)F.vcu * NTHR + F.tid; i < (size_t)(DBG_DUMP_F32) / 4; i += (size_t)G * NTHR) *(f32x4*)(F.out + i * 4) = *(const f32x4*)(srcf + i * 4);
#else
#ifndef DBG_DUMP_N
#define DBG_DUMP_N ((size_t)ROW_M * D)
#endif
        const bf16* src = (const bf16*)(ws + (size_t)(DBG_DUMP_OFF));
        for (size_t i = (size_t)F.vcu * NTHR + F.tid; i < (size_t)(DBG_DUMP_N) / 8; i += (size_t)G * NTHR) { f32x4 v0, v1; pg8::unpack8(*(const u32x4*)(src + i * 8), v0, v1); *(f32x4*)(F.out + i * 8) = v0; *(f32x4*)(F.out + i * 8 + 4) = v1; }
#endif
    }
#endif
#undef IN
#undef SEAM
}

extern "C" void kernel_launch(void* const* d_in, const int* in_sizes, int n_in, void* d_out, int out_size, void* d_ws, size_t ws_size, hipStream_t stream) {
    static int grid = 0;
    if (grid == 0) {
        if (n_in != 35 || out_size != (int)O_END || ws_size < WS_END) { fprintf(stderr, "kernel_launch: unexpected shapes (n_in %d, out %d, ws %zu, need %zu)\n", n_in, out_size, ws_size, (size_t)WS_END); grid = -1; return; }
        int dev = 0, cus = 0, per_cu = 0;
        if (hipGetDevice(&dev) != hipSuccess || hipDeviceGetAttribute(&cus, hipDeviceAttributeMultiprocessorCount, dev) != hipSuccess) { grid = -1; return; }
        if (hipFuncSetAttribute((const void*)hawk_fwd, hipFuncAttributeMaxDynamicSharedMemorySize, LDS_BYTES) != hipSuccess) { fprintf(stderr, "kernel_launch: hipFuncSetAttribute failed\n"); grid = -1; return; }
        if (hipOccupancyMaxActiveBlocksPerMultiprocessor(&per_cu, (const void*)hawk_fwd, NTHR, LDS_BYTES) != hipSuccess || per_cu < 1) fprintf(stderr, "kernel_launch: occupancy query reports %d\n", per_cu);
        (void)hipGetLastError();
        grid = cus;
    }
    if (grid < 0) return;
    if (hipMemsetAsync((char*)d_ws + WS_CTL, 0, CTL_BYTES, stream) != hipSuccess) return;
    Args a{};
    for (int i = 0; i < 35; ++i) a.in[i] = d_in[i];
    a.out = (float*)d_out; a.ws = (unsigned char*)d_ws;
#if MK_PER_PHASE
#ifndef DBG_LAST_PHASE
#define DBG_LAST_PHASE (NPHASES - 1)
#endif
    if (DBG_LAST_PHASE < NPHASES - 1) (void)hipMemsetAsync(d_out, 0, (size_t)out_size * 4, stream);
    for (int p = 0; p <= DBG_LAST_PHASE; ++p) { a.ph_lo = p; a.ph_hi = p + 1; hipLaunchKernelGGL(hawk_fwd, dim3(grid), dim3(NTHR), LDS_BYTES, stream, a); }
#ifdef DBG_DUMP_OFF
    a.ph_lo = 99; a.ph_hi = 100; hipLaunchKernelGGL(hawk_fwd, dim3(grid), dim3(NTHR), LDS_BYTES, stream, a);
#endif
#else
    a.ph_lo = 0; a.ph_hi = NPHASES;
    hipLaunchKernelGGL(hawk_fwd, dim3(grid), dim3(NTHR), LDS_BYTES, stream, a);
#endif
}
```

```cpp
#include <hip/hip_runtime.h>
#include <cstdio>
#include <cstdint>

#ifndef MK_PER_PHASE
#define MK_PER_PHASE 0
#endif

#define GAS __attribute__((address_space(1)))
#define LAS __attribute__((address_space(3)))
typedef unsigned short bf16;
typedef short bf16x8 __attribute__((ext_vector_type(8)));
typedef short s16x4 __attribute__((ext_vector_type(4)));
typedef float f32x2 __attribute__((ext_vector_type(2)));
typedef float f32x4 __attribute__((ext_vector_type(4)));
typedef float f32x16 __attribute__((ext_vector_type(16)));
typedef unsigned u32x2 __attribute__((ext_vector_type(2)));
typedef unsigned u32x4 __attribute__((ext_vector_type(4)));

constexpr int D = 1024, NB = 8, SEQ = 2048, NMETA = 16, TP = SEQ + NMETA;
constexpr int DB = 32, DS = 8, PAST = 16384, PAGE = 128, NPAGES = PAST / PAGE;
constexpr int NH = 8, QKN = 128, QKR = 64, VH = 128, KVL = 512, QL = 768, DFF = 4096;
constexpr int NIN = 5440, NINP = 5632;
constexpr int ROW_S = NB * SEQ;
constexpr int ROW_M = ROW_S + DB * DS;
constexpr int R = 16896;
constexpr float EPS = 1e-5f;
constexpr float DN_ALPHA = 1.189207115002721f;
constexpr float SM_SCALE = 0.07216878364870322f;
constexpr float LOG2E = 1.4426950408889634f;
constexpr int NROPE = TP + DS;
constexpr int NSPLIT = 8;

constexpr size_t O_YP = 0, O_YS = O_YP + (size_t)NB * SEQ * D, O_PCKV = O_YS + (size_t)DB * DS * D, O_PKPE = O_PCKV + (size_t)NB * TP * KVL,
    O_PCONV = O_PKPE + (size_t)NB * TP * QKR, O_PH = O_PCONV + (size_t)NB * 3 * D, O_SCKV = O_PH + (size_t)NB * D, O_SKPE = O_SCKV + (size_t)DB * DS * KVL,
    O_SCONV = O_SKPE + (size_t)DB * DS * QKR, O_SH = O_SCONV + (size_t)DB * 3 * D, O_END = O_SH + (size_t)DB * D;
static_assert(O_END == 26861568, "output size");

constexpr size_t al256(size_t x) { return (x + 255) & ~(size_t)255; }
constexpr size_t WS_CTL = 0, CTL_BYTES = 1u << 20;
constexpr size_t WS_WIN = CTL_BYTES;
constexpr size_t WS_WQ = WS_WIN + al256((size_t)NINP * D * 2);
constexpr size_t WS_WKV = WS_WQ + al256((size_t)1536 * QL * 2);
constexpr size_t WS_WBRR = WS_WKV + al256((size_t)2048 * KVL * 2);
constexpr size_t WS_WBRM = WS_WBRR + al256((size_t)D * D * 2);
constexpr size_t WS_WO = WS_WBRM + al256((size_t)D * D * 2);
constexpr size_t WS_WUP = WS_WO + al256((size_t)D * D * 2);
constexpr size_t WS_WDN = WS_WUP + al256((size_t)DFF * D * 2);
constexpr size_t WS_WAX = WS_WDN + al256((size_t)DFF * D * 2);
constexpr size_t WS_WUKS = WS_WAX + al256((size_t)8 * 256 * 128 * 2);
constexpr size_t WS_ROPEC = WS_WUKS + al256((size_t)8 * 512 * 128 * 2);
constexpr size_t WS_ROPES = WS_ROPEC + al256((size_t)NROPE * 32 * 4);
constexpr size_t WS_SPL = WS_ROPES + al256((size_t)NROPE * 32 * 4);
constexpr size_t WS_H = WS_SPL + al256(4096);
constexpr size_t WS_RX = WS_H + al256((size_t)R * D * 2);
constexpr size_t WS_GRG = WS_RX + al256((size_t)R * D * 2);
constexpr size_t WS_CQ = WS_GRG + al256((size_t)R * D * 2);
constexpr size_t WS_CKVR = WS_CQ + al256((size_t)R * QL * 2);
constexpr size_t WS_G = WS_CKVR + al256((size_t)R * KVL * 2);
constexpr size_t WS_KPE = WS_G + al256((size_t)R * 2048 * 2);
constexpr size_t WS_SSQQ = WS_KPE + al256((size_t)R * 64 * 2);
constexpr size_t WS_SSQKV = WS_SSQQ + al256((size_t)R * 12 * 4);
constexpr size_t WS_QA = WS_SSQKV + al256((size_t)R * 8 * 4);
constexpr size_t WS_KN = WS_QA + al256((size_t)R * 1536 * 2);
constexpr size_t WS_V = WS_KN + al256((size_t)R * D * 2);
constexpr size_t WS_CKVNS = WS_V + al256((size_t)R * D * 2);
constexpr size_t WS_SEG = WS_CKVNS + al256((size_t)256 * KVL * 2);
constexpr size_t WS_HRG = WS_SEG + al256((size_t)8 * 3 * 1024 * 2 * 4);
constexpr size_t WS_O = WS_HRG + al256((size_t)R * D * 2);
constexpr size_t WS_OPART = WS_O + al256((size_t)R * D * 2);
constexpr size_t WS_ML = WS_OPART + al256((size_t)DB * NSPLIT * 64 * 512 * 4);
constexpr size_t WS_MIX = WS_ML + al256((size_t)DB * NSPLIT * 64 * 2 * 4);
constexpr size_t WS_PRE = WS_MIX + al256((size_t)R * D * 2);
constexpr size_t WS_X1 = WS_PRE + al256((size_t)R * D * 4);
constexpr size_t WS_U = WS_X1 + al256((size_t)R * D * 2);
constexpr size_t WS_END = WS_U + al256((size_t)R * DFF * 2);
static_assert(WS_END < (1ull << 32), "32-bit workspace offsets");

constexpr int CW_BAR = 4096;

constexpr int LDS_BYTES = 147456;
constexpr int MISC_OFF = 135168;
constexpr int NWAVES = 8, NTHR = 512;

__device__ __forceinline__ float bf2f(unsigned short b) { return __uint_as_float(((unsigned)b) << 16); }
__device__ __forceinline__ float bflo(unsigned w) { return __uint_as_float(w << 16); }
__device__ __forceinline__ float bfhi(unsigned w) { return __uint_as_float(w & 0xffff0000u); }
typedef __bf16 bf16x2_t __attribute__((ext_vector_type(2)));
__device__ __forceinline__ unsigned cvt_pk_bf16(float lo, float hi) { const f32x2 v = {lo, hi}; return __builtin_bit_cast(unsigned, __builtin_convertvector(v, bf16x2_t)); }
__device__ __forceinline__ float fast_exp2(float x) { return __builtin_amdgcn_exp2f(x); }
__device__ __forceinline__ float fast_rcp(float x) { return __builtin_amdgcn_rcpf(x); }
__device__ __forceinline__ float sigmoidf_(float x) { return fast_rcp(1.0f + fast_exp2(-x * LOG2E)); }
__device__ __forceinline__ float gelu_tanh(float x) { const float y = 0.7978845608028654f * (x + 0.044715f * x * x * x); return x * fast_rcp(1.0f + fast_exp2(-2.0f * LOG2E * y)); }
__device__ __forceinline__ float wave_sum(float v) {
#pragma unroll
    for (int o = 1; o < 64; o <<= 1) v += __shfl_xor(v, o);
    return v;
}
#define LDS_WAIT() asm volatile("s_waitcnt lgkmcnt(0)" ::: "memory")
#define VM_WAIT() asm volatile("s_waitcnt vmcnt(0)" ::: "memory")
namespace pg8 {
#define PG8_LAS __attribute__((address_space(3)))
constexpr int BM = 256, BK = 64, HALF = 128, HTB = HALF * BK * 2  , STAGE_BYTES = 8 * HTB, NXCD = 8, WGM = 8;
__host__ __device__ __forceinline__ int lds_byte(int r, int c) { const int st = (r >> 4) * 2 + (c >> 5), rr = r & 15, cc = c & 31, ob = rr * 64 + cc * 2; return st * 1024 + (ob ^ (((ob >> 9) & 1) << 5)); }
__host__ __device__ __forceinline__ void stage_rc(int b, int& R, int& C) { const int st = b / 1024, sb = b % 1024, swz = sb ^ (((sb >> 9) & 1) << 5); R = (st >> 1) * 16 + swz / 64; C = (st & 1) * 32 + (swz % 64) / 2; }
__host__ __device__ __forceinline__ int perm32(int rho) { const int n = rho >> 4, i = rho & 15; return 8 * (i >> 2) + 4 * n + (i & 3); }

struct Unit { const char* A; const char* B; int pm, pn; };

struct TileSched {
    const char* A; const char* B; size_t aT, bT; int nM, nN, nwg, G, c, rm_from, rm_add;
    __device__ __forceinline__ void init(const void* A_, const void* B_, int K, int nM_, int nN_, int G_, int c_, int rm_from_ = 1 << 30, int rm_add_ = 0) {
        A = (const char*)A_; B = (const char*)B_; aT = (size_t)BM * K * 2; bT = aT; nM = nM_; nN = nN_; nwg = nM * nN; G = G_; c = c_; rm_from = rm_from_; rm_add = rm_add_; }
    __device__ __forceinline__ bool next(int i, Unit& u) const {
        const long L = (long)i * G + c; if (L >= nwg) return false;
        int wgid = (int)L; { const int q = nwg / NXCD, r = nwg % NXCD, xcd = wgid % NXCD, off = wgid / NXCD; wgid = (xcd < r ? xcd * (q + 1) : r * (q + 1) + (xcd - r) * q) + off; }
        const int nig = WGM * nN, gid = wgid / nig, fm = gid * WGM, gsz = (nM - fm) < WGM ? (nM - fm) : WGM;
        int pm = fm + ((wgid % nig) % gsz); const int pn = (wgid % nig) / gsz; if (pm >= rm_from) pm += rm_add;
        u.pm = pm; u.pn = pn; u.A = A + (size_t)pm * aT; u.B = B + (size_t)pn * bT; return true;
    }
    __device__ __forceinline__ void a_ready(const Unit&) const {}
    __device__ __forceinline__ void done(const Unit&) const {}
};
template <class Epi, class Sched, bool ALIGN_EPI = false, bool SP2 = false>
__device__ __forceinline__ void gemm_phase(PG8_LAS unsigned char* lds, const int K, const Sched& S, const Epi& E) {
    const int tid = threadIdx.x, wid = __builtin_amdgcn_readfirstlane(tid >> 6), lane = tid & 63, wr = wid >> 2, wc = wid & 3, fr = lane & 15, fq = lane >> 4;
    const int nt = K / BK;
    unsigned voffA[2], voffB[2];
#pragma unroll
    for (int i = 0; i < 2; ++i) { int R, C; stage_rc(tid * 16 + i * 8192, R, C); const int Rb = Epi::PERM ? ((R & ~31) + perm32(R & 31)) : R;
        voffA[i] = (unsigned)(R * K + C) * 2u; voffB[i] = (unsigned)(Rb * K + C) * 2u; }
    const size_t kstep = (size_t)(BK * 2);
    const size_t hstep = (size_t)HALF * K * 2;
    const unsigned ldsw = (unsigned)wid * 1024u;
    const int aoff = lds_byte(wr * 64 + fr, fq * 8), boff = lds_byte(wc * 32 + fr, fq * 8);
#define PG8_SA(b, h) (((b) * 2 + (h)) * HTB)
#define PG8_SB(b, h) ((4 + (b) * 2 + (h)) * HTB)
#define PG8_STAGE(bufoff, gbase, voff) do { _Pragma("unroll") for (int _i = 0; _i < 2; ++_i) \
        __builtin_amdgcn_global_load_lds((const unsigned*)((const char*)(gbase) + (voff)[_i]), (PG8_LAS unsigned*)(lds + (bufoff) + ldsw + _i * 8192), 16, 0, 0); } while (0)
#define PG8_LDA(dst, b, h) do { _Pragma("unroll") for (int m = 0; m < 4; ++m) _Pragma("unroll") for (int k = 0; k < 2; ++k) dst[m][k] = *(const PG8_LAS bf16x8*)(lds + PG8_SA(b, h) + aoff + m * 2048 + k * 1024); } while (0)
#define PG8_LDB(dst, b, h) do { _Pragma("unroll") for (int n = 0; n < 2; ++n) _Pragma("unroll") for (int k = 0; k < 2; ++k) dst[n][k] = *(const PG8_LAS bf16x8*)(lds + PG8_SB(b, h) + boff + n * 2048 + k * 1024); } while (0)
#define PG8_MMA(ai, bj, At, Bt) do { __builtin_amdgcn_s_setprio(1); _Pragma("unroll") for (int m = 0; m < 4; ++m) _Pragma("unroll") for (int n = 0; n < 2; ++n) _Pragma("unroll") for (int k = 0; k < 2; ++k) \
        acc[ai][bj][m][n] = __builtin_amdgcn_mfma_f32_16x16x32_bf16(Bt[n][k], At[m][k], acc[ai][bj][m][n], 0, 0, 0); __builtin_amdgcn_s_setprio(0); } while (0)
#define PG8_WAIT_V(n) asm volatile("s_waitcnt vmcnt(" #n ")" ::: "memory")
#define PG8_WAIT_L(n) asm volatile("s_waitcnt lgkmcnt(" #n ")" ::: "memory")
#define PG8_BAR __builtin_amdgcn_s_barrier()
#define PG8_SCHED __builtin_amdgcn_sched_barrier(0)
    Unit cur, nxt; int ui = 0;
    if (!S.next(0, cur)) return;
    f32x4 acc[2][2][4][2];
#pragma unroll
    for (int a = 0; a < 2; ++a)
#pragma unroll
        for (int b = 0; b < 2; ++b)
#pragma unroll
            for (int m = 0; m < 4; ++m)
#pragma unroll
                for (int n = 0; n < 2; ++n) acc[a][b][m][n] = (f32x4){0.f, 0.f, 0.f, 0.f};
    bf16x8 At[4][2], B0[2][2], B1[2][2];
    const char* cA = cur.A; const char* cB = cur.B;
    S.a_ready(cur);
    if constexpr (SP2) {
        PG8_STAGE(PG8_SB(0, 0), cB, voffB); PG8_STAGE(PG8_SB(0, 1), cB + hstep, voffB); PG8_STAGE(PG8_SA(0, 0), cA, voffA); PG8_STAGE(PG8_SA(0, 1), cA + hstep, voffA);
        if (wr == 1) PG8_BAR;
        PG8_WAIT_V(2); PG8_BAR;
        PG8_STAGE(PG8_SB(1, 0), cB + kstep, voffB); PG8_STAGE(PG8_SA(1, 0), cA + kstep, voffA); PG8_STAGE(PG8_SB(1, 1), cB + hstep + kstep, voffB);
        PG8_WAIT_V(6); PG8_BAR;
    } else {
        PG8_STAGE(PG8_SB(0, 0), cB, voffB); PG8_STAGE(PG8_SA(0, 0), cA, voffA); PG8_STAGE(PG8_SB(0, 1), cB + hstep, voffB); PG8_STAGE(PG8_SA(0, 1), cA + hstep, voffA);
        if (wr == 1) PG8_BAR;
        PG8_WAIT_V(4); PG8_BAR;
        PG8_STAGE(PG8_SB(1, 0), cB + kstep, voffB); PG8_STAGE(PG8_SA(1, 0), cA + kstep, voffA); PG8_STAGE(PG8_SB(1, 1), cB + hstep + kstep, voffB);
        PG8_WAIT_V(6); PG8_BAR;
    }
    for (;;) {
        const bool has_next = S.next(ui + 1, nxt);
        const char* nA = has_next ? nxt.A : cA; const char* nB = has_next ? nxt.B : cB;
        for (int t = 0; t < nt; t += 2) {
            const bool last = (t == nt - 2);
            const char* a1 = cA + (size_t)(t + 1) * kstep;
            const char* a2 = last ? nA : cA + (size_t)(t + 2) * kstep; const char* b2 = last ? nB : cB + (size_t)(t + 2) * kstep;
            const char* a3 = a2 + kstep; const char* b3 = b2 + kstep;
            if (last && has_next) S.a_ready(nxt);
            if constexpr (SP2) {
            PG8_LDB(B0, 0, 0); PG8_LDB(B1, 0, 1); PG8_SCHED; PG8_LDA(At, 0, 0); PG8_STAGE(PG8_SA(1, 1), a1 + hstep, voffA);
            PG8_WAIT_V(8); PG8_WAIT_L(0); PG8_BAR; PG8_MMA(0, 0, At, B0); PG8_MMA(0, 1, At, B1); PG8_BAR; PG8_SCHED;
            PG8_LDA(At, 0, 1); PG8_STAGE(PG8_SB(0, 0), b2, voffB); PG8_STAGE(PG8_SB(0, 1), b2 + hstep, voffB); PG8_STAGE(PG8_SA(0, 0), a2, voffA);
            PG8_WAIT_V(8); PG8_WAIT_L(0); PG8_BAR; PG8_MMA(1, 0, At, B0); PG8_MMA(1, 1, At, B1); PG8_BAR; PG8_SCHED;
            PG8_LDB(B0, 1, 0); PG8_LDB(B1, 1, 1); PG8_SCHED; PG8_LDA(At, 1, 0); PG8_STAGE(PG8_SA(0, 1), a2 + hstep, voffA);
            PG8_WAIT_V(8); PG8_WAIT_L(0); PG8_BAR; PG8_MMA(0, 0, At, B0); PG8_MMA(0, 1, At, B1); PG8_BAR; PG8_SCHED;
            PG8_LDA(At, 1, 1); PG8_STAGE(PG8_SB(1, 0), b3, voffB); PG8_STAGE(PG8_SB(1, 1), b3 + hstep, voffB); PG8_STAGE(PG8_SA(1, 0), a3, voffA);
            PG8_WAIT_V(8); PG8_WAIT_L(0); PG8_BAR; PG8_MMA(1, 0, At, B0); PG8_MMA(1, 1, At, B1); PG8_BAR; PG8_SCHED;
            } else {
            PG8_LDB(B0, 0, 0); PG8_SCHED; PG8_LDA(At, 0, 0); PG8_STAGE(PG8_SA(1, 1), a1 + hstep, voffA);
            PG8_WAIT_L(8); PG8_BAR; PG8_WAIT_L(0); PG8_MMA(0, 0, At, B0); PG8_BAR; PG8_SCHED;
            PG8_LDB(B1, 0, 1); PG8_STAGE(PG8_SB(0, 0), b2, voffB);
            PG8_BAR; PG8_WAIT_L(0); PG8_MMA(0, 1, At, B1); PG8_BAR;
            PG8_LDA(At, 0, 1); PG8_STAGE(PG8_SA(0, 0), a2, voffA);
            PG8_BAR; PG8_WAIT_L(0); PG8_MMA(1, 0, At, B0); PG8_BAR; PG8_SCHED;
            PG8_STAGE(PG8_SB(0, 1), b2 + hstep, voffB);
            PG8_WAIT_V(6); PG8_BAR; PG8_MMA(1, 1, At, B1); PG8_BAR;
            PG8_LDB(B0, 1, 0); PG8_SCHED; PG8_LDA(At, 1, 0); PG8_STAGE(PG8_SA(0, 1), a2 + hstep, voffA);
            PG8_WAIT_L(8); PG8_BAR; PG8_WAIT_L(0); PG8_MMA(0, 0, At, B0); PG8_BAR; PG8_SCHED;
            PG8_LDB(B1, 1, 1); PG8_STAGE(PG8_SB(1, 0), b3, voffB);
            PG8_BAR; PG8_WAIT_L(0); PG8_MMA(0, 1, At, B1); PG8_BAR;
            PG8_LDA(At, 1, 1); PG8_STAGE(PG8_SA(1, 0), a3, voffA);
            PG8_BAR; PG8_WAIT_L(0); PG8_MMA(1, 0, At, B0); PG8_BAR; PG8_SCHED;
            PG8_STAGE(PG8_SB(1, 1), b3 + hstep, voffB);
            PG8_WAIT_V(6); PG8_BAR; PG8_MMA(1, 1, At, B1); PG8_BAR;
            }
        }
        if constexpr (ALIGN_EPI) { if (wr == 0) PG8_BAR; }
        if constexpr (!Epi::AFTER_DRAIN) { E(acc, cur, wr, wc, fr, fq); S.done(cur); }
        if (!has_next) break;
#pragma unroll
        for (int a = 0; a < 2; ++a)
#pragma unroll
            for (int b = 0; b < 2; ++b)
#pragma unroll
                for (int m = 0; m < 4; ++m)
#pragma unroll
                    for (int n = 0; n < 2; ++n) acc[a][b][m][n] = (f32x4){0.f, 0.f, 0.f, 0.f};
        cur = nxt; cA = nA; cB = nB; ++ui;
        if constexpr (ALIGN_EPI) { if (wr == 1) PG8_BAR; }
    }
    PG8_WAIT_V(0);
    if constexpr (!ALIGN_EPI) { if (wr == 0) PG8_BAR; }
    PG8_BAR;
    if constexpr (Epi::AFTER_DRAIN) { E.fused(acc, cur, wr, wc, fr, fq, lds, wid, lane); S.done(cur); }
#undef PG8_SA
#undef PG8_SB
#undef PG8_STAGE
#undef PG8_LDA
#undef PG8_LDB
#undef PG8_MMA
#undef PG8_WAIT_V
#undef PG8_WAIT_L
#undef PG8_BAR
#undef PG8_SCHED
}
}
#define RLX_AGENT __ATOMIC_RELAXED, __HIP_MEMORY_SCOPE_AGENT
#define XB_TMO      128
#define XB_XCNT(j)  (256  + 64 * (j))
#define XB_XSUB(j)  (1280 + 64 * (j))
#define XB_XGEN(j)  (2304 + 64 * (j))
#define XB_TOP      3328
#define XB_TOPGEN   3392
#define XCD_BAR_WORDS 3456
#define XB_SPIN_CAP (1u << 18)

__device__ __forceinline__ unsigned xb_ld(unsigned* p)              { return __hip_atomic_load(p, __ATOMIC_RELAXED, __HIP_MEMORY_SCOPE_AGENT); }
__device__ __forceinline__ unsigned xb_add(unsigned* p, unsigned v) { return __hip_atomic_fetch_add(p, v, __ATOMIC_RELAXED, __HIP_MEMORY_SCOPE_AGENT); }
__device__ __forceinline__ unsigned xb_xcc_id() { return (unsigned)__builtin_amdgcn_s_getreg((3 << 11) | 20) & 0xFu; }
#define XB_SPIN(cond, bar) do { unsigned _sp = 0; while (cond) { __builtin_amdgcn_s_sleep(1); \
    if ((++_sp & 255u) == 0u) { if (xb_ld(&(bar)[XB_TMO])) break; if (_sp > XB_SPIN_CAP) { atomicAdd(&(bar)[XB_TMO], 1u); break; } } } } while (0)

struct XcdBarrier {
    unsigned* bar; unsigned x;
    volatile LAS unsigned* st;
};

__device__ __forceinline__ XcdBarrier xcd_barrier_post(unsigned* bar, volatile LAS unsigned* st) {
    XcdBarrier b; b.bar = bar; b.x = xb_xcc_id(); b.st = st;
    if (threadIdx.x == 0) (void)xb_add(&bar[XB_XCNT(b.x)], 1u);
    return b;
}
__device__ __forceinline__ void xcd_barrier_complete(unsigned* bar, unsigned x, unsigned& nloc, unsigned& nx) {
    const unsigned G = gridDim.x * gridDim.y * gridDim.z;
    unsigned sum, cnt, mine, sp = 0u;
    for (;;) {
        sum = 0u; cnt = 0u; mine = 0u;
#pragma unroll
        for (unsigned j = 0; j < 16; ++j) { const unsigned c = xb_ld(&bar[XB_XCNT(j)]); sum += c; cnt += (c > 0u) ? 1u : 0u; mine = (j == x) ? c : mine; }
        if (sum == G) break;
        __builtin_amdgcn_s_sleep(1);
        if ((++sp & 255u) == 0u) { if (xb_ld(&bar[XB_TMO])) break; if (sp > XB_SPIN_CAP) { atomicAdd(&bar[XB_TMO], 1u); break; } }
    }
    nloc = mine > 0u ? mine : 1u; nx = cnt > 0u ? cnt : 1u;
}

__device__ __forceinline__ void xcd_barrier(const XcdBarrier& b) {
    asm volatile("s_waitcnt vmcnt(0)" ::: "memory");
    __syncthreads();
    if (threadIdx.x == 0) {
        unsigned* bar = b.bar;
        __builtin_amdgcn_s_waitcnt(0);
        unsigned nloc = b.st[0], nx = b.st[1];
        if (nloc == 0u) { xcd_barrier_complete(bar, b.x, nloc, nx); b.st[0] = nloc; b.st[1] = nx; }
        const unsigned old = xb_add(&bar[XB_XSUB(b.x)], 1u);
        const unsigned gen = old / nloc;
        if (old + 1u == (gen + 1u) * nloc) {
            __builtin_amdgcn_fence(__ATOMIC_RELEASE, "agent");
            asm volatile("s_waitcnt vmcnt(0)" ::: "memory");
            const unsigned og = xb_add(&bar[XB_TOP], 1u);
            const unsigned tg = og / nx;
            if (og + 1u == (tg + 1u) * nx) xb_add(&bar[XB_TOPGEN], 1u);
            else XB_SPIN(xb_ld(&bar[XB_TOPGEN]) == tg, bar);
            __builtin_amdgcn_fence(__ATOMIC_ACQUIRE, "agent");
            xb_add(&bar[XB_XGEN(b.x)], 1u);
            asm volatile("s_waitcnt vmcnt(0)" ::: "memory");
        } else {
            XB_SPIN(xb_ld(&bar[XB_XGEN(b.x)]) == gen, bar);
            __builtin_amdgcn_fence(__ATOMIC_ACQUIRE, "agent");
            asm volatile("s_waitcnt vmcnt(0)" ::: "memory");
        }
    }
    __syncthreads();
}

__device__ __forceinline__ int rope_idx_of_row(int row) {
    if (row < ROW_S) return NMETA + (row & (SEQ - 1));
    if (row < ROW_M) return TP + ((row - ROW_S) & (DS - 1));
    if (row < ROW_M + NMETA) return row - ROW_M;
    return -1;
}
namespace pg8 {
#define EPI_ROWS(ai, m) (row0 + (ai) * HALF + (m) * 16)
__device__ __forceinline__ u32x4 pack8(const f32x4 v0, const f32x4 v1) { u32x4 w; w.x = cvt_pk_bf16(v0[0], v0[1]); w.y = cvt_pk_bf16(v0[2], v0[3]); w.z = cvt_pk_bf16(v1[0], v1[1]); w.w = cvt_pk_bf16(v1[2], v1[3]); return w; }
__device__ __forceinline__ void unpack8(const u32x4 w, f32x4& v0, f32x4& v1) { v0 = (f32x4){bflo(w.x), bfhi(w.x), bflo(w.y), bfhi(w.y)}; v1 = (f32x4){bflo(w.z), bfhi(w.z), bflo(w.w), bfhi(w.w)}; }

struct EpiWin {
    static constexpr bool PERM = true, AFTER_DRAIN = false;
    bf16 *RX, *GRG, *CQ, *CKVR, *G, *KPE; float *SSQQ, *SSQKV; const float* b_gate; const float *ropec, *ropes; float* out;
    __device__ __forceinline__ void operator()(const f32x4 (&acc)[2][2][4][2], const Unit& u, int wr, int wc, int fr, int fq) const {
        const int pn = u.pn, row0 = u.pm * BM + wr * 64 + fr, cw = wc * 32 + 8 * fq;
        if (pn < 4 || (pn >= 8 && pn < 13)) {
            bf16* base; int ld, colt, nslot = 0, slot0 = 0; float* ssq = nullptr;
            if (pn < 4) { base = RX; ld = D; colt = pn * BM; }
            else if (pn < 11) { base = CQ; ld = QL; colt = (pn - 8) * BM; ssq = SSQQ; nslot = 12; slot0 = (pn - 8) * 4 + wc; }
            else { base = CKVR; ld = KVL; colt = (pn - 11) * BM; ssq = SSQKV; nslot = 8; slot0 = (pn - 11) * 4 + wc; }
#pragma unroll
            for (int ai = 0; ai < 2; ++ai)
#pragma unroll
                for (int m = 0; m < 4; ++m) { const int row = EPI_ROWS(ai, m); float s = 0.f;
#pragma unroll
                    for (int bj = 0; bj < 2; ++bj) { const f32x4 v0 = acc[ai][bj][m][0], v1 = acc[ai][bj][m][1];
                        *(u32x4*)(base + (size_t)row * ld + colt + bj * HALF + cw) = pack8(v0, v1);
                        s += (v0[0] * v0[0] + v0[1] * v0[1]) + (v0[2] * v0[2] + v0[3] * v0[3]) + (v1[0] * v1[0] + v1[1] * v1[1]) + (v1[2] * v1[2] + v1[3] * v1[3]); }
                    if (ssq) { s += __shfl_xor(s, 16); s += __shfl_xor(s, 32); if (fq == 0) ssq[(size_t)row * nslot + slot0] = s; } }
        } else if (pn < 8) {
            const int colt = (pn - 4) * BM;
#pragma unroll
            for (int ai = 0; ai < 2; ++ai)
#pragma unroll
                for (int m = 0; m < 4; ++m) { const int row = EPI_ROWS(ai, m);
#pragma unroll
                    for (int bj = 0; bj < 2; ++bj) { f32x4 v0 = acc[ai][bj][m][0], v1 = acc[ai][bj][m][1];
#pragma unroll
                        for (int j = 0; j < 4; ++j) { v0[j] = gelu_tanh(v0[j]); v1[j] = gelu_tanh(v1[j]); }
                        *(u32x4*)(GRG + (size_t)row * D + colt + bj * HALF + cw) = pack8(v0, v1); } }
        } else if (pn < 21) {
            const int colt = (pn - 13) * BM;
            f32x4 bv[2][2];
#pragma unroll
            for (int bj = 0; bj < 2; ++bj)
#pragma unroll
                for (int n = 0; n < 2; ++n) bv[bj][n] = *(const f32x4*)(b_gate + colt + bj * HALF + cw + 4 * n);
#pragma unroll
            for (int ai = 0; ai < 2; ++ai)
#pragma unroll
                for (int m = 0; m < 4; ++m) { const int row = EPI_ROWS(ai, m);
#pragma unroll
                    for (int bj = 0; bj < 2; ++bj) { f32x4 v0 = acc[ai][bj][m][0] + bv[bj][0], v1 = acc[ai][bj][m][1] + bv[bj][1];
#pragma unroll
                        for (int j = 0; j < 4; ++j) { v0[j] = sigmoidf_(v0[j]); v1[j] = sigmoidf_(v1[j]); }
                        *(u32x4*)(G + (size_t)row * 2048 + colt + bj * HALF + cw) = pack8(v0, v1); } }
        } else if (wc == 0) {
#pragma unroll
            for (int ai = 0; ai < 2; ++ai)
#pragma unroll
                for (int m = 0; m < 4; ++m) { const int row = EPI_ROWS(ai, m); const int pi = rope_idx_of_row(row);
                    if (pi >= 0) {
#pragma unroll
                        for (int n = 0; n < 2; ++n) { const int i0 = 8 * fq + 4 * n;
                            const f32x4 cs = *(const f32x4*)(ropec + pi * 32 + i0), sn = *(const f32x4*)(ropes + pi * 32 + i0);
                            const f32x4 x1 = acc[ai][0][m][n], x2 = acc[ai][1][m][n];
                            const f32x4 o1 = x1 * cs - x2 * sn, o2 = x1 * sn + x2 * cs;
                            u32x2 w1, w2; w1.x = cvt_pk_bf16(o1[0], o1[1]); w1.y = cvt_pk_bf16(o1[2], o1[3]); w2.x = cvt_pk_bf16(o2[0], o2[1]); w2.y = cvt_pk_bf16(o2[2], o2[3]);
                            *(u32x2*)(KPE + (size_t)row * 64 + i0) = w1; *(u32x2*)(KPE + (size_t)row * 64 + 32 + i0) = w2;
                            if (row < ROW_S) { float* o = out + O_PKPE + ((size_t)(row >> 11) * TP + pi) * 64 + i0; *(f32x4*)o = o1; *(f32x4*)(o + 32) = o2; }
                            else if (row < ROW_M) { float* o = out + O_SKPE + (size_t)(row - ROW_S) * 64 + i0; *(f32x4*)o = o1; *(f32x4*)(o + 32) = o2; }
                            else {
#pragma unroll
                                for (int b = 0; b < NB; ++b) { float* o = out + O_PKPE + ((size_t)b * TP + pi) * 64 + i0; *(f32x4*)o = o1; *(f32x4*)(o + 32) = o2; } } } } }
        }
    }
};
struct EpiQ {
    static constexpr bool PERM = true, AFTER_DRAIN = false;
    bf16* QA; const float* SSQQ; const float *ropec, *ropes;
    __device__ __forceinline__ void operator()(const f32x4 (&acc)[2][2][4][2], const Unit& u, int wr, int wc, int fr, int fq) const {
        const int pn = u.pn, row0 = u.pm * BM + wr * 64 + fr, cw = wc * 32 + 8 * fq;
#pragma unroll
        for (int ai = 0; ai < 2; ++ai)
#pragma unroll
            for (int m = 0; m < 4; ++m) { const int row = EPI_ROWS(ai, m);
                const f32x4 s0 = *(const f32x4*)(SSQQ + (size_t)row * 12), s1 = *(const f32x4*)(SSQQ + (size_t)row * 12 + 4), s2 = *(const f32x4*)(SSQQ + (size_t)row * 12 + 8);
                const float ss = ((s0[0] + s0[1]) + (s0[2] + s0[3])) + ((s1[0] + s1[1]) + (s1[2] + s1[3])) + ((s2[0] + s2[1]) + (s2[2] + s2[3]));
                const float rstd = __builtin_amdgcn_rsqf(ss * (1.0f / QL) + EPS);
                if (pn < 4) {
#pragma unroll
                    for (int bj = 0; bj < 2; ++bj) { const int h = pn * 2 + bj;
                        *(u32x4*)(QA + (size_t)row * 1536 + h * 192 + cw) = pack8(acc[ai][bj][m][0] * rstd, acc[ai][bj][m][1] * rstd); }
                } else {
                    const int h = (pn - 4) * 4 + wc; int pi = rope_idx_of_row(row); if (pi < 0) pi = 0;
#pragma unroll
                    for (int n = 0; n < 2; ++n) { const int i0 = 8 * fq + 4 * n;
                        const f32x4 cs = *(const f32x4*)(ropec + pi * 32 + i0), sn = *(const f32x4*)(ropes + pi * 32 + i0);
                        const f32x4 x1 = acc[ai][0][m][n] * rstd, x2 = acc[ai][1][m][n] * rstd;
                        const f32x4 o1 = x1 * cs - x2 * sn, o2 = x1 * sn + x2 * cs;
                        u32x2 w1, w2; w1.x = cvt_pk_bf16(o1[0], o1[1]); w1.y = cvt_pk_bf16(o1[2], o1[3]); w2.x = cvt_pk_bf16(o2[0], o2[1]); w2.y = cvt_pk_bf16(o2[2], o2[3]);
                        *(u32x2*)(QA + (size_t)row * 1536 + h * 192 + 128 + i0) = w1; *(u32x2*)(QA + (size_t)row * 1536 + h * 192 + 160 + i0) = w2; }
                } }
    }
};
struct EpiKV {
    static constexpr bool PERM = true, AFTER_DRAIN = false;
    bf16 *KN, *V; const float* SSQKV;
    __device__ __forceinline__ void operator()(const f32x4 (&acc)[2][2][4][2], const Unit& u, int wr, int wc, int fr, int fq) const {
        const int pn = u.pn, row0 = u.pm * BM + wr * 64 + fr, cw = wc * 32 + 8 * fq;
        bf16* base = pn < 4 ? KN : V; const int colt = (pn & 3) * BM;
#pragma unroll
        for (int ai = 0; ai < 2; ++ai)
#pragma unroll
            for (int m = 0; m < 4; ++m) { const int row = EPI_ROWS(ai, m);
                const f32x4 s0 = *(const f32x4*)(SSQKV + (size_t)row * 8), s1 = *(const f32x4*)(SSQKV + (size_t)row * 8 + 4);
                const float ss = ((s0[0] + s0[1]) + (s0[2] + s0[3])) + ((s1[0] + s1[1]) + (s1[2] + s1[3]));
                const float rstd = __builtin_amdgcn_rsqf(ss * (1.0f / KVL) + EPS);
#pragma unroll
                for (int bj = 0; bj < 2; ++bj) *(u32x4*)(base + (size_t)row * D + colt + bj * HALF + cw) = pack8(acc[ai][bj][m][0] * rstd, acc[ai][bj][m][1] * rstd); }
    }
};
template <int MODE> struct EpiZ {
    static constexpr bool PERM = true, AFTER_DRAIN = false;
    bf16* MIX; const bf16* G;
    __device__ __forceinline__ void operator()(const f32x4 (&acc)[2][2][4][2], const Unit& u, int wr, int wc, int fr, int fq) const {
        const int row0 = u.pm * BM + wr * 64 + fr, col0 = u.pn * BM + wc * 32 + 8 * fq;
#pragma unroll
        for (int ai = 0; ai < 2; ++ai)
#pragma unroll
            for (int m = 0; m < 4; ++m) { const int row = EPI_ROWS(ai, m);
#pragma unroll
                for (int bj = 0; bj < 2; ++bj) { const int col = col0 + bj * HALF;
                    f32x4 g0, g1; unpack8(*(const u32x4*)(G + (size_t)row * 2048 + MODE * D + col), g0, g1);
                    f32x4 v0 = acc[ai][bj][m][0] * g0, v1 = acc[ai][bj][m][1] * g1;
                    if (MODE == 1) { f32x4 t0, t1; unpack8(*(const u32x4*)(MIX + (size_t)row * D + col), t0, t1); v0 += t0; v1 += t1; }
                    *(u32x4*)(MIX + (size_t)row * D + col) = pack8(v0, v1); } }
    }
};
struct EpiRes {
    static constexpr bool PERM = false, AFTER_DRAIN = false;
    float* OUT; const bf16* RES; const float* bias;
    __device__ __forceinline__ void operator()(const f32x4 (&acc)[2][2][4][2], const Unit& u, int wr, int wc, int fr, int fq) const {
        const int row0 = u.pm * BM + wr * 64 + fr, col0 = u.pn * BM + wc * 32 + 4 * fq;
        f32x4 bv[2][2];
#pragma unroll
        for (int bj = 0; bj < 2; ++bj)
#pragma unroll
            for (int n = 0; n < 2; ++n) bv[bj][n] = bias ? *(const f32x4*)(bias + col0 + bj * HALF + n * 16) : (f32x4){0.f, 0.f, 0.f, 0.f};
#pragma unroll
        for (int ai = 0; ai < 2; ++ai)
#pragma unroll
            for (int m = 0; m < 4; ++m) { const size_t ro = (size_t)EPI_ROWS(ai, m) * D + col0;
#pragma unroll
                for (int bj = 0; bj < 2; ++bj)
#pragma unroll
                    for (int n = 0; n < 2; ++n) { const u32x2 w = *(const u32x2*)(RES + ro + bj * HALF + n * 16);
                        const f32x4 r = (f32x4){bflo(w.x), bfhi(w.x), bflo(w.y), bfhi(w.y)};
                        *(f32x4*)(OUT + ro + bj * HALF + n * 16) = r * DN_ALPHA + acc[ai][bj][m][n] + bv[bj][n]; } }
    }
};
struct EpiUp {
    static constexpr bool PERM = true, AFTER_DRAIN = false;
    bf16* U; const float* bias;
    __device__ __forceinline__ void operator()(const f32x4 (&acc)[2][2][4][2], const Unit& u, int wr, int wc, int fr, int fq) const {
        const int row0 = u.pm * BM + wr * 64 + fr, col0 = u.pn * BM + wc * 32 + 8 * fq;
        f32x4 bv[2][2];
#pragma unroll
        for (int bj = 0; bj < 2; ++bj)
#pragma unroll
            for (int n = 0; n < 2; ++n) bv[bj][n] = *(const f32x4*)(bias + col0 + bj * HALF + 4 * n);
#pragma unroll
        for (int ai = 0; ai < 2; ++ai)
#pragma unroll
            for (int m = 0; m < 4; ++m) { const int row = EPI_ROWS(ai, m);
#pragma unroll
                for (int bj = 0; bj < 2; ++bj) { f32x4 v0 = acc[ai][bj][m][0] + bv[bj][0], v1 = acc[ai][bj][m][1] + bv[bj][1];
#pragma unroll
                    for (int j = 0; j < 4; ++j) { const float a = fmaxf(v0[j], 0.f), b = fmaxf(v1[j], 0.f); v0[j] = a * a; v1[j] = b * b; }
                    *(u32x4*)(U + (size_t)row * DFF + col0 + bj * HALF) = pack8(v0, v1); } }
    }
};
#undef EPI_ROWS
}
struct Frame {
    LAS unsigned char* lds;
    volatile LAS unsigned* MISC;
    unsigned* ctl;
    int tid, lane, wave, vcu, G;
    const void* const* in;
    float* out; unsigned char* ws;
};
struct Args { const void* in[35]; float* out; unsigned char* ws; int ph_lo, ph_hi; };
#define IN_F(i) ((const float*)args.in[i])
enum { I_XP = 0, I_XS, I_CCKV, I_CKPE, I_PT, I_SCONV, I_SRG, I_META, I_LNG, I_LNB, I_WIN, I_BGATE, I_CONVW, I_CONVB, I_WA, I_BA, I_WX, I_BX, I_LAM, I_WBRR,
       I_QG, I_WUQ, I_KVG, I_WUK, I_WUV, I_WBRM, I_WO, I_LN1G, I_LN1B, I_WUP, I_BUP, I_WDN, I_BDN, I_LN2G, I_LN2B };

__device__ __forceinline__ void tr_item(const float* src, size_t ldn, int scol0, bf16* dst, int dK, int drow0, int k0, const float* kscale, LAS float* scr, int lane) {
    if (scol0 >= 0) {
#pragma unroll 8
        for (int i = 0; i < 32; ++i) { const int kk = 2 * i + (lane >> 5); scr[kk * 33 + (lane & 31)] = src[(size_t)(k0 + kk) * ldn + scol0 + (lane & 31)]; }
    } else {
#pragma unroll 8
        for (int i = 0; i < 32; ++i) { const int kk = 2 * i + (lane >> 5); scr[kk * 33 + (lane & 31)] = 0.f; }
    }
    LDS_WAIT(); asm volatile("" ::: "memory");
    const int c = lane & 7;
    float ks[8];
#pragma unroll
    for (int e = 0; e < 8; ++e) ks[e] = kscale ? kscale[k0 + 8 * c + e] : 1.0f;
#pragma unroll
    for (int j = 0; j < 4; ++j) { const int n = (lane >> 3) + 8 * j; const LAS float* s = scr + (8 * c) * 33 + n;
        u32x4 o; o.x = cvt_pk_bf16(s[0 * 33] * ks[0], s[1 * 33] * ks[1]); o.y = cvt_pk_bf16(s[2 * 33] * ks[2], s[3 * 33] * ks[3]);
        o.z = cvt_pk_bf16(s[4 * 33] * ks[4], s[5 * 33] * ks[5]); o.w = cvt_pk_bf16(s[6 * 33] * ks[6], s[7 * 33] * ks[7]);
        *(u32x4*)(dst + (size_t)(drow0 + n) * dK + k0 + 8 * c) = o; }
    LDS_WAIT(); asm volatile("" ::: "memory");
}
__device__ __forceinline__ void ln_row(const float* xrow, const float* g, const float* b, bf16* obf, float* of32, int lane) {
    const f32x4* xr = (const f32x4*)xrow + lane;
    f32x4 v[4]; float s = 0.f;
#pragma unroll
    for (int j = 0; j < 4; ++j) { v[j] = xr[64 * j]; s += (v[j].x + v[j].y) + (v[j].z + v[j].w); }
    const float mean = wave_sum(s) * (1.f / D); float s2 = 0.f;
#pragma unroll
    for (int j = 0; j < 4; ++j) { v[j] = v[j] - mean; s2 += (v[j].x * v[j].x + v[j].y * v[j].y) + (v[j].z * v[j].z + v[j].w * v[j].w); }
    const float rstd = __builtin_amdgcn_rsqf(wave_sum(s2) * (1.f / D) + EPS);
#pragma unroll
    for (int j = 0; j < 4; ++j) { const f32x4 gg = ((const f32x4*)g)[lane + 64 * j], bb = ((const f32x4*)b)[lane + 64 * j]; const f32x4 y = v[j] * rstd * gg + bb;
        if (obf) { u32x2 w; w.x = cvt_pk_bf16(y.x, y.y); w.y = cvt_pk_bf16(y.z, y.w); ((u32x2*)obf)[lane + 64 * j] = w; }
        if (of32) ((f32x4*)of32)[lane + 64 * j] = y; }
}
__device__ __forceinline__ const float* src_row(const float* xp, const float* xs, const float* meta, int row) {
    if (row < ROW_S) return xp + (size_t)row * D;
    if (row < ROW_M) return xs + (size_t)(row - ROW_S) * D;
    if (row < ROW_M + NMETA) return meta + (size_t)(row - ROW_M) * D;
    return nullptr;
}
__device__ __forceinline__ void p0_prologue(const Frame& F, const Args& args) {
    unsigned char* ws = F.ws;
    LAS float* scr = (LAS float*)(F.lds + F.wave * 16384);
    const int gw = F.vcu * NWAVES + F.wave, NGW = F.G * NWAVES, lane = F.lane;
    constexpr int I_1 = 16 * (NINP / 32), I_2 = 12 * 48, I_3 = 8 * 32, I_4 = 8 * 32, I_5 = 16 * 32, I_8 = 16 * 128, I_9 = 64 * 32, I_10 = 8 * 8;
    constexpr int NITEMS = I_1 + I_2 + I_3 + I_4 + 3 * I_5 + I_8 + I_9 + 2 * I_10;
    for (int it = gw; it < NITEMS; it += NGW) {
        int r = it;
        if (r < I_1) { const int nb = r % (NINP / 32), kb = r / (NINP / 32), n0 = 32 * nb; int sc;
            if (n0 < 3328) sc = n0; else if (n0 < 5376) sc = n0 + 64; else { const int w = n0 - 5376; sc = (w == 0) ? 3328 : (w == 128 ? 3360 : -1); }
            tr_item(IN_F(I_WIN), NIN, sc, (bf16*)(ws + WS_WIN), D, n0, 64 * kb, nullptr, scr, lane); continue; } r -= I_1;
        if (r < I_2) { const int nb = r % 48, kb = r / 48, n0 = 32 * nb; int sc;
            if (n0 < 1024) sc = (n0 >> 7) * 192 + (n0 & 127);
            else { const int w = n0 - 1024, tt = w >> 8, wi = w & 255, half = wi >> 7, hh = (wi & 127) >> 5; sc = (4 * tt + hh) * 192 + 128 + 32 * half; }
            tr_item(IN_F(I_WUQ), 1536, sc, (bf16*)(ws + WS_WQ), QL, n0, 64 * kb, IN_F(I_QG), scr, lane); continue; } r -= I_2;
        if (r < I_3) { const int nb = r % 32, kb = r / 32; tr_item(IN_F(I_WUK), 1024, 32 * nb, (bf16*)(ws + WS_WKV), KVL, 32 * nb, 64 * kb, IN_F(I_KVG), scr, lane); continue; } r -= I_3;
        if (r < I_4) { const int nb = r % 32, kb = r / 32; tr_item(IN_F(I_WUV), 1024, 32 * nb, (bf16*)(ws + WS_WKV), KVL, 1024 + 32 * nb, 64 * kb, IN_F(I_KVG), scr, lane); continue; } r -= I_4;
        if (r < I_5) { const int nb = r % 32, kb = r / 32; tr_item(IN_F(I_WBRR), D, 32 * nb, (bf16*)(ws + WS_WBRR), D, 32 * nb, 64 * kb, nullptr, scr, lane); continue; } r -= I_5;
        if (r < I_5) { const int nb = r % 32, kb = r / 32; tr_item(IN_F(I_WBRM), D, 32 * nb, (bf16*)(ws + WS_WBRM), D, 32 * nb, 64 * kb, nullptr, scr, lane); continue; } r -= I_5;
        if (r < I_5) { const int nb = r % 32, kb = r / 32; tr_item(IN_F(I_WO), D, 32 * nb, (bf16*)(ws + WS_WO), D, 32 * nb, 64 * kb, nullptr, scr, lane); continue; } r -= I_5;
        if (r < I_8) { const int nb = r % 128, kb = r / 128; tr_item(IN_F(I_WUP), DFF, 32 * nb, (bf16*)(ws + WS_WUP), D, 32 * nb, 64 * kb, nullptr, scr, lane); continue; } r -= I_8;
        if (r < I_9) { const int nb = r % 32, kb = r / 32; tr_item(IN_F(I_WDN), D, 32 * nb, (bf16*)(ws + WS_WDN), DFF, 32 * nb, 64 * kb, nullptr, scr, lane); continue; } r -= I_9;
        if (r < I_10) { const int blk = r >> 3, nb = r & 3, kb = (r >> 2) & 1; tr_item(IN_F(I_WA) + (size_t)blk * 128 * 128, 128, 32 * nb, (bf16*)(ws + WS_WAX), 128, blk * 256 + 32 * nb, 64 * kb, nullptr, scr, lane); continue; } r -= I_10;
        { const int blk = r >> 3, nb = r & 3, kb = (r >> 2) & 1; tr_item(IN_F(I_WX) + (size_t)blk * 128 * 128, 128, 32 * nb, (bf16*)(ws + WS_WAX), 128, blk * 256 + 128 + 32 * nb, 64 * kb, nullptr, scr, lane); }
    }
    const int gt = F.vcu * NTHR + F.tid, NGT = F.G * NTHR;
    for (int i = gt; i < 8 * 512 * 16; i += NGT) { const int c8 = i & 15, r = (i >> 4) & 511, h = i >> 13;
        const f32x4 a = *(const f32x4*)(IN_F(I_WUK) + (size_t)r * 1024 + h * 128 + c8 * 8), b = *(const f32x4*)(IN_F(I_WUK) + (size_t)r * 1024 + h * 128 + c8 * 8 + 4);
        *(u32x4*)((bf16*)(ws + WS_WUKS) + ((size_t)h * 512 + r) * 128 + c8 * 8) = pg8::pack8(a, b); }
    for (int i = gt; i < NROPE * 32; i += NGT) { const int pi = i >> 5, k = i & 31; const int pos = pi < TP ? pi : PAST + (pi - TP);
        double pw = 1.0; for (int j = 0; j < k; ++j) pw *= 1.3335214321633240;
        const float inv = 1.0f / (float)pw; const float ang = (float)pos * inv; const double a = (double)ang;
        const double n2 = __builtin_rint(a * 0.15915494309189535); const double r = (a - n2 * 6.283185307179586) - n2 * 2.4492935982947064e-16;
        const double q = __builtin_rint(r * 0.6366197723675814); const double t = (r - q * 1.5707963267948966) - q * 6.123233995736766e-17; const int qi = ((int)q) & 3;
        const double t2 = t * t;
        const double st = t * (1.0 + t2 * (-1.0 / 6 + t2 * (1.0 / 120 + t2 * (-1.0 / 5040 + t2 * (1.0 / 362880 + t2 * (-1.0 / 39916800 + t2 * (1.0 / 6227020800.0)))))));
        const double ct = 1.0 + t2 * (-0.5 + t2 * (1.0 / 24 + t2 * (-1.0 / 720 + t2 * (1.0 / 40320 + t2 * (-1.0 / 3628800 + t2 * (1.0 / 479001600.0 + t2 * (-1.0 / 87178291200.0)))))));
        const double cv = qi == 0 ? ct : (qi == 1 ? -st : (qi == 2 ? -ct : st)), sv = qi == 0 ? st : (qi == 1 ? ct : (qi == 2 ? -st : -ct));
        ((float*)(ws + WS_ROPEC))[i] = (float)cv; ((float*)(ws + WS_ROPES))[i] = (float)sv; }
    for (int i = gt; i < D; i += NGT) { const float l = IN_F(I_LAM)[i]; ((float*)(ws + WS_SPL))[i] = (l > 0.f) ? log1pf(expf(-l)) : (-l + log1pf(expf(l))); }
    for (int m = gw; m < R; m += NGW) { const float* s = src_row(IN_F(I_XP), IN_F(I_XS), IN_F(I_META), m); bf16* o = (bf16*)(ws + WS_H) + (size_t)m * D;
        if (s) ln_row(s, IN_F(I_LNG), IN_F(I_LNB), o, nullptr, lane);
        else { for (int j = 0; j < 2; ++j) ((u32x4*)o)[lane + 64 * j] = (u32x4){0u, 0u, 0u, 0u}; } }
}
constexpr int RG_XC = 0;
constexpr int RG_PRIV = 2 * 16384;
constexpr int RG_PW = 2 * 64 * 17 * 4 + 512;
constexpr int RG_CW = RG_PRIV + 8 * RG_PW;
constexpr int RG_END = RG_CW + 5 * 128 * 4;
static_assert(RG_END <= MISC_OFF, "rg lds");
__device__ __forceinline__ unsigned off256(unsigned row, unsigned ch) { return 256u * row + 16u * (ch ^ (((row & 3) << 2) | ((row >> 2) & 3))); }

struct RgParams {
    const bf16 *RX, *GRG, *WAX; bf16* HRG; const float *conv_w, *conv_b, *ba, *bx, *spl, *state_conv, *state_rg; float* SEG; float* out;
};
__device__ __forceinline__ int prompt_row(int b, int p) { return p < NMETA ? ROW_M + p : b * SEQ + (p - NMETA); }

template <int MODE>
__device__ __forceinline__ void rg_unit(const Frame& F, const RgParams& P, const int b  , const int n, const int seg) {
    LAS unsigned char* lds = F.lds;
    int tid = F.tid; asm volatile("" : "+v"(tid));
    const int lane = tid & 63, wave = F.wave, l15 = lane & 15, g = lane >> 4;
    LAS float* PA = (LAS float*)(lds + RG_PRIV + wave * RG_PW); LAS float* PU = PA + 64 * 17; LAS float* PS = PU + 64 * 17;
    bf16x8 wfa[4], wfx[4];
    { const bf16* wa = P.WAX + ((size_t)n * 256 + 16 * wave + l15) * 128 + 8 * g; const bf16* wx = wa + 128 * 128;
#pragma unroll
      for (int ks = 0; ks < 4; ++ks) { wfa[ks] = *(const bf16x8*)(wa + 32 * ks); wfx[ks] = *(const bf16x8*)(wx + 32 * ks); } }
    const int cl = 16 * wave + l15, cg = n * 128 + cl;
    const float ba_c = P.ba[cg], bx_c = P.bx[cg], spl8 = -8.0f * P.spl[cg] * LOG2E;
    const int cv_tp = tid >> 4, cv_c8 = tid & 15, cg_v = n * 128 + 8 * cv_c8;
    if (tid < 5 * 32) { const int k = tid >> 5, c4 = (tid & 31) * 4; *(LAS f32x4*)(lds + RG_CW + (k * 128 + c4) * 4) = k < 4 ? *(const f32x4*)(P.conv_w + k * D + n * 128 + c4) : *(const f32x4*)(P.conv_b + n * 128 + c4); }
    __syncthreads();
    float hc = 0.f, cA = 1.f;
    if (MODE == 1) { for (int s2 = 0; s2 < seg; ++s2) { const f32x2 sv = *(const f32x2*)(P.SEG + (((size_t)b * 3 + s2) * D + cg) * 2); hc = sv.x * hc + sv.y; } }
    const int nchunks = (MODE == 2) ? 1 : (seg == 0 ? 9 : 8);
    auto chunk_p0 = [&](int ch) -> int { return seg == 0 ? (ch == 0 ? 0 : NMETA + 64 * (ch - 1)) : NMETA + 512 * seg + 64 * ch; };
    u32x4 xw[5];
    auto load_x = [&](int ch) {
        const int p0n = chunk_p0(ch);
#pragma unroll
        for (int r = 0; r < 5; ++r) { const int p = p0n + 2 * cv_tp - 3 + r;
            xw[r] = (u32x4){0u, 0u, 0u, 0u};
            if (p >= 0) xw[r] = *(const u32x4*)(P.RX + (size_t)prompt_row(b, p < TP ? p : TP - 1) * D + cg_v); }
    };
    if (MODE != 2) load_x(0);
    for (int ch = 0; ch < nchunks; ++ch) {
        int p0 = 0, nvalid = 64;
        if (MODE != 2) { p0 = chunk_p0(ch); if (seg == 0 && ch == 0) nvalid = NMETA; }
        LAS unsigned char* XC = lds + RG_XC + (ch & 1) * 16384;
        {
            float cw[4][8], cbias[8];
#pragma unroll
            for (int k = 0; k < 5; ++k) { const f32x4 a = *(const LAS f32x4*)(lds + RG_CW + (k * 128 + 8 * cv_c8) * 4), c = *(const LAS f32x4*)(lds + RG_CW + (k * 128 + 8 * cv_c8 + 4) * 4);
#pragma unroll
                for (int e = 0; e < 4; ++e) { if (k < 4) { cw[k][e] = a[e]; cw[k][4 + e] = c[e]; } else { cbias[e] = a[e]; cbias[4 + e] = c[e]; } } }
            if (MODE != 2) {
                float x[5][8];
#pragma unroll
                for (int r = 0; r < 5; ++r) { const u32x4 w = xw[r];
                    x[r][0] = bflo(w.x); x[r][1] = bfhi(w.x); x[r][2] = bflo(w.y); x[r][3] = bfhi(w.y); x[r][4] = bflo(w.z); x[r][5] = bfhi(w.z); x[r][6] = bflo(w.w); x[r][7] = bfhi(w.w); }
                if (ch + 1 < nchunks) load_x(ch + 1);
#pragma unroll
                for (int t = 0; t < 2; ++t) { const int row = 2 * cv_tp + t;
                    float acc[8];
#pragma unroll
                    for (int e = 0; e < 8; ++e) acc[e] = cbias[e] + x[t][e] * cw[0][e] + x[t + 1][e] * cw[1][e] + x[t + 2][e] * cw[2][e] + x[t + 3][e] * cw[3][e];
                    u32x4 o; o.x = cvt_pk_bf16(acc[0], acc[1]); o.y = cvt_pk_bf16(acc[2], acc[3]); o.z = cvt_pk_bf16(acc[4], acc[5]); o.w = cvt_pk_bf16(acc[6], acc[7]);
                    *(LAS u32x4*)(XC + off256(row, cv_c8)) = o; }
            } else {
#pragma unroll
                for (int t = 0; t < 2; ++t) { const int row = 2 * cv_tp + t, j = row & 7, bb = 8 * b + (row >> 3);
                    float acc[8];
#pragma unroll
                    for (int e = 0; e < 8; ++e) acc[e] = cbias[e];
#pragma unroll
                    for (int k = 0; k < 4; ++k) { const int xi = j + k; float xv[8];
                        if (xi < 3) { const f32x4 a = *(const f32x4*)(P.state_conv + ((size_t)bb * 3 + xi) * D + cg_v), c = *(const f32x4*)(P.state_conv + ((size_t)bb * 3 + xi) * D + cg_v + 4);
#pragma unroll
                            for (int e = 0; e < 4; ++e) { xv[e] = a[e]; xv[4 + e] = c[e]; } }
                        else { const u32x4 w = *(const u32x4*)(P.RX + (size_t)(ROW_S + bb * 8 + xi - 3) * D + cg_v);
                            xv[0] = bflo(w.x); xv[1] = bfhi(w.x); xv[2] = bflo(w.y); xv[3] = bfhi(w.y); xv[4] = bflo(w.z); xv[5] = bfhi(w.z); xv[6] = bflo(w.w); xv[7] = bfhi(w.w); }
#pragma unroll
                        for (int e = 0; e < 8; ++e) acc[e] += xv[e] * cw[k][e]; }
                    u32x4 o; o.x = cvt_pk_bf16(acc[0], acc[1]); o.y = cvt_pk_bf16(acc[2], acc[3]); o.z = cvt_pk_bf16(acc[4], acc[5]); o.w = cvt_pk_bf16(acc[6], acc[7]);
                    *(LAS u32x4*)(XC + off256(row, cv_c8)) = o; }
            }
        }
        __syncthreads();
        f32x4 ga[4], gx[4];
#pragma unroll
        for (int tb = 0; tb < 4; ++tb) { ga[tb] = (f32x4){0.f, 0.f, 0.f, 0.f}; gx[tb] = (f32x4){0.f, 0.f, 0.f, 0.f}; }
#pragma unroll
        for (int tb = 0; tb < 4; ++tb)
#pragma unroll
            for (int ks = 0; ks < 4; ++ks) { const bf16x8 af = *(const LAS bf16x8*)(XC + off256(16 * tb + l15, 4 * ks + g));
                ga[tb] = __builtin_amdgcn_mfma_f32_16x16x32_bf16(af, wfa[ks], ga[tb], 0, 0, 0); gx[tb] = __builtin_amdgcn_mfma_f32_16x16x32_bf16(af, wfx[ks], gx[tb], 0, 0, 0); }
#pragma unroll
        for (int tb = 0; tb < 4; ++tb)
#pragma unroll
            for (int e = 0; e < 4; ++e) { const int tok = 16 * tb + 4 * g + e;
                const float xcv = bf2f(*(const LAS bf16*)(XC + off256(tok, cl >> 3) + 2 * (cl & 7)));
                const float rr = sigmoidf_(ga[tb][e] + ba_c), ii = sigmoidf_(gx[tb][e] + bx_c);
                float a = fast_exp2(rr * spl8); float u = __builtin_amdgcn_sqrtf(fmaxf(1.0f - a * a, 0.f)) * ii * xcv;
                if (nvalid < 64) { if (tok >= nvalid) { a = 1.f; u = 0.f; } }
                PA[tok * 17 + l15] = a; PU[tok * 17 + l15] = u; }
        LDS_WAIT(); asm volatile("" ::: "memory");
        float av[16], uv[16];
#pragma unroll
        for (int i = 0; i < 16; ++i) { av[i] = PA[(16 * g + i) * 17 + l15]; uv[i] = PU[(16 * g + i) * 17 + l15]; }
        if (MODE == 2) {
#pragma unroll
            for (int t2 = 0; t2 < 2; ++t2) { const int bb = 8 * b + 2 * g + t2; float h = P.state_rg[(size_t)bb * D + cg];
#pragma unroll
                for (int j = 0; j < 8; ++j) { h = av[8 * t2 + j] * h + uv[8 * t2 + j]; PA[(16 * g + 8 * t2 + j) * 17 + l15] = h; }
                P.out[O_SH + (size_t)bb * D + cg] = h; }
        } else {
            float A = 1.f, Hh = 0.f;
#pragma unroll
            for (int i = 0; i < 16; ++i) { Hh = av[i] * Hh + uv[i]; A *= av[i]; }
            *(LAS f32x2*)(PS + (g * 16 + l15) * 2) = (f32x2){A, Hh};
            LDS_WAIT(); asm volatile("" ::: "memory");
            float hin = hc, hend = hc, Aend = 1.f;
#pragma unroll
            for (int q = 0; q < 4; ++q) { const f32x2 sv = *(LAS f32x2*)(PS + (q * 16 + l15) * 2); if (q < g) hin = sv.x * hin + sv.y; hend = sv.x * hend + sv.y; Aend *= sv.x; }
            hc = hend; cA *= Aend;
            if (MODE == 1) { float h = hin;
#pragma unroll
                for (int i = 0; i < 16; ++i) { h = av[i] * h + uv[i]; PA[(16 * g + i) * 17 + l15] = h; } }
        }
        if (MODE != 0) {
            LDS_WAIT(); asm volatile("" ::: "memory");
            const int row = lane; int grow;
            if (MODE == 2) grow = ROW_S + 64 * b + row; else { const int p = p0 + row; grow = prompt_row(b, p < TP ? p : TP - 1); }
            if (MODE == 2 || (row < nvalid && p0 >= NMETA)) {
                f32x4 g0, g1, g2, g3; pg8::unpack8(*(const u32x4*)(P.GRG + (size_t)grow * D + n * 128 + 16 * wave), g0, g1); pg8::unpack8(*(const u32x4*)(P.GRG + (size_t)grow * D + n * 128 + 16 * wave + 8), g2, g3);
                float hv[16];
#pragma unroll
                for (int c = 0; c < 16; ++c) hv[c] = PA[row * 17 + c];
                const f32x4 h0 = (f32x4){hv[0], hv[1], hv[2], hv[3]}, h1 = (f32x4){hv[4], hv[5], hv[6], hv[7]}, h2 = (f32x4){hv[8], hv[9], hv[10], hv[11]}, h3 = (f32x4){hv[12], hv[13], hv[14], hv[15]};
                *(u32x4*)(P.HRG + (size_t)grow * D + n * 128 + 16 * wave) = pg8::pack8(h0 * g0, h1 * g1); *(u32x4*)(P.HRG + (size_t)grow * D + n * 128 + 16 * wave + 8) = pg8::pack8(h2 * g2, h3 * g3); }
            LDS_WAIT(); asm volatile("" ::: "memory");
        }
    }
    if (MODE == 0) { if (g == 0) *(f32x2*)(P.SEG + (((size_t)b * 3 + seg) * D + cg) * 2) = (f32x2){cA, hc}; }
    if (MODE == 1 && seg == 3) { if (g == 0) P.out[O_PH + (size_t)b * D + cg] = hc; }
    __syncthreads();
}
template <int K>
__device__ __forceinline__ void skinny_partial(const Frame& F, const bf16* __restrict__ A, const int lda, const bf16* __restrict__ Bt, const int ldb, const int r0, const int c0, const int lane, float& v0, float& v1) {
    LAS unsigned char* lds = F.lds;
    constexpr int KP = K > 1024 ? 1024 : K, NPASS = K / KP, RB = KP * 2  , SLAB = 32 * RB, NPW = KP / 128  , CPW = KP / 64  ;
    static_assert(K % KP == 0 && KP % 128 == 0 && 2 * SLAB <= MISC_OFF, "skinny shape");
    const int w = F.wave, hh = lane >> 5, l31 = lane & 31;
    f32x16 acc = (f32x16){};
    __syncthreads();
#pragma unroll 1
    for (int ps = 0; ps < NPASS; ++ps) {
#pragma unroll
        for (int i = 0; i < NPW; ++i) { const unsigned pos = 1024u * (w * NPW + i) + 16u * lane, row = pos / RB, chp = (pos % RB) >> 4, ch = chp ^ (row & 15u);
            __builtin_amdgcn_global_load_lds((const unsigned*)(A + (size_t)(r0 + row) * lda + ps * KP + 8 * ch), (LAS unsigned*)(lds + 1024 * (w * NPW + i)), 16, 0, 0);
            __builtin_amdgcn_global_load_lds((const unsigned*)(Bt + (size_t)(c0 + row) * ldb + ps * KP + 8 * ch), (LAS unsigned*)(lds + SLAB + 1024 * (w * NPW + i)), 16, 0, 0); }
        VM_WAIT(); __syncthreads();
#pragma unroll
        for (int s = 0; s < NPW; ++s) { const unsigned ch = (unsigned)(w * CPW + 2 * s + hh) ^ (unsigned)(l31 & 15);
            const bf16x8 af = *(const LAS bf16x8*)(lds + l31 * RB + 16 * ch), bfr = *(const LAS bf16x8*)(lds + SLAB + l31 * RB + 16 * ch);
            acc = __builtin_amdgcn_mfma_f32_32x32x16_bf16(bfr, af, acc, 0, 0, 0); }
        __syncthreads();
    }
#pragma unroll
    for (int r = 0; r < 16; ++r) *(LAS float*)(lds + ((w * 16 + r) * 64 + lane) * 4) = acc[r];
    __syncthreads();
    const int t = F.tid, ln = t & 63, rg = 2 * (t >> 6);
    float s0 = 0.f, s1 = 0.f;
#pragma unroll
    for (int ww = 0; ww < 8; ++ww) { s0 += *(const LAS float*)(lds + ((ww * 16 + rg) * 64 + ln) * 4); s1 += *(const LAS float*)(lds + ((ww * 16 + rg + 1) * 64 + ln) * 4); }
    v0 = s0; v1 = s1;
}
__device__ __forceinline__ void skinny_coord(const int tid, int& row, int& col) { const int ln = tid & 63, rg = 2 * (tid >> 6); row = ln & 31; col = (rg & 3) + 8 * (rg >> 2) + 4 * (ln >> 5); }
constexpr int PA_KB = 64 * 384, PA_VB = 64 * 256;
constexpr int PA_K0 = 0, PA_V0 = 2 * PA_KB, PA_END = PA_V0 + 2 * PA_VB;
static_assert(PA_END <= MISC_OFF, "prompt attention lds");
__device__ __forceinline__ unsigned offK384(unsigned row, unsigned ch) { return 384u * row + 16u * (ch ^ ((row >> 1) & 7)); }
struct PAttnParams { const bf16 *QA, *KN, *KPE, *V; bf16* O; };

__device__ __forceinline__ void pattn_unit(const Frame& F, const PAttnParams& P, const int b, const int h, const int x) {
    LAS unsigned char* lds = F.lds;
    int lane = F.lane; asm volatile("" : "+v"(lane));
    const int w = F.wave, hh = lane >> 5, l31 = lane & 31;
#pragma nounroll
    for (int half = 0; half < 2; ++half) {
    const int xb = half ? 7 - x : x;
    const int tq = 256 * xb + 32 * w + l31;
    const size_t qrow = (size_t)b * SEQ + tq;
    bf16x8 qf[12];
#pragma unroll
    for (int s = 0; s < 12; ++s) qf[s] = *(const bf16x8*)(P.QA + qrow * 1536 + h * 192 + 16 * s + 8 * hh);
    f32x16 o[4];
#pragma unroll
    for (int i = 0; i < 4; ++i) o[i] = (f32x16){};
    float m = -1e30f, l = 0.f;
    const int ntiles = 1 + 4 * (xb + 1);
    unsigned ksrc[3], kstep[3], vsrc[2];
    const char* wsb = (const char*)P.KN - WS_KN;
#pragma unroll
    for (int i = 0; i < 3; ++i) { const unsigned pos = 1024u * (w + 8 * i) + 16u * lane, row = pos / 384u, chp = (pos % 384u) >> 4, ch = chp ^ ((row >> 1) & 7u);
        if (ch < 16) { ksrc[i] = (unsigned)WS_KN + (row * D + h * 128 + 8 * ch) * 2u; kstep[i] = D * 2; } else { ksrc[i] = (unsigned)WS_KPE + (row * 64 + 8 * (ch - 16)) * 2u; kstep[i] = 64 * 2; } }
#pragma unroll
    for (int i = 0; i < 2; ++i) { const unsigned pos = 1024u * (w + 8 * i) + 16u * lane, row = pos >> 8, chp = (pos & 255u) >> 4, ch = chp ^ (((row & 3) << 2) | ((row >> 2) & 3));
        vsrc[i] = (unsigned)WS_V + (row * D + h * 128 + 8 * ch) * 2u; }
    auto issue = [&](int it, int buf) {
        const unsigned row0 = it == 0 ? (unsigned)ROW_M : (unsigned)(b * SEQ + 64 * (it - 1));
#pragma unroll
        for (int i = 0; i < 3; ++i) __builtin_amdgcn_global_load_lds((const unsigned*)(wsb + (ksrc[i] + row0 * kstep[i])), (LAS unsigned*)(lds + PA_K0 + buf * PA_KB + 1024 * (w + 8 * i)), 16, 0, 0);
#pragma unroll
        for (int i = 0; i < 2; ++i) __builtin_amdgcn_global_load_lds((const unsigned*)(wsb + (vsrc[i] + row0 * (unsigned)(D * 2))), (LAS unsigned*)(lds + PA_V0 + buf * PA_VB + 1024 * (w + 8 * i)), 16, 0, 0);
    };
    issue(0, 0); VM_WAIT(); __syncthreads();
    constexpr float SC = SM_SCALE * LOG2E;
    const int trq = (lane & 15) >> 2, trp = lane & 3, trblk = (lane >> 4) & 1;
    unsigned kb4[4], vb8[2][4];
    { const unsigned sw = (l31 >> 1) & 7u, a = sw >> 1, c = sw & 1u;
#pragma unroll
      for (int v = 0; v < 4; ++v) kb4[v] = 384u * l31 + 16u * ((unsigned)hh ^ c) + 32u * ((unsigned)v ^ a);
      const unsigned clo = 2u * trblk + (trp >> 1);
#pragma unroll
      for (int t = 0; t < 2; ++t)
#pragma unroll
          for (int db = 0; db < 4; ++db) vb8[t][db] = 256u * (4u * hh + trq) + 8u * (trp & 1) + 16u * (clo ^ ((2u * t + hh) & 3u)) + 64u * ((unsigned)db ^ (unsigned)trq); }
#pragma nounroll
    for (int it = 0; it < ntiles; ++it) {
        const int buf = it & 1;
        if (it + 1 < ntiles) issue(it + 1, buf ^ 1);
        const int qmin = 256 * xb + 32 * w; const bool skip = (it > 0) && (64 * (it - 1) > qmin + 31);
        const int lim0 = (it == 0) ? NMETA : tq - 64 * (it - 1) + 1, lim1 = (it == 0) ? 0 : lim0 - 32;
        if (!skip) {
            f32x16 p0 = (f32x16){}, p1 = (f32x16){};
            const LAS unsigned char* Kb = lds + PA_K0 + buf * PA_KB;
#pragma unroll
            for (int sg = 0; sg < 6; ++sg) {
#pragma unroll
                for (int s = 2 * sg; s < 2 * sg + 2; ++s) { const bf16x8 a0 = *(const LAS bf16x8*)(Kb + kb4[s & 3] + 128 * (s >> 2)), a1 = *(const LAS bf16x8*)(Kb + kb4[s & 3] + 12288 + 128 * (s >> 2));
                    p0 = __builtin_amdgcn_mfma_f32_32x32x16_bf16(a0, qf[s], p0, 0, 0, 0); p1 = __builtin_amdgcn_mfma_f32_32x32x16_bf16(a1, qf[s], p1, 0, 0, 0); }
                __builtin_amdgcn_sched_barrier(0); }
            float pmax = -3e38f;
#pragma unroll
            for (int r = 0; r < 16; ++r) { const int kl = (r & 3) + 8 * (r >> 2) + 4 * hh;
                float x0 = p0[r] * SC, x1 = p1[r] * SC;
                x0 = kl < lim0 ? x0 : -3e38f; x1 = kl < lim1 ? x1 : -3e38f;
                p0[r] = x0; p1[r] = x1; pmax = fmaxf(pmax, fmaxf(x0, x1)); }
            pmax = fmaxf(pmax, __shfl_xor(pmax, 32));
            const float mn = fmaxf(m, pmax), alpha = fast_exp2(m - mn); m = mn;
            float ps = 0.f;
#pragma unroll
            for (int r = 0; r < 16; ++r) { p0[r] = fast_exp2(p0[r] - mn); p1[r] = fast_exp2(p1[r] - mn); ps += p0[r] + p1[r]; }
            l = l * alpha + ps;
#pragma unroll
            for (int i = 0; i < 4; ++i) o[i] = o[i] * alpha;
            const LAS unsigned char* Vb = lds + PA_V0 + buf * PA_VB;
#pragma unroll
            for (int kb = 0; kb < 2; ++kb)
#pragma unroll
                for (int s2 = 0; s2 < 2; ++s2) {
                    bf16x8 pf; { const f32x16& pp = kb ? p1 : p0; u32x4 t; t.x = cvt_pk_bf16(pp[8 * s2 + 0], pp[8 * s2 + 1]); t.y = cvt_pk_bf16(pp[8 * s2 + 2], pp[8 * s2 + 3]); t.z = cvt_pk_bf16(pp[8 * s2 + 4], pp[8 * s2 + 5]); t.w = cvt_pk_bf16(pp[8 * s2 + 6], pp[8 * s2 + 7]); pf = __builtin_bit_cast(bf16x8, t); }
#pragma unroll
                    for (int db = 0; db < 4; ++db) {
                        const s16x4 t0 = __builtin_amdgcn_ds_read_tr16_b64_v4i16((LAS s16x4*)(Vb + vb8[0][db] + 256 * (32 * kb + 16 * s2)));
                        const s16x4 t1 = __builtin_amdgcn_ds_read_tr16_b64_v4i16((LAS s16x4*)(Vb + vb8[1][db] + 256 * (32 * kb + 16 * s2 + 8)));
                        bf16x8 vf; vf[0] = t0[0]; vf[1] = t0[1]; vf[2] = t0[2]; vf[3] = t0[3]; vf[4] = t1[0]; vf[5] = t1[1]; vf[6] = t1[2]; vf[7] = t1[3];
                        o[db] = __builtin_amdgcn_mfma_f32_32x32x16_bf16(vf, pf, o[db], 0, 0, 0); }
                    __builtin_amdgcn_sched_barrier(0); }
        }
        VM_WAIT(); __syncthreads();
    }
    l += __shfl_xor(l, 32);
    const float il = 1.0f / l;
    bf16* orow = P.O + qrow * D + h * 128;
#pragma unroll
    for (int db = 0; db < 4; ++db)
#pragma unroll
        for (int rq = 0; rq < 4; ++rq) { u32x2 wv; wv.x = cvt_pk_bf16(o[db][4 * rq] * il, o[db][4 * rq + 1] * il); wv.y = cvt_pk_bf16(o[db][4 * rq + 2] * il, o[db][4 * rq + 3] * il);
            *(u32x2*)(orow + 32 * db + 8 * rq + 4 * hh) = wv; }
    __syncthreads();
    }
}
constexpr int SA_CKVB = 32 * 1024, SA_KPEB = 32 * 128;
constexpr int SA_CKV0 = 0, SA_KPE0 = 2 * SA_CKVB, SA_SB = SA_KPE0 + 2 * SA_KPEB, SA_PB = SA_SB + 64 * 36 * 4, SA_AL = SA_PB + 64 * 64, SA_QL2 = SA_AL + 256, SA_END = SA_QL2 + 64 * 576;
constexpr int SA_QL = 0;
static_assert(64 * 576 * 2 <= SA_SB && SA_END <= MISC_OFF, "sample attention lds");
__device__ __forceinline__ unsigned off1024(unsigned row, unsigned ch) { return 1024u * row + 16u * (ch ^ (((row & 3) << 2) | ((row >> 2) & 3))); }
__device__ __forceinline__ unsigned offkpe(unsigned row, unsigned ch) { return 128u * row + 16u * (ch ^ ((row >> 1) & 7)); }
__device__ __forceinline__ unsigned offQ2(unsigned rho, unsigned ch) { return 576u * rho + 16u * (ch ^ ((rho >> 2) & 3)); }
__device__ __forceinline__ unsigned offP(unsigned rho, unsigned ch) { return 64u * rho + 16u * (ch ^ ((rho >> 2) & 3)); }
struct SAttnParams { const float *cckv, *ckpe; const int* pt; const bf16 *QA, *WUKS, *CKVNS, *KPE; float *OPART, *ML; };

__device__ __forceinline__ void sattn_unit(const Frame& F, const SAttnParams& P, const int b, const int sp) {
    LAS unsigned char* lds = F.lds;
    int tid = F.tid; asm volatile("" : "+v"(tid));
    const int lane = tid & 63, w = F.wave, hh = lane >> 5, l31 = lane & 31, l15 = lane & 15, g = lane >> 4;
    {
        const int h = w;
        bf16x8 qa[4];
#pragma unroll
        for (int ks = 0; ks < 4; ++ks) qa[ks] = *(const bf16x8*)(P.QA + (size_t)(ROW_S + b * 8 + (l15 & 7)) * 1536 + h * 192 + 32 * ks + 8 * g);
        const bf16* wk = P.WUKS + ((size_t)h * 512 + l15) * 128 + 8 * g;
        for (int rb = 0; rb < 32; ++rb) {
            f32x4 acc = (f32x4){0.f, 0.f, 0.f, 0.f};
#pragma unroll
            for (int ks = 0; ks < 4; ++ks) { const bf16x8 bw = *(const bf16x8*)(wk + (size_t)rb * 16 * 128 + 32 * ks); acc = __builtin_amdgcn_mfma_f32_16x16x32_bf16(qa[ks], bw, acc, 0, 0, 0); }
            if (g < 2) {
#pragma unroll
                for (int e = 0; e < 4; ++e) *(LAS bf16*)(lds + SA_QL + ((h * 8 + 4 * g + e) * 576 + 16 * rb + l15) * 2) = (bf16)(cvt_pk_bf16(acc[e], 0.f) & 0xffffu);
            }
        }
        { const int rho = tid >> 3, c8 = tid & 7; const int hq = rho >> 3, j = rho & 7;
          *(LAS u32x4*)(lds + SA_QL + (rho * 576 + 512 + 8 * c8) * 2) = *(const u32x4*)(P.QA + (size_t)(ROW_S + b * 8 + j) * 1536 + hq * 192 + 128 + 8 * c8); }
    }
    __syncthreads();
#ifdef DBG_QLAT
    { bf16* dbg = (bf16*)((unsigned char*)P.OPART - WS_OPART + WS_U) + (size_t)(b * NSPLIT + sp) * 64 * 576;
      for (int i = tid; i < 64 * 576 / 8; i += NTHR) *(u32x4*)(dbg + i * 8) = *(const LAS u32x4*)(lds + SA_QL + i * 16); }
#endif
    const int kb = w & 1, rb = w >> 1;
    bf16x8 qb[9];
#pragma unroll
    for (int s = 0; s < 9; ++s) qb[s] = *(const LAS bf16x8*)(lds + SA_QL + ((16 * rb + l15) * 576 + 32 * s + 8 * g) * 2);
    for (int i = tid; i < 64 * 36; i += NTHR) { const int rho = i / 36, c = i % 36; *(LAS u32x4*)(lds + SA_QL2 + offQ2(rho, c)) = *(const LAS u32x4*)(lds + SA_QL + (rho * 576 + 288 + 8 * c) * 2); }
    __syncthreads();
    const unsigned q2b = offQ2(16 * rb + l15, g);
    f32x16 o[2][2];
#pragma unroll
    for (int i = 0; i < 2; ++i)
#pragma unroll
        for (int j = 0; j < 2; ++j) o[i][j] = (f32x16){};
    const int srho = tid >> 3, skg = tid & 7;
    float m = -1e30f, l = 0.f;
    constexpr float SC = SM_SCALE * LOG2E;
    const int ptv = P.pt[b * NPAGES + 16 * sp + (lane & 15)];
    f32x4 crA[8], krA, crB[8], krB;
    auto issue = [&](int it, f32x4 (&cr)[8], f32x4& kr) {
        const unsigned phys = (unsigned)__builtin_amdgcn_readlane(ptv, it >> 2); const unsigned key0 = phys * PAGE + (unsigned)(it & 3) * 32u;
        const char* cbase = (const char*)P.cckv; const char* kbase = (const char*)P.ckpe;
#pragma unroll
        for (int i = 0; i < 4; ++i) { const unsigned off = ((key0 + (tid >> 6) + 8 * i) * KVL + 4 * (tid & 63)) * 4u; cr[2 * i] = *(const f32x4*)(cbase + off); cr[2 * i + 1] = *(const f32x4*)(cbase + off + 1024); }
        kr = *(const f32x4*)(kbase + ((key0 + (tid >> 4)) * QKR + 4 * (tid & 15)) * 4u);
    };
    auto commit = [&](int buf, const f32x4 (&cr)[8], const f32x4& kr) {
#pragma unroll
        for (int i = 0; i < 4; ++i)
#pragma unroll
            for (int hf = 0; hf < 2; ++hf) { const f32x4 v = cr[2 * i + hf]; u32x2 wv; wv.x = cvt_pk_bf16(v[0], v[1]); wv.y = cvt_pk_bf16(v[2], v[3]);
                *(LAS u32x2*)(lds + SA_CKV0 + buf * SA_CKVB + off1024((tid >> 6) + 8 * i, 32 * hf + ((tid & 63) >> 1)) + 8 * (tid & 1)) = wv; }
        u32x2 wv; wv.x = cvt_pk_bf16(kr[0], kr[1]); wv.y = cvt_pk_bf16(kr[2], kr[3]);
        *(LAS u32x2*)(lds + SA_KPE0 + buf * SA_KPEB + offkpe(tid >> 4, (tid & 15) >> 1) + 8 * (tid & 1)) = wv;
    };
    const int trq = l15 >> 2, trp = lane & 3, trblk = g & 1;
    unsigned sa4[4], ka2[2], va4[2][2], pa2[2];
    { const unsigned a = l15 & 3u, c = (l15 >> 2) & 3u, e = (l15 >> 1) & 7u, f = (l31 >> 2) & 3u, clo = 2u * trblk + (trp >> 1);
#pragma unroll
      for (int v = 0; v < 4; ++v) sa4[v] = 1024u * (16u * kb + l15) + 16u * ((unsigned)g ^ c) + 64u * ((unsigned)v ^ a);
#pragma unroll
      for (int s2 = 0; s2 < 2; ++s2) { ka2[s2] = offkpe(16u * kb + l15, 4u * s2 + g); pa2[s2] = offP(l31, 2u * s2 + hh); }
#pragma unroll
      for (int t = 0; t < 2; ++t)
#pragma unroll
          for (int db = 0; db < 2; ++db) va4[t][db] = 1024u * (8u * hh + 4u * t + trq) + 8u * (trp & 1) + 16u * (clo ^ ((2u * hh + t) & 3u)) + 64u * (((2u * (w & 1) + db) ^ (unsigned)trq)) + 256u * (w >> 1); }
    auto compute = [&](const int buf, const bool newtile) {
#ifdef SA_PROBE_SLEEP
        __builtin_amdgcn_s_sleep(SA_PROBE_SLEEP);
#endif
        {
            const LAS unsigned char* Cb = lds + SA_CKV0 + buf * SA_CKVB; const LAS unsigned char* Kb = lds + SA_KPE0 + buf * SA_KPEB;
            f32x4 acc = (f32x4){0.f, 0.f, 0.f, 0.f};
#pragma unroll
            for (int s = 0; s < 16; ++s) { const bf16x8 a = *(const LAS bf16x8*)(Cb + sa4[s & 3] + 256 * (s >> 2));
                const bf16x8 q = s < 9 ? qb[s < 9 ? s : 0] : *(const LAS bf16x8*)(lds + SA_QL2 + q2b + 64 * (s - 9));
                acc = __builtin_amdgcn_mfma_f32_16x16x32_bf16(a, q, acc, 0, 0, 0);
                if ((s & 3) == 3) __builtin_amdgcn_sched_barrier(0); }
#pragma unroll
            for (int s = 0; s < 2; ++s) { const bf16x8 a = *(const LAS bf16x8*)(Kb + ka2[s]); const bf16x8 q = *(const LAS bf16x8*)(lds + SA_QL2 + q2b + 64 * (7 + s));
                acc = __builtin_amdgcn_mfma_f32_16x16x32_bf16(a, q, acc, 0, 0, 0); }
            *(LAS f32x4*)(lds + SA_SB + ((16 * rb + l15) * 36 + 16 * kb + 4 * g) * 4) = acc;
        }
        __syncthreads();
        {
            f32x4 v = *(const LAS f32x4*)(lds + SA_SB + (srho * 36 + 4 * skg) * 4) * SC;
            if (newtile) {
#pragma unroll
                for (int e = 0; e < 4; ++e) if (4 * skg + e > (srho & 7)) v[e] = -3e38f;
            }
            float tm = fmaxf(fmaxf(v[0], v[1]), fmaxf(v[2], v[3]));
            tm = fmaxf(tm, __shfl_xor(tm, 1)); tm = fmaxf(tm, __shfl_xor(tm, 2)); tm = fmaxf(tm, __shfl_xor(tm, 4));
            const float mn = fmaxf(m, tm), alpha = fast_exp2(m - mn); m = mn;
#pragma unroll
            for (int e = 0; e < 4; ++e) v[e] = fast_exp2(v[e] - mn);
            float ps = (v[0] + v[1]) + (v[2] + v[3]);
            ps += __shfl_xor(ps, 1); ps += __shfl_xor(ps, 2); ps += __shfl_xor(ps, 4);
            l = l * alpha + ps;
            u32x2 wv; wv.x = cvt_pk_bf16(v[0], v[1]); wv.y = cvt_pk_bf16(v[2], v[3]);
            *(LAS u32x2*)(lds + SA_PB + offP(srho, skg >> 1) + 8 * (skg & 1)) = wv;
            if (skg == 0) *(LAS float*)(lds + SA_AL + srho * 4) = alpha;
        }
    };
    auto pv = [&](const int buf) {
        const LAS unsigned char* Cb = lds + SA_CKV0 + buf * SA_CKVB;
        const float a0 = *(const LAS float*)(lds + SA_AL + l31 * 4), a1 = *(const LAS float*)(lds + SA_AL + (32 + l31) * 4);
#pragma unroll
        for (int db = 0; db < 2; ++db) { o[db][0] = o[db][0] * a0; o[db][1] = o[db][1] * a1; }
#pragma unroll
        for (int s2 = 0; s2 < 2; ++s2) {
            const bf16x8 pb0 = *(const LAS bf16x8*)(lds + SA_PB + pa2[s2]), pb1 = *(const LAS bf16x8*)(lds + SA_PB + pa2[s2] + 2048);
#pragma unroll
            for (int db = 0; db < 2; ++db) {
                const s16x4 t0 = __builtin_amdgcn_ds_read_tr16_b64_v4i16((LAS s16x4*)(Cb + va4[0][db] + 16384 * s2));
                const s16x4 t1 = __builtin_amdgcn_ds_read_tr16_b64_v4i16((LAS s16x4*)(Cb + va4[1][db] + 16384 * s2));
                bf16x8 vf; vf[0] = t0[0]; vf[1] = t0[1]; vf[2] = t0[2]; vf[3] = t0[3]; vf[4] = t1[0]; vf[5] = t1[1]; vf[6] = t1[2]; vf[7] = t1[3];
                o[db][0] = __builtin_amdgcn_mfma_f32_32x32x16_bf16(vf, pb0, o[db][0], 0, 0, 0);
                o[db][1] = __builtin_amdgcn_mfma_f32_32x32x16_bf16(vf, pb1, o[db][1], 0, 0, 0); } }
    };
    constexpr int NT = (PAST / NSPLIT) / 32;
    issue(0, crA, krA); commit(0, crA, krA); issue(1, crB, krB); issue(2, crA, krA); __syncthreads();
#pragma nounroll
    for (int it = 0; it < NT; it += 2) {
        compute(0, false);
        commit(1, crB, krB); if (it + 3 < NT) issue(it + 3, crB, krB);
        __syncthreads();
        pv(0);
        compute(1, false);
        if (it + 2 < NT) { commit(0, crA, krA); if (it + 4 < NT) issue(it + 4, crA, krA); }
        __syncthreads();
        pv(1);
    }
    if (sp == NSPLIT - 1) {
        __syncthreads();
        { const char* wsb = (const char*)P.KPE - WS_KPE;
#pragma nounroll
          for (int i = tid; i < 32 * 64; i += NTHR) { const int key = i >> 6, ch = i & 63; u32x4 v = (u32x4){0u, 0u, 0u, 0u}; if (key < DS) v = *(const u32x4*)(wsb + ((unsigned)WS_CKVNS + (unsigned)(((b * DS + key) * KVL + 8 * ch) * 2)));
            *(LAS u32x4*)(lds + SA_CKV0 + off1024(key, ch)) = v; }
          if (tid < 32 * 8) { const int key = tid >> 3, ch = tid & 7; u32x4 v = (u32x4){0u, 0u, 0u, 0u}; if (key < DS) v = *(const u32x4*)(wsb + ((unsigned)WS_KPE + (unsigned)(((ROW_S + b * DS + key) * 64 + 8 * ch) * 2)));
            *(LAS u32x4*)(lds + SA_KPE0 + offkpe(key, ch)) = v; } }
        __syncthreads();
        compute(0, true);
        __syncthreads();
        pv(0);
    }
    float* op = P.OPART + ((size_t)(b * NSPLIT + sp) * 64) * KVL;
#pragma unroll
    for (int db = 0; db < 2; ++db)
#pragma unroll
        for (int rbk = 0; rbk < 2; ++rbk)
#pragma unroll
            for (int rq = 0; rq < 4; ++rq) *(f32x4*)(op + (size_t)(32 * rbk + l31) * KVL + 64 * w + 32 * db + 8 * rq + 4 * hh) = (f32x4){o[db][rbk][4 * rq], o[db][rbk][4 * rq + 1], o[db][rbk][4 * rq + 2], o[db][rbk][4 * rq + 3]};
    if (skg == 0) *(f32x2*)(P.ML + ((size_t)(b * NSPLIT + sp) * 64 + srho) * 2) = (f32x2){m, l};
    __syncthreads();
}

struct SCombParams { const float *OPART, *ML, *w_uv; bf16* O; };
__device__ __forceinline__ void scomb_unit(const Frame& F, const SCombParams& P, const int b, const int h) {
    LAS float* OL = (LAS float*)F.lds;
    int tid = F.tid; asm volatile("" : "+v"(tid));
    {
        const int r = tid;
#pragma unroll
        for (int j = 0; j < 8; ++j) { const int rho = h * 8 + j; float mm[NSPLIT], ll[NSPLIT], M = -3e38f;
#pragma unroll
            for (int s = 0; s < NSPLIT; ++s) { const f32x2 v = *(const f32x2*)(P.ML + ((size_t)(b * NSPLIT + s) * 64 + rho) * 2); mm[s] = v.x; ll[s] = v.y; M = fmaxf(M, v.x); }
            float L = 0.f, acc = 0.f;
#pragma unroll
            for (int s = 0; s < NSPLIT; ++s) { const float wgt = fast_exp2(mm[s] - M); L += wgt * ll[s]; acc += wgt * P.OPART[((size_t)(b * NSPLIT + s) * 64 + rho) * KVL + r]; }
            OL[j * 512 + r] = acc / L; }
    }
    __syncthreads();
    {
        const int d = tid & 127, rq = tid >> 7; float acc[8];
#pragma unroll
        for (int j = 0; j < 8; ++j) acc[j] = 0.f;
        const float* wp = P.w_uv + (size_t)(128 * rq) * 1024 + h * 128 + d;
#pragma unroll 16
        for (int r = 0; r < 128; ++r) { const float wv = wp[(size_t)r * 1024];
#pragma unroll
            for (int j = 0; j < 8; ++j) acc[j] += OL[j * 512 + 128 * rq + r] * wv; }
        LAS float* PT = OL + 8 * 512;
#pragma unroll
        for (int j = 0; j < 8; ++j) PT[(rq * 8 + j) * 128 + d] = acc[j];
        __syncthreads();
        const int j = tid >> 6, d2 = (tid & 63) * 2;
        const float o0 = (PT[(0 * 8 + j) * 128 + d2] + PT[(1 * 8 + j) * 128 + d2]) + (PT[(2 * 8 + j) * 128 + d2] + PT[(3 * 8 + j) * 128 + d2]);
        const float o1 = (PT[(0 * 8 + j) * 128 + d2 + 1] + PT[(1 * 8 + j) * 128 + d2 + 1]) + (PT[(2 * 8 + j) * 128 + d2 + 1] + PT[(3 * 8 + j) * 128 + d2 + 1]);
        *(unsigned*)(P.O + (size_t)(ROW_S + b * 8 + j) * D + h * 128 + d2) = cvt_pk_bf16(o0, o1);
    }
    __syncthreads();
}
__device__ __forceinline__ void thin_ckv_conv(const Frame& F, const Args& args) {
    unsigned char* ws = F.ws; float* out = F.out;
    const int gw = F.vcu * NWAVES + F.wave, NGW = F.G * NWAVES, lane = F.lane;
    const bf16* CKVR = (const bf16*)(ws + WS_CKVR); const float* SSQ = (const float*)(ws + WS_SSQKV); const bf16* RX = (const bf16*)(ws + WS_RX);
    const f32x4 g0 = *(const f32x4*)(IN_F(I_KVG) + 8 * lane), g1 = *(const f32x4*)(IN_F(I_KVG) + 8 * lane + 4);
    for (int row = gw; row < ROW_M + NMETA; row += NGW) {
        const f32x4 s0 = *(const f32x4*)(SSQ + (size_t)row * 8), s1 = *(const f32x4*)(SSQ + (size_t)row * 8 + 4);
        const float ss = ((s0[0] + s0[1]) + (s0[2] + s0[3])) + ((s1[0] + s1[1]) + (s1[2] + s1[3]));
        const float rstd = __builtin_amdgcn_rsqf(ss * (1.0f / KVL) + EPS);
        f32x4 v0, v1; pg8::unpack8(*(const u32x4*)(CKVR + (size_t)row * KVL + 8 * lane), v0, v1);
        v0 = v0 * rstd * g0; v1 = v1 * rstd * g1;
        if (row < ROW_S) { float* o = out + O_PCKV + ((size_t)(row >> 11) * TP + NMETA + (row & (SEQ - 1))) * KVL + 8 * lane; *(f32x4*)o = v0; *(f32x4*)(o + 4) = v1; }
        else if (row < ROW_M) { float* o = out + O_SCKV + (size_t)(row - ROW_S) * KVL + 8 * lane; *(f32x4*)o = v0; *(f32x4*)(o + 4) = v1;
            *(u32x4*)((bf16*)(ws + WS_CKVNS) + (size_t)(row - ROW_S) * KVL + 8 * lane) = pg8::pack8(v0, v1); }
        else { for (int b = 0; b < NB; ++b) { float* o = out + O_PCKV + ((size_t)b * TP + (row - ROW_M)) * KVL + 8 * lane; *(f32x4*)o = v0; *(f32x4*)(o + 4) = v1; } }
    }
    for (int i = gw; i < NB * 3 + DB * 3; i += NGW) {
        int srow; float* o;
        if (i < NB * 3) { const int b = i / 3, k = i % 3; srow = b * SEQ + SEQ - 3 + k; o = out + O_PCONV + (size_t)i * D; }
        else { const int q = i - NB * 3, b = q / 3, k = q % 3; srow = ROW_S + b * DS + DS - 3 + k; o = out + O_SCONV + (size_t)q * D; }
#pragma unroll
        for (int j = 0; j < 2; ++j) { f32x4 v0, v1; pg8::unpack8(*(const u32x4*)(RX + (size_t)srow * D + 8 * (lane + 64 * j)), v0, v1); *(f32x4*)(o + 8 * (lane + 64 * j)) = v0; *(f32x4*)(o + 8 * (lane + 64 * j) + 4) = v1; }
    }
}

constexpr int NPHASES = 11;
__global__ void __launch_bounds__(NTHR, 2) hawk_fwd(Args args) {
    extern __shared__ __attribute__((aligned(16))) unsigned char lds_raw[];
    Frame F;
    F.lds = (LAS unsigned char*)lds_raw; F.MISC = (volatile LAS unsigned*)(F.lds + MISC_OFF);
    F.tid = threadIdx.x; F.lane = F.tid & 63; F.wave = __builtin_amdgcn_readfirstlane(F.tid >> 6);
    F.G = gridDim.x; { const int bx = blockIdx.x; F.vcu = (F.G % 8 == 0) ? (bx % 8) * (F.G / 8) + bx / 8 : bx; }
    F.out = args.out; F.ws = args.ws; F.ctl = (unsigned*)(args.ws + WS_CTL);
    unsigned char* ws = args.ws;
    for (int u = F.tid; u < 64; u += NTHR) ((LAS unsigned*)(F.lds + MISC_OFF))[u] = 0u;
    __syncthreads();
#if MK_PER_PHASE
#define GRID_BAR() do { } while (0)
#else
    XcdBarrier bar = xcd_barrier_post((unsigned*)F.ctl + CW_BAR, F.MISC + 8);
#define GRID_BAR() xcd_barrier(bar)
#endif
    const int lo = args.ph_lo, hi = args.ph_hi;
#ifndef PH_MASK
#define PH_MASK 0x7ff
#endif
#define IN(k) ((((PH_MASK) >> (k)) & 1) && lo <= (k) && (k) < hi)
#ifndef DUP_MASK
#define DUP_MASK 0
#endif
#ifndef P3DUP
#define P3DUP 0
#endif
#define REP(k) _Pragma("nounroll") for (int rep_ = 0; rep_ < 1 + (((DUP_MASK) >> (k)) & 1); ++rep_)
#define SEAM(k) do { if (IN(k) && IN((k) + 1)) GRID_BAR(); F.tid = threadIdx.x; F.lane = F.tid & 63; } while (0)
    const int G = F.G, bx = blockIdx.x;

    if (IN(0)) REP(0) { p0_prologue(F, args); }
    SEAM(0);
    if (IN(1)) REP(1) {
        pg8::TileSched S; S.init(ws + WS_H, ws + WS_WIN, D, 66, 22, G, bx);
        pg8::EpiWin E{(bf16*)(ws + WS_RX), (bf16*)(ws + WS_GRG), (bf16*)(ws + WS_CQ), (bf16*)(ws + WS_CKVR), (bf16*)(ws + WS_G), (bf16*)(ws + WS_KPE), (float*)(ws + WS_SSQQ), (float*)(ws + WS_SSQKV),
                      IN_F(I_BGATE), (const float*)(ws + WS_ROPEC), (const float*)(ws + WS_ROPES), F.out};
        pg8::gemm_phase<pg8::EpiWin, pg8::TileSched, true, true>(F.lds, D, S, E);
    }
    SEAM(1);
    const RgParams RGP{(const bf16*)(ws + WS_RX), (const bf16*)(ws + WS_GRG), (const bf16*)(ws + WS_WAX), (bf16*)(ws + WS_HRG), IN_F(I_CONVW), IN_F(I_CONVB), IN_F(I_BA), IN_F(I_BX),
                       (const float*)(ws + WS_SPL), IN_F(I_SCONV), IN_F(I_SRG), (float*)(ws + WS_SEG), F.out};
    if (IN(2)) REP(2) {
        for (int u = F.vcu; u < 192; u += G) rg_unit<0>(F, RGP, u / 24, (u / 3) % 8, u % 3);
        { pg8::TileSched S; S.init(ws + WS_CQ, ws + WS_WQ, QL, 64, 6, G, bx);
          pg8::EpiQ E{(bf16*)(ws + WS_QA), (const float*)(ws + WS_SSQQ), (const float*)(ws + WS_ROPEC), (const float*)(ws + WS_ROPES)};
          pg8::gemm_phase<pg8::EpiQ, pg8::TileSched, true, true>(F.lds, QL, S, E); }
        { pg8::TileSched S; S.init(ws + WS_CKVR, ws + WS_WKV, KVL, 64, 8, G, bx ^ 0xF8);
          pg8::EpiKV E{(bf16*)(ws + WS_KN), (bf16*)(ws + WS_V), (const float*)(ws + WS_SSQKV)};
          pg8::gemm_phase<pg8::EpiKV, pg8::TileSched, true, true>(F.lds, KVL, S, E); }
        {
            int lane_ = F.lane; asm volatile("" : "+v"(lane_));
            int trow, tcol; skinny_coord(F.tid, trow, tcol);
            const bf16* CQs = (const bf16*)(ws + WS_CQ); const bf16* WQs = (const bf16*)(ws + WS_WQ); bf16* QAs = (bf16*)(ws + WS_QA); const float* SQ = (const float*)(ws + WS_SSQQ);
            for (int u = F.vcu; u < 8 * 40 + 64; u += G) {
                if (u < 8 * 40) {
                    const int rt = u / 40, ci = u % 40, r0 = ROW_S + 32 * rt, row = r0 + trow;
                    float ss = 0.f;
#pragma unroll
                    for (int i = 0; i < 12; ++i) ss += SQ[(size_t)row * 12 + i];
                    const float rstd = __builtin_amdgcn_rsqf(ss * (1.0f / QL) + EPS);
                    if (ci < 32) { float v0, v1; skinny_partial<768>(F, CQs, QL, WQs, QL, r0, 32 * ci, lane_, v0, v1);
                        const int col = 32 * ci + tcol, h = col >> 7, d = col & 127;
                        *(unsigned*)(QAs + (size_t)row * 1536 + h * 192 + d) = cvt_pk_bf16(v0 * rstd, v1 * rstd); }
                    else { const int h = ci - 32, c1 = 1024 + 256 * (h >> 2) + 32 * (h & 3); float a0, a1, b0, b1;
                        skinny_partial<768>(F, CQs, QL, WQs, QL, r0, c1, lane_, a0, a1); skinny_partial<768>(F, CQs, QL, WQs, QL, r0, c1 + 128, lane_, b0, b1);
                        const int pi = rope_idx_of_row(row); const float* rc = (const float*)(ws + WS_ROPEC) + pi * 32 + tcol; const float* rs = (const float*)(ws + WS_ROPES) + pi * 32 + tcol;
                        a0 *= rstd; a1 *= rstd; b0 *= rstd; b1 *= rstd;
                        *(unsigned*)(QAs + (size_t)row * 1536 + h * 192 + 128 + tcol) = cvt_pk_bf16(a0 * rc[0] - b0 * rs[0], a1 * rc[1] - b1 * rs[1]);
                        *(unsigned*)(QAs + (size_t)row * 1536 + h * 192 + 160 + tcol) = cvt_pk_bf16(a0 * rs[0] + b0 * rc[0], a1 * rs[1] + b1 * rc[1]); }
                } else {
                    const int ci = u - 8 * 40, row = ROW_M + trow; float v0, v1;
                    skinny_partial<512>(F, (const bf16*)(ws + WS_CKVR), KVL, (const bf16*)(ws + WS_WKV), KVL, ROW_M, 32 * ci, lane_, v0, v1);
                    const float* SK = (const float*)(ws + WS_SSQKV) + (size_t)row * 8; const float ss = ((SK[0] + SK[1]) + (SK[2] + SK[3])) + ((SK[4] + SK[5]) + (SK[6] + SK[7]));
                    const float rstd = __builtin_amdgcn_rsqf(ss * (1.0f / KVL) + EPS); const int col = 32 * ci + tcol;
                    bf16* dst = col < 1024 ? (bf16*)(ws + WS_KN) + (size_t)row * D + col : (bf16*)(ws + WS_V) + (size_t)row * D + (col - 1024);
                    *(unsigned*)dst = cvt_pk_bf16(v0 * rstd, v1 * rstd); }
            }
            __syncthreads();
        }
        thin_ckv_conv(F, args);
    }
    SEAM(2);
    if (IN(3)) {
        const PAttnParams PA{(const bf16*)(ws + WS_QA), (const bf16*)(ws + WS_KN), (const bf16*)(ws + WS_KPE), (const bf16*)(ws + WS_V), (bf16*)(ws + WS_O)};
        const SAttnParams SA{IN_F(I_CCKV), IN_F(I_CKPE), (const int*)args.in[I_PT], (const bf16*)(ws + WS_QA), (const bf16*)(ws + WS_WUKS), (const bf16*)(ws + WS_CKVNS), (const bf16*)(ws + WS_KPE),
                             (float*)(ws + WS_OPART), (float*)(ws + WS_ML)};
#ifndef SFIRST_ALL
        const bool sfirst = (F.vcu & 1) == 0;
#else
        const bool sfirst = true;
#endif
#ifndef P3_MASK
#define P3_MASK 7
#endif
#pragma nounroll
        for (int ph = 0; ph < 2; ++ph) {
            if ((ph == 0) == sfirst) { if (P3_MASK & 1) for (int r3 = 0; r3 < 1 + (P3DUP & 1); ++r3) for (int u = F.vcu; u < DB * NSPLIT; u += G) sattn_unit(F, SA, u / NSPLIT, u % NSPLIT); }
            else { if (P3_MASK & 2) for (int r3 = 0; r3 < 1 + ((P3DUP >> 1) & 1); ++r3) for (int u = F.vcu; u < 256; u += G) { const int bh = u >> 2; pattn_unit(F, PA, bh >> 3, bh & 7, u & 3); } }
        }
        if (P3_MASK & 4) for (int r3 = 0; r3 < 1 + ((P3DUP >> 2) & 1); ++r3) for (int u = F.vcu; u < 256; u += G) rg_unit<1>(F, RGP, u >> 5, (u >> 2) & 7, u & 3);
        if (P3_MASK & 4) for (int u = F.vcu; u < 32; u += G) rg_unit<2>(F, RGP, u >> 3, u & 7, 0);
    }
    SEAM(3);
    if (IN(4)) REP(4) {
        const SCombParams SC{(const float*)(ws + WS_OPART), (const float*)(ws + WS_ML), IN_F(I_WUV), (bf16*)(ws + WS_O)};
        for (int u = F.vcu; u < DB * NH; u += G) scomb_unit(F, SC, u >> 3, u & 7);
    }
    SEAM(4);
    if (IN(5)) REP(5) {
        { pg8::TileSched S; S.init(ws + WS_HRG, ws + WS_WBRR, D, 64, 4, G, bx); pg8::EpiZ<0> E{(bf16*)(ws + WS_MIX), (const bf16*)(ws + WS_G)};
          pg8::gemm_phase<pg8::EpiZ<0>, pg8::TileSched, true, true>(F.lds, D, S, E); }
        { pg8::TileSched S; S.init(ws + WS_O, ws + WS_WBRM, D, 64, 4, G, bx); pg8::EpiZ<1> E{(bf16*)(ws + WS_MIX), (const bf16*)(ws + WS_G)};
          pg8::gemm_phase<pg8::EpiZ<1>, pg8::TileSched, true, true>(F.lds, D, S, E); }
        {
            int lane_ = F.lane; asm volatile("" : "+v"(lane_));
            int trow, tcol; skinny_coord(F.tid, trow, tcol);
            for (int u = F.vcu; u < 8 * 32; u += G) { const int r0 = ROW_S + 32 * (u >> 5), c0 = 32 * (u & 31), row = r0 + trow, col = c0 + tcol; float a0, a1, b0, b1;
                skinny_partial<1024>(F, (const bf16*)(ws + WS_HRG), D, (const bf16*)(ws + WS_WBRR), D, r0, c0, lane_, a0, a1);
                skinny_partial<1024>(F, (const bf16*)(ws + WS_O), D, (const bf16*)(ws + WS_WBRM), D, r0, c0, lane_, b0, b1);
                const unsigned gr = *(const unsigned*)((const bf16*)(ws + WS_G) + (size_t)row * 2048 + col), gm = *(const unsigned*)((const bf16*)(ws + WS_G) + (size_t)row * 2048 + D + col);
                *(unsigned*)((bf16*)(ws + WS_MIX) + (size_t)row * D + col) = cvt_pk_bf16(bflo(gr) * a0 + bflo(gm) * b0, bfhi(gr) * a1 + bfhi(gm) * b1); }
            __syncthreads();
        }
    }
    SEAM(5);
    if (IN(6)) REP(6) {
        pg8::TileSched S; S.init(ws + WS_MIX, ws + WS_WO, D, 64, 4, G, bx); pg8::EpiRes E{(float*)(ws + WS_PRE), (const bf16*)(ws + WS_H), nullptr};
        pg8::gemm_phase<pg8::EpiRes, pg8::TileSched, true, true>(F.lds, D, S, E);
        {   int lane_ = F.lane; asm volatile("" : "+v"(lane_));
            int trow, tcol; skinny_coord(F.tid, trow, tcol);
            for (int u = F.vcu; u < 8 * 32; u += G) { const int r0 = ROW_S + 32 * (u >> 5), c0 = 32 * (u & 31), row = r0 + trow, col = c0 + tcol; float a0, a1;
                skinny_partial<1024>(F, (const bf16*)(ws + WS_MIX), D, (const bf16*)(ws + WS_WO), D, r0, c0, lane_, a0, a1);
                const unsigned hv = *(const unsigned*)((const bf16*)(ws + WS_H) + (size_t)row * D + col);
                *(f32x2*)((float*)(ws + WS_PRE) + (size_t)row * D + col) = (f32x2){DN_ALPHA * bflo(hv) + a0, DN_ALPHA * bfhi(hv) + a1}; }
            __syncthreads();
        }
    }
    SEAM(6);
    if (IN(7)) REP(7) {
        const int gw = F.vcu * NWAVES + F.wave, NGW = G * NWAVES;
        for (int row = gw; row < ROW_M; row += NGW) ln_row((const float*)(ws + WS_PRE) + (size_t)row * D, IN_F(I_LN1G), IN_F(I_LN1B), (bf16*)(ws + WS_X1) + (size_t)row * D, nullptr, F.lane);
    }
    SEAM(7);
    if (IN(8)) REP(8) {
        pg8::TileSched S; S.init(ws + WS_X1, ws + WS_WUP, D, 64, 16, G, bx); pg8::EpiUp E{(bf16*)(ws + WS_U), IN_F(I_BUP)};
        pg8::gemm_phase<pg8::EpiUp, pg8::TileSched, true, true>(F.lds, D, S, E);
        {   int lane_ = F.lane; asm volatile("" : "+v"(lane_));
            int trow, tcol; skinny_coord(F.tid, trow, tcol);
            for (int u = F.vcu; u < 8 * 128; u += G) { const int r0 = ROW_S + 32 * (u >> 7), c0 = 32 * (u & 127), row = r0 + trow, col = c0 + tcol; float a0, a1;
                skinny_partial<1024>(F, (const bf16*)(ws + WS_X1), D, (const bf16*)(ws + WS_WUP), D, r0, c0, lane_, a0, a1);
                a0 = fmaxf(a0 + IN_F(I_BUP)[col], 0.f); a1 = fmaxf(a1 + IN_F(I_BUP)[col + 1], 0.f);
                *(unsigned*)((bf16*)(ws + WS_U) + (size_t)row * DFF + col) = cvt_pk_bf16(a0 * a0, a1 * a1); }
            __syncthreads();
        }
    }
    SEAM(8);
    if (IN(9)) REP(9) {
        pg8::TileSched S; S.init(ws + WS_U, ws + WS_WDN, DFF, 64, 4, G, bx); pg8::EpiRes E{(float*)(ws + WS_PRE), (const bf16*)(ws + WS_X1), IN_F(I_BDN)};
        pg8::gemm_phase<pg8::EpiRes, pg8::TileSched, true, true>(F.lds, DFF, S, E);
        {   int lane_ = F.lane; asm volatile("" : "+v"(lane_));
            int trow, tcol; skinny_coord(F.tid, trow, tcol);
            for (int u = F.vcu; u < 8 * 32; u += G) { const int r0 = ROW_S + 32 * (u >> 5), c0 = 32 * (u & 31), row = r0 + trow, col = c0 + tcol; float a0, a1;
                skinny_partial<4096>(F, (const bf16*)(ws + WS_U), DFF, (const bf16*)(ws + WS_WDN), DFF, r0, c0, lane_, a0, a1);
                const unsigned xv = *(const unsigned*)((const bf16*)(ws + WS_X1) + (size_t)row * D + col);
                *(f32x2*)((float*)(ws + WS_PRE) + (size_t)row * D + col) = (f32x2){DN_ALPHA * bflo(xv) + a0 + IN_F(I_BDN)[col], DN_ALPHA * bfhi(xv) + a1 + IN_F(I_BDN)[col + 1]}; }
            __syncthreads();
        }
    }
    SEAM(9);
    if (IN(10)) REP(10) {
        const int gw = F.vcu * NWAVES + F.wave, NGW = G * NWAVES;
        for (int row = gw; row < ROW_M; row += NGW) { float* o = row < ROW_S ? F.out + O_YP + (size_t)row * D : F.out + O_YS + (size_t)(row - ROW_S) * D;
            ln_row((const float*)(ws + WS_PRE) + (size_t)row * D, IN_F(I_LN2G), IN_F(I_LN2B), nullptr, o, F.lane); }
    }
#ifdef DBG_DUMP_OFF
    if (lo == 99) {
#ifdef DBG_DUMP_F32
        const float* srcf = (const float*)(ws + (size_t)(DBG_DUMP_OFF));
        for (size_t i = (size_t)F.vcu * NTHR + F.tid; i < (size_t)(DBG_DUMP_F32) / 4; i += (size_t)G * NTHR) *(f32x4*)(F.out + i * 4) = *(const f32x4*)(srcf + i * 4);
#else
#ifndef DBG_DUMP_N
#define DBG_DUMP_N ((size_t)ROW_M * D)
#endif
        const bf16* src = (const bf16*)(ws + (size_t)(DBG_DUMP_OFF));
        for (size_t i = (size_t)F.vcu * NTHR + F.tid; i < (size_t)(DBG_DUMP_N) / 8; i += (size_t)G * NTHR) { f32x4 v0, v1; pg8::unpack8(*(const u32x4*)(src + i * 8), v0, v1); *(f32x4*)(F.out + i * 8) = v0; *(f32x4*)(F.out + i * 8 + 4) = v1; }
#endif
    }
#endif
#undef IN
#undef SEAM
}

extern "C" void kernel_launch(void* const* d_in, const int* in_sizes, int n_in, void* d_out, int out_size, void* d_ws, size_t ws_size, hipStream_t stream) {
    static int grid = 0;
    if (grid == 0) {
        if (n_in != 35 || out_size != (int)O_END || ws_size < WS_END) { fprintf(stderr, "kernel_launch: unexpected shapes (n_in %d, out %d, ws %zu, need %zu)\n", n_in, out_size, ws_size, (size_t)WS_END); grid = -1; return; }
        int dev = 0, cus = 0, per_cu = 0;
        if (hipGetDevice(&dev) != hipSuccess || hipDeviceGetAttribute(&cus, hipDeviceAttributeMultiprocessorCount, dev) != hipSuccess) { grid = -1; return; }
        if (hipFuncSetAttribute((const void*)hawk_fwd, hipFuncAttributeMaxDynamicSharedMemorySize, LDS_BYTES) != hipSuccess) { fprintf(stderr, "kernel_launch: hipFuncSetAttribute failed\n"); grid = -1; return; }
        if (hipOccupancyMaxActiveBlocksPerMultiprocessor(&per_cu, (const void*)hawk_fwd, NTHR, LDS_BYTES) != hipSuccess || per_cu < 1) fprintf(stderr, "kernel_launch: occupancy query reports %d\n", per_cu);
        (void)hipGetLastError();
        grid = cus;
    }
    if (grid < 0) return;
    if (hipMemsetAsync((char*)d_ws + WS_CTL, 0, CTL_BYTES, stream) != hipSuccess) return;
    Args a{};
    for (int i = 0; i < 35; ++i) a.in[i] = d_in[i];
    a.out = (float*)d_out; a.ws = (unsigned char*)d_ws;
#if MK_PER_PHASE
#ifndef DBG_LAST_PHASE
#define DBG_LAST_PHASE (NPHASES - 1)
#endif
    if (DBG_LAST_PHASE < NPHASES - 1) (void)hipMemsetAsync(d_out, 0, (size_t)out_size * 4, stream);
    for (int p = 0; p <= DBG_LAST_PHASE; ++p) { a.ph_lo = p; a.ph_hi = p + 1; hipLaunchKernelGGL(hawk_fwd, dim3(grid), dim3(NTHR), LDS_BYTES, stream, a); }
#ifdef DBG_DUMP_OFF
    a.ph_lo = 99; a.ph_hi = 100; hipLaunchKernelGGL(hawk_fwd, dim3(grid), dim3(NTHR), LDS_BYTES, stream, a);
#endif
#else
    a.ph_lo = 0; a.ph_hi = NPHASES;
    hipLaunchKernelGGL(hawk_fwd, dim3(grid), dim3(NTHR), LDS_BYTES, stream, a);
#endif
}
```

```cpp
#include <hip/hip_runtime.h>
#include <cstdio>
#include <cstdint>

#ifndef MK_PER_PHASE
#define MK_PER_PHASE 0
#endif

#define GAS __attribute__((address_space(1)))
#define LAS __attribute__((address_space(3)))
typedef unsigned short bf16;
typedef short bf16x8 __attribute__((ext_vector_type(8)));
typedef short s16x4 __attribute__((ext_vector_type(4)));
typedef float f32x2 __attribute__((ext_vector_type(2)));
typedef float f32x4 __attribute__((ext_vector_type(4)));
typedef float f32x16 __attribute__((ext_vector_type(16)));
typedef unsigned u32x2 __attribute__((ext_vector_type(2)));
typedef unsigned u32x4 __attribute__((ext_vector_type(4)));

constexpr int D = 1024, NB = 8, SEQ = 2048, NMETA = 16, TP = SEQ + NMETA;
constexpr int DB = 32, DS = 8, PAST = 16384, PAGE = 128, NPAGES = PAST / PAGE;
constexpr int NH = 8, QKN = 128, QKR = 64, VH = 128, KVL = 512, QL = 768, DFF = 4096;
constexpr int NIN = 5440, NINP = 5632;
constexpr int ROW_S = NB * SEQ;
constexpr int ROW_M = ROW_S + DB * DS;
constexpr int R = 16896;
constexpr float EPS = 1e-5f;
constexpr float DN_ALPHA = 1.189207115002721f;
constexpr float SM_SCALE = 0.07216878364870322f;
constexpr float LOG2E = 1.4426950408889634f;
constexpr int NROPE = TP + DS;
constexpr int NSPLIT = 8;

constexpr size_t O_YP = 0, O_YS = O_YP + (size_t)NB * SEQ * D, O_PCKV = O_YS + (size_t)DB * DS * D, O_PKPE = O_PCKV + (size_t)NB * TP * KVL,
    O_PCONV = O_PKPE + (size_t)NB * TP * QKR, O_PH = O_PCONV + (size_t)NB * 3 * D, O_SCKV = O_PH + (size_t)NB * D, O_SKPE = O_SCKV + (size_t)DB * DS * KVL,
    O_SCONV = O_SKPE + (size_t)DB * DS * QKR, O_SH = O_SCONV + (size_t)DB * 3 * D, O_END = O_SH + (size_t)DB * D;
static_assert(O_END == 26861568, "output size");

constexpr size_t al256(size_t x) { return (x + 255) & ~(size_t)255; }
constexpr size_t WS_CTL = 0, CTL_BYTES = 1u << 20;
constexpr size_t WS_WIN = CTL_BYTES;
constexpr size_t WS_WQ = WS_WIN + al256((size_t)NINP * D * 2);
constexpr size_t WS_WKV = WS_WQ + al256((size_t)1536 * QL * 2);
constexpr size_t WS_WBRR = WS_WKV + al256((size_t)2048 * KVL * 2);
constexpr size_t WS_WBRM = WS_WBRR + al256((size_t)D * D * 2);
constexpr size_t WS_WO = WS_WBRM + al256((size_t)D * D * 2);
constexpr size_t WS_WUP = WS_WO + al256((size_t)D * D * 2);
constexpr size_t WS_WDN = WS_WUP + al256((size_t)DFF * D * 2);
constexpr size_t WS_WAX = WS_WDN + al256((size_t)DFF * D * 2);
constexpr size_t WS_WUKS = WS_WAX + al256((size_t)8 * 256 * 128 * 2);
constexpr size_t WS_ROPEC = WS_WUKS + al256((size_t)8 * 512 * 128 * 2);
constexpr size_t WS_ROPES = WS_ROPEC + al256((size_t)NROPE * 32 * 4);
constexpr size_t WS_SPL = WS_ROPES + al256((size_t)NROPE * 32 * 4);
constexpr size_t WS_H = WS_SPL + al256(4096);
constexpr size_t WS_RX = WS_H + al256((size_t)R * D * 2);
constexpr size_t WS_GRG = WS_RX + al256((size_t)R * D * 2);
constexpr size_t WS_CQ = WS_GRG + al256((size_t)R * D * 2);
constexpr size_t WS_CKVR = WS_CQ + al256((size_t)R * QL * 2);
constexpr size_t WS_G = WS_CKVR + al256((size_t)R * KVL * 2);
constexpr size_t WS_KPE = WS_G + al256((size_t)R * 2048 * 2);
constexpr size_t WS_SSQQ = WS_KPE + al256((size_t)R * 64 * 2);
constexpr size_t WS_SSQKV = WS_SSQQ + al256((size_t)R * 12 * 4);
constexpr size_t WS_QA = WS_SSQKV + al256((size_t)R * 8 * 4);
constexpr size_t WS_KN = WS_QA + al256((size_t)R * 1536 * 2);
constexpr size_t WS_V = WS_KN + al256((size_t)R * D * 2);
constexpr size_t WS_CKVNS = WS_V + al256((size_t)R * D * 2);
constexpr size_t WS_SEG = WS_CKVNS + al256((size_t)256 * KVL * 2);
constexpr size_t WS_HRG = WS_SEG + al256((size_t)8 * 3 * 1024 * 2 * 4);
constexpr size_t WS_O = WS_HRG + al256((size_t)R * D * 2);
constexpr size_t WS_OPART = WS_O + al256((size_t)R * D * 2);
constexpr size_t WS_ML = WS_OPART + al256((size_t)DB * NSPLIT * 64 * 512 * 4);
constexpr size_t WS_MIX = WS_ML + al256((size_t)DB * NSPLIT * 64 * 2 * 4);
constexpr size_t WS_PRE = WS_MIX + al256((size_t)R * D * 2);
constexpr size_t WS_X1 = WS_PRE + al256((size_t)R * D * 4);
constexpr size_t WS_U = WS_X1 + al256((size_t)R * D * 2);
constexpr size_t WS_END = WS_U + al256((size_t)R * DFF * 2);
static_assert(WS_END < (1ull << 32), "32-bit workspace offsets");

constexpr int CW_BAR = 4096;

constexpr int LDS_BYTES = 147456;
constexpr int MISC_OFF = 135168;
constexpr int NWAVES = 8, NTHR = 512;

__device__ __forceinline__ float bf2f(unsigned short b) { return __uint_as_float(((unsigned)b) << 16); }
__device__ __forceinline__ float bflo(unsigned w) { return __uint_as_float(w << 16); }
__device__ __forceinline__ float bfhi(unsigned w) { return __uint_as_float(w & 0xffff0000u); }
typedef __bf16 bf16x2_t __attribute__((ext_vector_type(2)));
__device__ __forceinline__ unsigned cvt_pk_bf16(float lo, float hi) { const f32x2 v = {lo, hi}; return __builtin_bit_cast(unsigned, __builtin_convertvector(v, bf16x2_t)); }
__device__ __forceinline__ float fast_exp2(float x) { return __builtin_amdgcn_exp2f(x); }
__device__ __forceinline__ float fast_rcp(float x) { return __builtin_amdgcn_rcpf(x); }
__device__ __forceinline__ float sigmoidf_(float x) { return fast_rcp(1.0f + fast_exp2(-x * LOG2E)); }
__device__ __forceinline__ float gelu_tanh(float x) { const float y = 0.7978845608028654f * (x + 0.044715f * x * x * x); return x * fast_rcp(1.0f + fast_exp2(-2.0f * LOG2E * y)); }
__device__ __forceinline__ float wave_sum(float v) {
#pragma unroll
    for (int o = 1; o < 64; o <<= 1) v += __shfl_xor(v, o);
    return v;
}
#define LDS_WAIT() asm volatile("s_waitcnt lgkmcnt(0)" ::: "memory")
#define VM_WAIT() asm volatile("s_waitcnt vmcnt(0)" ::: "memory")
namespace pg8 {
#define PG8_LAS __attribute__((address_space(3)))
constexpr int BM = 256, BK = 64, HALF = 128, HTB = HALF * BK * 2  , STAGE_BYTES = 8 * HTB, NXCD = 8, WGM = 8;
__host__ __device__ __forceinline__ int lds_byte(int r, int c) { const int st = (r >> 4) * 2 + (c >> 5), rr = r & 15, cc = c & 31, ob = rr * 64 + cc * 2; return st * 1024 + (ob ^ (((ob >> 9) & 1) << 5)); }
__host__ __device__ __forceinline__ void stage_rc(int b, int& R, int& C) { const int st = b / 1024, sb = b % 1024, swz = sb ^ (((sb >> 9) & 1) << 5); R = (st >> 1) * 16 + swz / 64; C = (st & 1) * 32 + (swz % 64) / 2; }
__host__ __device__ __forceinline__ int perm32(int rho) { const int n = rho >> 4, i = rho & 15; return 8 * (i >> 2) + 4 * n + (i & 3); }

struct Unit { const char* A; const char* B; int pm, pn; };

struct TileSched {
    const char* A; const char* B; size_t aT, bT; int nM, nN, nwg, G, c, rm_from, rm_add;
    __device__ __forceinline__ void init(const void* A_, const void* B_, int K, int nM_, int nN_, int G_, int c_, int rm_from_ = 1 << 30, int rm_add_ = 0) {
        A = (const char*)A_; B = (const char*)B_; aT = (size_t)BM * K * 2; bT = aT; nM = nM_; nN = nN_; nwg = nM * nN; G = G_; c = c_; rm_from = rm_from_; rm_add = rm_add_; }
    __device__ __forceinline__ bool next(int i, Unit& u) const { const long L = (long)i * G + c; if (L >= nwg) return false; return at((int)L, u); }
    __device__ __forceinline__ bool at(int L, Unit& u) const {
        int wgid = L; { const int q = nwg / NXCD, r = nwg % NXCD, xcd = wgid % NXCD, off = wgid / NXCD; wgid = (xcd < r ? xcd * (q + 1) : r * (q + 1) + (xcd - r) * q) + off; }
        const int nig = WGM * nN, gid = wgid / nig, fm = gid * WGM, gsz = (nM - fm) < WGM ? (nM - fm) : WGM;
        int pm = fm + ((wgid % nig) % gsz); const int pn = (wgid % nig) / gsz; if (pm >= rm_from) pm += rm_add;
        u.pm = pm; u.pn = pn; u.A = A + (size_t)pm * aT; u.B = B + (size_t)pn * bT; return true;
    }
    __device__ __forceinline__ void a_ready(const Unit&) const {}
    __device__ __forceinline__ void done(const Unit&) const {}
};
struct KvSched : TileSched {
    __device__ __forceinline__ bool next(int i, Unit& u) const {
        int L;
        if (c < 64) { if (i > 0) return false; L = c; }
        else if (c < 128) { if (i > 2) return false; L = i == 0 ? c : (i == 1 ? 256 + c : 256 + (c - 64)); }
        else { if (i > 1) return false; L = i == 0 ? c : 256 + c; }
        return at(L, u);
    }
};
template <class Epi, class Sched, bool ALIGN_EPI = false, bool SP2 = false>
__device__ __forceinline__ void gemm_phase(PG8_LAS unsigned char* lds, const int K, const Sched& S, const Epi& E) {
    const int tid = threadIdx.x, wid = __builtin_amdgcn_readfirstlane(tid >> 6), lane = tid & 63, wr = wid >> 2, wc = wid & 3, fr = lane & 15, fq = lane >> 4;
    const int nt = K / BK;
    unsigned voffA[2], voffB[2];
#pragma unroll
    for (int i = 0; i < 2; ++i) { int R, C; stage_rc(tid * 16 + i * 8192, R, C); const int Rb = Epi::PERM ? ((R & ~31) + perm32(R & 31)) : R;
        voffA[i] = (unsigned)(R * K + C) * 2u; voffB[i] = (unsigned)(Rb * K + C) * 2u; }
    const size_t kstep = (size_t)(BK * 2);
    const size_t hstep = (size_t)HALF * K * 2;
    const unsigned ldsw = (unsigned)wid * 1024u;
    const int aoff = lds_byte(wr * 64 + fr, fq * 8), boff = lds_byte(wc * 32 + fr, fq * 8);
#define PG8_SA(b, h) (((b) * 2 + (h)) * HTB)
#define PG8_SB(b, h) ((4 + (b) * 2 + (h)) * HTB)
#define PG8_STAGE(bufoff, gbase, voff) do { _Pragma("unroll") for (int _i = 0; _i < 2; ++_i) \
        __builtin_amdgcn_global_load_lds((const unsigned*)((const char*)(gbase) + (voff)[_i]), (PG8_LAS unsigned*)(lds + (bufoff) + ldsw + _i * 8192), 16, 0, 0); } while (0)
#define PG8_LDA(dst, b, h) do { _Pragma("unroll") for (int m = 0; m < 4; ++m) _Pragma("unroll") for (int k = 0; k < 2; ++k) dst[m][k] = *(const PG8_LAS bf16x8*)(lds + PG8_SA(b, h) + aoff + m * 2048 + k * 1024); } while (0)
#define PG8_LDB(dst, b, h) do { _Pragma("unroll") for (int n = 0; n < 2; ++n) _Pragma("unroll") for (int k = 0; k < 2; ++k) dst[n][k] = *(const PG8_LAS bf16x8*)(lds + PG8_SB(b, h) + boff + n * 2048 + k * 1024); } while (0)
#define PG8_MMA(ai, bj, At, Bt) do { __builtin_amdgcn_s_setprio(1); _Pragma("unroll") for (int m = 0; m < 4; ++m) _Pragma("unroll") for (int n = 0; n < 2; ++n) _Pragma("unroll") for (int k = 0; k < 2; ++k) \
        acc[ai][bj][m][n] = __builtin_amdgcn_mfma_f32_16x16x32_bf16(Bt[n][k], At[m][k], acc[ai][bj][m][n], 0, 0, 0); __builtin_amdgcn_s_setprio(0); } while (0)
#define PG8_WAIT_V(n) asm volatile("s_waitcnt vmcnt(" #n ")" ::: "memory")
#define PG8_WAIT_L(n) asm volatile("s_waitcnt lgkmcnt(" #n ")" ::: "memory")
#define PG8_BAR __builtin_amdgcn_s_barrier()
#define PG8_SCHED __builtin_amdgcn_sched_barrier(0)
    Unit cur, nxt; int ui = 0;
    if (!S.next(0, cur)) return;
    f32x4 acc[2][2][4][2];
#pragma unroll
    for (int a = 0; a < 2; ++a)
#pragma unroll
        for (int b = 0; b < 2; ++b)
#pragma unroll
            for (int m = 0; m < 4; ++m)
#pragma unroll
                for (int n = 0; n < 2; ++n) acc[a][b][m][n] = (f32x4){0.f, 0.f, 0.f, 0.f};
    bf16x8 At[4][2], B0[2][2], B1[2][2];
    const char* cA = cur.A; const char* cB = cur.B;
    S.a_ready(cur);
    if constexpr (SP2) {
        PG8_STAGE(PG8_SB(0, 0), cB, voffB); PG8_STAGE(PG8_SB(0, 1), cB + hstep, voffB); PG8_STAGE(PG8_SA(0, 0), cA, voffA); PG8_STAGE(PG8_SA(0, 1), cA + hstep, voffA);
        if (wr == 1) PG8_BAR;
        PG8_WAIT_V(2); PG8_BAR;
        PG8_STAGE(PG8_SB(1, 0), cB + kstep, voffB); PG8_STAGE(PG8_SA(1, 0), cA + kstep, voffA); PG8_STAGE(PG8_SB(1, 1), cB + hstep + kstep, voffB);
        PG8_WAIT_V(6); PG8_BAR;
    } else {
        PG8_STAGE(PG8_SB(0, 0), cB, voffB); PG8_STAGE(PG8_SA(0, 0), cA, voffA); PG8_STAGE(PG8_SB(0, 1), cB + hstep, voffB); PG8_STAGE(PG8_SA(0, 1), cA + hstep, voffA);
        if (wr == 1) PG8_BAR;
        PG8_WAIT_V(4); PG8_BAR;
        PG8_STAGE(PG8_SB(1, 0), cB + kstep, voffB); PG8_STAGE(PG8_SA(1, 0), cA + kstep, voffA); PG8_STAGE(PG8_SB(1, 1), cB + hstep + kstep, voffB);
        PG8_WAIT_V(6); PG8_BAR;
    }
    for (;;) {
        const bool has_next = S.next(ui + 1, nxt);
        const char* nA = has_next ? nxt.A : cA; const char* nB = has_next ? nxt.B : cB;
        for (int t = 0; t < nt; t += 2) {
            const bool last = (t == nt - 2);
            const char* a1 = cA + (size_t)(t + 1) * kstep;
            const char* a2 = last ? nA : cA + (size_t)(t + 2) * kstep; const char* b2 = last ? nB : cB + (size_t)(t + 2) * kstep;
            const char* a3 = a2 + kstep; const char* b3 = b2 + kstep;
            if (last && has_next) S.a_ready(nxt);
            if constexpr (SP2) {
            PG8_LDB(B0, 0, 0); PG8_LDB(B1, 0, 1); PG8_SCHED; PG8_LDA(At, 0, 0); PG8_STAGE(PG8_SA(1, 1), a1 + hstep, voffA);
            PG8_WAIT_V(8); PG8_WAIT_L(0); PG8_BAR; PG8_MMA(0, 0, At, B0); PG8_MMA(0, 1, At, B1); PG8_BAR; PG8_SCHED;
            PG8_LDA(At, 0, 1); PG8_STAGE(PG8_SB(0, 0), b2, voffB); PG8_STAGE(PG8_SB(0, 1), b2 + hstep, voffB); PG8_STAGE(PG8_SA(0, 0), a2, voffA);
            PG8_WAIT_V(8); PG8_WAIT_L(0); PG8_BAR; PG8_MMA(1, 0, At, B0); PG8_MMA(1, 1, At, B1); PG8_BAR; PG8_SCHED;
            PG8_LDB(B0, 1, 0); PG8_LDB(B1, 1, 1); PG8_SCHED; PG8_LDA(At, 1, 0); PG8_STAGE(PG8_SA(0, 1), a2 + hstep, voffA);
            PG8_WAIT_V(8); PG8_WAIT_L(0); PG8_BAR; PG8_MMA(0, 0, At, B0); PG8_MMA(0, 1, At, B1); PG8_BAR; PG8_SCHED;
            PG8_LDA(At, 1, 1); PG8_STAGE(PG8_SB(1, 0), b3, voffB); PG8_STAGE(PG8_SB(1, 1), b3 + hstep, voffB); PG8_STAGE(PG8_SA(1, 0), a3, voffA);
            PG8_WAIT_V(8); PG8_WAIT_L(0); PG8_BAR; PG8_MMA(1, 0, At, B0); PG8_MMA(1, 1, At, B1); PG8_BAR; PG8_SCHED;
            } else {
            PG8_LDB(B0, 0, 0); PG8_SCHED; PG8_LDA(At, 0, 0); PG8_STAGE(PG8_SA(1, 1), a1 + hstep, voffA);
            PG8_WAIT_L(8); PG8_BAR; PG8_WAIT_L(0); PG8_MMA(0, 0, At, B0); PG8_BAR; PG8_SCHED;
            PG8_LDB(B1, 0, 1); PG8_STAGE(PG8_SB(0, 0), b2, voffB);
            PG8_BAR; PG8_WAIT_L(0); PG8_MMA(0, 1, At, B1); PG8_BAR;
            PG8_LDA(At, 0, 1); PG8_STAGE(PG8_SA(0, 0), a2, voffA);
            PG8_BAR; PG8_WAIT_L(0); PG8_MMA(1, 0, At, B0); PG8_BAR; PG8_SCHED;
            PG8_STAGE(PG8_SB(0, 1), b2 + hstep, voffB);
            PG8_WAIT_V(6); PG8_BAR; PG8_MMA(1, 1, At, B1); PG8_BAR;
            PG8_LDB(B0, 1, 0); PG8_SCHED; PG8_LDA(At, 1, 0); PG8_STAGE(PG8_SA(0, 1), a2 + hstep, voffA);
            PG8_WAIT_L(8); PG8_BAR; PG8_WAIT_L(0); PG8_MMA(0, 0, At, B0); PG8_BAR; PG8_SCHED;
            PG8_LDB(B1, 1, 1); PG8_STAGE(PG8_SB(1, 0), b3, voffB);
            PG8_BAR; PG8_WAIT_L(0); PG8_MMA(0, 1, At, B1); PG8_BAR;
            PG8_LDA(At, 1, 1); PG8_STAGE(PG8_SA(1, 0), a3, voffA);
            PG8_BAR; PG8_WAIT_L(0); PG8_MMA(1, 0, At, B0); PG8_BAR; PG8_SCHED;
            PG8_STAGE(PG8_SB(1, 1), b3 + hstep, voffB);
            PG8_WAIT_V(6); PG8_BAR; PG8_MMA(1, 1, At, B1); PG8_BAR;
            }
        }
        if constexpr (ALIGN_EPI) { if (wr == 0) PG8_BAR; }
        if constexpr (!Epi::AFTER_DRAIN) { E(acc, cur, wr, wc, fr, fq); S.done(cur); }
        if (!has_next) break;
#pragma unroll
        for (int a = 0; a < 2; ++a)
#pragma unroll
            for (int b = 0; b < 2; ++b)
#pragma unroll
                for (int m = 0; m < 4; ++m)
#pragma unroll
                    for (int n = 0; n < 2; ++n) acc[a][b][m][n] = (f32x4){0.f, 0.f, 0.f, 0.f};
        cur = nxt; cA = nA; cB = nB; ++ui;
        if constexpr (ALIGN_EPI) { if (wr == 1) PG8_BAR; }
    }
    PG8_WAIT_V(0);
    if constexpr (!ALIGN_EPI) { if (wr == 0) PG8_BAR; }
    PG8_BAR;
    if constexpr (Epi::AFTER_DRAIN) { E.fused(acc, cur, wr, wc, fr, fq, lds, wid, lane); S.done(cur); }
#undef PG8_SA
#undef PG8_SB
#undef PG8_STAGE
#undef PG8_LDA
#undef PG8_LDB
#undef PG8_MMA
#undef PG8_WAIT_V
#undef PG8_WAIT_L
#undef PG8_BAR
#undef PG8_SCHED
}
}
#define RLX_AGENT __ATOMIC_RELAXED, __HIP_MEMORY_SCOPE_AGENT
#define XB_TMO      128
#define XB_XCNT(j)  (256  + 64 * (j))
#define XB_XSUB(j)  (1280 + 64 * (j))
#define XB_XGEN(j)  (2304 + 64 * (j))
#define XB_TOP      3328
#define XB_TOPGEN   3392
#define XCD_BAR_WORDS 3456
#define XB_SPIN_CAP (1u << 18)

__device__ __forceinline__ unsigned xb_ld(unsigned* p)              { return __hip_atomic_load(p, __ATOMIC_RELAXED, __HIP_MEMORY_SCOPE_AGENT); }
__device__ __forceinline__ unsigned xb_add(unsigned* p, unsigned v) { return __hip_atomic_fetch_add(p, v, __ATOMIC_RELAXED, __HIP_MEMORY_SCOPE_AGENT); }
__device__ __forceinline__ unsigned xb_xcc_id() { return (unsigned)__builtin_amdgcn_s_getreg((3 << 11) | 20) & 0xFu; }
#define XB_SPIN(cond, bar) do { unsigned _sp = 0; while (cond) { __builtin_amdgcn_s_sleep(1); \
    if ((++_sp & 255u) == 0u) { if (xb_ld(&(bar)[XB_TMO])) break; if (_sp > XB_SPIN_CAP) { atomicAdd(&(bar)[XB_TMO], 1u); break; } } } } while (0)

struct XcdBarrier {
    unsigned* bar; unsigned x;
    volatile LAS unsigned* st;
};

__device__ __forceinline__ XcdBarrier xcd_barrier_post(unsigned* bar, volatile LAS unsigned* st) {
    XcdBarrier b; b.bar = bar; b.x = xb_xcc_id(); b.st = st;
    if (threadIdx.x == 0) (void)xb_add(&bar[XB_XCNT(b.x)], 1u);
    return b;
}
__device__ __forceinline__ void xcd_barrier_complete(unsigned* bar, unsigned x, unsigned& nloc, unsigned& nx) {
    const unsigned G = gridDim.x * gridDim.y * gridDim.z;
    unsigned sum, cnt, mine, sp = 0u;
    for (;;) {
        sum = 0u; cnt = 0u; mine = 0u;
#pragma unroll
        for (unsigned j = 0; j < 16; ++j) { const unsigned c = xb_ld(&bar[XB_XCNT(j)]); sum += c; cnt += (c > 0u) ? 1u : 0u; mine = (j == x) ? c : mine; }
        if (sum == G) break;
        __builtin_amdgcn_s_sleep(1);
        if ((++sp & 255u) == 0u) { if (xb_ld(&bar[XB_TMO])) break; if (sp > XB_SPIN_CAP) { atomicAdd(&bar[XB_TMO], 1u); break; } }
    }
    nloc = mine > 0u ? mine : 1u; nx = cnt > 0u ? cnt : 1u;
}

__device__ __forceinline__ void xcd_barrier(const XcdBarrier& b) {
    asm volatile("s_waitcnt vmcnt(0)" ::: "memory");
    __syncthreads();
    if (threadIdx.x == 0) {
        unsigned* bar = b.bar;
        __builtin_amdgcn_s_waitcnt(0);
        unsigned nloc = b.st[0], nx = b.st[1];
        if (nloc == 0u) { xcd_barrier_complete(bar, b.x, nloc, nx); b.st[0] = nloc; b.st[1] = nx; }
        const unsigned old = xb_add(&bar[XB_XSUB(b.x)], 1u);
        const unsigned gen = old / nloc;
        if (old + 1u == (gen + 1u) * nloc) {
            __builtin_amdgcn_fence(__ATOMIC_RELEASE, "agent");
            asm volatile("s_waitcnt vmcnt(0)" ::: "memory");
            const unsigned og = xb_add(&bar[XB_TOP], 1u);
            const unsigned tg = og / nx;
            if (og + 1u == (tg + 1u) * nx) xb_add(&bar[XB_TOPGEN], 1u);
            else XB_SPIN(xb_ld(&bar[XB_TOPGEN]) == tg, bar);
            __builtin_amdgcn_fence(__ATOMIC_ACQUIRE, "agent");
            xb_add(&bar[XB_XGEN(b.x)], 1u);
            asm volatile("s_waitcnt vmcnt(0)" ::: "memory");
        } else {
            XB_SPIN(xb_ld(&bar[XB_XGEN(b.x)]) == gen, bar);
            __builtin_amdgcn_fence(__ATOMIC_ACQUIRE, "agent");
            asm volatile("s_waitcnt vmcnt(0)" ::: "memory");
        }
    }
    __syncthreads();
}

__device__ __forceinline__ int rope_idx_of_row(int row) {
    if (row < ROW_S) return NMETA + (row & (SEQ - 1));
    if (row < ROW_M) return TP + ((row - ROW_S) & (DS - 1));
    if (row < ROW_M + NMETA) return row - ROW_M;
    return -1;
}
namespace pg8 {
#define EPI_ROWS(ai, m) (row0 + (ai) * HALF + (m) * 16)
__device__ __forceinline__ u32x4 pack8(const f32x4 v0, const f32x4 v1) { u32x4 w; w.x = cvt_pk_bf16(v0[0], v0[1]); w.y = cvt_pk_bf16(v0[2], v0[3]); w.z = cvt_pk_bf16(v1[0], v1[1]); w.w = cvt_pk_bf16(v1[2], v1[3]); return w; }
__device__ __forceinline__ void unpack8(const u32x4 w, f32x4& v0, f32x4& v1) { v0 = (f32x4){bflo(w.x), bfhi(w.x), bflo(w.y), bfhi(w.y)}; v1 = (f32x4){bflo(w.z), bfhi(w.z), bflo(w.w), bfhi(w.w)}; }

struct EpiWin {
    static constexpr bool PERM = true, AFTER_DRAIN = false;
    bf16 *RX, *GRG, *CQ, *CKVR, *G, *KPE; float *SSQQ, *SSQKV; const float* b_gate; const float *ropec, *ropes; float* out;
    __device__ __forceinline__ void operator()(const f32x4 (&acc)[2][2][4][2], const Unit& u, int wr, int wc, int fr, int fq) const {
        const int pn = u.pn, row0 = u.pm * BM + wr * 64 + fr, cw = wc * 32 + 8 * fq;
        if (pn < 4 || (pn >= 8 && pn < 13)) {
            bf16* base; int ld, colt, nslot = 0, slot0 = 0; float* ssq = nullptr;
            if (pn < 4) { base = RX; ld = D; colt = pn * BM; }
            else if (pn < 11) { base = CQ; ld = QL; colt = (pn - 8) * BM; ssq = SSQQ; nslot = 12; slot0 = (pn - 8) * 4 + wc; }
            else { base = CKVR; ld = KVL; colt = (pn - 11) * BM; ssq = SSQKV; nslot = 8; slot0 = (pn - 11) * 4 + wc; }
#pragma unroll
            for (int ai = 0; ai < 2; ++ai)
#pragma unroll
                for (int m = 0; m < 4; ++m) { const int row = EPI_ROWS(ai, m); float s = 0.f;
#pragma unroll
                    for (int bj = 0; bj < 2; ++bj) { const f32x4 v0 = acc[ai][bj][m][0], v1 = acc[ai][bj][m][1];
                        *(u32x4*)(base + (size_t)row * ld + colt + bj * HALF + cw) = pack8(v0, v1);
                        s += (v0[0] * v0[0] + v0[1] * v0[1]) + (v0[2] * v0[2] + v0[3] * v0[3]) + (v1[0] * v1[0] + v1[1] * v1[1]) + (v1[2] * v1[2] + v1[3] * v1[3]); }
                    if (ssq) { s += __shfl_xor(s, 16); s += __shfl_xor(s, 32); if (fq == 0) ssq[(size_t)row * nslot + slot0] = s; } }
        } else if (pn < 8) {
            const int colt = (pn - 4) * BM;
#pragma unroll
            for (int ai = 0; ai < 2; ++ai)
#pragma unroll
                for (int m = 0; m < 4; ++m) { const int row = EPI_ROWS(ai, m);
#pragma unroll
                    for (int bj = 0; bj < 2; ++bj) { f32x4 v0 = acc[ai][bj][m][0], v1 = acc[ai][bj][m][1];
#pragma unroll
                        for (int j = 0; j < 4; ++j) { v0[j] = gelu_tanh(v0[j]); v1[j] = gelu_tanh(v1[j]); }
                        *(u32x4*)(GRG + (size_t)row * D + colt + bj * HALF + cw) = pack8(v0, v1); } }
        } else if (pn < 21) {
            const int colt = (pn - 13) * BM;
            f32x4 bv[2][2];
#pragma unroll
            for (int bj = 0; bj < 2; ++bj)
#pragma unroll
                for (int n = 0; n < 2; ++n) bv[bj][n] = *(const f32x4*)(b_gate + colt + bj * HALF + cw + 4 * n);
#pragma unroll
            for (int ai = 0; ai < 2; ++ai)
#pragma unroll
                for (int m = 0; m < 4; ++m) { const int row = EPI_ROWS(ai, m);
#pragma unroll
                    for (int bj = 0; bj < 2; ++bj) { f32x4 v0 = acc[ai][bj][m][0] + bv[bj][0], v1 = acc[ai][bj][m][1] + bv[bj][1];
#pragma unroll
                        for (int j = 0; j < 4; ++j) { v0[j] = sigmoidf_(v0[j]); v1[j] = sigmoidf_(v1[j]); }
                        *(u32x4*)(G + (size_t)row * 2048 + colt + bj * HALF + cw) = pack8(v0, v1); } }
        } else if (wc == 0) {
#pragma unroll
            for (int ai = 0; ai < 2; ++ai)
#pragma unroll
                for (int m = 0; m < 4; ++m) { const int row = EPI_ROWS(ai, m); const int pi = rope_idx_of_row(row);
                    if (pi >= 0) {
#pragma unroll
                        for (int n = 0; n < 2; ++n) { const int i0 = 8 * fq + 4 * n;
                            const f32x4 cs = *(const f32x4*)(ropec + pi * 32 + i0), sn = *(const f32x4*)(ropes + pi * 32 + i0);
                            const f32x4 x1 = acc[ai][0][m][n], x2 = acc[ai][1][m][n];
                            const f32x4 o1 = x1 * cs - x2 * sn, o2 = x1 * sn + x2 * cs;
                            u32x2 w1, w2; w1.x = cvt_pk_bf16(o1[0], o1[1]); w1.y = cvt_pk_bf16(o1[2], o1[3]); w2.x = cvt_pk_bf16(o2[0], o2[1]); w2.y = cvt_pk_bf16(o2[2], o2[3]);
                            *(u32x2*)(KPE + (size_t)row * 64 + i0) = w1; *(u32x2*)(KPE + (size_t)row * 64 + 32 + i0) = w2;
                            if (row < ROW_S) { float* o = out + O_PKPE + ((size_t)(row >> 11) * TP + pi) * 64 + i0; *(f32x4*)o = o1; *(f32x4*)(o + 32) = o2; }
                            else if (row < ROW_M) { float* o = out + O_SKPE + (size_t)(row - ROW_S) * 64 + i0; *(f32x4*)o = o1; *(f32x4*)(o + 32) = o2; }
                            else {
#pragma unroll
                                for (int b = 0; b < NB; ++b) { float* o = out + O_PKPE + ((size_t)b * TP + pi) * 64 + i0; *(f32x4*)o = o1; *(f32x4*)(o + 32) = o2; } } } } }
        }
    }
};
struct EpiQ {
    static constexpr bool PERM = true, AFTER_DRAIN = false;
    bf16* QA; const float* SSQQ; const float *ropec, *ropes;
    __device__ __forceinline__ void operator()(const f32x4 (&acc)[2][2][4][2], const Unit& u, int wr, int wc, int fr, int fq) const {
        const int pn = u.pn, row0 = u.pm * BM + wr * 64 + fr, cw = wc * 32 + 8 * fq;
#pragma unroll
        for (int ai = 0; ai < 2; ++ai)
#pragma unroll
            for (int m = 0; m < 4; ++m) { const int row = EPI_ROWS(ai, m);
                const f32x4 s0 = *(const f32x4*)(SSQQ + (size_t)row * 12), s1 = *(const f32x4*)(SSQQ + (size_t)row * 12 + 4), s2 = *(const f32x4*)(SSQQ + (size_t)row * 12 + 8);
                const float ss = ((s0[0] + s0[1]) + (s0[2] + s0[3])) + ((s1[0] + s1[1]) + (s1[2] + s1[3])) + ((s2[0] + s2[1]) + (s2[2] + s2[3]));
                const float rstd = __builtin_amdgcn_rsqf(ss * (1.0f / QL) + EPS);
                if (pn < 4) {
#pragma unroll
                    for (int bj = 0; bj < 2; ++bj) { const int h = pn * 2 + bj;
                        *(u32x4*)(QA + (size_t)row * 1536 + h * 192 + cw) = pack8(acc[ai][bj][m][0] * rstd, acc[ai][bj][m][1] * rstd); }
                } else {
                    const int h = (pn - 4) * 4 + wc; int pi = rope_idx_of_row(row); if (pi < 0) pi = 0;
#pragma unroll
                    for (int n = 0; n < 2; ++n) { const int i0 = 8 * fq + 4 * n;
                        const f32x4 cs = *(const f32x4*)(ropec + pi * 32 + i0), sn = *(const f32x4*)(ropes + pi * 32 + i0);
                        const f32x4 x1 = acc[ai][0][m][n] * rstd, x2 = acc[ai][1][m][n] * rstd;
                        const f32x4 o1 = x1 * cs - x2 * sn, o2 = x1 * sn + x2 * cs;
                        u32x2 w1, w2; w1.x = cvt_pk_bf16(o1[0], o1[1]); w1.y = cvt_pk_bf16(o1[2], o1[3]); w2.x = cvt_pk_bf16(o2[0], o2[1]); w2.y = cvt_pk_bf16(o2[2], o2[3]);
                        *(u32x2*)(QA + (size_t)row * 1536 + h * 192 + 128 + i0) = w1; *(u32x2*)(QA + (size_t)row * 1536 + h * 192 + 160 + i0) = w2; }
                } }
    }
};
struct EpiKV {
    static constexpr bool PERM = true, AFTER_DRAIN = false;
    bf16 *KN, *V; const float* SSQKV;
    __device__ __forceinline__ void operator()(const f32x4 (&acc)[2][2][4][2], const Unit& u, int wr, int wc, int fr, int fq) const {
        const int pn = u.pn, row0 = u.pm * BM + wr * 64 + fr, cw = wc * 32 + 8 * fq;
        bf16* base = pn < 4 ? KN : V; const int colt = (pn & 3) * BM;
#pragma unroll
        for (int ai = 0; ai < 2; ++ai)
#pragma unroll
            for (int m = 0; m < 4; ++m) { const int row = EPI_ROWS(ai, m);
                const f32x4 s0 = *(const f32x4*)(SSQKV + (size_t)row * 8), s1 = *(const f32x4*)(SSQKV + (size_t)row * 8 + 4);
                const float ss = ((s0[0] + s0[1]) + (s0[2] + s0[3])) + ((s1[0] + s1[1]) + (s1[2] + s1[3]));
                const float rstd = __builtin_amdgcn_rsqf(ss * (1.0f / KVL) + EPS);
#pragma unroll
                for (int bj = 0; bj < 2; ++bj) *(u32x4*)(base + (size_t)row * D + colt + bj * HALF + cw) = pack8(acc[ai][bj][m][0] * rstd, acc[ai][bj][m][1] * rstd); }
    }
};
template <int MODE> struct EpiZ {
    static constexpr bool PERM = true, AFTER_DRAIN = false;
    bf16* MIX; const bf16* G;
    __device__ __forceinline__ void operator()(const f32x4 (&acc)[2][2][4][2], const Unit& u, int wr, int wc, int fr, int fq) const {
        const int row0 = u.pm * BM + wr * 64 + fr, col0 = u.pn * BM + wc * 32 + 8 * fq;
#pragma unroll
        for (int ai = 0; ai < 2; ++ai)
#pragma unroll
            for (int m = 0; m < 4; ++m) { const int row = EPI_ROWS(ai, m);
#pragma unroll
                for (int bj = 0; bj < 2; ++bj) { const int col = col0 + bj * HALF;
                    f32x4 g0, g1; unpack8(*(const u32x4*)(G + (size_t)row * 2048 + MODE * D + col), g0, g1);
                    f32x4 v0 = acc[ai][bj][m][0] * g0, v1 = acc[ai][bj][m][1] * g1;
                    if (MODE == 1) { f32x4 t0, t1; unpack8(*(const u32x4*)(MIX + (size_t)row * D + col), t0, t1); v0 += t0; v1 += t1; }
                    *(u32x4*)(MIX + (size_t)row * D + col) = pack8(v0, v1); } }
    }
};
struct EpiRes {
    static constexpr bool PERM = true, AFTER_DRAIN = false;
    bf16* OUT; const bf16* RES; const float* bias;
    __device__ __forceinline__ void operator()(const f32x4 (&acc)[2][2][4][2], const Unit& u, int wr, int wc, int fr, int fq) const {
        const int row0 = u.pm * BM + wr * 64 + fr, col0 = u.pn * BM + wc * 32 + 8 * fq;
        f32x4 bv[2][2];
#pragma unroll
        for (int bj = 0; bj < 2; ++bj)
#pragma unroll
            for (int n = 0; n < 2; ++n) bv[bj][n] = bias ? *(const f32x4*)(bias + col0 + bj * HALF + 4 * n) : (f32x4){0.f, 0.f, 0.f, 0.f};
#pragma unroll
        for (int ai = 0; ai < 2; ++ai)
#pragma unroll
            for (int m = 0; m < 4; ++m) { const size_t ro = (size_t)EPI_ROWS(ai, m) * D + col0;
#pragma unroll
                for (int bj = 0; bj < 2; ++bj) { f32x4 r0, r1; unpack8(*(const u32x4*)(RES + ro + bj * HALF), r0, r1);
                    *(u32x4*)(OUT + ro + bj * HALF) = pack8(r0 * DN_ALPHA + acc[ai][bj][m][0] + bv[bj][0], r1 * DN_ALPHA + acc[ai][bj][m][1] + bv[bj][1]); } }
    }
};
struct EpiUp {
    static constexpr bool PERM = true, AFTER_DRAIN = false;
    bf16* U; const float* bias;
    __device__ __forceinline__ void operator()(const f32x4 (&acc)[2][2][4][2], const Unit& u, int wr, int wc, int fr, int fq) const {
        const int row0 = u.pm * BM + wr * 64 + fr, col0 = u.pn * BM + wc * 32 + 8 * fq;
        f32x4 bv[2][2];
#pragma unroll
        for (int bj = 0; bj < 2; ++bj)
#pragma unroll
            for (int n = 0; n < 2; ++n) bv[bj][n] = *(const f32x4*)(bias + col0 + bj * HALF + 4 * n);
#pragma unroll
        for (int ai = 0; ai < 2; ++ai)
#pragma unroll
            for (int m = 0; m < 4; ++m) { const int row = EPI_ROWS(ai, m);
#pragma unroll
                for (int bj = 0; bj < 2; ++bj) { f32x4 v0 = acc[ai][bj][m][0] + bv[bj][0], v1 = acc[ai][bj][m][1] + bv[bj][1];
#pragma unroll
                    for (int j = 0; j < 4; ++j) { const float a = fmaxf(v0[j], 0.f), b = fmaxf(v1[j], 0.f); v0[j] = a * a; v1[j] = b * b; }
                    *(u32x4*)(U + (size_t)row * DFF + col0 + bj * HALF) = pack8(v0, v1); } }
    }
};
#undef EPI_ROWS
}
struct Frame {
    LAS unsigned char* lds;
    volatile LAS unsigned* MISC;
    unsigned* ctl;
    int tid, lane, wave, vcu, G;
    const void* const* in;
    float* out; unsigned char* ws;
};
struct Args { const void* in[35]; float* out; unsigned char* ws; int ph_lo, ph_hi; };
#define IN_F(i) ((const float*)args.in[i])
enum { I_XP = 0, I_XS, I_CCKV, I_CKPE, I_PT, I_SCONV, I_SRG, I_META, I_LNG, I_LNB, I_WIN, I_BGATE, I_CONVW, I_CONVB, I_WA, I_BA, I_WX, I_BX, I_LAM, I_WBRR,
       I_QG, I_WUQ, I_KVG, I_WUK, I_WUV, I_WBRM, I_WO, I_LN1G, I_LN1B, I_WUP, I_BUP, I_WDN, I_BDN, I_LN2G, I_LN2B };

__device__ __forceinline__ void tr_item(const float* src, size_t ldn, int scol0, bf16* dst, int dK, int drow0, int k0, const float* kscale, LAS float* scr, int lane) {
    if (scol0 >= 0) {
#pragma unroll 8
        for (int i = 0; i < 32; ++i) { const int kk = 2 * i + (lane >> 5); scr[kk * 33 + (lane & 31)] = src[(size_t)(k0 + kk) * ldn + scol0 + (lane & 31)]; }
    } else {
#pragma unroll 8
        for (int i = 0; i < 32; ++i) { const int kk = 2 * i + (lane >> 5); scr[kk * 33 + (lane & 31)] = 0.f; }
    }
    LDS_WAIT(); asm volatile("" ::: "memory");
    const int c = lane & 7;
    float ks[8];
#pragma unroll
    for (int e = 0; e < 8; ++e) ks[e] = kscale ? kscale[k0 + 8 * c + e] : 1.0f;
#pragma unroll
    for (int j = 0; j < 4; ++j) { const int n = (lane >> 3) + 8 * j; const LAS float* s = scr + (8 * c) * 33 + n;
        u32x4 o; o.x = cvt_pk_bf16(s[0 * 33] * ks[0], s[1 * 33] * ks[1]); o.y = cvt_pk_bf16(s[2 * 33] * ks[2], s[3 * 33] * ks[3]);
        o.z = cvt_pk_bf16(s[4 * 33] * ks[4], s[5 * 33] * ks[5]); o.w = cvt_pk_bf16(s[6 * 33] * ks[6], s[7 * 33] * ks[7]);
        *(u32x4*)(dst + (size_t)(drow0 + n) * dK + k0 + 8 * c) = o; }
    LDS_WAIT(); asm volatile("" ::: "memory");
}
template <bool XBF = false>
__device__ __forceinline__ void ln_row(const void* xrow, const float* g, const float* b, bf16* obf, float* of32, int lane) {
    f32x4 v[4]; float s = 0.f;
#pragma unroll
    for (int j = 0; j < 4; ++j) {
        if (XBF) { const u32x2 w = ((const u32x2*)xrow)[lane + 64 * j]; v[j] = (f32x4){bflo(w.x), bfhi(w.x), bflo(w.y), bfhi(w.y)}; } else v[j] = ((const f32x4*)xrow)[lane + 64 * j];
        s += (v[j].x + v[j].y) + (v[j].z + v[j].w); }
    const float mean = wave_sum(s) * (1.f / D); float s2 = 0.f;
#pragma unroll
    for (int j = 0; j < 4; ++j) { v[j] = v[j] - mean; s2 += (v[j].x * v[j].x + v[j].y * v[j].y) + (v[j].z * v[j].z + v[j].w * v[j].w); }
    const float rstd = __builtin_amdgcn_rsqf(wave_sum(s2) * (1.f / D) + EPS);
#pragma unroll
    for (int j = 0; j < 4; ++j) { const f32x4 gg = ((const f32x4*)g)[lane + 64 * j], bb = ((const f32x4*)b)[lane + 64 * j]; const f32x4 y = v[j] * rstd * gg + bb;
        if (obf) { u32x2 w; w.x = cvt_pk_bf16(y.x, y.y); w.y = cvt_pk_bf16(y.z, y.w); ((u32x2*)obf)[lane + 64 * j] = w; }
        if (of32) ((f32x4*)of32)[lane + 64 * j] = y; }
}
__device__ __forceinline__ const float* src_row(const float* xp, const float* xs, const float* meta, int row) {
    if (row < ROW_S) return xp + (size_t)row * D;
    if (row < ROW_M) return xs + (size_t)(row - ROW_S) * D;
    if (row < ROW_M + NMETA) return meta + (size_t)(row - ROW_M) * D;
    return nullptr;
}
__device__ __forceinline__ void p0_prologue(const Frame& F, const Args& args) {
    unsigned char* ws = F.ws;
    LAS float* scr = (LAS float*)(F.lds + F.wave * 16384);
    const int gw = F.vcu * NWAVES + F.wave, NGW = F.G * NWAVES, lane = F.lane;
    constexpr int I_1 = 16 * (NINP / 32), I_2 = 12 * 48, I_3 = 8 * 32, I_4 = 8 * 32, I_5 = 16 * 32, I_8 = 16 * 128, I_9 = 64 * 32, I_10 = 8 * 8;
    constexpr int NITEMS = I_1 + I_2 + I_3 + I_4 + 3 * I_5 + I_8 + I_9 + 2 * I_10;
    for (int it = gw; it < NITEMS; it += NGW) {
        int r = it;
        if (r < I_1) { const int nb = r % (NINP / 32), kb = r / (NINP / 32), n0 = 32 * nb; int sc;
            if (n0 < 3328) sc = n0; else if (n0 < 5376) sc = n0 + 64; else { const int w = n0 - 5376; sc = (w == 0) ? 3328 : (w == 128 ? 3360 : -1); }
            tr_item(IN_F(I_WIN), NIN, sc, (bf16*)(ws + WS_WIN), D, n0, 64 * kb, nullptr, scr, lane); continue; } r -= I_1;
        if (r < I_2) { const int nb = r % 48, kb = r / 48, n0 = 32 * nb; int sc;
            if (n0 < 1024) sc = (n0 >> 7) * 192 + (n0 & 127);
            else { const int w = n0 - 1024, tt = w >> 8, wi = w & 255, half = wi >> 7, hh = (wi & 127) >> 5; sc = (4 * tt + hh) * 192 + 128 + 32 * half; }
            tr_item(IN_F(I_WUQ), 1536, sc, (bf16*)(ws + WS_WQ), QL, n0, 64 * kb, IN_F(I_QG), scr, lane); continue; } r -= I_2;
        if (r < I_3) { const int nb = r % 32, kb = r / 32; tr_item(IN_F(I_WUK), 1024, 32 * nb, (bf16*)(ws + WS_WKV), KVL, 32 * nb, 64 * kb, IN_F(I_KVG), scr, lane); continue; } r -= I_3;
        if (r < I_4) { const int nb = r % 32, kb = r / 32; tr_item(IN_F(I_WUV), 1024, 32 * nb, (bf16*)(ws + WS_WKV), KVL, 1024 + 32 * nb, 64 * kb, IN_F(I_KVG), scr, lane); continue; } r -= I_4;
        if (r < I_5) { const int nb = r % 32, kb = r / 32; tr_item(IN_F(I_WBRR), D, 32 * nb, (bf16*)(ws + WS_WBRR), D, 32 * nb, 64 * kb, nullptr, scr, lane); continue; } r -= I_5;
        if (r < I_5) { const int nb = r % 32, kb = r / 32; tr_item(IN_F(I_WBRM), D, 32 * nb, (bf16*)(ws + WS_WBRM), D, 32 * nb, 64 * kb, nullptr, scr, lane); continue; } r -= I_5;
        if (r < I_5) { const int nb = r % 32, kb = r / 32; tr_item(IN_F(I_WO), D, 32 * nb, (bf16*)(ws + WS_WO), D, 32 * nb, 64 * kb, nullptr, scr, lane); continue; } r -= I_5;
        if (r < I_8) { const int nb = r % 128, kb = r / 128; tr_item(IN_F(I_WUP), DFF, 32 * nb, (bf16*)(ws + WS_WUP), D, 32 * nb, 64 * kb, nullptr, scr, lane); continue; } r -= I_8;
        if (r < I_9) { const int nb = r % 32, kb = r / 32; tr_item(IN_F(I_WDN), D, 32 * nb, (bf16*)(ws + WS_WDN), DFF, 32 * nb, 64 * kb, nullptr, scr, lane); continue; } r -= I_9;
        if (r < I_10) { const int blk = r >> 3, nb = r & 3, kb = (r >> 2) & 1; tr_item(IN_F(I_WA) + (size_t)blk * 128 * 128, 128, 32 * nb, (bf16*)(ws + WS_WAX), 128, blk * 256 + 32 * nb, 64 * kb, nullptr, scr, lane); continue; } r -= I_10;
        { const int blk = r >> 3, nb = r & 3, kb = (r >> 2) & 1; tr_item(IN_F(I_WX) + (size_t)blk * 128 * 128, 128, 32 * nb, (bf16*)(ws + WS_WAX), 128, blk * 256 + 128 + 32 * nb, 64 * kb, nullptr, scr, lane); }
    }
    const int gt = F.vcu * NTHR + F.tid, NGT = F.G * NTHR;
    for (int i = gt; i < 8 * 512 * 16; i += NGT) { const int c8 = i & 15, r = (i >> 4) & 511, h = i >> 13;
        const f32x4 a = *(const f32x4*)(IN_F(I_WUK) + (size_t)r * 1024 + h * 128 + c8 * 8), b = *(const f32x4*)(IN_F(I_WUK) + (size_t)r * 1024 + h * 128 + c8 * 8 + 4);
        *(u32x4*)((bf16*)(ws + WS_WUKS) + ((size_t)h * 512 + r) * 128 + c8 * 8) = pg8::pack8(a, b); }
    for (int i = gt; i < NROPE * 32; i += NGT) { const int pi = i >> 5, k = i & 31; const int pos = pi < TP ? pi : PAST + (pi - TP);
        double pw = 1.0; for (int j = 0; j < k; ++j) pw *= 1.3335214321633240;
        const float inv = 1.0f / (float)pw; const float ang = (float)pos * inv; const double a = (double)ang;
        const double n2 = __builtin_rint(a * 0.15915494309189535); const double r = (a - n2 * 6.283185307179586) - n2 * 2.4492935982947064e-16;
        const double q = __builtin_rint(r * 0.6366197723675814); const double t = (r - q * 1.5707963267948966) - q * 6.123233995736766e-17; const int qi = ((int)q) & 3;
        const double t2 = t * t;
        const double st = t * (1.0 + t2 * (-1.0 / 6 + t2 * (1.0 / 120 + t2 * (-1.0 / 5040 + t2 * (1.0 / 362880 + t2 * (-1.0 / 39916800 + t2 * (1.0 / 6227020800.0)))))));
        const double ct = 1.0 + t2 * (-0.5 + t2 * (1.0 / 24 + t2 * (-1.0 / 720 + t2 * (1.0 / 40320 + t2 * (-1.0 / 3628800 + t2 * (1.0 / 479001600.0 + t2 * (-1.0 / 87178291200.0)))))));
        const double cv = qi == 0 ? ct : (qi == 1 ? -st : (qi == 2 ? -ct : st)), sv = qi == 0 ? st : (qi == 1 ? ct : (qi == 2 ? -st : -ct));
        ((float*)(ws + WS_ROPEC))[i] = (float)cv; ((float*)(ws + WS_ROPES))[i] = (float)sv; }
    for (int i = gt; i < D; i += NGT) { const float l = IN_F(I_LAM)[i]; ((float*)(ws + WS_SPL))[i] = (l > 0.f) ? log1pf(expf(-l)) : (-l + log1pf(expf(l))); }
    for (int m = gw; m < R; m += NGW) { const float* s = src_row(IN_F(I_XP), IN_F(I_XS), IN_F(I_META), m); bf16* o = (bf16*)(ws + WS_H) + (size_t)m * D;
        if (s) ln_row(s, IN_F(I_LNG), IN_F(I_LNB), o, nullptr, lane);
        else { for (int j = 0; j < 2; ++j) ((u32x4*)o)[lane + 64 * j] = (u32x4){0u, 0u, 0u, 0u}; } }
}
constexpr int RG_XC = 0;
constexpr int RG_PRIV = 2 * 16384;
constexpr int RG_PW = 2 * 64 * 17 * 4 + 512;
constexpr int RG_CW = RG_PRIV + 8 * RG_PW;
constexpr int RG_END = RG_CW + 5 * 128 * 4;
static_assert(RG_END <= MISC_OFF, "rg lds");
__device__ __forceinline__ unsigned off256(unsigned row, unsigned ch) { return 256u * row + 16u * (ch ^ (((row & 3) << 2) | ((row >> 2) & 3))); }

struct RgParams {
    const bf16 *RX, *GRG, *WAX; bf16* HRG; const float *conv_w, *conv_b, *ba, *bx, *spl, *state_conv, *state_rg; float* SEG; float* out;
};
__device__ __forceinline__ int prompt_row(int b, int p) { return p < NMETA ? ROW_M + p : b * SEQ + (p - NMETA); }

template <int MODE>
__device__ __forceinline__ void rg_unit(const Frame& F, const RgParams& P, const int b  , const int n, const int seg) {
    LAS unsigned char* lds = F.lds;
    int tid = F.tid; asm volatile("" : "+v"(tid));
    const int lane = tid & 63, wave = F.wave, l15 = lane & 15, g = lane >> 4;
    LAS float* PA = (LAS float*)(lds + RG_PRIV + wave * RG_PW); LAS float* PU = PA + 64 * 17; LAS float* PS = PU + 64 * 17;
    bf16x8 wfa[4], wfx[4];
    { const bf16* wa = P.WAX + ((size_t)n * 256 + 16 * wave + l15) * 128 + 8 * g; const bf16* wx = wa + 128 * 128;
#pragma unroll
      for (int ks = 0; ks < 4; ++ks) { wfa[ks] = *(const bf16x8*)(wa + 32 * ks); wfx[ks] = *(const bf16x8*)(wx + 32 * ks); } }
    const int cl = 16 * wave + l15, cg = n * 128 + cl;
    const float ba_c = P.ba[cg], bx_c = P.bx[cg], spl8 = -8.0f * P.spl[cg] * LOG2E;
    const int cv_tp = tid >> 4, cv_c8 = tid & 15, cg_v = n * 128 + 8 * cv_c8;
    if (tid < 5 * 32) { const int k = tid >> 5, c4 = (tid & 31) * 4; *(LAS f32x4*)(lds + RG_CW + (k * 128 + c4) * 4) = k < 4 ? *(const f32x4*)(P.conv_w + k * D + n * 128 + c4) : *(const f32x4*)(P.conv_b + n * 128 + c4); }
    __syncthreads();
    float hc = 0.f, cA = 1.f;
    if (MODE == 1) { for (int s2 = 0; s2 < seg; ++s2) { const f32x2 sv = *(const f32x2*)(P.SEG + (((size_t)b * 3 + s2) * D + cg) * 2); hc = sv.x * hc + sv.y; } }
    const int nchunks = (MODE == 2) ? 1 : (seg == 0 ? 9 : 8);
    auto chunk_p0 = [&](int ch) -> int { return seg == 0 ? (ch == 0 ? 0 : NMETA + 64 * (ch - 1)) : NMETA + 512 * seg + 64 * ch; };
    u32x4 xw[5];
    auto load_x = [&](int ch) {
        const int p0n = chunk_p0(ch);
#pragma unroll
        for (int r = 0; r < 5; ++r) { const int p = p0n + 2 * cv_tp - 3 + r;
            xw[r] = (u32x4){0u, 0u, 0u, 0u};
            if (p >= 0) xw[r] = *(const u32x4*)(P.RX + (size_t)prompt_row(b, p < TP ? p : TP - 1) * D + cg_v); }
    };
    if (MODE != 2) load_x(0);
    for (int ch = 0; ch < nchunks; ++ch) {
        int p0 = 0, nvalid = 64;
        if (MODE != 2) { p0 = chunk_p0(ch); if (seg == 0 && ch == 0) nvalid = NMETA; }
        LAS unsigned char* XC = lds + RG_XC + (ch & 1) * 16384;
        {
            float cw[4][8], cbias[8];
#pragma unroll
            for (int k = 0; k < 5; ++k) { const f32x4 a = *(const LAS f32x4*)(lds + RG_CW + (k * 128 + 8 * cv_c8) * 4), c = *(const LAS f32x4*)(lds + RG_CW + (k * 128 + 8 * cv_c8 + 4) * 4);
#pragma unroll
                for (int e = 0; e < 4; ++e) { if (k < 4) { cw[k][e] = a[e]; cw[k][4 + e] = c[e]; } else { cbias[e] = a[e]; cbias[4 + e] = c[e]; } } }
            if (MODE != 2) {
                float x[5][8];
#pragma unroll
                for (int r = 0; r < 5; ++r) { const u32x4 w = xw[r];
                    x[r][0] = bflo(w.x); x[r][1] = bfhi(w.x); x[r][2] = bflo(w.y); x[r][3] = bfhi(w.y); x[r][4] = bflo(w.z); x[r][5] = bfhi(w.z); x[r][6] = bflo(w.w); x[r][7] = bfhi(w.w); }
                if (ch + 1 < nchunks) load_x(ch + 1);
#pragma unroll
                for (int t = 0; t < 2; ++t) { const int row = 2 * cv_tp + t;
                    float acc[8];
#pragma unroll
                    for (int e = 0; e < 8; ++e) acc[e] = cbias[e] + x[t][e] * cw[0][e] + x[t + 1][e] * cw[1][e] + x[t + 2][e] * cw[2][e] + x[t + 3][e] * cw[3][e];
                    u32x4 o; o.x = cvt_pk_bf16(acc[0], acc[1]); o.y = cvt_pk_bf16(acc[2], acc[3]); o.z = cvt_pk_bf16(acc[4], acc[5]); o.w = cvt_pk_bf16(acc[6], acc[7]);
                    *(LAS u32x4*)(XC + off256(row, cv_c8)) = o; }
            } else {
#pragma unroll
                for (int t = 0; t < 2; ++t) { const int row = 2 * cv_tp + t, j = row & 7, bb = 8 * b + (row >> 3);
                    float acc[8];
#pragma unroll
                    for (int e = 0; e < 8; ++e) acc[e] = cbias[e];
#pragma unroll
                    for (int k = 0; k < 4; ++k) { const int xi = j + k; float xv[8];
                        if (xi < 3) { const f32x4 a = *(const f32x4*)(P.state_conv + ((size_t)bb * 3 + xi) * D + cg_v), c = *(const f32x4*)(P.state_conv + ((size_t)bb * 3 + xi) * D + cg_v + 4);
#pragma unroll
                            for (int e = 0; e < 4; ++e) { xv[e] = a[e]; xv[4 + e] = c[e]; } }
                        else { const u32x4 w = *(const u32x4*)(P.RX + (size_t)(ROW_S + bb * 8 + xi - 3) * D + cg_v);
                            xv[0] = bflo(w.x); xv[1] = bfhi(w.x); xv[2] = bflo(w.y); xv[3] = bfhi(w.y); xv[4] = bflo(w.z); xv[5] = bfhi(w.z); xv[6] = bflo(w.w); xv[7] = bfhi(w.w); }
#pragma unroll
                        for (int e = 0; e < 8; ++e) acc[e] += xv[e] * cw[k][e]; }
                    u32x4 o; o.x = cvt_pk_bf16(acc[0], acc[1]); o.y = cvt_pk_bf16(acc[2], acc[3]); o.z = cvt_pk_bf16(acc[4], acc[5]); o.w = cvt_pk_bf16(acc[6], acc[7]);
                    *(LAS u32x4*)(XC + off256(row, cv_c8)) = o; }
            }
        }
        __syncthreads();
        u32x4 gw0 = (u32x4){0u, 0u, 0u, 0u}, gw1 = gw0;
        if (MODE != 0) { int grow; if (MODE == 2) grow = ROW_S + 64 * b + lane; else { const int p = p0 + lane; grow = prompt_row(b, p < TP ? p : TP - 1); }
            gw0 = *(const u32x4*)(P.GRG + (size_t)grow * D + n * 128 + 16 * wave); gw1 = *(const u32x4*)(P.GRG + (size_t)grow * D + n * 128 + 16 * wave + 8); }
        f32x4 ga[4], gx[4];
#pragma unroll
        for (int tb = 0; tb < 4; ++tb) { ga[tb] = (f32x4){0.f, 0.f, 0.f, 0.f}; gx[tb] = (f32x4){0.f, 0.f, 0.f, 0.f}; }
#pragma unroll
        for (int tb = 0; tb < 4; ++tb)
#pragma unroll
            for (int ks = 0; ks < 4; ++ks) { const bf16x8 af = *(const LAS bf16x8*)(XC + off256(16 * tb + l15, 4 * ks + g));
                ga[tb] = __builtin_amdgcn_mfma_f32_16x16x32_bf16(af, wfa[ks], ga[tb], 0, 0, 0); gx[tb] = __builtin_amdgcn_mfma_f32_16x16x32_bf16(af, wfx[ks], gx[tb], 0, 0, 0); }
#pragma unroll
        for (int tb = 0; tb < 4; ++tb)
#pragma unroll
            for (int e = 0; e < 4; ++e) { const int tok = 16 * tb + 4 * g + e;
                const float xcv = bf2f(*(const LAS bf16*)(XC + off256(tok, cl >> 3) + 2 * (cl & 7)));
                const float rr = sigmoidf_(ga[tb][e] + ba_c), ii = sigmoidf_(gx[tb][e] + bx_c);
                float a = fast_exp2(rr * spl8); float u = __builtin_amdgcn_sqrtf(fmaxf(1.0f - a * a, 0.f)) * ii * xcv;
                if (nvalid < 64) { if (tok >= nvalid) { a = 1.f; u = 0.f; } }
                PA[tok * 17 + l15] = a; PU[tok * 17 + l15] = u; }
        LDS_WAIT(); asm volatile("" ::: "memory");
        float av[16], uv[16];
#pragma unroll
        for (int i = 0; i < 16; ++i) { av[i] = PA[(16 * g + i) * 17 + l15]; uv[i] = PU[(16 * g + i) * 17 + l15]; }
        if (MODE == 2) {
#pragma unroll
            for (int t2 = 0; t2 < 2; ++t2) { const int bb = 8 * b + 2 * g + t2; float h = P.state_rg[(size_t)bb * D + cg];
#pragma unroll
                for (int j = 0; j < 8; ++j) { h = av[8 * t2 + j] * h + uv[8 * t2 + j]; PA[(16 * g + 8 * t2 + j) * 17 + l15] = h; }
                P.out[O_SH + (size_t)bb * D + cg] = h; }
        } else {
            float A = 1.f, Hh = 0.f;
#pragma unroll
            for (int i = 0; i < 16; ++i) { Hh = av[i] * Hh + uv[i]; A *= av[i]; }
            *(LAS f32x2*)(PS + (g * 16 + l15) * 2) = (f32x2){A, Hh};
            LDS_WAIT(); asm volatile("" ::: "memory");
            float hin = hc, hend = hc, Aend = 1.f;
#pragma unroll
            for (int q = 0; q < 4; ++q) { const f32x2 sv = *(LAS f32x2*)(PS + (q * 16 + l15) * 2); if (q < g) hin = sv.x * hin + sv.y; hend = sv.x * hend + sv.y; Aend *= sv.x; }
            hc = hend; cA *= Aend;
            if (MODE == 1) { float h = hin;
#pragma unroll
                for (int i = 0; i < 16; ++i) { h = av[i] * h + uv[i]; PA[(16 * g + i) * 17 + l15] = h; } }
        }
        if (MODE != 0) {
            LDS_WAIT(); asm volatile("" ::: "memory");
            const int row = lane; int grow;
            if (MODE == 2) grow = ROW_S + 64 * b + row; else { const int p = p0 + row; grow = prompt_row(b, p < TP ? p : TP - 1); }
            if (MODE == 2 || (row < nvalid && p0 >= NMETA)) {
                f32x4 g0, g1, g2, g3; pg8::unpack8(gw0, g0, g1); pg8::unpack8(gw1, g2, g3);
                float hv[16];
#pragma unroll
                for (int c = 0; c < 16; ++c) hv[c] = PA[row * 17 + c];
                const f32x4 h0 = (f32x4){hv[0], hv[1], hv[2], hv[3]}, h1 = (f32x4){hv[4], hv[5], hv[6], hv[7]}, h2 = (f32x4){hv[8], hv[9], hv[10], hv[11]}, h3 = (f32x4){hv[12], hv[13], hv[14], hv[15]};
                *(u32x4*)(P.HRG + (size_t)grow * D + n * 128 + 16 * wave) = pg8::pack8(h0 * g0, h1 * g1); *(u32x4*)(P.HRG + (size_t)grow * D + n * 128 + 16 * wave + 8) = pg8::pack8(h2 * g2, h3 * g3); }
            LDS_WAIT(); asm volatile("" ::: "memory");
        }
    }
    if (MODE == 0) { if (g == 0) *(f32x2*)(P.SEG + (((size_t)b * 3 + seg) * D + cg) * 2) = (f32x2){cA, hc}; }
    if (MODE == 1 && seg == 3) { if (g == 0) P.out[O_PH + (size_t)b * D + cg] = hc; }
    __syncthreads();
}
template <int K>
__device__ __forceinline__ void skinny_partial(const Frame& F, const bf16* __restrict__ A, const int lda, const bf16* __restrict__ Bt, const int ldb, const int r0, const int c0, const int lane, float& v0, float& v1) {
    LAS unsigned char* lds = F.lds;
    constexpr int KP = K > 1024 ? 1024 : K, NPASS = K / KP, RB = KP * 2  , SLAB = 32 * RB, NPW = KP / 128  , CPW = KP / 64  ;
    static_assert(K % KP == 0 && KP % 128 == 0 && 2 * SLAB <= MISC_OFF, "skinny shape");
    const int w = F.wave, hh = lane >> 5, l31 = lane & 31;
    f32x16 acc = (f32x16){};
    __syncthreads();
#pragma unroll 1
    for (int ps = 0; ps < NPASS; ++ps) {
#pragma unroll
        for (int i = 0; i < NPW; ++i) { const unsigned pos = 1024u * (w * NPW + i) + 16u * lane, row = pos / RB, chp = (pos % RB) >> 4, ch = chp ^ (row & 15u);
            __builtin_amdgcn_global_load_lds((const unsigned*)(A + (size_t)(r0 + row) * lda + ps * KP + 8 * ch), (LAS unsigned*)(lds + 1024 * (w * NPW + i)), 16, 0, 0);
            __builtin_amdgcn_global_load_lds((const unsigned*)(Bt + (size_t)(c0 + row) * ldb + ps * KP + 8 * ch), (LAS unsigned*)(lds + SLAB + 1024 * (w * NPW + i)), 16, 0, 0); }
        VM_WAIT(); __syncthreads();
#pragma unroll
        for (int s = 0; s < NPW; ++s) { const unsigned ch = (unsigned)(w * CPW + 2 * s + hh) ^ (unsigned)(l31 & 15);
            const bf16x8 af = *(const LAS bf16x8*)(lds + l31 * RB + 16 * ch), bfr = *(const LAS bf16x8*)(lds + SLAB + l31 * RB + 16 * ch);
            acc = __builtin_amdgcn_mfma_f32_32x32x16_bf16(bfr, af, acc, 0, 0, 0); }
        __syncthreads();
    }
#pragma unroll
    for (int r = 0; r < 16; ++r) *(LAS float*)(lds + ((w * 16 + r) * 64 + lane) * 4) = acc[r];
    __syncthreads();
    const int t = F.tid, ln = t & 63, rg = 2 * (t >> 6);
    float s0 = 0.f, s1 = 0.f;
#pragma unroll
    for (int ww = 0; ww < 8; ++ww) { s0 += *(const LAS float*)(lds + ((ww * 16 + rg) * 64 + ln) * 4); s1 += *(const LAS float*)(lds + ((ww * 16 + rg + 1) * 64 + ln) * 4); }
    v0 = s0; v1 = s1;
}
__device__ __forceinline__ void skinny_coord(const int tid, int& row, int& col) { const int ln = tid & 63, rg = 2 * (tid >> 6); row = ln & 31; col = (rg & 3) + 8 * (rg >> 2) + 4 * (ln >> 5); }
constexpr int PA_KB = 64 * 384, PA_VB = 64 * 256;
constexpr int PA_K0 = 0, PA_V0 = 2 * PA_KB, PA_END = PA_V0 + 2 * PA_VB;
static_assert(PA_END <= MISC_OFF, "prompt attention lds");
__device__ __forceinline__ unsigned offK384(unsigned row, unsigned ch) { return 384u * row + 16u * (ch ^ ((row >> 1) & 7)); }
struct PAttnParams { const bf16 *QA, *KN, *KPE, *V; bf16* O; };

__device__ __forceinline__ void pattn_unit(const Frame& F, const PAttnParams& P, const int b, const int h, const int x) {
    LAS unsigned char* lds = F.lds;
    int lane = F.lane; asm volatile("" : "+v"(lane));
    const int w = F.wave, hh = lane >> 5, l31 = lane & 31;
#pragma nounroll
    for (int half = 0; half < 2; ++half) {
    const int xb = half ? 7 - x : x;
    const int tq = 256 * xb + 32 * w + l31;
    const size_t qrow = (size_t)b * SEQ + tq;
    bf16x8 qf[12];
#pragma unroll
    for (int s = 0; s < 12; ++s) qf[s] = *(const bf16x8*)(P.QA + qrow * 1536 + h * 192 + 16 * s + 8 * hh);
    f32x16 o[4];
#pragma unroll
    for (int i = 0; i < 4; ++i) o[i] = (f32x16){};
    float m = -1e30f, l = 0.f;
    const int ntiles = 1 + 4 * (xb + 1);
    unsigned ksrc[3], kstep[3], vsrc[2];
    const char* wsb = (const char*)P.KN - WS_KN;
#pragma unroll
    for (int i = 0; i < 3; ++i) { const unsigned pos = 1024u * (w + 8 * i) + 16u * lane, row = pos / 384u, chp = (pos % 384u) >> 4, ch = chp ^ ((row >> 1) & 7u);
        if (ch < 16) { ksrc[i] = (unsigned)WS_KN + (row * D + h * 128 + 8 * ch) * 2u; kstep[i] = D * 2; } else { ksrc[i] = (unsigned)WS_KPE + (row * 64 + 8 * (ch - 16)) * 2u; kstep[i] = 64 * 2; } }
#pragma unroll
    for (int i = 0; i < 2; ++i) { const unsigned pos = 1024u * (w + 8 * i) + 16u * lane, row = pos >> 8, chp = (pos & 255u) >> 4, ch = chp ^ (((row & 3) << 2) | ((row >> 2) & 3));
        vsrc[i] = (unsigned)WS_V + (row * D + h * 128 + 8 * ch) * 2u; }
    auto issue = [&](int it, int buf) {
        const unsigned row0 = it == 0 ? (unsigned)ROW_M : (unsigned)(b * SEQ + 64 * (it - 1));
#pragma unroll
        for (int i = 0; i < 3; ++i) __builtin_amdgcn_global_load_lds((const unsigned*)(wsb + (ksrc[i] + row0 * kstep[i])), (LAS unsigned*)(lds + PA_K0 + buf * PA_KB + 1024 * (w + 8 * i)), 16, 0, 0);
#pragma unroll
        for (int i = 0; i < 2; ++i) __builtin_amdgcn_global_load_lds((const unsigned*)(wsb + (vsrc[i] + row0 * (unsigned)(D * 2))), (LAS unsigned*)(lds + PA_V0 + buf * PA_VB + 1024 * (w + 8 * i)), 16, 0, 0);
    };
    issue(0, 0); VM_WAIT(); __syncthreads();
    constexpr float SC = SM_SCALE * LOG2E;
    const int trq = (lane & 15) >> 2, trp = lane & 3, trblk = (lane >> 4) & 1;
    unsigned kb4[4], vb8[2][4];
    { const unsigned sw = (l31 >> 1) & 7u, a = sw >> 1, c = sw & 1u;
#pragma unroll
      for (int v = 0; v < 4; ++v) kb4[v] = 384u * l31 + 16u * ((unsigned)hh ^ c) + 32u * ((unsigned)v ^ a);
      const unsigned clo = 2u * trblk + (trp >> 1);
#pragma unroll
      for (int t = 0; t < 2; ++t)
#pragma unroll
          for (int db = 0; db < 4; ++db) vb8[t][db] = 256u * (4u * hh + trq) + 8u * (trp & 1) + 16u * (clo ^ ((2u * t + hh) & 3u)) + 64u * ((unsigned)db ^ (unsigned)trq); }
#pragma nounroll
    for (int it = 0; it < ntiles; ++it) {
        const int buf = it & 1;
        if (it + 1 < ntiles) issue(it + 1, buf ^ 1);
        const int qmin = 256 * xb + 32 * w; const bool skip = (it > 0) && (64 * (it - 1) > qmin + 31);
        const int lim0 = (it == 0) ? NMETA : tq - 64 * (it - 1) + 1, lim1 = (it == 0) ? 0 : lim0 - 32;
        if (!skip) {
            f32x16 p0 = (f32x16){}, p1 = (f32x16){};
            const LAS unsigned char* Kb = lds + PA_K0 + buf * PA_KB;
#pragma unroll
            for (int sg = 0; sg < 6; ++sg) {
#pragma unroll
                for (int s = 2 * sg; s < 2 * sg + 2; ++s) { const bf16x8 a0 = *(const LAS bf16x8*)(Kb + kb4[s & 3] + 128 * (s >> 2)), a1 = *(const LAS bf16x8*)(Kb + kb4[s & 3] + 12288 + 128 * (s >> 2));
                    p0 = __builtin_amdgcn_mfma_f32_32x32x16_bf16(a0, qf[s], p0, 0, 0, 0); p1 = __builtin_amdgcn_mfma_f32_32x32x16_bf16(a1, qf[s], p1, 0, 0, 0); }
                __builtin_amdgcn_sched_barrier(0); }
            float pmax = -3e38f;
#pragma unroll
            for (int r = 0; r < 16; ++r) { const int kl = (r & 3) + 8 * (r >> 2) + 4 * hh;
                float x0 = p0[r] * SC, x1 = p1[r] * SC;
                x0 = kl < lim0 ? x0 : -3e38f; x1 = kl < lim1 ? x1 : -3e38f;
                p0[r] = x0; p1[r] = x1; pmax = fmaxf(pmax, fmaxf(x0, x1)); }
            pmax = fmaxf(pmax, __shfl_xor(pmax, 32));
            const float mn = fmaxf(m, pmax), alpha = fast_exp2(m - mn); m = mn;
            float ps = 0.f;
#pragma unroll
            for (int r = 0; r < 16; ++r) { p0[r] = fast_exp2(p0[r] - mn); p1[r] = fast_exp2(p1[r] - mn); ps += p0[r] + p1[r]; }
            l = l * alpha + ps;
#pragma unroll
            for (int i = 0; i < 4; ++i) o[i] = o[i] * alpha;
            const LAS unsigned char* Vb = lds + PA_V0 + buf * PA_VB;
#pragma unroll
            for (int kb = 0; kb < 2; ++kb)
#pragma unroll
                for (int s2 = 0; s2 < 2; ++s2) {
                    bf16x8 pf; { const f32x16& pp = kb ? p1 : p0; u32x4 t; t.x = cvt_pk_bf16(pp[8 * s2 + 0], pp[8 * s2 + 1]); t.y = cvt_pk_bf16(pp[8 * s2 + 2], pp[8 * s2 + 3]); t.z = cvt_pk_bf16(pp[8 * s2 + 4], pp[8 * s2 + 5]); t.w = cvt_pk_bf16(pp[8 * s2 + 6], pp[8 * s2 + 7]); pf = __builtin_bit_cast(bf16x8, t); }
#pragma unroll
                    for (int db = 0; db < 4; ++db) {
                        const s16x4 t0 = __builtin_amdgcn_ds_read_tr16_b64_v4i16((LAS s16x4*)(Vb + vb8[0][db] + 256 * (32 * kb + 16 * s2)));
                        const s16x4 t1 = __builtin_amdgcn_ds_read_tr16_b64_v4i16((LAS s16x4*)(Vb + vb8[1][db] + 256 * (32 * kb + 16 * s2 + 8)));
                        bf16x8 vf; vf[0] = t0[0]; vf[1] = t0[1]; vf[2] = t0[2]; vf[3] = t0[3]; vf[4] = t1[0]; vf[5] = t1[1]; vf[6] = t1[2]; vf[7] = t1[3];
                        o[db] = __builtin_amdgcn_mfma_f32_32x32x16_bf16(vf, pf, o[db], 0, 0, 0); }
                    __builtin_amdgcn_sched_barrier(0); }
        }
        VM_WAIT(); __syncthreads();
    }
    l += __shfl_xor(l, 32);
    const float il = 1.0f / l;
    bf16* orow = P.O + qrow * D + h * 128;
#pragma unroll
    for (int db = 0; db < 4; ++db)
#pragma unroll
        for (int rq = 0; rq < 4; ++rq) { u32x2 wv; wv.x = cvt_pk_bf16(o[db][4 * rq] * il, o[db][4 * rq + 1] * il); wv.y = cvt_pk_bf16(o[db][4 * rq + 2] * il, o[db][4 * rq + 3] * il);
            *(u32x2*)(orow + 32 * db + 8 * rq + 4 * hh) = wv; }
    __syncthreads();
    }
}
constexpr int SA_CKVB = 32 * 1024, SA_KPEB = 32 * 128;
constexpr int SA_CKV0 = 0, SA_KPE0 = 2 * SA_CKVB, SA_SB = SA_KPE0 + 2 * SA_KPEB, SA_PB = SA_SB + 64 * 36 * 4, SA_AL = SA_PB + 64 * 64, SA_QL2 = SA_AL + 256, SA_END = SA_QL2 + 64 * 576;
constexpr int SA_QL = 0;
static_assert(64 * 576 * 2 <= SA_SB && SA_END <= MISC_OFF, "sample attention lds");
__device__ __forceinline__ unsigned off1024(unsigned row, unsigned ch) { return 1024u * row + 16u * (ch ^ (((row & 3) << 2) | ((row >> 2) & 3))); }
__device__ __forceinline__ unsigned offkpe(unsigned row, unsigned ch) { return 128u * row + 16u * (ch ^ ((row >> 1) & 7)); }
__device__ __forceinline__ unsigned offQ2(unsigned rho, unsigned ch) { return 576u * rho + 16u * (ch ^ ((rho >> 2) & 3)); }
__device__ __forceinline__ unsigned offP(unsigned rho, unsigned ch) { return 64u * rho + 16u * (ch ^ ((rho >> 2) & 3)); }
struct SAttnParams { const float *cckv, *ckpe; const int* pt; const bf16 *QA, *WUKS, *CKVNS, *KPE; float *OPART, *ML; };

__device__ __forceinline__ void sattn_unit(const Frame& F, const SAttnParams& P, const int b, const int sp) {
    LAS unsigned char* lds = F.lds;
    int tid = F.tid; asm volatile("" : "+v"(tid));
    const int lane = tid & 63, w = F.wave, hh = lane >> 5, l31 = lane & 31, l15 = lane & 15, g = lane >> 4;
    {
        const int h = w;
        bf16x8 qa[4];
#pragma unroll
        for (int ks = 0; ks < 4; ++ks) qa[ks] = *(const bf16x8*)(P.QA + (size_t)(ROW_S + b * 8 + (l15 & 7)) * 1536 + h * 192 + 32 * ks + 8 * g);
        const bf16* wk = P.WUKS + ((size_t)h * 512 + l15) * 128 + 8 * g;
        for (int rb = 0; rb < 32; ++rb) {
            f32x4 acc = (f32x4){0.f, 0.f, 0.f, 0.f};
#pragma unroll
            for (int ks = 0; ks < 4; ++ks) { const bf16x8 bw = *(const bf16x8*)(wk + (size_t)rb * 16 * 128 + 32 * ks); acc = __builtin_amdgcn_mfma_f32_16x16x32_bf16(qa[ks], bw, acc, 0, 0, 0); }
            if (g < 2) {
#pragma unroll
                for (int e = 0; e < 4; ++e) *(LAS bf16*)(lds + SA_QL + ((h * 8 + 4 * g + e) * 576 + 16 * rb + l15) * 2) = (bf16)(cvt_pk_bf16(acc[e], 0.f) & 0xffffu);
            }
        }
        { const int rho = tid >> 3, c8 = tid & 7; const int hq = rho >> 3, j = rho & 7;
          *(LAS u32x4*)(lds + SA_QL + (rho * 576 + 512 + 8 * c8) * 2) = *(const u32x4*)(P.QA + (size_t)(ROW_S + b * 8 + j) * 1536 + hq * 192 + 128 + 8 * c8); }
    }
    __syncthreads();
#ifdef DBG_QLAT
    { bf16* dbg = (bf16*)((unsigned char*)P.OPART - WS_OPART + WS_U) + (size_t)(b * NSPLIT + sp) * 64 * 576;
      for (int i = tid; i < 64 * 576 / 8; i += NTHR) *(u32x4*)(dbg + i * 8) = *(const LAS u32x4*)(lds + SA_QL + i * 16); }
#endif
    const int kb = w & 1, rb = w >> 1;
    bf16x8 qb[9];
#pragma unroll
    for (int s = 0; s < 9; ++s) qb[s] = *(const LAS bf16x8*)(lds + SA_QL + ((16 * rb + l15) * 576 + 32 * s + 8 * g) * 2);
    for (int i = tid; i < 64 * 36; i += NTHR) { const int rho = i / 36, c = i % 36; *(LAS u32x4*)(lds + SA_QL2 + offQ2(rho, c)) = *(const LAS u32x4*)(lds + SA_QL + (rho * 576 + 288 + 8 * c) * 2); }
    __syncthreads();
    const unsigned q2b = offQ2(16 * rb + l15, g);
    f32x16 o[2][2];
#pragma unroll
    for (int i = 0; i < 2; ++i)
#pragma unroll
        for (int j = 0; j < 2; ++j) o[i][j] = (f32x16){};
    const int srho = tid >> 3, skg = tid & 7;
    float m = -1e30f, l = 0.f;
    constexpr float SC = SM_SCALE * LOG2E;
    const int ptv = P.pt[b * NPAGES + 16 * sp + (lane & 15)];
    f32x4 crA[8], krA, crB[8], krB;
    auto issue = [&](int it, f32x4 (&cr)[8], f32x4& kr) {
        const unsigned phys = (unsigned)__builtin_amdgcn_readlane(ptv, it >> 2); const unsigned key0 = phys * PAGE + (unsigned)(it & 3) * 32u;
        const char* cbase = (const char*)P.cckv; const char* kbase = (const char*)P.ckpe;
#pragma unroll
        for (int i = 0; i < 4; ++i) { const unsigned off = ((key0 + (tid >> 6) + 8 * i) * KVL + 4 * (tid & 63)) * 4u; cr[2 * i] = *(const f32x4*)(cbase + off); cr[2 * i + 1] = *(const f32x4*)(cbase + off + 1024); }
        kr = *(const f32x4*)(kbase + ((key0 + (tid >> 4)) * QKR + 4 * (tid & 15)) * 4u);
    };
    auto commit = [&](int buf, const f32x4 (&cr)[8], const f32x4& kr) {
#pragma unroll
        for (int i = 0; i < 4; ++i)
#pragma unroll
            for (int hf = 0; hf < 2; ++hf) { const f32x4 v = cr[2 * i + hf]; u32x2 wv; wv.x = cvt_pk_bf16(v[0], v[1]); wv.y = cvt_pk_bf16(v[2], v[3]);
                *(LAS u32x2*)(lds + SA_CKV0 + buf * SA_CKVB + off1024((tid >> 6) + 8 * i, 32 * hf + ((tid & 63) >> 1)) + 8 * (tid & 1)) = wv; }
        u32x2 wv; wv.x = cvt_pk_bf16(kr[0], kr[1]); wv.y = cvt_pk_bf16(kr[2], kr[3]);
        *(LAS u32x2*)(lds + SA_KPE0 + buf * SA_KPEB + offkpe(tid >> 4, (tid & 15) >> 1) + 8 * (tid & 1)) = wv;
    };
    const int trq = l15 >> 2, trp = lane & 3, trblk = g & 1;
    unsigned sa4[4], ka2[2], va4[2][2], pa2[2];
    { const unsigned a = l15 & 3u, c = (l15 >> 2) & 3u, e = (l15 >> 1) & 7u, f = (l31 >> 2) & 3u, clo = 2u * trblk + (trp >> 1);
#pragma unroll
      for (int v = 0; v < 4; ++v) sa4[v] = 1024u * (16u * kb + l15) + 16u * ((unsigned)g ^ c) + 64u * ((unsigned)v ^ a);
#pragma unroll
      for (int s2 = 0; s2 < 2; ++s2) { ka2[s2] = offkpe(16u * kb + l15, 4u * s2 + g); pa2[s2] = offP(l31, 2u * s2 + hh); }
#pragma unroll
      for (int t = 0; t < 2; ++t)
#pragma unroll
          for (int db = 0; db < 2; ++db) va4[t][db] = 1024u * (8u * hh + 4u * t + trq) + 8u * (trp & 1) + 16u * (clo ^ ((2u * hh + t) & 3u)) + 64u * (((2u * (w & 1) + db) ^ (unsigned)trq)) + 256u * (w >> 1); }
    auto compute = [&](const int buf, const bool newtile) {
#ifdef SA_PROBE_SLEEP
        __builtin_amdgcn_s_sleep(SA_PROBE_SLEEP);
#endif
        {
            const LAS unsigned char* Cb = lds + SA_CKV0 + buf * SA_CKVB; const LAS unsigned char* Kb = lds + SA_KPE0 + buf * SA_KPEB;
            f32x4 acc = (f32x4){0.f, 0.f, 0.f, 0.f};
#pragma unroll
            for (int s = 0; s < 16; ++s) { const bf16x8 a = *(const LAS bf16x8*)(Cb + sa4[s & 3] + 256 * (s >> 2));
                const bf16x8 q = s < 9 ? qb[s < 9 ? s : 0] : *(const LAS bf16x8*)(lds + SA_QL2 + q2b + 64 * (s - 9));
                acc = __builtin_amdgcn_mfma_f32_16x16x32_bf16(a, q, acc, 0, 0, 0);
                if ((s & 3) == 3) __builtin_amdgcn_sched_barrier(0); }
#pragma unroll
            for (int s = 0; s < 2; ++s) { const bf16x8 a = *(const LAS bf16x8*)(Kb + ka2[s]); const bf16x8 q = *(const LAS bf16x8*)(lds + SA_QL2 + q2b + 64 * (7 + s));
                acc = __builtin_amdgcn_mfma_f32_16x16x32_bf16(a, q, acc, 0, 0, 0); }
            *(LAS f32x4*)(lds + SA_SB + ((16 * rb + l15) * 36 + 16 * kb + 4 * g) * 4) = acc;
        }
        __syncthreads();
        {
            f32x4 v = *(const LAS f32x4*)(lds + SA_SB + (srho * 36 + 4 * skg) * 4) * SC;
            if (newtile) {
#pragma unroll
                for (int e = 0; e < 4; ++e) if (4 * skg + e > (srho & 7)) v[e] = -3e38f;
            }
            float tm = fmaxf(fmaxf(v[0], v[1]), fmaxf(v[2], v[3]));
            tm = fmaxf(tm, __shfl_xor(tm, 1)); tm = fmaxf(tm, __shfl_xor(tm, 2)); tm = fmaxf(tm, __shfl_xor(tm, 4));
            const float mn = fmaxf(m, tm), alpha = fast_exp2(m - mn); m = mn;
#pragma unroll
            for (int e = 0; e < 4; ++e) v[e] = fast_exp2(v[e] - mn);
            float ps = (v[0] + v[1]) + (v[2] + v[3]);
            ps += __shfl_xor(ps, 1); ps += __shfl_xor(ps, 2); ps += __shfl_xor(ps, 4);
            l = l * alpha + ps;
            u32x2 wv; wv.x = cvt_pk_bf16(v[0], v[1]); wv.y = cvt_pk_bf16(v[2], v[3]);
            *(LAS u32x2*)(lds + SA_PB + offP(srho, skg >> 1) + 8 * (skg & 1)) = wv;
            if (skg == 0) *(LAS float*)(lds + SA_AL + srho * 4) = alpha;
        }
    };
    auto pv = [&](const int buf) {
        const LAS unsigned char* Cb = lds + SA_CKV0 + buf * SA_CKVB;
        const float a0 = *(const LAS float*)(lds + SA_AL + l31 * 4), a1 = *(const LAS float*)(lds + SA_AL + (32 + l31) * 4);
#pragma unroll
        for (int db = 0; db < 2; ++db) { o[db][0] = o[db][0] * a0; o[db][1] = o[db][1] * a1; }
#pragma unroll
        for (int s2 = 0; s2 < 2; ++s2) {
            const bf16x8 pb0 = *(const LAS bf16x8*)(lds + SA_PB + pa2[s2]), pb1 = *(const LAS bf16x8*)(lds + SA_PB + pa2[s2] + 2048);
#pragma unroll
            for (int db = 0; db < 2; ++db) {
                const s16x4 t0 = __builtin_amdgcn_ds_read_tr16_b64_v4i16((LAS s16x4*)(Cb + va4[0][db] + 16384 * s2));
                const s16x4 t1 = __builtin_amdgcn_ds_read_tr16_b64_v4i16((LAS s16x4*)(Cb + va4[1][db] + 16384 * s2));
                bf16x8 vf; vf[0] = t0[0]; vf[1] = t0[1]; vf[2] = t0[2]; vf[3] = t0[3]; vf[4] = t1[0]; vf[5] = t1[1]; vf[6] = t1[2]; vf[7] = t1[3];
                o[db][0] = __builtin_amdgcn_mfma_f32_32x32x16_bf16(vf, pb0, o[db][0], 0, 0, 0);
                o[db][1] = __builtin_amdgcn_mfma_f32_32x32x16_bf16(vf, pb1, o[db][1], 0, 0, 0); } }
    };
    constexpr int NT = (PAST / NSPLIT) / 32;
    issue(0, crA, krA); commit(0, crA, krA); issue(1, crB, krB); issue(2, crA, krA); __syncthreads();
#pragma nounroll
    for (int it = 0; it < NT; it += 2) {
        compute(0, false);
        commit(1, crB, krB); if (it + 3 < NT) issue(it + 3, crB, krB);
        __syncthreads();
        pv(0);
        compute(1, false);
        if (it + 2 < NT) { commit(0, crA, krA); if (it + 4 < NT) issue(it + 4, crA, krA); }
        __syncthreads();
        pv(1);
    }
    if (sp == NSPLIT - 1) {
        __syncthreads();
        { const char* wsb = (const char*)P.KPE - WS_KPE;
#pragma nounroll
          for (int i = tid; i < 32 * 64; i += NTHR) { const int key = i >> 6, ch = i & 63; u32x4 v = (u32x4){0u, 0u, 0u, 0u}; if (key < DS) v = *(const u32x4*)(wsb + ((unsigned)WS_CKVNS + (unsigned)(((b * DS + key) * KVL + 8 * ch) * 2)));
            *(LAS u32x4*)(lds + SA_CKV0 + off1024(key, ch)) = v; }
          if (tid < 32 * 8) { const int key = tid >> 3, ch = tid & 7; u32x4 v = (u32x4){0u, 0u, 0u, 0u}; if (key < DS) v = *(const u32x4*)(wsb + ((unsigned)WS_KPE + (unsigned)(((ROW_S + b * DS + key) * 64 + 8 * ch) * 2)));
            *(LAS u32x4*)(lds + SA_KPE0 + offkpe(key, ch)) = v; } }
        __syncthreads();
        compute(0, true);
        __syncthreads();
        pv(0);
    }
    float* op = P.OPART + ((size_t)(b * NSPLIT + sp) * 64) * KVL;
#pragma unroll
    for (int db = 0; db < 2; ++db)
#pragma unroll
        for (int rbk = 0; rbk < 2; ++rbk)
#pragma unroll
            for (int rq = 0; rq < 4; ++rq) *(f32x4*)(op + (size_t)(32 * rbk + l31) * KVL + 64 * w + 32 * db + 8 * rq + 4 * hh) = (f32x4){o[db][rbk][4 * rq], o[db][rbk][4 * rq + 1], o[db][rbk][4 * rq + 2], o[db][rbk][4 * rq + 3]};
    if (skg == 0) *(f32x2*)(P.ML + ((size_t)(b * NSPLIT + sp) * 64 + srho) * 2) = (f32x2){m, l};
    __syncthreads();
}

struct SCombParams { const float *OPART, *ML, *w_uv; bf16* O; };
__device__ __forceinline__ void scomb_unit(const Frame& F, const SCombParams& P, const int b, const int h) {
    LAS float* OL = (LAS float*)F.lds;
    int tid = F.tid; asm volatile("" : "+v"(tid));
    {
        const int r = tid;
#pragma unroll
        for (int j = 0; j < 8; ++j) { const int rho = h * 8 + j; float mm[NSPLIT], ll[NSPLIT], M = -3e38f;
#pragma unroll
            for (int s = 0; s < NSPLIT; ++s) { const f32x2 v = *(const f32x2*)(P.ML + ((size_t)(b * NSPLIT + s) * 64 + rho) * 2); mm[s] = v.x; ll[s] = v.y; M = fmaxf(M, v.x); }
            float L = 0.f, acc = 0.f;
#pragma unroll
            for (int s = 0; s < NSPLIT; ++s) { const float wgt = fast_exp2(mm[s] - M); L += wgt * ll[s]; acc += wgt * P.OPART[((size_t)(b * NSPLIT + s) * 64 + rho) * KVL + r]; }
            OL[j * 512 + r] = acc / L; }
    }
    __syncthreads();
    {
        const int d = tid & 127, rq = tid >> 7; float acc[8];
#pragma unroll
        for (int j = 0; j < 8; ++j) acc[j] = 0.f;
        const float* wp = P.w_uv + (size_t)(128 * rq) * 1024 + h * 128 + d;
#pragma unroll 16
        for (int r = 0; r < 128; ++r) { const float wv = wp[(size_t)r * 1024];
#pragma unroll
            for (int j = 0; j < 8; ++j) acc[j] += OL[j * 512 + 128 * rq + r] * wv; }
        LAS float* PT = OL + 8 * 512;
#pragma unroll
        for (int j = 0; j < 8; ++j) PT[(rq * 8 + j) * 128 + d] = acc[j];
        __syncthreads();
        const int j = tid >> 6, d2 = (tid & 63) * 2;
        const float o0 = (PT[(0 * 8 + j) * 128 + d2] + PT[(1 * 8 + j) * 128 + d2]) + (PT[(2 * 8 + j) * 128 + d2] + PT[(3 * 8 + j) * 128 + d2]);
        const float o1 = (PT[(0 * 8 + j) * 128 + d2 + 1] + PT[(1 * 8 + j) * 128 + d2 + 1]) + (PT[(2 * 8 + j) * 128 + d2 + 1] + PT[(3 * 8 + j) * 128 + d2 + 1]);
        *(unsigned*)(P.O + (size_t)(ROW_S + b * 8 + j) * D + h * 128 + d2) = cvt_pk_bf16(o0, o1);
    }
    __syncthreads();
}
__device__ __forceinline__ void thin_ckv_conv(const Frame& F, const Args& args) {
    unsigned char* ws = F.ws; float* out = F.out;
    const int gw = F.vcu * NWAVES + F.wave, NGW = F.G * NWAVES, lane = F.lane;
    const bf16* CKVR = (const bf16*)(ws + WS_CKVR); const float* SSQ = (const float*)(ws + WS_SSQKV); const bf16* RX = (const bf16*)(ws + WS_RX);
    const f32x4 g0 = *(const f32x4*)(IN_F(I_KVG) + 8 * lane), g1 = *(const f32x4*)(IN_F(I_KVG) + 8 * lane + 4);
    for (int row = gw; row < ROW_M + NMETA; row += NGW) {
        const f32x4 s0 = *(const f32x4*)(SSQ + (size_t)row * 8), s1 = *(const f32x4*)(SSQ + (size_t)row * 8 + 4);
        const float ss = ((s0[0] + s0[1]) + (s0[2] + s0[3])) + ((s1[0] + s1[1]) + (s1[2] + s1[3]));
        const float rstd = __builtin_amdgcn_rsqf(ss * (1.0f / KVL) + EPS);
        f32x4 v0, v1; pg8::unpack8(*(const u32x4*)(CKVR + (size_t)row * KVL + 8 * lane), v0, v1);
        v0 = v0 * rstd * g0; v1 = v1 * rstd * g1;
        if (row < ROW_S) { float* o = out + O_PCKV + ((size_t)(row >> 11) * TP + NMETA + (row & (SEQ - 1))) * KVL + 8 * lane; *(f32x4*)o = v0; *(f32x4*)(o + 4) = v1; }
        else if (row < ROW_M) { float* o = out + O_SCKV + (size_t)(row - ROW_S) * KVL + 8 * lane; *(f32x4*)o = v0; *(f32x4*)(o + 4) = v1;
            *(u32x4*)((bf16*)(ws + WS_CKVNS) + (size_t)(row - ROW_S) * KVL + 8 * lane) = pg8::pack8(v0, v1); }
        else { for (int b = 0; b < NB; ++b) { float* o = out + O_PCKV + ((size_t)b * TP + (row - ROW_M)) * KVL + 8 * lane; *(f32x4*)o = v0; *(f32x4*)(o + 4) = v1; } }
    }
    for (int i = gw; i < NB * 3 + DB * 3; i += NGW) {
        int srow; float* o;
        if (i < NB * 3) { const int b = i / 3, k = i % 3; srow = b * SEQ + SEQ - 3 + k; o = out + O_PCONV + (size_t)i * D; }
        else { const int q = i - NB * 3, b = q / 3, k = q % 3; srow = ROW_S + b * DS + DS - 3 + k; o = out + O_SCONV + (size_t)q * D; }
#pragma unroll
        for (int j = 0; j < 2; ++j) { f32x4 v0, v1; pg8::unpack8(*(const u32x4*)(RX + (size_t)srow * D + 8 * (lane + 64 * j)), v0, v1); *(f32x4*)(o + 8 * (lane + 64 * j)) = v0; *(f32x4*)(o + 8 * (lane + 64 * j) + 4) = v1; }
    }
}

constexpr int NPHASES = 11;
__global__ void __launch_bounds__(NTHR, 2) hawk_fwd(Args args) {
    extern __shared__ __attribute__((aligned(16))) unsigned char lds_raw[];
    Frame F;
    F.lds = (LAS unsigned char*)lds_raw; F.MISC = (volatile LAS unsigned*)(F.lds + MISC_OFF);
    F.tid = threadIdx.x; F.lane = F.tid & 63; F.wave = __builtin_amdgcn_readfirstlane(F.tid >> 6);
    F.G = gridDim.x; { const int bx = blockIdx.x; F.vcu = (F.G % 8 == 0) ? (bx % 8) * (F.G / 8) + bx / 8 : bx; }
    F.out = args.out; F.ws = args.ws; F.ctl = (unsigned*)(args.ws + WS_CTL);
    unsigned char* ws = args.ws;
    for (int u = F.tid; u < 64; u += NTHR) ((LAS unsigned*)(F.lds + MISC_OFF))[u] = 0u;
    __syncthreads();
#if MK_PER_PHASE
#define GRID_BAR() do { } while (0)
#else
    XcdBarrier bar = xcd_barrier_post((unsigned*)F.ctl + CW_BAR, F.MISC + 8);
#define GRID_BAR() xcd_barrier(bar)
#endif
    const int lo = args.ph_lo, hi = args.ph_hi;
#ifndef PH_MASK
#define PH_MASK 0x7ff
#endif
#define IN(k) ((((PH_MASK) >> (k)) & 1) && lo <= (k) && (k) < hi)
#ifndef DUP_MASK
#define DUP_MASK 0
#endif
#ifndef P3DUP
#define P3DUP 0
#endif
#ifndef P2DUP
#define P2DUP 0
#endif
#ifndef P5DUP
#define P5DUP 0
#endif
#ifndef P8DUP
#define P8DUP 0
#endif
#define DUPL(mask, bit) _Pragma("nounroll") for (int dup_ = 0; dup_ < 1 + (((mask) >> (bit)) & 1); ++dup_)
#define REP(k) _Pragma("nounroll") for (int rep_ = 0; rep_ < 1 + (((DUP_MASK) >> (k)) & 1); ++rep_)
#define SEAM(k) do { if (IN(k) && IN((k) + 1)) GRID_BAR(); F.tid = threadIdx.x; F.lane = F.tid & 63; } while (0)
    const int G = F.G, bx = blockIdx.x;

    if (IN(0)) REP(0) { p0_prologue(F, args); }
    SEAM(0);
    if (IN(1)) REP(1) {
        pg8::TileSched S; S.init(ws + WS_H, ws + WS_WIN, D, 66, 22, G, bx);
        pg8::EpiWin E{(bf16*)(ws + WS_RX), (bf16*)(ws + WS_GRG), (bf16*)(ws + WS_CQ), (bf16*)(ws + WS_CKVR), (bf16*)(ws + WS_G), (bf16*)(ws + WS_KPE), (float*)(ws + WS_SSQQ), (float*)(ws + WS_SSQKV),
                      IN_F(I_BGATE), (const float*)(ws + WS_ROPEC), (const float*)(ws + WS_ROPES), F.out};
        pg8::gemm_phase<pg8::EpiWin, pg8::TileSched, true, true>(F.lds, D, S, E);
    }
    SEAM(1);
    const RgParams RGP{(const bf16*)(ws + WS_RX), (const bf16*)(ws + WS_GRG), (const bf16*)(ws + WS_WAX), (bf16*)(ws + WS_HRG), IN_F(I_CONVW), IN_F(I_CONVB), IN_F(I_BA), IN_F(I_BX),
                       (const float*)(ws + WS_SPL), IN_F(I_SCONV), IN_F(I_SRG), (float*)(ws + WS_SEG), F.out};
    if (IN(2)) REP(2) {
        DUPL(P2DUP, 0) if (G == 256) { const int u = bx < 64 ? bx : (bx >= 128 ? bx - 64 : -1); if (u >= 0) rg_unit<0>(F, RGP, u / 24, (u / 3) % 8, u % 3); }
        else for (int u = F.vcu; u < 192; u += G) rg_unit<0>(F, RGP, u / 24, (u / 3) % 8, u % 3);
        DUPL(P2DUP, 1) { pg8::TileSched S; S.init(ws + WS_CQ, ws + WS_WQ, QL, 64, 6, G, bx);
          pg8::EpiQ E{(bf16*)(ws + WS_QA), (const float*)(ws + WS_SSQQ), (const float*)(ws + WS_ROPEC), (const float*)(ws + WS_ROPES)};
          pg8::gemm_phase<pg8::EpiQ, pg8::TileSched, true, true>(F.lds, QL, S, E); }
        DUPL(P2DUP, 2) { pg8::EpiKV E{(bf16*)(ws + WS_KN), (bf16*)(ws + WS_V), (const float*)(ws + WS_SSQKV)};
          if (G == 256) { pg8::KvSched S; S.init(ws + WS_CKVR, ws + WS_WKV, KVL, 64, 8, G, bx); pg8::gemm_phase<pg8::EpiKV, pg8::KvSched, true, true>(F.lds, KVL, S, E); }
          else { pg8::TileSched S; S.init(ws + WS_CKVR, ws + WS_WKV, KVL, 64, 8, G, bx); pg8::gemm_phase<pg8::EpiKV, pg8::TileSched, true, true>(F.lds, KVL, S, E); } }
        DUPL(P2DUP, 3) {
            int lane_ = F.lane; asm volatile("" : "+v"(lane_));
            int trow, tcol; skinny_coord(F.tid, trow, tcol);
            const bf16* CQs = (const bf16*)(ws + WS_CQ); const bf16* WQs = (const bf16*)(ws + WS_WQ); bf16* QAs = (bf16*)(ws + WS_QA); const float* SQ = (const float*)(ws + WS_SSQQ);
            for (int u = F.vcu; u < 8 * 40 + 64; u += G) {
                if (u < 8 * 40) {
                    const int rt = u / 40, ci = u % 40, r0 = ROW_S + 32 * rt, row = r0 + trow;
                    float ss = 0.f;
#pragma unroll
                    for (int i = 0; i < 12; ++i) ss += SQ[(size_t)row * 12 + i];
                    const float rstd = __builtin_amdgcn_rsqf(ss * (1.0f / QL) + EPS);
                    if (ci < 32) { float v0, v1; skinny_partial<768>(F, CQs, QL, WQs, QL, r0, 32 * ci, lane_, v0, v1);
                        const int col = 32 * ci + tcol, h = col >> 7, d = col & 127;
                        *(unsigned*)(QAs + (size_t)row * 1536 + h * 192 + d) = cvt_pk_bf16(v0 * rstd, v1 * rstd); }
                    else { const int h = ci - 32, c1 = 1024 + 256 * (h >> 2) + 32 * (h & 3); float a0, a1, b0, b1;
                        skinny_partial<768>(F, CQs, QL, WQs, QL, r0, c1, lane_, a0, a1); skinny_partial<768>(F, CQs, QL, WQs, QL, r0, c1 + 128, lane_, b0, b1);
                        const int pi = rope_idx_of_row(row); const float* rc = (const float*)(ws + WS_ROPEC) + pi * 32 + tcol; const float* rs = (const float*)(ws + WS_ROPES) + pi * 32 + tcol;
                        a0 *= rstd; a1 *= rstd; b0 *= rstd; b1 *= rstd;
                        *(unsigned*)(QAs + (size_t)row * 1536 + h * 192 + 128 + tcol) = cvt_pk_bf16(a0 * rc[0] - b0 * rs[0], a1 * rc[1] - b1 * rs[1]);
                        *(unsigned*)(QAs + (size_t)row * 1536 + h * 192 + 160 + tcol) = cvt_pk_bf16(a0 * rs[0] + b0 * rc[0], a1 * rs[1] + b1 * rc[1]); }
                } else {
                    const int ci = u - 8 * 40, row = ROW_M + trow; float v0, v1;
                    skinny_partial<512>(F, (const bf16*)(ws + WS_CKVR), KVL, (const bf16*)(ws + WS_WKV), KVL, ROW_M, 32 * ci, lane_, v0, v1);
                    const float* SK = (const float*)(ws + WS_SSQKV) + (size_t)row * 8; const float ss = ((SK[0] + SK[1]) + (SK[2] + SK[3])) + ((SK[4] + SK[5]) + (SK[6] + SK[7]));
                    const float rstd = __builtin_amdgcn_rsqf(ss * (1.0f / KVL) + EPS); const int col = 32 * ci + tcol;
                    bf16* dst = col < 1024 ? (bf16*)(ws + WS_KN) + (size_t)row * D + col : (bf16*)(ws + WS_V) + (size_t)row * D + (col - 1024);
                    *(unsigned*)dst = cvt_pk_bf16(v0 * rstd, v1 * rstd); }
            }
            __syncthreads();
        }
        DUPL(P2DUP, 4) thin_ckv_conv(F, args);
    }
    SEAM(2);
    if (IN(3)) {
        const PAttnParams PA{(const bf16*)(ws + WS_QA), (const bf16*)(ws + WS_KN), (const bf16*)(ws + WS_KPE), (const bf16*)(ws + WS_V), (bf16*)(ws + WS_O)};
        const SAttnParams SA{IN_F(I_CCKV), IN_F(I_CKPE), (const int*)args.in[I_PT], (const bf16*)(ws + WS_QA), (const bf16*)(ws + WS_WUKS), (const bf16*)(ws + WS_CKVNS), (const bf16*)(ws + WS_KPE),
                             (float*)(ws + WS_OPART), (float*)(ws + WS_ML)};
#ifndef SFIRST_ALL
        const bool sfirst = (F.vcu & 1) == 0;
#else
        const bool sfirst = true;
#endif
#ifndef P3_MASK
#define P3_MASK 7
#endif
#ifdef P3_SPECIAL
        if ((F.vcu & 1) == 0) { for (int u = F.vcu; u < F.vcu + 2; ++u) sattn_unit(F, SA, u / NSPLIT, u % NSPLIT); }
        else { for (int u = F.vcu - 1; u <= F.vcu; ++u) { const int bh = u >> 2; pattn_unit(F, PA, bh >> 3, bh & 7, u & 3); }
               for (int u = F.vcu - 1; u <= F.vcu; ++u) rg_unit<1>(F, RGP, u >> 5, (u >> 2) & 7, u & 3);
               if (F.vcu < 64) { const int u = F.vcu >> 1; rg_unit<2>(F, RGP, u >> 3, u & 7, 0); } }
#else
#pragma nounroll
        for (int ph = 0; ph < 2; ++ph) {
            if ((ph == 0) == sfirst) { if (P3_MASK & 1) for (int r3 = 0; r3 < 1 + (P3DUP & 1); ++r3) for (int u = F.vcu; u < DB * NSPLIT; u += G) sattn_unit(F, SA, u / NSPLIT, u % NSPLIT); }
            else { if (P3_MASK & 2) for (int r3 = 0; r3 < 1 + ((P3DUP >> 1) & 1); ++r3) for (int u = F.vcu; u < 256; u += G) { const int bh = u >> 2; pattn_unit(F, PA, bh >> 3, bh & 7, u & 3); } }
        }
        if (P3_MASK & 4) for (int r3 = 0; r3 < 1 + ((P3DUP >> 2) & 1); ++r3) for (int u = F.vcu; u < 256; u += G) rg_unit<1>(F, RGP, u >> 5, (u >> 2) & 7, u & 3);
        if (P3_MASK & 4) for (int u = F.vcu; u < 32; u += G) rg_unit<2>(F, RGP, u >> 3, u & 7, 0);
#endif
    }
    SEAM(3);
    if (IN(4)) REP(4) {
        const SCombParams SC{(const float*)(ws + WS_OPART), (const float*)(ws + WS_ML), IN_F(I_WUV), (bf16*)(ws + WS_O)};
        for (int u = F.vcu; u < DB * NH; u += G) scomb_unit(F, SC, u >> 3, u & 7);
    }
    SEAM(4);
    if (IN(5)) REP(5) {
        DUPL(P5DUP, 0) { pg8::TileSched S; S.init(ws + WS_HRG, ws + WS_WBRR, D, 64, 4, G, bx); pg8::EpiZ<0> E{(bf16*)(ws + WS_MIX), (const bf16*)(ws + WS_G)};
          pg8::gemm_phase<pg8::EpiZ<0>, pg8::TileSched, true, true>(F.lds, D, S, E); }
        { pg8::TileSched S; S.init(ws + WS_O, ws + WS_WBRM, D, 64, 4, G, bx); pg8::EpiZ<1> E{(bf16*)(ws + WS_MIX), (const bf16*)(ws + WS_G)};
          pg8::gemm_phase<pg8::EpiZ<1>, pg8::TileSched, true, true>(F.lds, D, S, E); }
        DUPL(P5DUP, 2) {
            int lane_ = F.lane; asm volatile("" : "+v"(lane_));
            int trow, tcol; skinny_coord(F.tid, trow, tcol);
            for (int u = F.vcu; u < 8 * 32; u += G) { const int r0 = ROW_S + 32 * (u >> 5), c0 = 32 * (u & 31), row = r0 + trow, col = c0 + tcol; float a0, a1, b0, b1;
                skinny_partial<1024>(F, (const bf16*)(ws + WS_HRG), D, (const bf16*)(ws + WS_WBRR), D, r0, c0, lane_, a0, a1);
                skinny_partial<1024>(F, (const bf16*)(ws + WS_O), D, (const bf16*)(ws + WS_WBRM), D, r0, c0, lane_, b0, b1);
                const unsigned gr = *(const unsigned*)((const bf16*)(ws + WS_G) + (size_t)row * 2048 + col), gm = *(const unsigned*)((const bf16*)(ws + WS_G) + (size_t)row * 2048 + D + col);
                *(unsigned*)((bf16*)(ws + WS_MIX) + (size_t)row * D + col) = cvt_pk_bf16(bflo(gr) * a0 + bflo(gm) * b0, bfhi(gr) * a1 + bfhi(gm) * b1); }
            __syncthreads();
        }
    }
    SEAM(5);
    if (IN(6)) REP(6) {
        pg8::TileSched S; S.init(ws + WS_MIX, ws + WS_WO, D, 64, 4, G, bx); pg8::EpiRes E{(bf16*)(ws + WS_PRE), (const bf16*)(ws + WS_H), nullptr};
        pg8::gemm_phase<pg8::EpiRes, pg8::TileSched, true, true>(F.lds, D, S, E);
        {   int lane_ = F.lane; asm volatile("" : "+v"(lane_));
            int trow, tcol; skinny_coord(F.tid, trow, tcol);
            for (int u = F.vcu; u < 8 * 32; u += G) { const int r0 = ROW_S + 32 * (u >> 5), c0 = 32 * (u & 31), row = r0 + trow, col = c0 + tcol; float a0, a1;
                skinny_partial<1024>(F, (const bf16*)(ws + WS_MIX), D, (const bf16*)(ws + WS_WO), D, r0, c0, lane_, a0, a1);
                const unsigned hv = *(const unsigned*)((const bf16*)(ws + WS_H) + (size_t)row * D + col);
                *(unsigned*)((bf16*)(ws + WS_PRE) + (size_t)row * D + col) = cvt_pk_bf16(DN_ALPHA * bflo(hv) + a0, DN_ALPHA * bfhi(hv) + a1); }
            __syncthreads();
        }
    }
    SEAM(6);
    if (IN(7)) REP(7) {
        const int gw = F.vcu * NWAVES + F.wave, NGW = G * NWAVES;
        for (int row = gw; row < ROW_M; row += NGW) ln_row<true>((const bf16*)(ws + WS_PRE) + (size_t)row * D, IN_F(I_LN1G), IN_F(I_LN1B), (bf16*)(ws + WS_X1) + (size_t)row * D, nullptr, F.lane);
    }
    SEAM(7);
    if (IN(8)) REP(8) {
        pg8::TileSched S; S.init(ws + WS_X1, ws + WS_WUP, D, 64, 16, G, bx); pg8::EpiUp E{(bf16*)(ws + WS_U), IN_F(I_BUP)};
        DUPL(P8DUP, 0) pg8::gemm_phase<pg8::EpiUp, pg8::TileSched, true, true>(F.lds, D, S, E);
        {   int lane_ = F.lane; asm volatile("" : "+v"(lane_));
            int trow, tcol; skinny_coord(F.tid, trow, tcol);
            for (int u = F.vcu; u < 8 * 128; u += G) { const int r0 = ROW_S + 32 * (u >> 7), c0 = 32 * (u & 127), row = r0 + trow, col = c0 + tcol; float a0, a1;
                skinny_partial<1024>(F, (const bf16*)(ws + WS_X1), D, (const bf16*)(ws + WS_WUP), D, r0, c0, lane_, a0, a1);
                a0 = fmaxf(a0 + IN_F(I_BUP)[col], 0.f); a1 = fmaxf(a1 + IN_F(I_BUP)[col + 1], 0.f);
                *(unsigned*)((bf16*)(ws + WS_U) + (size_t)row * DFF + col) = cvt_pk_bf16(a0 * a0, a1 * a1); }
            __syncthreads();
        }
    }
    SEAM(8);
    if (IN(9)) REP(9) {
        pg8::TileSched S; S.init(ws + WS_U, ws + WS_WDN, DFF, 64, 4, G, bx); pg8::EpiRes E{(bf16*)(ws + WS_PRE), (const bf16*)(ws + WS_X1), IN_F(I_BDN)};
        pg8::gemm_phase<pg8::EpiRes, pg8::TileSched, true, true>(F.lds, DFF, S, E);
        {   int lane_ = F.lane; asm volatile("" : "+v"(lane_));
            int trow, tcol; skinny_coord(F.tid, trow, tcol);
            for (int u = F.vcu; u < 8 * 32; u += G) { const int r0 = ROW_S + 32 * (u >> 5), c0 = 32 * (u & 31), row = r0 + trow, col = c0 + tcol; float a0, a1;
                skinny_partial<4096>(F, (const bf16*)(ws + WS_U), DFF, (const bf16*)(ws + WS_WDN), DFF, r0, c0, lane_, a0, a1);
                const unsigned xv = *(const unsigned*)((const bf16*)(ws + WS_X1) + (size_t)row * D + col);
                *(unsigned*)((bf16*)(ws + WS_PRE) + (size_t)row * D + col) = cvt_pk_bf16(DN_ALPHA * bflo(xv) + a0 + IN_F(I_BDN)[col], DN_ALPHA * bfhi(xv) + a1 + IN_F(I_BDN)[col + 1]); }
            __syncthreads();
        }
    }
    SEAM(9);
    if (IN(10)) REP(10) {
        const int gw = F.vcu * NWAVES + F.wave, NGW = G * NWAVES;
        for (int row = gw; row < ROW_M; row += NGW) { float* o = row < ROW_S ? F.out + O_YP + (size_t)row * D : F.out + O_YS + (size_t)(row - ROW_S) * D;
            ln_row<true>((const bf16*)(ws + WS_PRE) + (size_t)row * D, IN_F(I_LN2G), IN_F(I_LN2B), nullptr, o, F.lane); }
    }
#ifdef DBG_DUMP_OFF
    if (lo == 99) {
#ifdef DBG_DUMP_F32
        const float* srcf = (const float*)(ws + (size_t)(DBG_DUMP_OFF));
        for (size_t i = (size_t)F.vcu * NTHR + F.tid; i < (size_t)(DBG_DUMP_F32) / 4; i += (size_t)G * NTHR) *(f32x4*)(F.out + i * 4) = *(const f32x4*)(srcf + i * 4);
#else
#ifndef DBG_DUMP_N
#define DBG_DUMP_N ((size_t)ROW_M * D)
#endif
        const bf16* src = (const bf16*)(ws + (size_t)(DBG_DUMP_OFF));
        for (size_t i = (size_t)F.vcu * NTHR + F.tid; i < (size_t)(DBG_DUMP_N) / 8; i += (size_t)G * NTHR) { f32x4 v0, v1; pg8::unpack8(*(const u32x4*)(src + i * 8), v0, v1); *(f32x4*)(F.out + i * 8) = v0; *(f32x4*)(F.out + i * 8 + 4) = v1; }
#endif
    }
#endif
#undef IN
#undef SEAM
}

extern "C" void kernel_launch(void* const* d_in, const int* in_sizes, int n_in, void* d_out, int out_size, void* d_ws, size_t ws_size, hipStream_t stream) {
    static int grid = 0;
    if (grid == 0) {
        if (n_in != 35 || out_size != (int)O_END || ws_size < WS_END) { fprintf(stderr, "kernel_launch: unexpected shapes (n_in %d, out %d, ws %zu, need %zu)\n", n_in, out_size, ws_size, (size_t)WS_END); grid = -1; return; }
        int dev = 0, cus = 0, per_cu = 0;
        if (hipGetDevice(&dev) != hipSuccess || hipDeviceGetAttribute(&cus, hipDeviceAttributeMultiprocessorCount, dev) != hipSuccess) { grid = -1; return; }
        if (hipFuncSetAttribute((const void*)hawk_fwd, hipFuncAttributeMaxDynamicSharedMemorySize, LDS_BYTES) != hipSuccess) { fprintf(stderr, "kernel_launch: hipFuncSetAttribute failed\n"); grid = -1; return; }
        if (hipOccupancyMaxActiveBlocksPerMultiprocessor(&per_cu, (const void*)hawk_fwd, NTHR, LDS_BYTES) != hipSuccess || per_cu < 1) fprintf(stderr, "kernel_launch: occupancy query reports %d\n", per_cu);
        (void)hipGetLastError();
        grid = cus;
    }
    if (grid < 0) return;
    if (hipMemsetAsync((char*)d_ws + WS_CTL, 0, CTL_BYTES, stream) != hipSuccess) return;
    Args a{};
    for (int i = 0; i < 35; ++i) a.in[i] = d_in[i];
    a.out = (float*)d_out; a.ws = (unsigned char*)d_ws;
#if MK_PER_PHASE
#ifndef DBG_LAST_PHASE
#define DBG_LAST_PHASE (NPHASES - 1)
#endif
    if (DBG_LAST_PHASE < NPHASES - 1) (void)hipMemsetAsync(d_out, 0, (size_t)out_size * 4, stream);
    for (int p = 0; p <= DBG_LAST_PHASE; ++p) { a.ph_lo = p; a.ph_hi = p + 1; hipLaunchKernelGGL(hawk_fwd, dim3(grid), dim3(NTHR), LDS_BYTES, stream, a); }
#ifdef DBG_DUMP_OFF
    a.ph_lo = 99; a.ph_hi = 100; hipLaunchKernelGGL(hawk_fwd, dim3(grid), dim3(NTHR), LDS_BYTES, stream, a);
#endif
#else
    a.ph_lo = 0; a.ph_hi = NPHASES;
    hipLaunchKernelGGL(hawk_fwd, dim3(grid), dim3(NTHR), LDS_BYTES, stream, a);
#endif
}
```

```cpp
#include <hip/hip_runtime.h>
#include <cstdio>
#include <cstdint>

#ifndef MK_PER_PHASE
#define MK_PER_PHASE 0
#endif

#define GAS __attribute__((address_space(1)))
#define LAS __attribute__((address_space(3)))
typedef unsigned short bf16;
typedef short bf16x8 __attribute__((ext_vector_type(8)));
typedef short s16x4 __attribute__((ext_vector_type(4)));
typedef float f32x2 __attribute__((ext_vector_type(2)));
typedef float f32x4 __attribute__((ext_vector_type(4)));
typedef float f32x16 __attribute__((ext_vector_type(16)));
typedef unsigned u32x2 __attribute__((ext_vector_type(2)));
typedef unsigned u32x4 __attribute__((ext_vector_type(4)));

constexpr int D = 1024, NB = 8, SEQ = 2048, NMETA = 16, TP = SEQ + NMETA;
constexpr int DB = 32, DS = 8, PAST = 16384, PAGE = 128, NPAGES = PAST / PAGE;
constexpr int NH = 8, QKN = 128, QKR = 64, VH = 128, KVL = 512, QL = 768, DFF = 4096;
constexpr int NIN = 5440, NINP = 5632;
constexpr int ROW_S = NB * SEQ;
constexpr int ROW_M = ROW_S + DB * DS;
constexpr int R = 16896;
constexpr float EPS = 1e-5f;
constexpr float DN_ALPHA = 1.189207115002721f;
constexpr float SM_SCALE = 0.07216878364870322f;
constexpr float LOG2E = 1.4426950408889634f;
constexpr int NROPE = TP + DS;
constexpr int NSPLIT = 8;

constexpr size_t O_YP = 0, O_YS = O_YP + (size_t)NB * SEQ * D, O_PCKV = O_YS + (size_t)DB * DS * D, O_PKPE = O_PCKV + (size_t)NB * TP * KVL,
    O_PCONV = O_PKPE + (size_t)NB * TP * QKR, O_PH = O_PCONV + (size_t)NB * 3 * D, O_SCKV = O_PH + (size_t)NB * D, O_SKPE = O_SCKV + (size_t)DB * DS * KVL,
    O_SCONV = O_SKPE + (size_t)DB * DS * QKR, O_SH = O_SCONV + (size_t)DB * 3 * D, O_END = O_SH + (size_t)DB * D;
static_assert(O_END == 26861568, "output size");

constexpr size_t al256(size_t x) { return (x + 255) & ~(size_t)255; }
constexpr size_t WS_CTL = 0, CTL_BYTES = 1u << 20;
constexpr size_t WS_WIN = CTL_BYTES;
constexpr size_t WS_WQ = WS_WIN + al256((size_t)NINP * D * 2);
constexpr size_t WS_WKV = WS_WQ + al256((size_t)1536 * QL * 2);
constexpr size_t WS_WBRR = WS_WKV + al256((size_t)2048 * KVL * 2);
constexpr size_t WS_WBRM = WS_WBRR + al256((size_t)D * D * 2);
constexpr size_t WS_WO = WS_WBRM + al256((size_t)D * D * 2);
constexpr size_t WS_WUP = WS_WO + al256((size_t)D * D * 2);
constexpr size_t WS_WDN = WS_WUP + al256((size_t)DFF * D * 2);
constexpr size_t WS_WAX = WS_WDN + al256((size_t)DFF * D * 2);
constexpr size_t WS_WUKS = WS_WAX + al256((size_t)8 * 256 * 128 * 2);
constexpr size_t WS_ROPEC = WS_WUKS + al256((size_t)8 * 512 * 128 * 2);
constexpr size_t WS_ROPES = WS_ROPEC + al256((size_t)NROPE * 32 * 4);
constexpr size_t WS_SPL = WS_ROPES + al256((size_t)NROPE * 32 * 4);
constexpr size_t WS_H = WS_SPL + al256(4096);
constexpr size_t WS_RX = WS_H + al256((size_t)R * D * 2);
constexpr size_t WS_GRG = WS_RX + al256((size_t)R * D * 2);
constexpr size_t WS_CQ = WS_GRG + al256((size_t)R * D * 2);
constexpr size_t WS_CKVR = WS_CQ + al256((size_t)R * QL * 2);
constexpr size_t WS_G = WS_CKVR + al256((size_t)R * KVL * 2);
constexpr size_t WS_KPE = WS_G + al256((size_t)R * 2048 * 2);
constexpr size_t WS_SSQQ = WS_KPE + al256((size_t)R * 64 * 2);
constexpr size_t WS_SSQKV = WS_SSQQ + al256((size_t)R * 12 * 4);
constexpr size_t WS_QA = WS_SSQKV + al256((size_t)R * 8 * 4);
constexpr size_t WS_KN = WS_QA + al256((size_t)R * 1536 * 2);
constexpr size_t WS_V = WS_KN + al256((size_t)R * D * 2);
constexpr size_t WS_CKVNS = WS_V + al256((size_t)R * D * 2);
constexpr size_t WS_SEG = WS_CKVNS + al256((size_t)256 * KVL * 2);
constexpr size_t WS_HRG = WS_SEG + al256((size_t)8 * 3 * 1024 * 2 * 4);
constexpr size_t WS_O = WS_HRG + al256((size_t)R * D * 2);
constexpr size_t WS_OPART = WS_O + al256((size_t)R * D * 2);
constexpr size_t WS_ML = WS_OPART + al256((size_t)DB * NSPLIT * 64 * 512 * 4);
constexpr size_t WS_MIX = WS_ML + al256((size_t)DB * NSPLIT * 64 * 2 * 4);
constexpr size_t WS_PRE = WS_MIX + al256((size_t)R * D * 2);
constexpr size_t WS_X1 = WS_PRE + al256((size_t)R * D * 4);
constexpr size_t WS_U = WS_X1 + al256((size_t)R * D * 2);
constexpr size_t WS_END = WS_U + al256((size_t)R * DFF * 2);
static_assert(WS_END < (1ull << 32), "32-bit workspace offsets");

constexpr int CW_BAR = 4096;

constexpr int LDS_BYTES = 147456;
constexpr int MISC_OFF = 135168;
constexpr int NWAVES = 8, NTHR = 512;

__device__ __forceinline__ float bf2f(unsigned short b) { return __uint_as_float(((unsigned)b) << 16); }
__device__ __forceinline__ float bflo(unsigned w) { return __uint_as_float(w << 16); }
__device__ __forceinline__ float bfhi(unsigned w) { return __uint_as_float(w & 0xffff0000u); }
typedef __bf16 bf16x2_t __attribute__((ext_vector_type(2)));
__device__ __forceinline__ unsigned cvt_pk_bf16(float lo, float hi) { const f32x2 v = {lo, hi}; return __builtin_bit_cast(unsigned, __builtin_convertvector(v, bf16x2_t)); }
__device__ __forceinline__ float fast_exp2(float x) { return __builtin_amdgcn_exp2f(x); }
__device__ __forceinline__ float fast_rcp(float x) { return __builtin_amdgcn_rcpf(x); }
__device__ __forceinline__ float sigmoidf_(float x) { return fast_rcp(1.0f + fast_exp2(-x * LOG2E)); }
__device__ __forceinline__ float gelu_tanh(float x) { const float y = 0.7978845608028654f * (x + 0.044715f * x * x * x); return x * fast_rcp(1.0f + fast_exp2(-2.0f * LOG2E * y)); }
__device__ __forceinline__ float wave_sum(float v) {
#pragma unroll
    for (int o = 1; o < 64; o <<= 1) v += __shfl_xor(v, o);
    return v;
}
#define LDS_WAIT() asm volatile("s_waitcnt lgkmcnt(0)" ::: "memory")
#define VM_WAIT() asm volatile("s_waitcnt vmcnt(0)" ::: "memory")
namespace pg8 {
#define PG8_LAS __attribute__((address_space(3)))
constexpr int BM = 256, BK = 64, HALF = 128, HTB = HALF * BK * 2  , STAGE_BYTES = 8 * HTB, NXCD = 8, WGM = 8;
__host__ __device__ __forceinline__ int lds_byte(int r, int c) { const int st = (r >> 4) * 2 + (c >> 5), rr = r & 15, cc = c & 31, ob = rr * 64 + cc * 2; return st * 1024 + (ob ^ (((ob >> 9) & 1) << 5)); }
__host__ __device__ __forceinline__ void stage_rc(int b, int& R, int& C) { const int st = b / 1024, sb = b % 1024, swz = sb ^ (((sb >> 9) & 1) << 5); R = (st >> 1) * 16 + swz / 64; C = (st & 1) * 32 + (swz % 64) / 2; }
__host__ __device__ __forceinline__ int perm32(int rho) { const int n = rho >> 4, i = rho & 15; return 8 * (i >> 2) + 4 * n + (i & 3); }

struct Unit { const char* A; const char* B; int pm, pn; };

struct TileSched {
    const char* A; const char* B; size_t aT, bT; int nM, nN, nwg, G, c, rm_from, rm_add;
    __device__ __forceinline__ void init(const void* A_, const void* B_, int K, int nM_, int nN_, int G_, int c_, int rm_from_ = 1 << 30, int rm_add_ = 0) {
        A = (const char*)A_; B = (const char*)B_; aT = (size_t)BM * K * 2; bT = aT; nM = nM_; nN = nN_; nwg = nM * nN; G = G_; c = c_; rm_from = rm_from_; rm_add = rm_add_; }
    __device__ __forceinline__ bool next(int i, Unit& u) const { const long L = (long)i * G + c; if (L >= nwg) return false; return at((int)L, u); }
    __device__ __forceinline__ bool at(int L, Unit& u) const {
        int wgid = L; { const int q = nwg / NXCD, r = nwg % NXCD, xcd = wgid % NXCD, off = wgid / NXCD; wgid = (xcd < r ? xcd * (q + 1) : r * (q + 1) + (xcd - r) * q) + off; }
        const int nig = WGM * nN, gid = wgid / nig, fm = gid * WGM, gsz = (nM - fm) < WGM ? (nM - fm) : WGM;
        int pm = fm + ((wgid % nig) % gsz); const int pn = (wgid % nig) / gsz; if (pm >= rm_from) pm += rm_add;
        u.pm = pm; u.pn = pn; u.A = A + (size_t)pm * aT; u.B = B + (size_t)pn * bT; return true;
    }
    __device__ __forceinline__ void a_ready(const Unit&) const {}
    __device__ __forceinline__ void done(const Unit&) const {}
};
struct KvSched : TileSched {
    __device__ __forceinline__ bool next(int i, Unit& u) const {
        int L;
        if (c < 64) { if (i > 0) return false; L = c; }
        else if (c < 128) { if (i > 2) return false; L = i == 0 ? c : (i == 1 ? 256 + c : 256 + (c - 64)); }
        else { if (i > 1) return false; L = i == 0 ? c : 256 + c; }
        return at(L, u);
    }
};
template <class Epi, class Sched, bool ALIGN_EPI = false, bool SP2 = false>
__device__ __forceinline__ void gemm_phase(PG8_LAS unsigned char* lds, const int K, const Sched& S, const Epi& E) {
    const int tid = threadIdx.x, wid = __builtin_amdgcn_readfirstlane(tid >> 6), lane = tid & 63, wr = wid >> 2, wc = wid & 3, fr = lane & 15, fq = lane >> 4;
    const int nt = K / BK;
    unsigned voffA[2], voffB[2];
#pragma unroll
    for (int i = 0; i < 2; ++i) { int R, C; stage_rc(tid * 16 + i * 8192, R, C); const int Rb = Epi::PERM ? ((R & ~31) + perm32(R & 31)) : R;
        voffA[i] = (unsigned)(R * K + C) * 2u; voffB[i] = (unsigned)(Rb * K + C) * 2u; }
    const size_t kstep = (size_t)(BK * 2);
    const size_t hstep = (size_t)HALF * K * 2;
    const unsigned ldsw = (unsigned)wid * 1024u;
    const int aoff = lds_byte(wr * 64 + fr, fq * 8), boff = lds_byte(wc * 32 + fr, fq * 8);
#define PG8_SA(b, h) (((b) * 2 + (h)) * HTB)
#define PG8_SB(b, h) ((4 + (b) * 2 + (h)) * HTB)
#define PG8_STAGE(bufoff, gbase, voff) do { _Pragma("unroll") for (int _i = 0; _i < 2; ++_i) \
        __builtin_amdgcn_global_load_lds((const unsigned*)((const char*)(gbase) + (voff)[_i]), (PG8_LAS unsigned*)(lds + (bufoff) + ldsw + _i * 8192), 16, 0, 0); } while (0)
#define PG8_LDA(dst, b, h) do { _Pragma("unroll") for (int m = 0; m < 4; ++m) _Pragma("unroll") for (int k = 0; k < 2; ++k) dst[m][k] = *(const PG8_LAS bf16x8*)(lds + PG8_SA(b, h) + aoff + m * 2048 + k * 1024); } while (0)
#define PG8_LDB(dst, b, h) do { _Pragma("unroll") for (int n = 0; n < 2; ++n) _Pragma("unroll") for (int k = 0; k < 2; ++k) dst[n][k] = *(const PG8_LAS bf16x8*)(lds + PG8_SB(b, h) + boff + n * 2048 + k * 1024); } while (0)
#define PG8_MMA(ai, bj, At, Bt) do { __builtin_amdgcn_s_setprio(1); _Pragma("unroll") for (int m = 0; m < 4; ++m) _Pragma("unroll") for (int n = 0; n < 2; ++n) _Pragma("unroll") for (int k = 0; k < 2; ++k) \
        acc[ai][bj][m][n] = __builtin_amdgcn_mfma_f32_16x16x32_bf16(Bt[n][k], At[m][k], acc[ai][bj][m][n], 0, 0, 0); __builtin_amdgcn_s_setprio(0); } while (0)
#define PG8_WAIT_V(n) asm volatile("s_waitcnt vmcnt(" #n ")" ::: "memory")
#define PG8_WAIT_L(n) asm volatile("s_waitcnt lgkmcnt(" #n ")" ::: "memory")
#define PG8_BAR __builtin_amdgcn_s_barrier()
#define PG8_SCHED __builtin_amdgcn_sched_barrier(0)
    Unit cur, nxt; int ui = 0;
    if (!S.next(0, cur)) return;
    f32x4 acc[2][2][4][2];
#pragma unroll
    for (int a = 0; a < 2; ++a)
#pragma unroll
        for (int b = 0; b < 2; ++b)
#pragma unroll
            for (int m = 0; m < 4; ++m)
#pragma unroll
                for (int n = 0; n < 2; ++n) acc[a][b][m][n] = (f32x4){0.f, 0.f, 0.f, 0.f};
    bf16x8 At[4][2], B0[2][2], B1[2][2];
    const char* cA = cur.A; const char* cB = cur.B;
    S.a_ready(cur);
    if constexpr (SP2) {
        PG8_STAGE(PG8_SB(0, 0), cB, voffB); PG8_STAGE(PG8_SB(0, 1), cB + hstep, voffB); PG8_STAGE(PG8_SA(0, 0), cA, voffA); PG8_STAGE(PG8_SA(0, 1), cA + hstep, voffA);
        if (wr == 1) PG8_BAR;
        PG8_WAIT_V(2); PG8_BAR;
        PG8_STAGE(PG8_SB(1, 0), cB + kstep, voffB); PG8_STAGE(PG8_SA(1, 0), cA + kstep, voffA); PG8_STAGE(PG8_SB(1, 1), cB + hstep + kstep, voffB);
        PG8_WAIT_V(6); PG8_BAR;
    } else {
        PG8_STAGE(PG8_SB(0, 0), cB, voffB); PG8_STAGE(PG8_SA(0, 0), cA, voffA); PG8_STAGE(PG8_SB(0, 1), cB + hstep, voffB); PG8_STAGE(PG8_SA(0, 1), cA + hstep, voffA);
        if (wr == 1) PG8_BAR;
        PG8_WAIT_V(4); PG8_BAR;
        PG8_STAGE(PG8_SB(1, 0), cB + kstep, voffB); PG8_STAGE(PG8_SA(1, 0), cA + kstep, voffA); PG8_STAGE(PG8_SB(1, 1), cB + hstep + kstep, voffB);
        PG8_WAIT_V(6); PG8_BAR;
    }
    for (;;) {
        const bool has_next = S.next(ui + 1, nxt);
        const char* nA = has_next ? nxt.A : cA; const char* nB = has_next ? nxt.B : cB;
        for (int t = 0; t < nt; t += 2) {
            const bool last = (t == nt - 2);
            const char* a1 = cA + (size_t)(t + 1) * kstep;
            const char* a2 = last ? nA : cA + (size_t)(t + 2) * kstep; const char* b2 = last ? nB : cB + (size_t)(t + 2) * kstep;
            const char* a3 = a2 + kstep; const char* b3 = b2 + kstep;
            if (last && has_next) S.a_ready(nxt);
            if constexpr (SP2) {
            PG8_LDB(B0, 0, 0); PG8_LDB(B1, 0, 1); PG8_SCHED; PG8_LDA(At, 0, 0); PG8_STAGE(PG8_SA(1, 1), a1 + hstep, voffA);
            PG8_WAIT_V(8); PG8_WAIT_L(0); PG8_BAR; PG8_MMA(0, 0, At, B0); PG8_MMA(0, 1, At, B1); PG8_BAR; PG8_SCHED;
            PG8_LDA(At, 0, 1); PG8_STAGE(PG8_SB(0, 0), b2, voffB); PG8_STAGE(PG8_SB(0, 1), b2 + hstep, voffB); PG8_STAGE(PG8_SA(0, 0), a2, voffA);
            PG8_WAIT_V(8); PG8_WAIT_L(0); PG8_BAR; PG8_MMA(1, 0, At, B0); PG8_MMA(1, 1, At, B1); PG8_BAR; PG8_SCHED;
            PG8_LDB(B0, 1, 0); PG8_LDB(B1, 1, 1); PG8_SCHED; PG8_LDA(At, 1, 0); PG8_STAGE(PG8_SA(0, 1), a2 + hstep, voffA);
            PG8_WAIT_V(8); PG8_WAIT_L(0); PG8_BAR; PG8_MMA(0, 0, At, B0); PG8_MMA(0, 1, At, B1); PG8_BAR; PG8_SCHED;
            PG8_LDA(At, 1, 1); PG8_STAGE(PG8_SB(1, 0), b3, voffB); PG8_STAGE(PG8_SB(1, 1), b3 + hstep, voffB); PG8_STAGE(PG8_SA(1, 0), a3, voffA);
            PG8_WAIT_V(8); PG8_WAIT_L(0); PG8_BAR; PG8_MMA(1, 0, At, B0); PG8_MMA(1, 1, At, B1); PG8_BAR; PG8_SCHED;
            } else {
            PG8_LDB(B0, 0, 0); PG8_SCHED; PG8_LDA(At, 0, 0); PG8_STAGE(PG8_SA(1, 1), a1 + hstep, voffA);
            PG8_WAIT_L(8); PG8_BAR; PG8_WAIT_L(0); PG8_MMA(0, 0, At, B0); PG8_BAR; PG8_SCHED;
            PG8_LDB(B1, 0, 1); PG8_STAGE(PG8_SB(0, 0), b2, voffB);
            PG8_BAR; PG8_WAIT_L(0); PG8_MMA(0, 1, At, B1); PG8_BAR;
            PG8_LDA(At, 0, 1); PG8_STAGE(PG8_SA(0, 0), a2, voffA);
            PG8_BAR; PG8_WAIT_L(0); PG8_MMA(1, 0, At, B0); PG8_BAR; PG8_SCHED;
            PG8_STAGE(PG8_SB(0, 1), b2 + hstep, voffB);
            PG8_WAIT_V(6); PG8_BAR; PG8_MMA(1, 1, At, B1); PG8_BAR;
            PG8_LDB(B0, 1, 0); PG8_SCHED; PG8_LDA(At, 1, 0); PG8_STAGE(PG8_SA(0, 1), a2 + hstep, voffA);
            PG8_WAIT_L(8); PG8_BAR; PG8_WAIT_L(0); PG8_MMA(0, 0, At, B0); PG8_BAR; PG8_SCHED;
            PG8_LDB(B1, 1, 1); PG8_STAGE(PG8_SB(1, 0), b3, voffB);
            PG8_BAR; PG8_WAIT_L(0); PG8_MMA(0, 1, At, B1); PG8_BAR;
            PG8_LDA(At, 1, 1); PG8_STAGE(PG8_SA(1, 0), a3, voffA);
            PG8_BAR; PG8_WAIT_L(0); PG8_MMA(1, 0, At, B0); PG8_BAR; PG8_SCHED;
            PG8_STAGE(PG8_SB(1, 1), b3 + hstep, voffB);
            PG8_WAIT_V(6); PG8_BAR; PG8_MMA(1, 1, At, B1); PG8_BAR;
            }
        }
        if constexpr (ALIGN_EPI) { if (wr == 0) PG8_BAR; }
        if constexpr (!Epi::AFTER_DRAIN) { E(acc, cur, wr, wc, fr, fq); S.done(cur); }
        if (!has_next) break;
#pragma unroll
        for (int a = 0; a < 2; ++a)
#pragma unroll
            for (int b = 0; b < 2; ++b)
#pragma unroll
                for (int m = 0; m < 4; ++m)
#pragma unroll
                    for (int n = 0; n < 2; ++n) acc[a][b][m][n] = (f32x4){0.f, 0.f, 0.f, 0.f};
        cur = nxt; cA = nA; cB = nB; ++ui;
        if constexpr (ALIGN_EPI) { if (wr == 1) PG8_BAR; }
    }
    PG8_WAIT_V(0);
    if constexpr (!ALIGN_EPI) { if (wr == 0) PG8_BAR; }
    PG8_BAR;
    if constexpr (Epi::AFTER_DRAIN) { E.fused(acc, cur, wr, wc, fr, fq, lds, wid, lane); S.done(cur); }
#undef PG8_SA
#undef PG8_SB
#undef PG8_STAGE
#undef PG8_LDA
#undef PG8_LDB
#undef PG8_MMA
#undef PG8_WAIT_V
#undef PG8_WAIT_L
#undef PG8_BAR
#undef PG8_SCHED
}
}
#define RLX_AGENT __ATOMIC_RELAXED, __HIP_MEMORY_SCOPE_AGENT
#define XB_TMO      128
#define XB_XCNT(j)  (256  + 64 * (j))
#define XB_XSUB(j)  (1280 + 64 * (j))
#define XB_XGEN(j)  (2304 + 64 * (j))
#define XB_TOP      3328
#define XB_TOPGEN   3392
#define XCD_BAR_WORDS 3456
#define XB_SPIN_CAP (1u << 18)

__device__ __forceinline__ unsigned xb_ld(unsigned* p)              { return __hip_atomic_load(p, __ATOMIC_RELAXED, __HIP_MEMORY_SCOPE_AGENT); }
__device__ __forceinline__ unsigned xb_add(unsigned* p, unsigned v) { return __hip_atomic_fetch_add(p, v, __ATOMIC_RELAXED, __HIP_MEMORY_SCOPE_AGENT); }
__device__ __forceinline__ unsigned xb_xcc_id() { return (unsigned)__builtin_amdgcn_s_getreg((3 << 11) | 20) & 0xFu; }
#define XB_SPIN(cond, bar) do { unsigned _sp = 0; while (cond) { __builtin_amdgcn_s_sleep(1); \
    if ((++_sp & 255u) == 0u) { if (xb_ld(&(bar)[XB_TMO])) break; if (_sp > XB_SPIN_CAP) { atomicAdd(&(bar)[XB_TMO], 1u); break; } } } } while (0)

struct XcdBarrier {
    unsigned* bar; unsigned x;
    volatile LAS unsigned* st;
};

__device__ __forceinline__ XcdBarrier xcd_barrier_post(unsigned* bar, volatile LAS unsigned* st) {
    XcdBarrier b; b.bar = bar; b.x = xb_xcc_id(); b.st = st;
    if (threadIdx.x == 0) (void)xb_add(&bar[XB_XCNT(b.x)], 1u);
    return b;
}
__device__ __forceinline__ void xcd_barrier_complete(unsigned* bar, unsigned x, unsigned& nloc, unsigned& nx) {
    const unsigned G = gridDim.x * gridDim.y * gridDim.z;
    unsigned sum, cnt, mine, sp = 0u;
    for (;;) {
        sum = 0u; cnt = 0u; mine = 0u;
#pragma unroll
        for (unsigned j = 0; j < 16; ++j) { const unsigned c = xb_ld(&bar[XB_XCNT(j)]); sum += c; cnt += (c > 0u) ? 1u : 0u; mine = (j == x) ? c : mine; }
        if (sum == G) break;
        __builtin_amdgcn_s_sleep(1);
        if ((++sp & 255u) == 0u) { if (xb_ld(&bar[XB_TMO])) break; if (sp > XB_SPIN_CAP) { atomicAdd(&bar[XB_TMO], 1u); break; } }
    }
    nloc = mine > 0u ? mine : 1u; nx = cnt > 0u ? cnt : 1u;
}

__device__ __forceinline__ void xcd_barrier(const XcdBarrier& b) {
    asm volatile("s_waitcnt vmcnt(0)" ::: "memory");
    __syncthreads();
    if (threadIdx.x == 0) {
        unsigned* bar = b.bar;
        __builtin_amdgcn_s_waitcnt(0);
        unsigned nloc = b.st[0], nx = b.st[1];
        if (nloc == 0u) { xcd_barrier_complete(bar, b.x, nloc, nx); b.st[0] = nloc; b.st[1] = nx; }
        const unsigned old = xb_add(&bar[XB_XSUB(b.x)], 1u);
        const unsigned gen = old / nloc;
        if (old + 1u == (gen + 1u) * nloc) {
            __builtin_amdgcn_fence(__ATOMIC_RELEASE, "agent");
            asm volatile("s_waitcnt vmcnt(0)" ::: "memory");
            const unsigned og = xb_add(&bar[XB_TOP], 1u);
            const unsigned tg = og / nx;
            if (og + 1u == (tg + 1u) * nx) xb_add(&bar[XB_TOPGEN], 1u);
            else XB_SPIN(xb_ld(&bar[XB_TOPGEN]) == tg, bar);
            __builtin_amdgcn_fence(__ATOMIC_ACQUIRE, "agent");
            xb_add(&bar[XB_XGEN(b.x)], 1u);
            asm volatile("s_waitcnt vmcnt(0)" ::: "memory");
        } else {
            XB_SPIN(xb_ld(&bar[XB_XGEN(b.x)]) == gen, bar);
            __builtin_amdgcn_fence(__ATOMIC_ACQUIRE, "agent");
            asm volatile("s_waitcnt vmcnt(0)" ::: "memory");
        }
    }
    __syncthreads();
}

__device__ __forceinline__ int rope_idx_of_row(int row) {
    if (row < ROW_S) return NMETA + (row & (SEQ - 1));
    if (row < ROW_M) return TP + ((row - ROW_S) & (DS - 1));
    if (row < ROW_M + NMETA) return row - ROW_M;
    return -1;
}
namespace pg8 {
#define EPI_ROWS(ai, m) (row0 + (ai) * HALF + (m) * 16)
__device__ __forceinline__ u32x4 pack8(const f32x4 v0, const f32x4 v1) { u32x4 w; w.x = cvt_pk_bf16(v0[0], v0[1]); w.y = cvt_pk_bf16(v0[2], v0[3]); w.z = cvt_pk_bf16(v1[0], v1[1]); w.w = cvt_pk_bf16(v1[2], v1[3]); return w; }
__device__ __forceinline__ void unpack8(const u32x4 w, f32x4& v0, f32x4& v1) { v0 = (f32x4){bflo(w.x), bfhi(w.x), bflo(w.y), bfhi(w.y)}; v1 = (f32x4){bflo(w.z), bfhi(w.z), bflo(w.w), bfhi(w.w)}; }

struct EpiWin {
    static constexpr bool PERM = true, AFTER_DRAIN = false;
    bf16 *RX, *GRG, *CQ, *CKVR, *G, *KPE; float *SSQQ, *SSQKV; const float* b_gate; const float *ropec, *ropes; float* out;
    __device__ __forceinline__ void operator()(const f32x4 (&acc)[2][2][4][2], const Unit& u, int wr, int wc, int fr, int fq) const {
        const int pn = u.pn, row0 = u.pm * BM + wr * 64 + fr, cw = wc * 32 + 8 * fq;
        if (pn < 4 || (pn >= 8 && pn < 13)) {
            bf16* base; int ld, colt, nslot = 0, slot0 = 0; float* ssq = nullptr;
            if (pn < 4) { base = RX; ld = D; colt = pn * BM; }
            else if (pn < 11) { base = CQ; ld = QL; colt = (pn - 8) * BM; ssq = SSQQ; nslot = 12; slot0 = (pn - 8) * 4 + wc; }
            else { base = CKVR; ld = KVL; colt = (pn - 11) * BM; ssq = SSQKV; nslot = 8; slot0 = (pn - 11) * 4 + wc; }
#pragma unroll
            for (int ai = 0; ai < 2; ++ai)
#pragma unroll
                for (int m = 0; m < 4; ++m) { const int row = EPI_ROWS(ai, m); float s = 0.f;
#pragma unroll
                    for (int bj = 0; bj < 2; ++bj) { const f32x4 v0 = acc[ai][bj][m][0], v1 = acc[ai][bj][m][1];
                        *(u32x4*)(base + (size_t)row * ld + colt + bj * HALF + cw) = pack8(v0, v1);
                        s += (v0[0] * v0[0] + v0[1] * v0[1]) + (v0[2] * v0[2] + v0[3] * v0[3]) + (v1[0] * v1[0] + v1[1] * v1[1]) + (v1[2] * v1[2] + v1[3] * v1[3]); }
                    if (ssq) { s += __shfl_xor(s, 16); s += __shfl_xor(s, 32); if (fq == 0) ssq[(size_t)row * nslot + slot0] = s; } }
        } else if (pn < 8) {
            const int colt = (pn - 4) * BM;
#pragma unroll
            for (int ai = 0; ai < 2; ++ai)
#pragma unroll
                for (int m = 0; m < 4; ++m) { const int row = EPI_ROWS(ai, m);
#pragma unroll
                    for (int bj = 0; bj < 2; ++bj) { f32x4 v0 = acc[ai][bj][m][0], v1 = acc[ai][bj][m][1];
#pragma unroll
                        for (int j = 0; j < 4; ++j) { v0[j] = gelu_tanh(v0[j]); v1[j] = gelu_tanh(v1[j]); }
                        *(u32x4*)(GRG + (size_t)row * D + colt + bj * HALF + cw) = pack8(v0, v1); } }
        } else if (pn < 21) {
            const int colt = (pn - 13) * BM;
            f32x4 bv[2][2];
#pragma unroll
            for (int bj = 0; bj < 2; ++bj)
#pragma unroll
                for (int n = 0; n < 2; ++n) bv[bj][n] = *(const f32x4*)(b_gate + colt + bj * HALF + cw + 4 * n);
#pragma unroll
            for (int ai = 0; ai < 2; ++ai)
#pragma unroll
                for (int m = 0; m < 4; ++m) { const int row = EPI_ROWS(ai, m);
#pragma unroll
                    for (int bj = 0; bj < 2; ++bj) { f32x4 v0 = acc[ai][bj][m][0] + bv[bj][0], v1 = acc[ai][bj][m][1] + bv[bj][1];
#pragma unroll
                        for (int j = 0; j < 4; ++j) { v0[j] = sigmoidf_(v0[j]); v1[j] = sigmoidf_(v1[j]); }
                        *(u32x4*)(G + (size_t)row * 2048 + colt + bj * HALF + cw) = pack8(v0, v1); } }
        } else if (wc == 0) {
#pragma unroll
            for (int ai = 0; ai < 2; ++ai)
#pragma unroll
                for (int m = 0; m < 4; ++m) { const int row = EPI_ROWS(ai, m); const int pi = rope_idx_of_row(row);
                    if (pi >= 0) {
#pragma unroll
                        for (int n = 0; n < 2; ++n) { const int i0 = 8 * fq + 4 * n;
                            const f32x4 cs = *(const f32x4*)(ropec + pi * 32 + i0), sn = *(const f32x4*)(ropes + pi * 32 + i0);
                            const f32x4 x1 = acc[ai][0][m][n], x2 = acc[ai][1][m][n];
                            const f32x4 o1 = x1 * cs - x2 * sn, o2 = x1 * sn + x2 * cs;
                            u32x2 w1, w2; w1.x = cvt_pk_bf16(o1[0], o1[1]); w1.y = cvt_pk_bf16(o1[2], o1[3]); w2.x = cvt_pk_bf16(o2[0], o2[1]); w2.y = cvt_pk_bf16(o2[2], o2[3]);
                            *(u32x2*)(KPE + (size_t)row * 64 + i0) = w1; *(u32x2*)(KPE + (size_t)row * 64 + 32 + i0) = w2;
                            if (row < ROW_S) { float* o = out + O_PKPE + ((size_t)(row >> 11) * TP + pi) * 64 + i0; *(f32x4*)o = o1; *(f32x4*)(o + 32) = o2; }
                            else if (row < ROW_M) { float* o = out + O_SKPE + (size_t)(row - ROW_S) * 64 + i0; *(f32x4*)o = o1; *(f32x4*)(o + 32) = o2; }
                            else {
#pragma unroll
                                for (int b = 0; b < NB; ++b) { float* o = out + O_PKPE + ((size_t)b * TP + pi) * 64 + i0; *(f32x4*)o = o1; *(f32x4*)(o + 32) = o2; } } } } }
        }
    }
};
struct EpiQ {
    static constexpr bool PERM = true, AFTER_DRAIN = false;
    bf16* QA; const float* SSQQ; const float *ropec, *ropes;
    __device__ __forceinline__ void operator()(const f32x4 (&acc)[2][2][4][2], const Unit& u, int wr, int wc, int fr, int fq) const {
        const int pn = u.pn, row0 = u.pm * BM + wr * 64 + fr, cw = wc * 32 + 8 * fq;
#pragma unroll
        for (int ai = 0; ai < 2; ++ai)
#pragma unroll
            for (int m = 0; m < 4; ++m) { const int row = EPI_ROWS(ai, m);
                const f32x4 s0 = *(const f32x4*)(SSQQ + (size_t)row * 12), s1 = *(const f32x4*)(SSQQ + (size_t)row * 12 + 4), s2 = *(const f32x4*)(SSQQ + (size_t)row * 12 + 8);
                const float ss = ((s0[0] + s0[1]) + (s0[2] + s0[3])) + ((s1[0] + s1[1]) + (s1[2] + s1[3])) + ((s2[0] + s2[1]) + (s2[2] + s2[3]));
                const float rstd = __builtin_amdgcn_rsqf(ss * (1.0f / QL) + EPS);
                if (pn < 4) {
#pragma unroll
                    for (int bj = 0; bj < 2; ++bj) { const int h = pn * 2 + bj;
                        *(u32x4*)(QA + (size_t)row * 1536 + h * 192 + cw) = pack8(acc[ai][bj][m][0] * rstd, acc[ai][bj][m][1] * rstd); }
                } else {
                    const int h = (pn - 4) * 4 + wc; int pi = rope_idx_of_row(row); if (pi < 0) pi = 0;
#pragma unroll
                    for (int n = 0; n < 2; ++n) { const int i0 = 8 * fq + 4 * n;
                        const f32x4 cs = *(const f32x4*)(ropec + pi * 32 + i0), sn = *(const f32x4*)(ropes + pi * 32 + i0);
                        const f32x4 x1 = acc[ai][0][m][n] * rstd, x2 = acc[ai][1][m][n] * rstd;
                        const f32x4 o1 = x1 * cs - x2 * sn, o2 = x1 * sn + x2 * cs;
                        u32x2 w1, w2; w1.x = cvt_pk_bf16(o1[0], o1[1]); w1.y = cvt_pk_bf16(o1[2], o1[3]); w2.x = cvt_pk_bf16(o2[0], o2[1]); w2.y = cvt_pk_bf16(o2[2], o2[3]);
                        *(u32x2*)(QA + (size_t)row * 1536 + h * 192 + 128 + i0) = w1; *(u32x2*)(QA + (size_t)row * 1536 + h * 192 + 160 + i0) = w2; }
                } }
    }
};
struct EpiKV {
    static constexpr bool PERM = true, AFTER_DRAIN = false;
    bf16 *KN, *V; const float* SSQKV;
    __device__ __forceinline__ void operator()(const f32x4 (&acc)[2][2][4][2], const Unit& u, int wr, int wc, int fr, int fq) const {
        const int pn = u.pn, row0 = u.pm * BM + wr * 64 + fr, cw = wc * 32 + 8 * fq;
        bf16* base = pn < 4 ? KN : V; const int colt = (pn & 3) * BM;
#pragma unroll
        for (int ai = 0; ai < 2; ++ai)
#pragma unroll
            for (int m = 0; m < 4; ++m) { const int row = EPI_ROWS(ai, m);
                const f32x4 s0 = *(const f32x4*)(SSQKV + (size_t)row * 8), s1 = *(const f32x4*)(SSQKV + (size_t)row * 8 + 4);
                const float ss = ((s0[0] + s0[1]) + (s0[2] + s0[3])) + ((s1[0] + s1[1]) + (s1[2] + s1[3]));
                const float rstd = __builtin_amdgcn_rsqf(ss * (1.0f / KVL) + EPS);
#pragma unroll
                for (int bj = 0; bj < 2; ++bj) *(u32x4*)(base + (size_t)row * D + colt + bj * HALF + cw) = pack8(acc[ai][bj][m][0] * rstd, acc[ai][bj][m][1] * rstd); }
    }
};
template <int MODE> struct EpiZ {
    static constexpr bool PERM = true, AFTER_DRAIN = false;
    bf16* MIX; const bf16* G;
    __device__ __forceinline__ void operator()(const f32x4 (&acc)[2][2][4][2], const Unit& u, int wr, int wc, int fr, int fq) const {
        const int row0 = u.pm * BM + wr * 64 + fr, col0 = u.pn * BM + wc * 32 + 8 * fq;
#pragma unroll
        for (int ai = 0; ai < 2; ++ai)
#pragma unroll
            for (int m = 0; m < 4; ++m) { const int row = EPI_ROWS(ai, m);
#pragma unroll
                for (int bj = 0; bj < 2; ++bj) { const int col = col0 + bj * HALF;
                    f32x4 g0, g1; unpack8(*(const u32x4*)(G + (size_t)row * 2048 + MODE * D + col), g0, g1);
                    f32x4 v0 = acc[ai][bj][m][0] * g0, v1 = acc[ai][bj][m][1] * g1;
                    if (MODE == 1) { f32x4 t0, t1; unpack8(*(const u32x4*)(MIX + (size_t)row * D + col), t0, t1); v0 += t0; v1 += t1; }
                    *(u32x4*)(MIX + (size_t)row * D + col) = pack8(v0, v1); } }
    }
};
struct EpiRes {
    static constexpr bool PERM = true, AFTER_DRAIN = false;
    bf16* OUT; const bf16* RES; const float* bias;
    __device__ __forceinline__ void operator()(const f32x4 (&acc)[2][2][4][2], const Unit& u, int wr, int wc, int fr, int fq) const {
        const int row0 = u.pm * BM + wr * 64 + fr, col0 = u.pn * BM + wc * 32 + 8 * fq;
        f32x4 bv[2][2];
#pragma unroll
        for (int bj = 0; bj < 2; ++bj)
#pragma unroll
            for (int n = 0; n < 2; ++n) bv[bj][n] = bias ? *(const f32x4*)(bias + col0 + bj * HALF + 4 * n) : (f32x4){0.f, 0.f, 0.f, 0.f};
#pragma unroll
        for (int ai = 0; ai < 2; ++ai)
#pragma unroll
            for (int m = 0; m < 4; ++m) { const size_t ro = (size_t)EPI_ROWS(ai, m) * D + col0;
#pragma unroll
                for (int bj = 0; bj < 2; ++bj) { f32x4 r0, r1; unpack8(*(const u32x4*)(RES + ro + bj * HALF), r0, r1);
                    *(u32x4*)(OUT + ro + bj * HALF) = pack8(r0 * DN_ALPHA + acc[ai][bj][m][0] + bv[bj][0], r1 * DN_ALPHA + acc[ai][bj][m][1] + bv[bj][1]); } }
    }
};
struct EpiUp {
    static constexpr bool PERM = true, AFTER_DRAIN = false;
    bf16* U; const float* bias;
    __device__ __forceinline__ void operator()(const f32x4 (&acc)[2][2][4][2], const Unit& u, int wr, int wc, int fr, int fq) const {
        const int row0 = u.pm * BM + wr * 64 + fr, col0 = u.pn * BM + wc * 32 + 8 * fq;
        f32x4 bv[2][2];
#pragma unroll
        for (int bj = 0; bj < 2; ++bj)
#pragma unroll
            for (int n = 0; n < 2; ++n) bv[bj][n] = *(const f32x4*)(bias + col0 + bj * HALF + 4 * n);
#pragma unroll
        for (int ai = 0; ai < 2; ++ai)
#pragma unroll
            for (int m = 0; m < 4; ++m) { const int row = EPI_ROWS(ai, m);
#pragma unroll
                for (int bj = 0; bj < 2; ++bj) { f32x4 v0 = acc[ai][bj][m][0] + bv[bj][0], v1 = acc[ai][bj][m][1] + bv[bj][1];
#pragma unroll
                    for (int j = 0; j < 4; ++j) { const float a = fmaxf(v0[j], 0.f), b = fmaxf(v1[j], 0.f); v0[j] = a * a; v1[j] = b * b; }
                    *(u32x4*)(U + (size_t)row * DFF + col0 + bj * HALF) = pack8(v0, v1); } }
    }
};
#undef EPI_ROWS
}
struct Frame {
    LAS unsigned char* lds;
    volatile LAS unsigned* MISC;
    unsigned* ctl;
    int tid, lane, wave, vcu, G;
    const void* const* in;
    float* out; unsigned char* ws;
};
struct Args { const void* in[35]; float* out; unsigned char* ws; int ph_lo, ph_hi; };
#define IN_F(i) ((const float*)args.in[i])
enum { I_XP = 0, I_XS, I_CCKV, I_CKPE, I_PT, I_SCONV, I_SRG, I_META, I_LNG, I_LNB, I_WIN, I_BGATE, I_CONVW, I_CONVB, I_WA, I_BA, I_WX, I_BX, I_LAM, I_WBRR,
       I_QG, I_WUQ, I_KVG, I_WUK, I_WUV, I_WBRM, I_WO, I_LN1G, I_LN1B, I_WUP, I_BUP, I_WDN, I_BDN, I_LN2G, I_LN2B };

__device__ __forceinline__ void tr_item(const float* src, size_t ldn, int scol0, bf16* dst, int dK, int drow0, int k0, const float* kscale, LAS float* scr, int lane) {
    if (scol0 >= 0) {
#pragma unroll 8
        for (int i = 0; i < 32; ++i) { const int kk = 2 * i + (lane >> 5); scr[kk * 33 + (lane & 31)] = src[(size_t)(k0 + kk) * ldn + scol0 + (lane & 31)]; }
    } else {
#pragma unroll 8
        for (int i = 0; i < 32; ++i) { const int kk = 2 * i + (lane >> 5); scr[kk * 33 + (lane & 31)] = 0.f; }
    }
    LDS_WAIT(); asm volatile("" ::: "memory");
    const int c = lane & 7;
    float ks[8];
#pragma unroll
    for (int e = 0; e < 8; ++e) ks[e] = kscale ? kscale[k0 + 8 * c + e] : 1.0f;
#pragma unroll
    for (int j = 0; j < 4; ++j) { const int n = (lane >> 3) + 8 * j; const LAS float* s = scr + (8 * c) * 33 + n;
        u32x4 o; o.x = cvt_pk_bf16(s[0 * 33] * ks[0], s[1 * 33] * ks[1]); o.y = cvt_pk_bf16(s[2 * 33] * ks[2], s[3 * 33] * ks[3]);
        o.z = cvt_pk_bf16(s[4 * 33] * ks[4], s[5 * 33] * ks[5]); o.w = cvt_pk_bf16(s[6 * 33] * ks[6], s[7 * 33] * ks[7]);
        *(u32x4*)(dst + (size_t)(drow0 + n) * dK + k0 + 8 * c) = o; }
    LDS_WAIT(); asm volatile("" ::: "memory");
}
template <bool XBF = false>
__device__ __forceinline__ void ln_row(const void* xrow, const float* g, const float* b, bf16* obf, float* of32, int lane) {
    f32x4 v[4]; float s = 0.f;
#pragma unroll
    for (int j = 0; j < 4; ++j) {
        if (XBF) { const u32x2 w = ((const u32x2*)xrow)[lane + 64 * j]; v[j] = (f32x4){bflo(w.x), bfhi(w.x), bflo(w.y), bfhi(w.y)}; } else v[j] = ((const f32x4*)xrow)[lane + 64 * j];
        s += (v[j].x + v[j].y) + (v[j].z + v[j].w); }
    const float mean = wave_sum(s) * (1.f / D); float s2 = 0.f;
#pragma unroll
    for (int j = 0; j < 4; ++j) { v[j] = v[j] - mean; s2 += (v[j].x * v[j].x + v[j].y * v[j].y) + (v[j].z * v[j].z + v[j].w * v[j].w); }
    const float rstd = __builtin_amdgcn_rsqf(wave_sum(s2) * (1.f / D) + EPS);
#pragma unroll
    for (int j = 0; j < 4; ++j) { const f32x4 gg = ((const f32x4*)g)[lane + 64 * j], bb = ((const f32x4*)b)[lane + 64 * j]; const f32x4 y = v[j] * rstd * gg + bb;
        if (obf) { u32x2 w; w.x = cvt_pk_bf16(y.x, y.y); w.y = cvt_pk_bf16(y.z, y.w); ((u32x2*)obf)[lane + 64 * j] = w; }
        if (of32) ((f32x4*)of32)[lane + 64 * j] = y; }
}
__device__ __forceinline__ const float* src_row(const float* xp, const float* xs, const float* meta, int row) {
    if (row < ROW_S) return xp + (size_t)row * D;
    if (row < ROW_M) return xs + (size_t)(row - ROW_S) * D;
    if (row < ROW_M + NMETA) return meta + (size_t)(row - ROW_M) * D;
    return nullptr;
}
__device__ __forceinline__ void p0_prologue(const Frame& F, const Args& args) {
    unsigned char* ws = F.ws;
    LAS float* scr = (LAS float*)(F.lds + F.wave * 16384);
    const int gw = F.vcu * NWAVES + F.wave, NGW = F.G * NWAVES, lane = F.lane;
    constexpr int I_1 = 16 * (NINP / 32), I_2 = 12 * 48, I_3 = 8 * 32, I_4 = 8 * 32, I_5 = 16 * 32, I_8 = 16 * 128, I_9 = 64 * 32, I_10 = 8 * 8;
    constexpr int NITEMS = I_1 + I_2 + I_3 + I_4 + 3 * I_5 + I_8 + I_9 + 2 * I_10;
    for (int it = gw; it < NITEMS; it += NGW) {
        int r = it;
        if (r < I_1) { const int nb = r % (NINP / 32), kb = r / (NINP / 32), n0 = 32 * nb; int sc;
            if (n0 < 3328) sc = n0; else if (n0 < 5376) sc = n0 + 64; else { const int w = n0 - 5376; sc = (w == 0) ? 3328 : (w == 128 ? 3360 : -1); }
            tr_item(IN_F(I_WIN), NIN, sc, (bf16*)(ws + WS_WIN), D, n0, 64 * kb, nullptr, scr, lane); continue; } r -= I_1;
        if (r < I_2) { const int nb = r % 48, kb = r / 48, n0 = 32 * nb; int sc;
            if (n0 < 1024) sc = (n0 >> 7) * 192 + (n0 & 127);
            else { const int w = n0 - 1024, tt = w >> 8, wi = w & 255, half = wi >> 7, hh = (wi & 127) >> 5; sc = (4 * tt + hh) * 192 + 128 + 32 * half; }
            tr_item(IN_F(I_WUQ), 1536, sc, (bf16*)(ws + WS_WQ), QL, n0, 64 * kb, IN_F(I_QG), scr, lane); continue; } r -= I_2;
        if (r < I_3) { const int nb = r % 32, kb = r / 32; tr_item(IN_F(I_WUK), 1024, 32 * nb, (bf16*)(ws + WS_WKV), KVL, 32 * nb, 64 * kb, IN_F(I_KVG), scr, lane); continue; } r -= I_3;
        if (r < I_4) { const int nb = r % 32, kb = r / 32; tr_item(IN_F(I_WUV), 1024, 32 * nb, (bf16*)(ws + WS_WKV), KVL, 1024 + 32 * nb, 64 * kb, IN_F(I_KVG), scr, lane); continue; } r -= I_4;
        if (r < I_5) { const int nb = r % 32, kb = r / 32; tr_item(IN_F(I_WBRR), D, 32 * nb, (bf16*)(ws + WS_WBRR), D, 32 * nb, 64 * kb, nullptr, scr, lane); continue; } r -= I_5;
        if (r < I_5) { const int nb = r % 32, kb = r / 32; tr_item(IN_F(I_WBRM), D, 32 * nb, (bf16*)(ws + WS_WBRM), D, 32 * nb, 64 * kb, nullptr, scr, lane); continue; } r -= I_5;
        if (r < I_5) { const int nb = r % 32, kb = r / 32; tr_item(IN_F(I_WO), D, 32 * nb, (bf16*)(ws + WS_WO), D, 32 * nb, 64 * kb, nullptr, scr, lane); continue; } r -= I_5;
        if (r < I_8) { const int nb = r % 128, kb = r / 128; tr_item(IN_F(I_WUP), DFF, 32 * nb, (bf16*)(ws + WS_WUP), D, 32 * nb, 64 * kb, nullptr, scr, lane); continue; } r -= I_8;
        if (r < I_9) { const int nb = r % 32, kb = r / 32; tr_item(IN_F(I_WDN), D, 32 * nb, (bf16*)(ws + WS_WDN), DFF, 32 * nb, 64 * kb, nullptr, scr, lane); continue; } r -= I_9;
        if (r < I_10) { const int blk = r >> 3, nb = r & 3, kb = (r >> 2) & 1; tr_item(IN_F(I_WA) + (size_t)blk * 128 * 128, 128, 32 * nb, (bf16*)(ws + WS_WAX), 128, blk * 256 + 32 * nb, 64 * kb, nullptr, scr, lane); continue; } r -= I_10;
        { const int blk = r >> 3, nb = r & 3, kb = (r >> 2) & 1; tr_item(IN_F(I_WX) + (size_t)blk * 128 * 128, 128, 32 * nb, (bf16*)(ws + WS_WAX), 128, blk * 256 + 128 + 32 * nb, 64 * kb, nullptr, scr, lane); }
    }
    const int gt = F.vcu * NTHR + F.tid, NGT = F.G * NTHR;
    for (int i = gt; i < 8 * 32 * 4 * 64; i += NGT) { const int ln = i & 63, ks = (i >> 6) & 3, rb = (i >> 8) & 31, h = i >> 13, r = 16 * rb + (ln & 15), d0 = 32 * ks + 8 * (ln >> 4);
        const f32x4 a = *(const f32x4*)(IN_F(I_WUK) + (size_t)r * 1024 + h * 128 + d0), b = *(const f32x4*)(IN_F(I_WUK) + (size_t)r * 1024 + h * 128 + d0 + 4);
        *(u32x4*)((bf16*)(ws + WS_WUKS) + (size_t)i * 8) = pg8::pack8(a, b); }
    for (int i = gt; i < NROPE * 32; i += NGT) { const int pi = i >> 5, k = i & 31; const int pos = pi < TP ? pi : PAST + (pi - TP);
        double pw = 1.0; for (int j = 0; j < k; ++j) pw *= 1.3335214321633240;
        const float inv = 1.0f / (float)pw; const float ang = (float)pos * inv; const double a = (double)ang;
        const double n2 = __builtin_rint(a * 0.15915494309189535); const double r = (a - n2 * 6.283185307179586) - n2 * 2.4492935982947064e-16;
        const double q = __builtin_rint(r * 0.6366197723675814); const double t = (r - q * 1.5707963267948966) - q * 6.123233995736766e-17; const int qi = ((int)q) & 3;
        const double t2 = t * t;
        const double st = t * (1.0 + t2 * (-1.0 / 6 + t2 * (1.0 / 120 + t2 * (-1.0 / 5040 + t2 * (1.0 / 362880 + t2 * (-1.0 / 39916800 + t2 * (1.0 / 6227020800.0)))))));
        const double ct = 1.0 + t2 * (-0.5 + t2 * (1.0 / 24 + t2 * (-1.0 / 720 + t2 * (1.0 / 40320 + t2 * (-1.0 / 3628800 + t2 * (1.0 / 479001600.0 + t2 * (-1.0 / 87178291200.0)))))));
        const double cv = qi == 0 ? ct : (qi == 1 ? -st : (qi == 2 ? -ct : st)), sv = qi == 0 ? st : (qi == 1 ? ct : (qi == 2 ? -st : -ct));
        ((float*)(ws + WS_ROPEC))[i] = (float)cv; ((float*)(ws + WS_ROPES))[i] = (float)sv; }
    for (int i = gt; i < D; i += NGT) { const float l = IN_F(I_LAM)[i]; ((float*)(ws + WS_SPL))[i] = (l > 0.f) ? log1pf(expf(-l)) : (-l + log1pf(expf(l))); }
    for (int m = gw; m < R; m += NGW) { const float* s = src_row(IN_F(I_XP), IN_F(I_XS), IN_F(I_META), m); bf16* o = (bf16*)(ws + WS_H) + (size_t)m * D;
        if (s) ln_row(s, IN_F(I_LNG), IN_F(I_LNB), o, nullptr, lane);
        else { for (int j = 0; j < 2; ++j) ((u32x4*)o)[lane + 64 * j] = (u32x4){0u, 0u, 0u, 0u}; } }
}
constexpr int RG_XC = 0;
constexpr int RG_PRIV = 2 * 16384;
constexpr int RG_PW = 2 * 64 * 17 * 4 + 512;
constexpr int RG_CW = RG_PRIV + 8 * RG_PW;
constexpr int RG_END = RG_CW + 5 * 128 * 4;
static_assert(RG_END <= MISC_OFF, "rg lds");
__device__ __forceinline__ unsigned off256(unsigned row, unsigned ch) { return 256u * row + 16u * (ch ^ (((row & 3) << 2) | ((row >> 2) & 3))); }

struct RgParams {
    const bf16 *RX, *GRG, *WAX; bf16* HRG; const float *conv_w, *conv_b, *ba, *bx, *spl, *state_conv, *state_rg; float* SEG; float* out;
};
__device__ __forceinline__ int prompt_row(int b, int p) { return p < NMETA ? ROW_M + p : b * SEQ + (p - NMETA); }

template <int MODE>
__device__ __forceinline__ void rg_unit(const Frame& F, const RgParams& P, const int b  , const int n, const int seg) {
    LAS unsigned char* lds = F.lds;
    int tid = F.tid; asm volatile("" : "+v"(tid));
    const int lane = tid & 63, wave = F.wave, l15 = lane & 15, g = lane >> 4;
    LAS float* PA = (LAS float*)(lds + RG_PRIV + wave * RG_PW); LAS float* PU = PA + 64 * 17; LAS float* PS = PU + 64 * 17;
    bf16x8 wfa[4], wfx[4];
    { const bf16* wa = P.WAX + ((size_t)n * 256 + 16 * wave + l15) * 128 + 8 * g; const bf16* wx = wa + 128 * 128;
#pragma unroll
      for (int ks = 0; ks < 4; ++ks) { wfa[ks] = *(const bf16x8*)(wa + 32 * ks); wfx[ks] = *(const bf16x8*)(wx + 32 * ks); } }
    const int cl = 16 * wave + l15, cg = n * 128 + cl;
    const float ba_c = P.ba[cg], bx_c = P.bx[cg], spl8 = -8.0f * P.spl[cg] * LOG2E;
    const int cv_tp = tid >> 4, cv_c8 = tid & 15, cg_v = n * 128 + 8 * cv_c8;
    if (tid < 5 * 32) { const int k = tid >> 5, c4 = (tid & 31) * 4; *(LAS f32x4*)(lds + RG_CW + (k * 128 + c4) * 4) = k < 4 ? *(const f32x4*)(P.conv_w + k * D + n * 128 + c4) : *(const f32x4*)(P.conv_b + n * 128 + c4); }
    __syncthreads();
    float hc = 0.f, cA = 1.f;
    if (MODE == 1) { for (int s2 = 0; s2 < seg; ++s2) { const f32x2 sv = *(const f32x2*)(P.SEG + (((size_t)b * 3 + s2) * D + cg) * 2); hc = sv.x * hc + sv.y; } }
    const int nchunks = (MODE == 2) ? 1 : (seg == 0 ? 9 : 8);
    auto chunk_p0 = [&](int ch) -> int { return seg == 0 ? (ch == 0 ? 0 : NMETA + 64 * (ch - 1)) : NMETA + 512 * seg + 64 * ch; };
    u32x4 xw[5];
    auto load_x = [&](int ch) {
        const int p0n = chunk_p0(ch);
#pragma unroll
        for (int r = 0; r < 5; ++r) { const int p = p0n + 2 * cv_tp - 3 + r;
            xw[r] = (u32x4){0u, 0u, 0u, 0u};
            if (p >= 0) xw[r] = *(const u32x4*)(P.RX + (size_t)prompt_row(b, p < TP ? p : TP - 1) * D + cg_v); }
    };
    if (MODE != 2) load_x(0);
    for (int ch = 0; ch < nchunks; ++ch) {
        int p0 = 0, nvalid = 64;
        if (MODE != 2) { p0 = chunk_p0(ch); if (seg == 0 && ch == 0) nvalid = NMETA; }
        LAS unsigned char* XC = lds + RG_XC + (ch & 1) * 16384;
        {
            float cw[4][8], cbias[8];
#pragma unroll
            for (int k = 0; k < 5; ++k) { const f32x4 a = *(const LAS f32x4*)(lds + RG_CW + (k * 128 + 8 * cv_c8) * 4), c = *(const LAS f32x4*)(lds + RG_CW + (k * 128 + 8 * cv_c8 + 4) * 4);
#pragma unroll
                for (int e = 0; e < 4; ++e) { if (k < 4) { cw[k][e] = a[e]; cw[k][4 + e] = c[e]; } else { cbias[e] = a[e]; cbias[4 + e] = c[e]; } } }
            if (MODE != 2) {
                float x[5][8];
#pragma unroll
                for (int r = 0; r < 5; ++r) { const u32x4 w = xw[r];
                    x[r][0] = bflo(w.x); x[r][1] = bfhi(w.x); x[r][2] = bflo(w.y); x[r][3] = bfhi(w.y); x[r][4] = bflo(w.z); x[r][5] = bfhi(w.z); x[r][6] = bflo(w.w); x[r][7] = bfhi(w.w); }
                if (ch + 1 < nchunks) load_x(ch + 1);
#pragma unroll
                for (int t = 0; t < 2; ++t) { const int row = 2 * cv_tp + t;
                    float acc[8];
#pragma unroll
                    for (int e = 0; e < 8; ++e) acc[e] = cbias[e] + x[t][e] * cw[0][e] + x[t + 1][e] * cw[1][e] + x[t + 2][e] * cw[2][e] + x[t + 3][e] * cw[3][e];
                    u32x4 o; o.x = cvt_pk_bf16(acc[0], acc[1]); o.y = cvt_pk_bf16(acc[2], acc[3]); o.z = cvt_pk_bf16(acc[4], acc[5]); o.w = cvt_pk_bf16(acc[6], acc[7]);
                    *(LAS u32x4*)(XC + off256(row, cv_c8)) = o; }
            } else {
#pragma unroll
                for (int t = 0; t < 2; ++t) { const int row = 2 * cv_tp + t, j = row & 7, bb = 8 * b + (row >> 3);
                    float acc[8];
#pragma unroll
                    for (int e = 0; e < 8; ++e) acc[e] = cbias[e];
#pragma unroll
                    for (int k = 0; k < 4; ++k) { const int xi = j + k; float xv[8];
                        if (xi < 3) { const f32x4 a = *(const f32x4*)(P.state_conv + ((size_t)bb * 3 + xi) * D + cg_v), c = *(const f32x4*)(P.state_conv + ((size_t)bb * 3 + xi) * D + cg_v + 4);
#pragma unroll
                            for (int e = 0; e < 4; ++e) { xv[e] = a[e]; xv[4 + e] = c[e]; } }
                        else { const u32x4 w = *(const u32x4*)(P.RX + (size_t)(ROW_S + bb * 8 + xi - 3) * D + cg_v);
                            xv[0] = bflo(w.x); xv[1] = bfhi(w.x); xv[2] = bflo(w.y); xv[3] = bfhi(w.y); xv[4] = bflo(w.z); xv[5] = bfhi(w.z); xv[6] = bflo(w.w); xv[7] = bfhi(w.w); }
#pragma unroll
                        for (int e = 0; e < 8; ++e) acc[e] += xv[e] * cw[k][e]; }
                    u32x4 o; o.x = cvt_pk_bf16(acc[0], acc[1]); o.y = cvt_pk_bf16(acc[2], acc[3]); o.z = cvt_pk_bf16(acc[4], acc[5]); o.w = cvt_pk_bf16(acc[6], acc[7]);
                    *(LAS u32x4*)(XC + off256(row, cv_c8)) = o; }
            }
        }
        __syncthreads();
        u32x4 gw0 = (u32x4){0u, 0u, 0u, 0u}, gw1 = gw0;
        if (MODE != 0) { int grow; if (MODE == 2) grow = ROW_S + 64 * b + lane; else { const int p = p0 + lane; grow = prompt_row(b, p < TP ? p : TP - 1); }
            gw0 = *(const u32x4*)(P.GRG + (size_t)grow * D + n * 128 + 16 * wave); gw1 = *(const u32x4*)(P.GRG + (size_t)grow * D + n * 128 + 16 * wave + 8); }
        f32x4 ga[4], gx[4];
#pragma unroll
        for (int tb = 0; tb < 4; ++tb) { ga[tb] = (f32x4){0.f, 0.f, 0.f, 0.f}; gx[tb] = (f32x4){0.f, 0.f, 0.f, 0.f}; }
#pragma unroll
        for (int tb = 0; tb < 4; ++tb)
#pragma unroll
            for (int ks = 0; ks < 4; ++ks) { const bf16x8 af = *(const LAS bf16x8*)(XC + off256(16 * tb + l15, 4 * ks + g));
                ga[tb] = __builtin_amdgcn_mfma_f32_16x16x32_bf16(af, wfa[ks], ga[tb], 0, 0, 0); gx[tb] = __builtin_amdgcn_mfma_f32_16x16x32_bf16(af, wfx[ks], gx[tb], 0, 0, 0); }
#pragma unroll
        for (int tb = 0; tb < 4; ++tb)
#pragma unroll
            for (int e = 0; e < 4; ++e) { const int tok = 16 * tb + 4 * g + e;
                const float xcv = bf2f(*(const LAS bf16*)(XC + off256(tok, cl >> 3) + 2 * (cl & 7)));
                const float rr = sigmoidf_(ga[tb][e] + ba_c), ii = sigmoidf_(gx[tb][e] + bx_c);
                float a = fast_exp2(rr * spl8); float u = __builtin_amdgcn_sqrtf(fmaxf(1.0f - a * a, 0.f)) * ii * xcv;
                if (nvalid < 64) { if (tok >= nvalid) { a = 1.f; u = 0.f; } }
                PA[tok * 17 + l15] = a; PU[tok * 17 + l15] = u; }
        LDS_WAIT(); asm volatile("" ::: "memory");
        float av[16], uv[16];
#pragma unroll
        for (int i = 0; i < 16; ++i) { av[i] = PA[(16 * g + i) * 17 + l15]; uv[i] = PU[(16 * g + i) * 17 + l15]; }
        if (MODE == 2) {
#pragma unroll
            for (int t2 = 0; t2 < 2; ++t2) { const int bb = 8 * b + 2 * g + t2; float h = P.state_rg[(size_t)bb * D + cg];
#pragma unroll
                for (int j = 0; j < 8; ++j) { h = av[8 * t2 + j] * h + uv[8 * t2 + j]; PA[(16 * g + 8 * t2 + j) * 17 + l15] = h; }
                P.out[O_SH + (size_t)bb * D + cg] = h; }
        } else {
            float A = 1.f, Hh = 0.f;
#pragma unroll
            for (int i = 0; i < 16; ++i) { Hh = av[i] * Hh + uv[i]; A *= av[i]; }
            *(LAS f32x2*)(PS + (g * 16 + l15) * 2) = (f32x2){A, Hh};
            LDS_WAIT(); asm volatile("" ::: "memory");
            float hin = hc, hend = hc, Aend = 1.f;
#pragma unroll
            for (int q = 0; q < 4; ++q) { const f32x2 sv = *(LAS f32x2*)(PS + (q * 16 + l15) * 2); if (q < g) hin = sv.x * hin + sv.y; hend = sv.x * hend + sv.y; Aend *= sv.x; }
            hc = hend; cA *= Aend;
            if (MODE == 1) { float h = hin;
#pragma unroll
                for (int i = 0; i < 16; ++i) { h = av[i] * h + uv[i]; PA[(16 * g + i) * 17 + l15] = h; } }
        }
        if (MODE != 0) {
            LDS_WAIT(); asm volatile("" ::: "memory");
            const int row = lane; int grow;
            if (MODE == 2) grow = ROW_S + 64 * b + row; else { const int p = p0 + row; grow = prompt_row(b, p < TP ? p : TP - 1); }
            if (MODE == 2 || (row < nvalid && p0 >= NMETA)) {
                f32x4 g0, g1, g2, g3; pg8::unpack8(gw0, g0, g1); pg8::unpack8(gw1, g2, g3);
                float hv[16];
#pragma unroll
                for (int c = 0; c < 16; ++c) hv[c] = PA[row * 17 + c];
                const f32x4 h0 = (f32x4){hv[0], hv[1], hv[2], hv[3]}, h1 = (f32x4){hv[4], hv[5], hv[6], hv[7]}, h2 = (f32x4){hv[8], hv[9], hv[10], hv[11]}, h3 = (f32x4){hv[12], hv[13], hv[14], hv[15]};
                *(u32x4*)(P.HRG + (size_t)grow * D + n * 128 + 16 * wave) = pg8::pack8(h0 * g0, h1 * g1); *(u32x4*)(P.HRG + (size_t)grow * D + n * 128 + 16 * wave + 8) = pg8::pack8(h2 * g2, h3 * g3); }
            LDS_WAIT(); asm volatile("" ::: "memory");
        }
    }
    if (MODE == 0) { if (g == 0) *(f32x2*)(P.SEG + (((size_t)b * 3 + seg) * D + cg) * 2) = (f32x2){cA, hc}; }
    if (MODE == 1 && seg == 3) { if (g == 0) P.out[O_PH + (size_t)b * D + cg] = hc; }
    __syncthreads();
}
template <int K>
__device__ __forceinline__ void skinny_partial(const Frame& F, const bf16* __restrict__ A, const int lda, const bf16* __restrict__ Bt, const int ldb, const int r0, const int c0, const int lane, float& v0, float& v1) {
    LAS unsigned char* lds = F.lds;
    constexpr int KP = K > 1024 ? 1024 : K, NPASS = K / KP, RB = KP * 2  , SLAB = 32 * RB, NPW = KP / 128  , CPW = KP / 64  ;
    static_assert(K % KP == 0 && KP % 128 == 0 && 2 * SLAB <= MISC_OFF, "skinny shape");
    const int w = F.wave, hh = lane >> 5, l31 = lane & 31;
    f32x16 acc = (f32x16){};
    __syncthreads();
#pragma unroll 1
    for (int ps = 0; ps < NPASS; ++ps) {
#pragma unroll
        for (int i = 0; i < NPW; ++i) { const unsigned pos = 1024u * (w * NPW + i) + 16u * lane, row = pos / RB, chp = (pos % RB) >> 4, ch = chp ^ (row & 15u);
            __builtin_amdgcn_global_load_lds((const unsigned*)(A + (size_t)(r0 + row) * lda + ps * KP + 8 * ch), (LAS unsigned*)(lds + 1024 * (w * NPW + i)), 16, 0, 0);
            __builtin_amdgcn_global_load_lds((const unsigned*)(Bt + (size_t)(c0 + row) * ldb + ps * KP + 8 * ch), (LAS unsigned*)(lds + SLAB + 1024 * (w * NPW + i)), 16, 0, 0); }
        VM_WAIT(); __syncthreads();
#pragma unroll
        for (int s = 0; s < NPW; ++s) { const unsigned ch = (unsigned)(w * CPW + 2 * s + hh) ^ (unsigned)(l31 & 15);
            const bf16x8 af = *(const LAS bf16x8*)(lds + l31 * RB + 16 * ch), bfr = *(const LAS bf16x8*)(lds + SLAB + l31 * RB + 16 * ch);
            acc = __builtin_amdgcn_mfma_f32_32x32x16_bf16(bfr, af, acc, 0, 0, 0); }
        __syncthreads();
    }
#pragma unroll
    for (int r = 0; r < 16; ++r) *(LAS float*)(lds + ((w * 16 + r) * 64 + lane) * 4) = acc[r];
    __syncthreads();
    const int t = F.tid, ln = t & 63, rg = 2 * (t >> 6);
    float s0 = 0.f, s1 = 0.f;
#pragma unroll
    for (int ww = 0; ww < 8; ++ww) { s0 += *(const LAS float*)(lds + ((ww * 16 + rg) * 64 + ln) * 4); s1 += *(const LAS float*)(lds + ((ww * 16 + rg + 1) * 64 + ln) * 4); }
    v0 = s0; v1 = s1;
}
__device__ __forceinline__ void skinny_coord(const int tid, int& row, int& col) { const int ln = tid & 63, rg = 2 * (tid >> 6); row = ln & 31; col = (rg & 3) + 8 * (rg >> 2) + 4 * (ln >> 5); }
constexpr int PA_KB = 64 * 384, PA_VB = 64 * 256;
constexpr int PA_K0 = 0, PA_V0 = 2 * PA_KB, PA_END = PA_V0 + 2 * PA_VB;
static_assert(PA_END <= MISC_OFF, "prompt attention lds");
__device__ __forceinline__ unsigned offK384(unsigned row, unsigned ch) { return 384u * row + 16u * (ch ^ ((row >> 1) & 7)); }
struct PAttnParams { const bf16 *QA, *KN, *KPE, *V; bf16* O; };

__device__ __forceinline__ void pattn_unit(const Frame& F, const PAttnParams& P, const int b, const int h, const int x) {
    LAS unsigned char* lds = F.lds;
    int lane = F.lane; asm volatile("" : "+v"(lane));
    const int w = F.wave, hh = lane >> 5, l31 = lane & 31;
#pragma nounroll
    for (int half = 0; half < 2; ++half) {
    const int xb = half ? 7 - x : x;
    const int tq = 256 * xb + 32 * w + l31;
    const size_t qrow = (size_t)b * SEQ + tq;
    bf16x8 qf[12];
#pragma unroll
    for (int s = 0; s < 12; ++s) qf[s] = *(const bf16x8*)(P.QA + qrow * 1536 + h * 192 + 16 * s + 8 * hh);
    f32x16 o[4];
#pragma unroll
    for (int i = 0; i < 4; ++i) o[i] = (f32x16){};
    float m = -1e30f, l = 0.f;
    const int ntiles = 1 + 4 * (xb + 1);
    unsigned ksrc[3], kstep[3], vsrc[2];
    const char* wsb = (const char*)P.KN - WS_KN;
#pragma unroll
    for (int i = 0; i < 3; ++i) { const unsigned pos = 1024u * (w + 8 * i) + 16u * lane, row = pos / 384u, chp = (pos % 384u) >> 4, ch = chp ^ ((row >> 1) & 7u);
        if (ch < 16) { ksrc[i] = (unsigned)WS_KN + (row * D + h * 128 + 8 * ch) * 2u; kstep[i] = D * 2; } else { ksrc[i] = (unsigned)WS_KPE + (row * 64 + 8 * (ch - 16)) * 2u; kstep[i] = 64 * 2; } }
#pragma unroll
    for (int i = 0; i < 2; ++i) { const unsigned pos = 1024u * (w + 8 * i) + 16u * lane, row = pos >> 8, chp = (pos & 255u) >> 4, ch = chp ^ (((row & 3) << 2) | ((row >> 2) & 3));
        vsrc[i] = (unsigned)WS_V + (row * D + h * 128 + 8 * ch) * 2u; }
    auto issue = [&](int it, int buf) {
        const unsigned row0 = it == 0 ? (unsigned)ROW_M : (unsigned)(b * SEQ + 64 * (it - 1));
#pragma unroll
        for (int i = 0; i < 3; ++i) __builtin_amdgcn_global_load_lds((const unsigned*)(wsb + (ksrc[i] + row0 * kstep[i])), (LAS unsigned*)(lds + PA_K0 + buf * PA_KB + 1024 * (w + 8 * i)), 16, 0, 0);
#pragma unroll
        for (int i = 0; i < 2; ++i) __builtin_amdgcn_global_load_lds((const unsigned*)(wsb + (vsrc[i] + row0 * (unsigned)(D * 2))), (LAS unsigned*)(lds + PA_V0 + buf * PA_VB + 1024 * (w + 8 * i)), 16, 0, 0);
    };
    issue(0, 0); VM_WAIT(); __syncthreads();
    constexpr float SC = SM_SCALE * LOG2E;
    const int trq = (lane & 15) >> 2, trp = lane & 3, trblk = (lane >> 4) & 1;
    unsigned kb4[4], vb8[2][4];
    { const unsigned sw = (l31 >> 1) & 7u, a = sw >> 1, c = sw & 1u;
#pragma unroll
      for (int v = 0; v < 4; ++v) kb4[v] = 384u * l31 + 16u * ((unsigned)hh ^ c) + 32u * ((unsigned)v ^ a);
      const unsigned clo = 2u * trblk + (trp >> 1);
#pragma unroll
      for (int t = 0; t < 2; ++t)
#pragma unroll
          for (int db = 0; db < 4; ++db) vb8[t][db] = 256u * (4u * hh + trq) + 8u * (trp & 1) + 16u * (clo ^ ((2u * t + hh) & 3u)) + 64u * ((unsigned)db ^ (unsigned)trq); }
#pragma nounroll
    for (int it = 0; it < ntiles; ++it) {
        const int buf = it & 1;
        if (it + 1 < ntiles) issue(it + 1, buf ^ 1);
        const int qmin = 256 * xb + 32 * w; const bool skip = (it > 0) && (64 * (it - 1) > qmin + 31);
        const int lim0 = (it == 0) ? NMETA : tq - 64 * (it - 1) + 1, lim1 = (it == 0) ? 0 : lim0 - 32;
        if (!skip) {
            f32x16 p0 = (f32x16){}, p1 = (f32x16){};
            const LAS unsigned char* Kb = lds + PA_K0 + buf * PA_KB;
#pragma unroll
            for (int sg = 0; sg < 6; ++sg) {
#pragma unroll
                for (int s = 2 * sg; s < 2 * sg + 2; ++s) { const bf16x8 a0 = *(const LAS bf16x8*)(Kb + kb4[s & 3] + 128 * (s >> 2)), a1 = *(const LAS bf16x8*)(Kb + kb4[s & 3] + 12288 + 128 * (s >> 2));
                    p0 = __builtin_amdgcn_mfma_f32_32x32x16_bf16(a0, qf[s], p0, 0, 0, 0); p1 = __builtin_amdgcn_mfma_f32_32x32x16_bf16(a1, qf[s], p1, 0, 0, 0); }
                __builtin_amdgcn_sched_barrier(0); }
            float pmax = -3e38f;
#pragma unroll
            for (int r = 0; r < 16; ++r) { const int kl = (r & 3) + 8 * (r >> 2) + 4 * hh;
                float x0 = p0[r] * SC, x1 = p1[r] * SC;
                x0 = kl < lim0 ? x0 : -3e38f; x1 = kl < lim1 ? x1 : -3e38f;
                p0[r] = x0; p1[r] = x1; pmax = fmaxf(pmax, fmaxf(x0, x1)); }
            pmax = fmaxf(pmax, __shfl_xor(pmax, 32));
            const float mn = fmaxf(m, pmax), alpha = fast_exp2(m - mn); m = mn;
            float ps = 0.f;
#pragma unroll
            for (int r = 0; r < 16; ++r) { p0[r] = fast_exp2(p0[r] - mn); p1[r] = fast_exp2(p1[r] - mn); ps += p0[r] + p1[r]; }
            l = l * alpha + ps;
#pragma unroll
            for (int i = 0; i < 4; ++i) o[i] = o[i] * alpha;
            const LAS unsigned char* Vb = lds + PA_V0 + buf * PA_VB;
#pragma unroll
            for (int kb = 0; kb < 2; ++kb)
#pragma unroll
                for (int s2 = 0; s2 < 2; ++s2) {
                    bf16x8 pf; { const f32x16& pp = kb ? p1 : p0; u32x4 t; t.x = cvt_pk_bf16(pp[8 * s2 + 0], pp[8 * s2 + 1]); t.y = cvt_pk_bf16(pp[8 * s2 + 2], pp[8 * s2 + 3]); t.z = cvt_pk_bf16(pp[8 * s2 + 4], pp[8 * s2 + 5]); t.w = cvt_pk_bf16(pp[8 * s2 + 6], pp[8 * s2 + 7]); pf = __builtin_bit_cast(bf16x8, t); }
#pragma unroll
                    for (int db = 0; db < 4; ++db) {
                        const s16x4 t0 = __builtin_amdgcn_ds_read_tr16_b64_v4i16((LAS s16x4*)(Vb + vb8[0][db] + 256 * (32 * kb + 16 * s2)));
                        const s16x4 t1 = __builtin_amdgcn_ds_read_tr16_b64_v4i16((LAS s16x4*)(Vb + vb8[1][db] + 256 * (32 * kb + 16 * s2 + 8)));
                        bf16x8 vf; vf[0] = t0[0]; vf[1] = t0[1]; vf[2] = t0[2]; vf[3] = t0[3]; vf[4] = t1[0]; vf[5] = t1[1]; vf[6] = t1[2]; vf[7] = t1[3];
                        o[db] = __builtin_amdgcn_mfma_f32_32x32x16_bf16(vf, pf, o[db], 0, 0, 0); }
                    __builtin_amdgcn_sched_barrier(0); }
        }
        VM_WAIT(); __syncthreads();
    }
    l += __shfl_xor(l, 32);
    const float il = 1.0f / l;
    bf16* orow = P.O + qrow * D + h * 128;
#pragma unroll
    for (int db = 0; db < 4; ++db)
#pragma unroll
        for (int rq = 0; rq < 4; ++rq) { u32x2 wv; wv.x = cvt_pk_bf16(o[db][4 * rq] * il, o[db][4 * rq + 1] * il); wv.y = cvt_pk_bf16(o[db][4 * rq + 2] * il, o[db][4 * rq + 3] * il);
            *(u32x2*)(orow + 32 * db + 8 * rq + 4 * hh) = wv; }
    __syncthreads();
    }
}
constexpr int SA_CKVB = 32 * 1024, SA_KPEB = 32 * 128;
constexpr int SA_CKV0 = 0, SA_KPE0 = 2 * SA_CKVB, SA_SB = SA_KPE0 + 2 * SA_KPEB, SA_PB = SA_SB + 64 * 36 * 4, SA_AL = SA_PB + 64 * 64, SA_QL2 = SA_AL + 256, SA_END = SA_QL2 + 64 * 576;
constexpr int SA_QL = 0;
static_assert(64 * 576 * 2 <= SA_SB && SA_END <= MISC_OFF, "sample attention lds");
__device__ __forceinline__ unsigned off1024(unsigned row, unsigned ch) { return 1024u * row + 16u * (ch ^ (((row & 3) << 2) | ((row >> 2) & 3))); }
__device__ __forceinline__ unsigned offkpe(unsigned row, unsigned ch) { return 128u * row + 16u * (ch ^ ((row >> 1) & 7)); }
__device__ __forceinline__ unsigned offQ2(unsigned rho, unsigned ch) { return 576u * rho + 16u * (ch ^ ((rho >> 2) & 3)); }
__device__ __forceinline__ unsigned offP(unsigned rho, unsigned ch) { return 64u * rho + 16u * (ch ^ ((rho >> 2) & 3)); }
struct SAttnParams { const float *cckv, *ckpe; const int* pt; const bf16 *QA, *WUKS, *CKVNS, *KPE; float *OPART, *ML; };

__device__ __forceinline__ void sattn_unit(const Frame& F, const SAttnParams& P, const int b, const int sp) {
    LAS unsigned char* lds = F.lds;
    int tid = F.tid; asm volatile("" : "+v"(tid));
    const int lane = tid & 63, w = F.wave, hh = lane >> 5, l31 = lane & 31, l15 = lane & 15, g = lane >> 4;
    {
        const int h = w;
        bf16x8 qa[4];
#pragma unroll
        for (int ks = 0; ks < 4; ++ks) qa[ks] = *(const bf16x8*)(P.QA + (size_t)(ROW_S + b * 8 + (l15 & 7)) * 1536 + h * 192 + 32 * ks + 8 * g);
        const bf16* wk = P.WUKS + (size_t)h * (32 * 4 * 512) + lane * 8;
        for (int rb = 0; rb < 32; ++rb) {
            f32x4 acc = (f32x4){0.f, 0.f, 0.f, 0.f};
#pragma unroll
            for (int ks = 0; ks < 4; ++ks) { const bf16x8 bw = *(const bf16x8*)(wk + (size_t)(rb * 4 + ks) * 512); acc = __builtin_amdgcn_mfma_f32_16x16x32_bf16(qa[ks], bw, acc, 0, 0, 0); }
            if (g < 2) {
#pragma unroll
                for (int e = 0; e < 4; ++e) *(LAS bf16*)(lds + SA_QL + ((h * 8 + 4 * g + e) * 576 + 16 * rb + l15) * 2) = (bf16)(cvt_pk_bf16(acc[e], 0.f) & 0xffffu);
            }
        }
        { const int rho = tid >> 3, c8 = tid & 7; const int hq = rho >> 3, j = rho & 7;
          *(LAS u32x4*)(lds + SA_QL + (rho * 576 + 512 + 8 * c8) * 2) = *(const u32x4*)(P.QA + (size_t)(ROW_S + b * 8 + j) * 1536 + hq * 192 + 128 + 8 * c8); }
    }
    __syncthreads();
#ifdef DBG_QLAT
    { bf16* dbg = (bf16*)((unsigned char*)P.OPART - WS_OPART + WS_U) + (size_t)(b * NSPLIT + sp) * 64 * 576;
      for (int i = tid; i < 64 * 576 / 8; i += NTHR) *(u32x4*)(dbg + i * 8) = *(const LAS u32x4*)(lds + SA_QL + i * 16); }
#endif
    const int kb = w & 1, rb = w >> 1;
    bf16x8 qb[9];
#pragma unroll
    for (int s = 0; s < 9; ++s) qb[s] = *(const LAS bf16x8*)(lds + SA_QL + ((16 * rb + l15) * 576 + 32 * s + 8 * g) * 2);
    for (int i = tid; i < 64 * 36; i += NTHR) { const int rho = i / 36, c = i % 36; *(LAS u32x4*)(lds + SA_QL2 + offQ2(rho, c)) = *(const LAS u32x4*)(lds + SA_QL + (rho * 576 + 288 + 8 * c) * 2); }
    __syncthreads();
    const unsigned q2b = offQ2(16 * rb + l15, g);
    f32x16 o[2][2];
#pragma unroll
    for (int i = 0; i < 2; ++i)
#pragma unroll
        for (int j = 0; j < 2; ++j) o[i][j] = (f32x16){};
    const int srho = tid >> 3, skg = tid & 7;
    float m = -1e30f, l = 0.f;
    constexpr float SC = SM_SCALE * LOG2E;
    const int ptv = P.pt[b * NPAGES + 16 * sp + (lane & 15)];
    f32x4 crA[8], krA, crB[8], krB;
    auto issue = [&](int it, f32x4 (&cr)[8], f32x4& kr) {
        const unsigned phys = (unsigned)__builtin_amdgcn_readlane(ptv, it >> 2); const unsigned key0 = phys * PAGE + (unsigned)(it & 3) * 32u;
        const char* cbase = (const char*)P.cckv; const char* kbase = (const char*)P.ckpe;
#pragma unroll
        for (int i = 0; i < 4; ++i) { const unsigned off = ((key0 + (tid >> 6) + 8 * i) * KVL + 4 * (tid & 63)) * 4u; cr[2 * i] = *(const f32x4*)(cbase + off); cr[2 * i + 1] = *(const f32x4*)(cbase + off + 1024); }
        kr = *(const f32x4*)(kbase + ((key0 + (tid >> 4)) * QKR + 4 * (tid & 15)) * 4u);
    };
    auto commit = [&](int buf, const f32x4 (&cr)[8], const f32x4& kr) {
#pragma unroll
        for (int i = 0; i < 4; ++i)
#pragma unroll
            for (int hf = 0; hf < 2; ++hf) { const f32x4 v = cr[2 * i + hf]; u32x2 wv; wv.x = cvt_pk_bf16(v[0], v[1]); wv.y = cvt_pk_bf16(v[2], v[3]);
                *(LAS u32x2*)(lds + SA_CKV0 + buf * SA_CKVB + off1024((tid >> 6) + 8 * i, 32 * hf + ((tid & 63) >> 1)) + 8 * (tid & 1)) = wv; }
        u32x2 wv; wv.x = cvt_pk_bf16(kr[0], kr[1]); wv.y = cvt_pk_bf16(kr[2], kr[3]);
        *(LAS u32x2*)(lds + SA_KPE0 + buf * SA_KPEB + offkpe(tid >> 4, (tid & 15) >> 1) + 8 * (tid & 1)) = wv;
    };
    const int trq = l15 >> 2, trp = lane & 3, trblk = g & 1;
    unsigned sa4[4], ka2[2], va4[2][2], pa2[2];
    { const unsigned a = l15 & 3u, c = (l15 >> 2) & 3u, e = (l15 >> 1) & 7u, f = (l31 >> 2) & 3u, clo = 2u * trblk + (trp >> 1);
#pragma unroll
      for (int v = 0; v < 4; ++v) sa4[v] = 1024u * (16u * kb + l15) + 16u * ((unsigned)g ^ c) + 64u * ((unsigned)v ^ a);
#pragma unroll
      for (int s2 = 0; s2 < 2; ++s2) { ka2[s2] = offkpe(16u * kb + l15, 4u * s2 + g); pa2[s2] = offP(l31, 2u * s2 + hh); }
#pragma unroll
      for (int t = 0; t < 2; ++t)
#pragma unroll
          for (int db = 0; db < 2; ++db) va4[t][db] = 1024u * (8u * hh + 4u * t + trq) + 8u * (trp & 1) + 16u * (clo ^ ((2u * hh + t) & 3u)) + 64u * (((2u * (w & 1) + db) ^ (unsigned)trq)) + 256u * (w >> 1); }
    auto compute = [&](const int buf, const bool newtile) {
#ifdef SA_PROBE_SLEEP
        __builtin_amdgcn_s_sleep(SA_PROBE_SLEEP);
#endif
        {
            const LAS unsigned char* Cb = lds + SA_CKV0 + buf * SA_CKVB; const LAS unsigned char* Kb = lds + SA_KPE0 + buf * SA_KPEB;
            f32x4 acc = (f32x4){0.f, 0.f, 0.f, 0.f};
#pragma unroll
            for (int s = 0; s < 16; ++s) { const bf16x8 a = *(const LAS bf16x8*)(Cb + sa4[s & 3] + 256 * (s >> 2));
                const bf16x8 q = s < 9 ? qb[s < 9 ? s : 0] : *(const LAS bf16x8*)(lds + SA_QL2 + q2b + 64 * (s - 9));
                acc = __builtin_amdgcn_mfma_f32_16x16x32_bf16(a, q, acc, 0, 0, 0);
                if ((s & 3) == 3) __builtin_amdgcn_sched_barrier(0); }
#pragma unroll
            for (int s = 0; s < 2; ++s) { const bf16x8 a = *(const LAS bf16x8*)(Kb + ka2[s]); const bf16x8 q = *(const LAS bf16x8*)(lds + SA_QL2 + q2b + 64 * (7 + s));
                acc = __builtin_amdgcn_mfma_f32_16x16x32_bf16(a, q, acc, 0, 0, 0); }
            *(LAS f32x4*)(lds + SA_SB + ((16 * rb + l15) * 36 + 16 * kb + 4 * g) * 4) = acc;
        }
        __syncthreads();
        {
            f32x4 v = *(const LAS f32x4*)(lds + SA_SB + (srho * 36 + 4 * skg) * 4) * SC;
            if (newtile) {
#pragma unroll
                for (int e = 0; e < 4; ++e) if (4 * skg + e > (srho & 7)) v[e] = -3e38f;
            }
            float tm = fmaxf(fmaxf(v[0], v[1]), fmaxf(v[2], v[3]));
            tm = fmaxf(tm, __shfl_xor(tm, 1)); tm = fmaxf(tm, __shfl_xor(tm, 2)); tm = fmaxf(tm, __shfl_xor(tm, 4));
            const float mn = fmaxf(m, tm), alpha = fast_exp2(m - mn); m = mn;
#pragma unroll
            for (int e = 0; e < 4; ++e) v[e] = fast_exp2(v[e] - mn);
            float ps = (v[0] + v[1]) + (v[2] + v[3]);
            ps += __shfl_xor(ps, 1); ps += __shfl_xor(ps, 2); ps += __shfl_xor(ps, 4);
            l = l * alpha + ps;
            u32x2 wv; wv.x = cvt_pk_bf16(v[0], v[1]); wv.y = cvt_pk_bf16(v[2], v[3]);
            *(LAS u32x2*)(lds + SA_PB + offP(srho, skg >> 1) + 8 * (skg & 1)) = wv;
            if (skg == 0) *(LAS float*)(lds + SA_AL + srho * 4) = alpha;
        }
    };
    auto pv = [&](const int buf) {
        const LAS unsigned char* Cb = lds + SA_CKV0 + buf * SA_CKVB;
        const float a0 = *(const LAS float*)(lds + SA_AL + l31 * 4), a1 = *(const LAS float*)(lds + SA_AL + (32 + l31) * 4);
#pragma unroll
        for (int db = 0; db < 2; ++db) { o[db][0] = o[db][0] * a0; o[db][1] = o[db][1] * a1; }
#pragma unroll
        for (int s2 = 0; s2 < 2; ++s2) {
            const bf16x8 pb0 = *(const LAS bf16x8*)(lds + SA_PB + pa2[s2]), pb1 = *(const LAS bf16x8*)(lds + SA_PB + pa2[s2] + 2048);
#pragma unroll
            for (int db = 0; db < 2; ++db) {
                const s16x4 t0 = __builtin_amdgcn_ds_read_tr16_b64_v4i16((LAS s16x4*)(Cb + va4[0][db] + 16384 * s2));
                const s16x4 t1 = __builtin_amdgcn_ds_read_tr16_b64_v4i16((LAS s16x4*)(Cb + va4[1][db] + 16384 * s2));
                bf16x8 vf; vf[0] = t0[0]; vf[1] = t0[1]; vf[2] = t0[2]; vf[3] = t0[3]; vf[4] = t1[0]; vf[5] = t1[1]; vf[6] = t1[2]; vf[7] = t1[3];
                o[db][0] = __builtin_amdgcn_mfma_f32_32x32x16_bf16(vf, pb0, o[db][0], 0, 0, 0);
                o[db][1] = __builtin_amdgcn_mfma_f32_32x32x16_bf16(vf, pb1, o[db][1], 0, 0, 0); } }
    };
    constexpr int NT = (PAST / NSPLIT) / 32;
    issue(0, crA, krA); commit(0, crA, krA); issue(1, crB, krB); issue(2, crA, krA); __syncthreads();
#pragma nounroll
    for (int it = 0; it < NT; it += 2) {
        compute(0, false);
        commit(1, crB, krB); if (it + 3 < NT) issue(it + 3, crB, krB);
        __syncthreads();
        pv(0);
        compute(1, false);
        if (it + 2 < NT) { commit(0, crA, krA); if (it + 4 < NT) issue(it + 4, crA, krA); }
        __syncthreads();
        pv(1);
    }
    if (sp == NSPLIT - 1) {
        __syncthreads();
        { const char* wsb = (const char*)P.KPE - WS_KPE;
#pragma nounroll
          for (int i = tid; i < 32 * 64; i += NTHR) { const int key = i >> 6, ch = i & 63; u32x4 v = (u32x4){0u, 0u, 0u, 0u}; if (key < DS) v = *(const u32x4*)(wsb + ((unsigned)WS_CKVNS + (unsigned)(((b * DS + key) * KVL + 8 * ch) * 2)));
            *(LAS u32x4*)(lds + SA_CKV0 + off1024(key, ch)) = v; }
          if (tid < 32 * 8) { const int key = tid >> 3, ch = tid & 7; u32x4 v = (u32x4){0u, 0u, 0u, 0u}; if (key < DS) v = *(const u32x4*)(wsb + ((unsigned)WS_KPE + (unsigned)(((ROW_S + b * DS + key) * 64 + 8 * ch) * 2)));
            *(LAS u32x4*)(lds + SA_KPE0 + offkpe(key, ch)) = v; } }
        __syncthreads();
        compute(0, true);
        __syncthreads();
        pv(0);
    }
    float* op = P.OPART + ((size_t)(b * NSPLIT + sp) * 64) * KVL;
#pragma unroll
    for (int db = 0; db < 2; ++db)
#pragma unroll
        for (int rbk = 0; rbk < 2; ++rbk)
#pragma unroll
            for (int rq = 0; rq < 4; ++rq) *(f32x4*)(op + (size_t)(32 * rbk + l31) * KVL + 64 * w + 32 * db + 8 * rq + 4 * hh) = (f32x4){o[db][rbk][4 * rq], o[db][rbk][4 * rq + 1], o[db][rbk][4 * rq + 2], o[db][rbk][4 * rq + 3]};
    if (skg == 0) *(f32x2*)(P.ML + ((size_t)(b * NSPLIT + sp) * 64 + srho) * 2) = (f32x2){m, l};
    __syncthreads();
}

struct SCombParams { const float *OPART, *ML, *w_uv; bf16* O; };
__device__ __forceinline__ void scomb_unit(const Frame& F, const SCombParams& P, const int b, const int h) {
    LAS float* OL = (LAS float*)F.lds;
    int tid = F.tid; asm volatile("" : "+v"(tid));
    {
        const int r = tid;
#pragma unroll
        for (int j = 0; j < 8; ++j) { const int rho = h * 8 + j; float mm[NSPLIT], ll[NSPLIT], M = -3e38f;
#pragma unroll
            for (int s = 0; s < NSPLIT; ++s) { const f32x2 v = *(const f32x2*)(P.ML + ((size_t)(b * NSPLIT + s) * 64 + rho) * 2); mm[s] = v.x; ll[s] = v.y; M = fmaxf(M, v.x); }
            float L = 0.f, acc = 0.f;
#pragma unroll
            for (int s = 0; s < NSPLIT; ++s) { const float wgt = fast_exp2(mm[s] - M); L += wgt * ll[s]; acc += wgt * P.OPART[((size_t)(b * NSPLIT + s) * 64 + rho) * KVL + r]; }
            OL[j * 512 + r] = acc / L; }
    }
    __syncthreads();
    {
        const int d = tid & 127, rq = tid >> 7; float acc[8];
#pragma unroll
        for (int j = 0; j < 8; ++j) acc[j] = 0.f;
        const float* wp = P.w_uv + (size_t)(128 * rq) * 1024 + h * 128 + d;
#pragma unroll 16
        for (int r = 0; r < 128; ++r) { const float wv = wp[(size_t)r * 1024];
#pragma unroll
            for (int j = 0; j < 8; ++j) acc[j] += OL[j * 512 + 128 * rq + r] * wv; }
        LAS float* PT = OL + 8 * 512;
#pragma unroll
        for (int j = 0; j < 8; ++j) PT[(rq * 8 + j) * 128 + d] = acc[j];
        __syncthreads();
        const int j = tid >> 6, d2 = (tid & 63) * 2;
        const float o0 = (PT[(0 * 8 + j) * 128 + d2] + PT[(1 * 8 + j) * 128 + d2]) + (PT[(2 * 8 + j) * 128 + d2] + PT[(3 * 8 + j) * 128 + d2]);
        const float o1 = (PT[(0 * 8 + j) * 128 + d2 + 1] + PT[(1 * 8 + j) * 128 + d2 + 1]) + (PT[(2 * 8 + j) * 128 + d2 + 1] + PT[(3 * 8 + j) * 128 + d2 + 1]);
        *(unsigned*)(P.O + (size_t)(ROW_S + b * 8 + j) * D + h * 128 + d2) = cvt_pk_bf16(o0, o1);
    }
    __syncthreads();
}
__device__ __forceinline__ void thin_ckv_conv(const Frame& F, const Args& args) {
    unsigned char* ws = F.ws; float* out = F.out;
    const int gw = F.vcu * NWAVES + F.wave, NGW = F.G * NWAVES, lane = F.lane;
    const bf16* CKVR = (const bf16*)(ws + WS_CKVR); const float* SSQ = (const float*)(ws + WS_SSQKV); const bf16* RX = (const bf16*)(ws + WS_RX);
    const f32x4 g0 = *(const f32x4*)(IN_F(I_KVG) + 8 * lane), g1 = *(const f32x4*)(IN_F(I_KVG) + 8 * lane + 4);
    for (int row = gw; row < ROW_M + NMETA; row += NGW) {
        const f32x4 s0 = *(const f32x4*)(SSQ + (size_t)row * 8), s1 = *(const f32x4*)(SSQ + (size_t)row * 8 + 4);
        const float ss = ((s0[0] + s0[1]) + (s0[2] + s0[3])) + ((s1[0] + s1[1]) + (s1[2] + s1[3]));
        const float rstd = __builtin_amdgcn_rsqf(ss * (1.0f / KVL) + EPS);
        f32x4 v0, v1; pg8::unpack8(*(const u32x4*)(CKVR + (size_t)row * KVL + 8 * lane), v0, v1);
        v0 = v0 * rstd * g0; v1 = v1 * rstd * g1;
        if (row < ROW_S) { float* o = out + O_PCKV + ((size_t)(row >> 11) * TP + NMETA + (row & (SEQ - 1))) * KVL + 8 * lane; *(f32x4*)o = v0; *(f32x4*)(o + 4) = v1; }
        else if (row < ROW_M) { float* o = out + O_SCKV + (size_t)(row - ROW_S) * KVL + 8 * lane; *(f32x4*)o = v0; *(f32x4*)(o + 4) = v1;
            *(u32x4*)((bf16*)(ws + WS_CKVNS) + (size_t)(row - ROW_S) * KVL + 8 * lane) = pg8::pack8(v0, v1); }
        else { for (int b = 0; b < NB; ++b) { float* o = out + O_PCKV + ((size_t)b * TP + (row - ROW_M)) * KVL + 8 * lane; *(f32x4*)o = v0; *(f32x4*)(o + 4) = v1; } }
    }
    for (int i = gw; i < NB * 3 + DB * 3; i += NGW) {
        int srow; float* o;
        if (i < NB * 3) { const int b = i / 3, k = i % 3; srow = b * SEQ + SEQ - 3 + k; o = out + O_PCONV + (size_t)i * D; }
        else { const int q = i - NB * 3, b = q / 3, k = q % 3; srow = ROW_S + b * DS + DS - 3 + k; o = out + O_SCONV + (size_t)q * D; }
#pragma unroll
        for (int j = 0; j < 2; ++j) { f32x4 v0, v1; pg8::unpack8(*(const u32x4*)(RX + (size_t)srow * D + 8 * (lane + 64 * j)), v0, v1); *(f32x4*)(o + 8 * (lane + 64 * j)) = v0; *(f32x4*)(o + 8 * (lane + 64 * j) + 4) = v1; }
    }
}

constexpr int NPHASES = 11;
__global__ void __launch_bounds__(NTHR, 2) hawk_fwd(Args args) {
    extern __shared__ __attribute__((aligned(16))) unsigned char lds_raw[];
    Frame F;
    F.lds = (LAS unsigned char*)lds_raw; F.MISC = (volatile LAS unsigned*)(F.lds + MISC_OFF);
    F.tid = threadIdx.x; F.lane = F.tid & 63; F.wave = __builtin_amdgcn_readfirstlane(F.tid >> 6);
    F.G = gridDim.x; { const int bx = blockIdx.x; F.vcu = (F.G % 8 == 0) ? (bx % 8) * (F.G / 8) + bx / 8 : bx; }
    F.out = args.out; F.ws = args.ws; F.ctl = (unsigned*)(args.ws + WS_CTL);
    unsigned char* ws = args.ws;
    for (int u = F.tid; u < 64; u += NTHR) ((LAS unsigned*)(F.lds + MISC_OFF))[u] = 0u;
    __syncthreads();
#if MK_PER_PHASE
#define GRID_BAR() do { } while (0)
#else
    XcdBarrier bar = xcd_barrier_post((unsigned*)F.ctl + CW_BAR, F.MISC + 8);
#define GRID_BAR() xcd_barrier(bar)
#endif
    const int lo = args.ph_lo, hi = args.ph_hi;
#ifndef PH_MASK
#define PH_MASK 0x7ff
#endif
#define IN(k) ((((PH_MASK) >> (k)) & 1) && lo <= (k) && (k) < hi)
#ifndef DUP_MASK
#define DUP_MASK 0
#endif
#ifndef P3DUP
#define P3DUP 0
#endif
#ifndef P2DUP
#define P2DUP 0
#endif
#ifndef P5DUP
#define P5DUP 0
#endif
#ifndef P8DUP
#define P8DUP 0
#endif
#define DUPL(mask, bit) _Pragma("nounroll") for (int dup_ = 0; dup_ < 1 + (((mask) >> (bit)) & 1); ++dup_)
#define REP(k) _Pragma("nounroll") for (int rep_ = 0; rep_ < 1 + (((DUP_MASK) >> (k)) & 1); ++rep_)
#define SEAM(k) do { if (IN(k) && IN((k) + 1)) GRID_BAR(); F.tid = threadIdx.x; F.lane = F.tid & 63; } while (0)
    const int G = F.G, bx = blockIdx.x;

    if (IN(0)) REP(0) { p0_prologue(F, args); }
    SEAM(0);
    if (IN(1)) REP(1) {
        pg8::TileSched S; S.init(ws + WS_H, ws + WS_WIN, D, 66, 22, G, bx);
        pg8::EpiWin E{(bf16*)(ws + WS_RX), (bf16*)(ws + WS_GRG), (bf16*)(ws + WS_CQ), (bf16*)(ws + WS_CKVR), (bf16*)(ws + WS_G), (bf16*)(ws + WS_KPE), (float*)(ws + WS_SSQQ), (float*)(ws + WS_SSQKV),
                      IN_F(I_BGATE), (const float*)(ws + WS_ROPEC), (const float*)(ws + WS_ROPES), F.out};
        pg8::gemm_phase<pg8::EpiWin, pg8::TileSched, true, true>(F.lds, D, S, E);
    }
    SEAM(1);
    const RgParams RGP{(const bf16*)(ws + WS_RX), (const bf16*)(ws + WS_GRG), (const bf16*)(ws + WS_WAX), (bf16*)(ws + WS_HRG), IN_F(I_CONVW), IN_F(I_CONVB), IN_F(I_BA), IN_F(I_BX),
                       (const float*)(ws + WS_SPL), IN_F(I_SCONV), IN_F(I_SRG), (float*)(ws + WS_SEG), F.out};
    if (IN(2)) REP(2) {
        DUPL(P2DUP, 0) if (G == 256) { const int u = bx < 64 ? bx : (bx >= 128 ? bx - 64 : -1); if (u >= 0) rg_unit<0>(F, RGP, u / 24, (u / 3) % 8, u % 3); }
        else for (int u = F.vcu; u < 192; u += G) rg_unit<0>(F, RGP, u / 24, (u / 3) % 8, u % 3);
        if (G == 256) { if (bx >= 64 && bx < 96) rg_unit<2>(F, RGP, (bx - 64) >> 3, bx & 7, 0); }
        else for (int u = F.vcu; u < 32; u += G) rg_unit<2>(F, RGP, u >> 3, u & 7, 0);
        DUPL(P2DUP, 1) { pg8::TileSched S; S.init(ws + WS_CQ, ws + WS_WQ, QL, 64, 6, G, bx);
          pg8::EpiQ E{(bf16*)(ws + WS_QA), (const float*)(ws + WS_SSQQ), (const float*)(ws + WS_ROPEC), (const float*)(ws + WS_ROPES)};
          pg8::gemm_phase<pg8::EpiQ, pg8::TileSched, true, true>(F.lds, QL, S, E); }
        DUPL(P2DUP, 2) { pg8::EpiKV E{(bf16*)(ws + WS_KN), (bf16*)(ws + WS_V), (const float*)(ws + WS_SSQKV)};
          if (G == 256) { pg8::KvSched S; S.init(ws + WS_CKVR, ws + WS_WKV, KVL, 64, 8, G, bx); pg8::gemm_phase<pg8::EpiKV, pg8::KvSched, true, true>(F.lds, KVL, S, E); }
          else { pg8::TileSched S; S.init(ws + WS_CKVR, ws + WS_WKV, KVL, 64, 8, G, bx); pg8::gemm_phase<pg8::EpiKV, pg8::TileSched, true, true>(F.lds, KVL, S, E); } }
        DUPL(P2DUP, 3) {
            int lane_ = F.lane; asm volatile("" : "+v"(lane_));
            int trow, tcol; skinny_coord(F.tid, trow, tcol);
            const bf16* CQs = (const bf16*)(ws + WS_CQ); const bf16* WQs = (const bf16*)(ws + WS_WQ); bf16* QAs = (bf16*)(ws + WS_QA); const float* SQ = (const float*)(ws + WS_SSQQ);
            for (int u = F.vcu; u < 8 * 40 + 64; u += G) {
                if (u < 8 * 40) {
                    const int rt = u / 40, ci = u % 40, r0 = ROW_S + 32 * rt, row = r0 + trow;
                    float ss = 0.f;
#pragma unroll
                    for (int i = 0; i < 12; ++i) ss += SQ[(size_t)row * 12 + i];
                    const float rstd = __builtin_amdgcn_rsqf(ss * (1.0f / QL) + EPS);
                    if (ci < 32) { float v0, v1; skinny_partial<768>(F, CQs, QL, WQs, QL, r0, 32 * ci, lane_, v0, v1);
                        const int col = 32 * ci + tcol, h = col >> 7, d = col & 127;
                        *(unsigned*)(QAs + (size_t)row * 1536 + h * 192 + d) = cvt_pk_bf16(v0 * rstd, v1 * rstd); }
                    else { const int h = ci - 32, c1 = 1024 + 256 * (h >> 2) + 32 * (h & 3); float a0, a1, b0, b1;
                        skinny_partial<768>(F, CQs, QL, WQs, QL, r0, c1, lane_, a0, a1); skinny_partial<768>(F, CQs, QL, WQs, QL, r0, c1 + 128, lane_, b0, b1);
                        const int pi = rope_idx_of_row(row); const float* rc = (const float*)(ws + WS_ROPEC) + pi * 32 + tcol; const float* rs = (const float*)(ws + WS_ROPES) + pi * 32 + tcol;
                        a0 *= rstd; a1 *= rstd; b0 *= rstd; b1 *= rstd;
                        *(unsigned*)(QAs + (size_t)row * 1536 + h * 192 + 128 + tcol) = cvt_pk_bf16(a0 * rc[0] - b0 * rs[0], a1 * rc[1] - b1 * rs[1]);
                        *(unsigned*)(QAs + (size_t)row * 1536 + h * 192 + 160 + tcol) = cvt_pk_bf16(a0 * rs[0] + b0 * rc[0], a1 * rs[1] + b1 * rc[1]); }
                } else {
                    const int ci = u - 8 * 40, row = ROW_M + trow; float v0, v1;
                    skinny_partial<512>(F, (const bf16*)(ws + WS_CKVR), KVL, (const bf16*)(ws + WS_WKV), KVL, ROW_M, 32 * ci, lane_, v0, v1);
                    const float* SK = (const float*)(ws + WS_SSQKV) + (size_t)row * 8; const float ss = ((SK[0] + SK[1]) + (SK[2] + SK[3])) + ((SK[4] + SK[5]) + (SK[6] + SK[7]));
                    const float rstd = __builtin_amdgcn_rsqf(ss * (1.0f / KVL) + EPS); const int col = 32 * ci + tcol;
                    bf16* dst = col < 1024 ? (bf16*)(ws + WS_KN) + (size_t)row * D + col : (bf16*)(ws + WS_V) + (size_t)row * D + (col - 1024);
                    *(unsigned*)dst = cvt_pk_bf16(v0 * rstd, v1 * rstd); }
            }
            __syncthreads();
        }
        DUPL(P2DUP, 4) thin_ckv_conv(F, args);
    }
    SEAM(2);
    if (IN(3)) {
        const PAttnParams PA{(const bf16*)(ws + WS_QA), (const bf16*)(ws + WS_KN), (const bf16*)(ws + WS_KPE), (const bf16*)(ws + WS_V), (bf16*)(ws + WS_O)};
        const SAttnParams SA{IN_F(I_CCKV), IN_F(I_CKPE), (const int*)args.in[I_PT], (const bf16*)(ws + WS_QA), (const bf16*)(ws + WS_WUKS), (const bf16*)(ws + WS_CKVNS), (const bf16*)(ws + WS_KPE),
                             (float*)(ws + WS_OPART), (float*)(ws + WS_ML)};
#ifndef SFIRST_ALL
        const bool sfirst = (F.vcu & 1) == 0;
#else
        const bool sfirst = true;
#endif
#ifndef P3_MASK
#define P3_MASK 7
#endif
#ifdef P3_SPECIAL
        if ((F.vcu & 1) == 0) { for (int u = F.vcu; u < F.vcu + 2; ++u) sattn_unit(F, SA, u / NSPLIT, u % NSPLIT); }
        else { for (int u = F.vcu - 1; u <= F.vcu; ++u) { const int bh = u >> 2; pattn_unit(F, PA, bh >> 3, bh & 7, u & 3); }
               for (int u = F.vcu - 1; u <= F.vcu; ++u) rg_unit<1>(F, RGP, u >> 5, (u >> 2) & 7, u & 3);
               if (F.vcu < 64) { const int u = F.vcu >> 1; rg_unit<2>(F, RGP, u >> 3, u & 7, 0); } }
#else
#pragma nounroll
        for (int ph = 0; ph < 2; ++ph) {
            if ((ph == 0) == sfirst) { if (P3_MASK & 1) for (int r3 = 0; r3 < 1 + (P3DUP & 1); ++r3) for (int u = F.vcu; u < DB * NSPLIT; u += G) sattn_unit(F, SA, u / NSPLIT, u % NSPLIT); }
            else { if (P3_MASK & 2) for (int r3 = 0; r3 < 1 + ((P3DUP >> 1) & 1); ++r3) for (int u = F.vcu; u < 256; u += G) { const int bh = u >> 2; pattn_unit(F, PA, bh >> 3, bh & 7, u & 3); } }
        }
        if (P3_MASK & 4) for (int r3 = 0; r3 < 1 + ((P3DUP >> 2) & 1); ++r3) for (int u = F.vcu; u < 256; u += G) rg_unit<1>(F, RGP, u >> 5, (u >> 2) & 7, u & 3);
#endif
    }
    SEAM(3);
    if (IN(4)) REP(4) {
        const SCombParams SC{(const float*)(ws + WS_OPART), (const float*)(ws + WS_ML), IN_F(I_WUV), (bf16*)(ws + WS_O)};
        for (int u = F.vcu; u < DB * NH; u += G) scomb_unit(F, SC, u >> 3, u & 7);
    }
    SEAM(4);
    if (IN(5)) REP(5) {
        DUPL(P5DUP, 0) { pg8::TileSched S; S.init(ws + WS_HRG, ws + WS_WBRR, D, 64, 4, G, bx); pg8::EpiZ<0> E{(bf16*)(ws + WS_MIX), (const bf16*)(ws + WS_G)};
          pg8::gemm_phase<pg8::EpiZ<0>, pg8::TileSched, true, true>(F.lds, D, S, E); }
        { pg8::TileSched S; S.init(ws + WS_O, ws + WS_WBRM, D, 64, 4, G, bx); pg8::EpiZ<1> E{(bf16*)(ws + WS_MIX), (const bf16*)(ws + WS_G)};
          pg8::gemm_phase<pg8::EpiZ<1>, pg8::TileSched, true, true>(F.lds, D, S, E); }
        DUPL(P5DUP, 2) {
            int lane_ = F.lane; asm volatile("" : "+v"(lane_));
            int trow, tcol; skinny_coord(F.tid, trow, tcol);
            for (int u = F.vcu; u < 8 * 32; u += G) { const int r0 = ROW_S + 32 * (u >> 5), c0 = 32 * (u & 31), row = r0 + trow, col = c0 + tcol; float a0, a1, b0, b1;
                skinny_partial<1024>(F, (const bf16*)(ws + WS_HRG), D, (const bf16*)(ws + WS_WBRR), D, r0, c0, lane_, a0, a1);
                skinny_partial<1024>(F, (const bf16*)(ws + WS_O), D, (const bf16*)(ws + WS_WBRM), D, r0, c0, lane_, b0, b1);
                const unsigned gr = *(const unsigned*)((const bf16*)(ws + WS_G) + (size_t)row * 2048 + col), gm = *(const unsigned*)((const bf16*)(ws + WS_G) + (size_t)row * 2048 + D + col);
                *(unsigned*)((bf16*)(ws + WS_MIX) + (size_t)row * D + col) = cvt_pk_bf16(bflo(gr) * a0 + bflo(gm) * b0, bfhi(gr) * a1 + bfhi(gm) * b1); }
            __syncthreads();
        }
    }
    SEAM(5);
    if (IN(6)) REP(6) {
        pg8::TileSched S; S.init(ws + WS_MIX, ws + WS_WO, D, 64, 4, G, bx); pg8::EpiRes E{(bf16*)(ws + WS_PRE), (const bf16*)(ws + WS_H), nullptr};
        pg8::gemm_phase<pg8::EpiRes, pg8::TileSched, true, true>(F.lds, D, S, E);
        {   int lane_ = F.lane; asm volatile("" : "+v"(lane_));
            int trow, tcol; skinny_coord(F.tid, trow, tcol);
            for (int u = F.vcu; u < 8 * 32; u += G) { const int r0 = ROW_S + 32 * (u >> 5), c0 = 32 * (u & 31), row = r0 + trow, col = c0 + tcol; float a0, a1;
                skinny_partial<1024>(F, (const bf16*)(ws + WS_MIX), D, (const bf16*)(ws + WS_WO), D, r0, c0, lane_, a0, a1);
                const unsigned hv = *(const unsigned*)((const bf16*)(ws + WS_H) + (size_t)row * D + col);
                *(unsigned*)((bf16*)(ws + WS_PRE) + (size_t)row * D + col) = cvt_pk_bf16(DN_ALPHA * bflo(hv) + a0, DN_ALPHA * bfhi(hv) + a1); }
            __syncthreads();
        }
    }
    SEAM(6);
    if (IN(7)) REP(7) {
        const int gw = F.vcu * NWAVES + F.wave, NGW = G * NWAVES;
        for (int row = gw; row < ROW_M; row += NGW) ln_row<true>((const bf16*)(ws + WS_PRE) + (size_t)row * D, IN_F(I_LN1G), IN_F(I_LN1B), (bf16*)(ws + WS_X1) + (size_t)row * D, nullptr, F.lane);
    }
    SEAM(7);
    if (IN(8)) REP(8) {
        pg8::TileSched S; S.init(ws + WS_X1, ws + WS_WUP, D, 64, 16, G, bx); pg8::EpiUp E{(bf16*)(ws + WS_U), IN_F(I_BUP)};
        DUPL(P8DUP, 0) pg8::gemm_phase<pg8::EpiUp, pg8::TileSched, true, true>(F.lds, D, S, E);
        {   int lane_ = F.lane; asm volatile("" : "+v"(lane_));
            int trow, tcol; skinny_coord(F.tid, trow, tcol);
            for (int u = F.vcu; u < 8 * 128; u += G) { const int r0 = ROW_S + 32 * (u >> 7), c0 = 32 * (u & 127), row = r0 + trow, col = c0 + tcol; float a0, a1;
                skinny_partial<1024>(F, (const bf16*)(ws + WS_X1), D, (const bf16*)(ws + WS_WUP), D, r0, c0, lane_, a0, a1);
                a0 = fmaxf(a0 + IN_F(I_BUP)[col], 0.f); a1 = fmaxf(a1 + IN_F(I_BUP)[col + 1], 0.f);
                *(unsigned*)((bf16*)(ws + WS_U) + (size_t)row * DFF + col) = cvt_pk_bf16(a0 * a0, a1 * a1); }
            __syncthreads();
        }
    }
    SEAM(8);
    if (IN(9)) REP(9) {
        pg8::TileSched S; S.init(ws + WS_U, ws + WS_WDN, DFF, 64, 4, G, bx); pg8::EpiRes E{(bf16*)(ws + WS_PRE), (const bf16*)(ws + WS_X1), IN_F(I_BDN)};
        pg8::gemm_phase<pg8::EpiRes, pg8::TileSched, true, true>(F.lds, DFF, S, E);
        {   int lane_ = F.lane; asm volatile("" : "+v"(lane_));
            int trow, tcol; skinny_coord(F.tid, trow, tcol);
            for (int u = F.vcu; u < 8 * 32; u += G) { const int r0 = ROW_S + 32 * (u >> 5), c0 = 32 * (u & 31), row = r0 + trow, col = c0 + tcol; float a0, a1;
                skinny_partial<4096>(F, (const bf16*)(ws + WS_U), DFF, (const bf16*)(ws + WS_WDN), DFF, r0, c0, lane_, a0, a1);
                const unsigned xv = *(const unsigned*)((const bf16*)(ws + WS_X1) + (size_t)row * D + col);
                *(unsigned*)((bf16*)(ws + WS_PRE) + (size_t)row * D + col) = cvt_pk_bf16(DN_ALPHA * bflo(xv) + a0 + IN_F(I_BDN)[col], DN_ALPHA * bfhi(xv) + a1 + IN_F(I_BDN)[col + 1]); }
            __syncthreads();
        }
    }
    SEAM(9);
    if (IN(10)) REP(10) {
        const int gw = F.vcu * NWAVES + F.wave, NGW = G * NWAVES;
        for (int row = gw; row < ROW_M; row += NGW) { float* o = row < ROW_S ? F.out + O_YP + (size_t)row * D : F.out + O_YS + (size_t)(row - ROW_S) * D;
            ln_row<true>((const bf16*)(ws + WS_PRE) + (size_t)row * D, IN_F(I_LN2G), IN_F(I_LN2B), nullptr, o, F.lane); }
    }
#ifdef DBG_DUMP_OFF
    if (lo == 99) {
#ifdef DBG_DUMP_F32
        const float* srcf = (const float*)(ws + (size_t)(DBG_DUMP_OFF));
        for (size_t i = (size_t)F.vcu * NTHR + F.tid; i < (size_t)(DBG_DUMP_F32) / 4; i += (size_t)G * NTHR) *(f32x4*)(F.out + i * 4) = *(const f32x4*)(srcf + i * 4);
#else
#ifndef DBG_DUMP_N
#define DBG_DUMP_N ((size_t)ROW_M * D)
#endif
        const bf16* src = (const bf16*)(ws + (size_t)(DBG_DUMP_OFF));
        for (size_t i = (size_t)F.vcu * NTHR + F.tid; i < (size_t)(DBG_DUMP_N) / 8; i += (size_t)G * NTHR) { f32x4 v0, v1; pg8::unpack8(*(const u32x4*)(src + i * 8), v0, v1); *(f32x4*)(F.out + i * 8) = v0; *(f32x4*)(F.out + i * 8 + 4) = v1; }
#endif
    }
#endif
#undef IN
#undef SEAM
}

extern "C" void kernel_launch(void* const* d_in, const int* in_sizes, int n_in, void* d_out, int out_size, void* d_ws, size_t ws_size, hipStream_t stream) {
    static int grid = 0;
    if (grid == 0) {
        if (n_in != 35 || out_size != (int)O_END || ws_size < WS_END) { fprintf(stderr, "kernel_launch: unexpected shapes (n_in %d, out %d, ws %zu, need %zu)\n", n_in, out_size, ws_size, (size_t)WS_END); grid = -1; return; }
        int dev = 0, cus = 0, per_cu = 0;
        if (hipGetDevice(&dev) != hipSuccess || hipDeviceGetAttribute(&cus, hipDeviceAttributeMultiprocessorCount, dev) != hipSuccess) { grid = -1; return; }
        if (hipFuncSetAttribute((const void*)hawk_fwd, hipFuncAttributeMaxDynamicSharedMemorySize, LDS_BYTES) != hipSuccess) { fprintf(stderr, "kernel_launch: hipFuncSetAttribute failed\n"); grid = -1; return; }
        if (hipOccupancyMaxActiveBlocksPerMultiprocessor(&per_cu, (const void*)hawk_fwd, NTHR, LDS_BYTES) != hipSuccess || per_cu < 1) fprintf(stderr, "kernel_launch: occupancy query reports %d\n", per_cu);
        (void)hipGetLastError();
        grid = cus;
    }
    if (grid < 0) return;
    if (hipMemsetAsync((char*)d_ws + WS_CTL, 0, CTL_BYTES, stream) != hipSuccess) return;
    Args a{};
    for (int i = 0; i < 35; ++i) a.in[i] = d_in[i];
    a.out = (float*)d_out; a.ws = (unsigned char*)d_ws;
#if MK_PER_PHASE
#ifndef DBG_LAST_PHASE
#define DBG_LAST_PHASE (NPHASES - 1)
#endif
    if (DBG_LAST_PHASE < NPHASES - 1) (void)hipMemsetAsync(d_out, 0, (size_t)out_size * 4, stream);
    for (int p = 0; p <= DBG_LAST_PHASE; ++p) { a.ph_lo = p; a.ph_hi = p + 1; hipLaunchKernelGGL(hawk_fwd, dim3(grid), dim3(NTHR), LDS_BYTES, stream, a); }
#ifdef DBG_DUMP_OFF
    a.ph_lo = 99; a.ph_hi = 100; hipLaunchKernelGGL(hawk_fwd, dim3(grid), dim3(NTHR), LDS_BYTES, stream, a);
#endif
#else
    a.ph_lo = 0; a.ph_hi = NPHASES;
    hipLaunchKernelGGL(hawk_fwd, dim3(grid), dim3(NTHR), LDS_BYTES, stream, a);
#endif
}
```
